# Optimizing an MI355X kernel written in HIP

```python
import math
import jax, jax.numpy as jnp
from jax import lax
import numpy as np

D_MODEL = 1024
BATCH = 8
SEQ = 2048
DEPTH = 4

CHUNK = 64
D_MIX = D_MODEL
D_BRANCH = D_MIX // 4
HG_HEADS = 4
HG_DIM = D_BRANCH // HG_HEADS
ML_HEADS = 4
ML_DIM = D_BRANCH // ML_HEADS
LRU_BLOCKS = 4
LRU_BLOCK = D_BRANCH // LRU_BLOCKS
CONV_W = 4
LRU_C = 8.0
S5_GROUP = 16
S5_GROUPS = D_BRANCH // S5_GROUP
S5_STATE = 64
DEEPNORM_ALPHA = (2.0 * DEPTH) ** 0.25
DEEPNORM_BETA = (8.0 * DEPTH) ** -0.25
LN_EPS = 1e-5
RMS_EPS = 1e-6
SPLIT_SIZES = (D_BRANCH, D_BRANCH, D_BRANCH, D_BRANCH,
               D_BRANCH, D_BRANCH, D_BRANCH, ML_HEADS, ML_HEADS, D_BRANCH,
               D_BRANCH, D_BRANCH,
               D_BRANCH, D_BRANCH)
D_IN = sum(SPLIT_SIZES)

kernel_name = "hybrid_hgrn2_mlstm_rglru_s5_deepnorm"


def _f32(a):
    return a.astype(jnp.float32)


def _layernorm(x, g, b):
    mu = jnp.mean(x, axis=-1, keepdims=True)
    var = jnp.mean(jnp.square(x - mu), axis=-1, keepdims=True)
    return (x - mu) * lax.rsqrt(var + LN_EPS) * _f32(g) + _f32(b)


def _head_rms(x, g, n_heads):
    bsz, s, w = x.shape
    xr = x.reshape(bsz, s, n_heads, w // n_heads)
    xr = xr * lax.rsqrt(jnp.mean(jnp.square(xr), axis=-1, keepdims=True) + RMS_EPS)
    return xr.reshape(bsz, s, w) * _f32(g)


def _chunk_heads(t, n_heads):
    bsz, s, w = t.shape
    return t.reshape(bsz, s // CHUNK, CHUNK, n_heads, w // n_heads).transpose(1, 0, 3, 2, 4)


def _chunk_gates(t):
    bsz, s, h = t.shape
    return t.reshape(bsz, s // CHUNK, CHUNK, h).transpose(1, 0, 3, 2)


def _unchunk(t):
    nc, bsz, h, c, d = t.shape
    return t.transpose(1, 0, 3, 2, 4).reshape(bsz, nc * c, h * d)


def _hgrn2(q_pre, f_pre, v, lb, norm_g):
    bsz = q_pre.shape[0]
    q = jax.nn.silu(q_pre)
    logf = jnp.logaddexp(jnp.log(lb), jnp.log1p(-lb) + jax.nn.log_sigmoid(f_pre))
    k = (1.0 - lb) * jax.nn.sigmoid(-f_pre)
    tri = jnp.tril(jnp.ones((CHUNK, CHUNK), dtype=bool))

    def step(state, inp):
        qc, kc, vc, gc = inp
        b = jnp.cumsum(gc, axis=2)
        diff = b[:, :, :, None, :] - b[:, :, None, :, :]
        decay = jnp.exp(jnp.where(tri[:, :, None], diff, -jnp.inf))
        attn = jnp.sum(qc[:, :, :, None, :] * kc[:, :, None, :, :] * decay, axis=-1)
        out = (jnp.einsum('bhts,bhse->bhte', attn, vc)
               + jnp.einsum('bhtd,bhde->bhte', qc * jnp.exp(b), state))
        b_last = b[:, :, -1:, :]
        state = (jnp.exp(b_last[:, :, 0, :])[..., None] * state
                 + jnp.einsum('bhsd,bhse->bhde', kc * jnp.exp(b_last - b), vc))
        return state, out

    s0 = jnp.zeros((bsz, HG_HEADS, HG_DIM, HG_DIM), jnp.float32)
    xs = (_chunk_heads(q, HG_HEADS), _chunk_heads(k, HG_HEADS),
          _chunk_heads(v, HG_HEADS), _chunk_heads(logf, HG_HEADS))
    _, o = lax.scan(step, s0, xs)
    return _head_rms(_unchunk(o), norm_g, HG_HEADS)


def _mlstm(q, k, v, ig_pre, fg_pre, norm_g):
    bsz = q.shape[0]
    k = k * (ML_DIM ** -0.5)
    logf = jax.nn.log_sigmoid(fg_pre)
    tri = jnp.tril(jnp.ones((CHUNK, CHUNK), dtype=bool))

    def step(carry, inp):
        cmat, nvec, m = carry
        qc, kc, vc, ig, lf = inp
        b = jnp.cumsum(lf, axis=-1)
        dmat = jnp.where(tri, b[..., :, None] - b[..., None, :] + ig[..., None, :], -jnp.inf)
        inter = b + m[..., None]
        m_t = jnp.maximum(inter, jnp.max(dmat, axis=-1))
        w = jnp.exp(dmat - m_t[..., None]) * jnp.einsum('bhtd,bhsd->bhts', qc, kc)
        w_inter = jnp.exp(inter - m_t)
        num = (w_inter[..., None] * jnp.einsum('bhtd,bhde->bhte', qc, cmat)
               + jnp.einsum('bhts,bhse->bhte', w, vc))
        den = w_inter * jnp.einsum('bhtd,bhd->bht', qc, nvec) + jnp.sum(w, axis=-1)
        h = num / jnp.maximum(jnp.abs(den), jnp.exp(-m_t))[..., None]
        b_last = b[..., -1]
        log_s = b_last[..., None] - b + ig
        m_new = jnp.maximum(b_last + m, jnp.max(log_s, axis=-1))
        ws = jnp.exp(log_s - m_new[..., None])
        dec = jnp.exp(b_last + m - m_new)
        cmat = dec[..., None, None] * cmat + jnp.einsum('bhs,bhsd,bhse->bhde', ws, kc, vc)
        nvec = dec[..., None] * nvec + jnp.einsum('bhs,bhsd->bhd', ws, kc)
        return (cmat, nvec, m_new), h

    c0 = (jnp.zeros((bsz, ML_HEADS, ML_DIM, ML_DIM), jnp.float32),
          jnp.zeros((bsz, ML_HEADS, ML_DIM), jnp.float32),
          jnp.zeros((bsz, ML_HEADS), jnp.float32))
    xs = (_chunk_heads(q, ML_HEADS), _chunk_heads(k, ML_HEADS), _chunk_heads(v, ML_HEADS),
          _chunk_gates(ig_pre), _chunk_gates(logf))
    _, h = lax.scan(step, c0, xs)
    return _head_rms(_unchunk(h), norm_g, ML_HEADS)


def _linear_scan_combine(e1, e2):
    a1, b1 = e1
    a2, b2 = e2
    return a1 * a2, a2 * b1 + b2


def _rglru(x_in, conv_w, conv_b, w_a, b_a, w_x, b_x, lam):
    bsz, s, w = x_in.shape
    rhs = _f32(conv_w).reshape(CONV_W, 1, w)
    xc = lax.conv_general_dilated(x_in, rhs, window_strides=(1,), padding=[(CONV_W - 1, 0)],
                                  dimension_numbers=('NWC', 'WIO', 'NWC'),
                                  feature_group_count=w) + _f32(conv_b)
    xb = xc.reshape(bsz, s, LRU_BLOCKS, LRU_BLOCK)
    r = jax.nn.sigmoid(jnp.einsum('bsnd,nde->bsne', xb, _f32(w_a)).reshape(bsz, s, w) + _f32(b_a))
    i = jax.nn.sigmoid(jnp.einsum('bsnd,nde->bsne', xb, _f32(w_x)).reshape(bsz, s, w) + _f32(b_x))
    log_a = LRU_C * r * jax.nn.log_sigmoid(_f32(lam))
    a = jnp.exp(log_a)
    bvals = jnp.sqrt(-jnp.expm1(2.0 * log_a)) * (i * xc)
    _, h = lax.associative_scan(_linear_scan_combine, (a, bvals), axis=1)
    return h


def _complex_scan_combine(e1, e2):
    ar1, ai1, br1, bi1 = e1
    ar2, ai2, br2, bi2 = e2
    return (ar2 * ar1 - ai2 * ai1, ar2 * ai1 + ai2 * ar1,
            ar2 * br1 - ai2 * bi1 + br2, ar2 * bi1 + ai2 * br1 + bi2)


def _s5(u, a_re, a_im, log_dt, b_re, b_im, c_re, c_im, d_skip, w_glu, b_glu):
    bsz, s, w = u.shape
    a_re, a_im, b_re, b_im = _f32(a_re), _f32(a_im), _f32(b_re), _f32(b_im)
    dt = jnp.exp(_f32(log_dt))[:, None]
    mag = jnp.exp(dt * a_re)
    ab_re, ab_im = mag * jnp.cos(dt * a_im), mag * jnp.sin(dt * a_im)
    den = a_re * a_re + a_im * a_im
    xr, xi = ab_re - 1.0, ab_im
    z_re = (xr * a_re + xi * a_im) / den
    z_im = (xi * a_re - xr * a_im) / den
    bb_re = z_re[..., None] * b_re - z_im[..., None] * b_im
    bb_im = z_re[..., None] * b_im + z_im[..., None] * b_re
    ug = u.reshape(bsz, s, S5_GROUPS, S5_GROUP)
    bu_re = jnp.einsum('bsgh,gph->bsgp', ug, bb_re)
    bu_im = jnp.einsum('bsgh,gph->bsgp', ug, bb_im)
    ar = jnp.broadcast_to(ab_re, bu_re.shape)
    ai = jnp.broadcast_to(ab_im, bu_re.shape)
    _, _, st_re, st_im = lax.associative_scan(_complex_scan_combine, (ar, ai, bu_re, bu_im), axis=1)
    y = (jnp.einsum('gnp,bsgp->bsgn', _f32(c_re), st_re)
         - jnp.einsum('gnp,bsgp->bsgn', _f32(c_im), st_im)).reshape(bsz, s, w)
    y = y + _f32(d_skip) * u
    z = jax.nn.gelu(y)
    return z * jax.nn.sigmoid(z @ _f32(w_glu) + _f32(b_glu))


def setup_inputs(seed: int = 0) -> dict:
    key = jax.random.key(seed)
    ks = jax.random.split(key, 32)
    nrm = lambda k, shape, scale: jax.random.normal(k, shape, jnp.float32) * scale
    db, L = D_BRANCH, DEPTH
    a_c = jax.random.uniform(ks[10], (L, db), jnp.float32, 0.9, 0.999)
    sig = a_c ** (1.0 / LRU_C)
    lru_lambda = jnp.log(sig) - jnp.log1p(-sig)
    n_idx = jnp.arange(S5_STATE, dtype=jnp.float32)
    return {
        "x": nrm(ks[0], (BATCH, SEQ, D_MODEL), 1.0),
        "w_in": nrm(ks[1], (L, D_MODEL, D_IN), D_MODEL ** -0.5),
        "b_in": nrm(ks[2], (L, D_IN), 0.01),
        "hgrn_lb_logits": nrm(ks[3], (L, db), 0.1),
        "hgrn_norm_g": 1.0 + nrm(ks[4], (L, db), 0.01),
        "mlstm_f_bias": jnp.linspace(3.0, 6.0, ML_HEADS, dtype=jnp.float32)[None, :] + nrm(ks[5], (L, ML_HEADS), 0.01),
        "mlstm_norm_g": 1.0 + nrm(ks[6], (L, db), 0.01),
        "lru_conv_w": nrm(ks[7], (L, CONV_W, db), CONV_W ** -0.5),
        "lru_conv_b": nrm(ks[8], (L, db), 0.01),
        "lru_w_a": nrm(ks[9], (L, LRU_BLOCKS, LRU_BLOCK, LRU_BLOCK), LRU_BLOCK ** -0.5),
        "lru_b_a": nrm(ks[11], (L, db), 0.01),
        "lru_w_x": nrm(ks[12], (L, LRU_BLOCKS, LRU_BLOCK, LRU_BLOCK), LRU_BLOCK ** -0.5),
        "lru_b_x": nrm(ks[13], (L, db), 0.01),
        "lru_lambda": lru_lambda,
        "s5_a_re": -0.5 + nrm(ks[14], (L, S5_GROUPS, S5_STATE), 0.01),
        "s5_a_im": math.pi * n_idx[None, None, :] + nrm(ks[15], (L, S5_GROUPS, S5_STATE), 0.01),
        "s5_log_dt": jax.random.uniform(ks[16], (L, S5_GROUPS), jnp.float32, math.log(1e-3), math.log(1e-1)),
        "s5_b_re": nrm(ks[17], (L, S5_GROUPS, S5_STATE, S5_GROUP), (2.0 * S5_GROUP) ** -0.5),
        "s5_b_im": nrm(ks[18], (L, S5_GROUPS, S5_STATE, S5_GROUP), (2.0 * S5_GROUP) ** -0.5),
        "s5_c_re": nrm(ks[19], (L, S5_GROUPS, S5_GROUP, S5_STATE), (2.0 * S5_STATE) ** -0.5),
        "s5_c_im": nrm(ks[20], (L, S5_GROUPS, S5_GROUP, S5_STATE), (2.0 * S5_STATE) ** -0.5),
        "s5_d": nrm(ks[21], (L, db), 1.0),
        "s5_w_glu": nrm(ks[22], (L, db, db), db ** -0.5),
        "s5_b_glu": nrm(ks[23], (L, db), 0.01),
        "w_out": nrm(ks[24], (L, D_MIX, D_MODEL), D_MIX ** -0.5 * DEEPNORM_BETA),
        "b_out": nrm(ks[25], (L, D_MODEL), 0.01),
        "ln_g": 1.0 + nrm(ks[26], (L, D_MODEL), 0.01),
        "ln_b": nrm(ks[27], (L, D_MODEL), 0.01),
    }


def reference(x, w_in, b_in, hgrn_lb_logits, hgrn_norm_g, mlstm_f_bias, mlstm_norm_g,
              lru_conv_w, lru_conv_b, lru_w_a, lru_b_a, lru_w_x, lru_b_x, lru_lambda,
              s5_a_re, s5_a_im, s5_log_dt, s5_b_re, s5_b_im, s5_c_re, s5_c_im, s5_d,
              s5_w_glu, s5_b_glu, w_out, b_out, ln_g, ln_b):
    lbs = jnp.cumsum(jax.nn.softmax(_f32(hgrn_lb_logits), axis=0), axis=0)
    lbs = lbs - lbs[0:1]
    split_idx = [sum(SPLIT_SIZES[:i + 1]) for i in range(len(SPLIT_SIZES) - 1)]
    h = _f32(x)
    for l in range(DEPTH):
        proj = h @ _f32(w_in[l]) + _f32(b_in[l])
        (a_q, a_f, a_i, a_g, b_q, b_k, b_v, b_ig, b_fg, b_g,
         c_x, c_g, d_u, d_g) = jnp.split(proj, split_idx, axis=-1)
        y_a = _hgrn2(a_q, a_f, a_i, lbs[l], hgrn_norm_g[l])
        y_b = _mlstm(b_q, b_k, b_v, b_ig, b_fg + _f32(mlstm_f_bias[l]), mlstm_norm_g[l])
        y_c = _rglru(c_x, lru_conv_w[l], lru_conv_b[l], lru_w_a[l], lru_b_a[l],
                     lru_w_x[l], lru_b_x[l], lru_lambda[l])
        y_d = _s5(d_u, s5_a_re[l], s5_a_im[l], s5_log_dt[l], s5_b_re[l], s5_b_im[l],
                  s5_c_re[l], s5_c_im[l], s5_d[l], s5_w_glu[l], s5_b_glu[l])
        mixed = jnp.concatenate([y_a * jax.nn.silu(a_g), y_b * jax.nn.silu(b_g),
                                 y_c * jax.nn.silu(c_g), y_d * jax.nn.silu(d_g)], axis=-1)
        y = mixed @ _f32(w_out[l]) + _f32(b_out[l])
        h = _layernorm(DEEPNORM_ALPHA * h + y, ln_g[l], ln_b[l])
    return h.astype(x.dtype)
```

```cpp
#include <hip/hip_runtime.h>
#include <hip/hip_cooperative_groups.h>
#include <stdint.h>
#include <stdio.h>
namespace cg = cooperative_groups;

#ifndef MEGA
#define MEGA 0
#endif

typedef unsigned short bfu;
using bf16x8 = __attribute__((ext_vector_type(8))) short;
using f32x4  = __attribute__((ext_vector_type(4))) float;
#define DI __device__ __forceinline__

constexpr int BATCH = 8, SEQ = 2048, DM = 1024, DEPTH = 4, NTOK = BATCH * SEQ, NCH = SEQ / 64;
constexpr int DIN = 3080, PS = 3200;
constexpr int COL_AQ = 0, COL_AF = 256, COL_AI = 512, COL_AG = 768;
constexpr int COL_BQ = 1024, COL_BK = 1280, COL_BV = 1536, COL_BIG = 1792, COL_BFG = 1796, COL_BG = 1800;
constexpr int COL_CX = 2056, COL_CG = 2312, COL_DU = 2568, COL_DG = 2824;
constexpr float DN_ALPHA = 1.681792830507429f;
constexpr int SMEM_BYTES = 56 * 1024;
constexpr int CNT_LN = 0, CNT_GLU = 4 * 128, CNT_TOTAL = 4 * 128 + 4 * 256;

struct Params {
  const float *x, *w_in, *b_in, *lb_logits, *hg_g, *ml_fb, *ml_g, *conv_w, *conv_b, *w_a, *b_a, *w_x, *b_x, *lam,
      *a_re, *a_im, *log_dt, *sb_re, *sb_im, *c_re, *c_im, *s5_d, *w_glu, *b_glu, *w_out, *b_out, *ln_g, *ln_b;
  float* out;
  bfu *wt_in, *wt_out, *wt_a, *wt_x, *wt_glu, *bt_bu, *bt_y, *hb, *proj, *mixed, *zbuf;
  float *abar, *abar64, *lbs, *hg_state, *hg_decay, *ml_state, *ml_n, *ml_decay, *lru_h, *lru_a, *s5_state;
  unsigned* cnt;
};

DI bfu f2bf(float x) { unsigned u = __float_as_uint(x); u += 0x7fffu + ((u >> 16) & 1u); return (bfu)(u >> 16); }
DI float bf2f(bfu h) { return __uint_as_float(((unsigned)h) << 16); }
DI unsigned pack2(float a, float b) { return (unsigned)f2bf(a) | ((unsigned)f2bf(b) << 16); }
DI float sigmoid_(float x) { return 1.f / (1.f + expf(-x)); }
DI float silu_(float x) { return x / (1.f + expf(-x)); }
DI float logsig_(float x) { return fminf(x, 0.f) - log1pf(expf(-fabsf(x))); }
DI float gelu_tanh_(float x) {
  float u = 0.7978845608028654f * (x + 0.044715f * x * x * x);
  float th = 1.f - 2.f / (expf(2.f * u) + 1.f);
  return 0.5f * x * (1.f + th);
}

template <int NT, int KS>
DI void wave_mma(f32x4 (&acc)[NT], const bfu* A, int lda, const bfu* Bt, int ldb, int lane) {
  const int r = lane & 15, q = lane >> 4;
#pragma unroll
  for (int ks = 0; ks < KS; ++ks) {
    bf16x8 a = *(const bf16x8*)(A + r * lda + ks * 32 + q * 8);
#pragma unroll
    for (int nt = 0; nt < NT; ++nt) {
      bf16x8 b = *(const bf16x8*)(Bt + (nt * 16 + r) * ldb + ks * 32 + q * 8);
      acc[nt] = __builtin_amdgcn_mfma_f32_16x16x32_bf16(a, b, acc[nt], 0, 0, 0);
    }
  }
}

DI float group16_sum(float v) {
  v += __shfl_xor(v, 1); v += __shfl_xor(v, 2); v += __shfl_xor(v, 4); v += __shfl_xor(v, 8);
  return v;
}
DI float wave_sum(float v) {
  v += __shfl_xor(v, 1); v += __shfl_xor(v, 2); v += __shfl_xor(v, 4); v += __shfl_xor(v, 8);
  v += __shfl_xor(v, 16); v += __shfl_xor(v, 32);
  return v;
}

DI bool last_arriver(unsigned* ctr, unsigned total, unsigned* s_flag) {
  __threadfence();
  __syncthreads();
  if (threadIdx.x == 0) { unsigned old = atomicAdd(ctr, 1u); *s_flag = (old == total - 1u) ? 1u : 0u; }
  __syncthreads();
  bool last = (*s_flag != 0u);
  if (last) __threadfence();
  return last;
}

DI void transpose_tile(const float* src, int sld, int cv, bfu* dst, int dld, float* tile) {
  const int tid = threadIdx.x;
  __syncthreads();
  for (int i = tid; i < 4096; i += 256) {
    int r = i >> 6, c = i & 63;
    tile[r * 65 + c] = (c < cv) ? src[(size_t)r * sld + c] : 0.f;
  }
  __syncthreads();
  for (int i = tid; i < 4096; i += 256) {
    int n = i >> 6, k = i & 63;
    dst[(size_t)n * dld + k] = f2bf(tile[k * 65 + n]);
  }
}

DI void phase0(const Params& p, unsigned char* smem) {
  const int tid = threadIdx.x;
  const int gtid = blockIdx.x * 256 + tid, gsz = gridDim.x * 256;
  for (int i = gtid; i < NTOK * DM / 8; i += gsz) {
    float4 a = ((const float4*)p.x)[2 * i], b = ((const float4*)p.x)[2 * i + 1];
    uint4 o; o.x = pack2(a.x, a.y); o.y = pack2(a.z, a.w); o.z = pack2(b.x, b.y); o.w = pack2(b.z, b.w);
    ((uint4*)p.hb)[i] = o;
  }
  float* tile = (float*)smem;
  const int NJ = 3200 + 1024 + 16 + 16 + 64;
  for (int job = blockIdx.x; job < NJ; job += gridDim.x) {
    const float* src; int sld, cv = 64, dld; bfu* dst;
    if (job < 3200) {
      int l = job / 800, rem = job % 800, kt = rem / 50, nt = rem % 50;
      src = p.w_in + (size_t)l * 1024 * DIN + (size_t)kt * 64 * DIN + nt * 64; sld = DIN;
      cv = DIN - nt * 64; cv = cv < 0 ? 0 : (cv > 64 ? 64 : cv);
      dst = p.wt_in + (size_t)l * PS * 1024 + (size_t)nt * 64 * 1024 + kt * 64; dld = 1024;
    } else if (job < 4224) {
      int j = job - 3200, l = j / 256, rem = j % 256, kt = rem / 16, nt = rem % 16;
      src = p.w_out + (size_t)l * 1048576 + (size_t)kt * 64 * 1024 + nt * 64; sld = 1024;
      dst = p.wt_out + (size_t)l * 1048576 + (size_t)nt * 64 * 1024 + kt * 64; dld = 1024;
    } else if (job < 4240) {
      int j = job - 4224; src = p.w_a + j * 4096; sld = 64; dst = p.wt_a + j * 4096; dld = 64;
    } else if (job < 4256) {
      int j = job - 4240; src = p.w_x + j * 4096; sld = 64; dst = p.wt_x + j * 4096; dld = 64;
    } else {
      int j = job - 4256, l = j / 16, rem = j % 16, kt = rem / 4, nt = rem % 4;
      src = p.w_glu + l * 65536 + kt * 64 * 256 + nt * 64; sld = 256;
      dst = p.wt_glu + l * 65536 + nt * 64 * 256 + kt * 64; dld = 256;
    }
    transpose_tile(src, sld, cv, dst, dld, tile);
  }
  for (int i = gtid; i < 4096; i += gsz) {
    int lg = i >> 6, pp = i & 63;
    double dt = exp((double)p.log_dt[lg]);
    double are = p.a_re[lg * 64 + pp], aim = p.a_im[lg * 64 + pp];
    double mag = exp(dt * are), ang = dt * aim;
    double abr = mag * cos(ang), abi = mag * sin(ang);
    double den = are * are + aim * aim;
    double xr = abr - 1.0, xi = abi;
    double zr = (xr * are + xi * aim) / den, zi = (xi * are - xr * aim) / den;
    bfu* o_re = p.bt_bu + ((size_t)lg * 128 + pp) * 32;
    bfu* o_im = p.bt_bu + ((size_t)lg * 128 + 64 + pp) * 32;
    for (int h = 0; h < 16; ++h) {
      double br = p.sb_re[(lg * 64 + pp) * 16 + h], bi = p.sb_im[(lg * 64 + pp) * 16 + h];
      o_re[h] = f2bf((float)(zr * br - zi * bi));
      o_im[h] = f2bf((float)(zr * bi + zi * br));
      o_re[16 + h] = 0; o_im[16 + h] = 0;
    }
    p.abar[(lg * 64 + pp) * 2 + 0] = (float)abr; p.abar[(lg * 64 + pp) * 2 + 1] = (float)abi;
    double mag64 = exp(64.0 * dt * are), ang64 = 64.0 * ang;
    p.abar64[(lg * 64 + pp) * 2 + 0] = (float)(mag64 * cos(ang64));
    p.abar64[(lg * 64 + pp) * 2 + 1] = (float)(mag64 * sin(ang64));
  }
  for (int i = gtid; i < 4 * 16 * 16 * 128; i += gsz) {
    int k = i & 127, lgn = i >> 7;
    p.bt_y[i] = (k < 64) ? f2bf(p.c_re[lgn * 64 + k]) : f2bf(-p.c_im[lgn * 64 + (k - 64)]);
  }
  for (int i = gtid; i < 256; i += gsz) {
    float v0 = p.lb_logits[i], v1 = p.lb_logits[256 + i], v2 = p.lb_logits[512 + i], v3 = p.lb_logits[768 + i];
    float m = fmaxf(fmaxf(v0, v1), fmaxf(v2, v3));
    float e0 = expf(v0 - m), e1 = expf(v1 - m), e2 = expf(v2 - m), e3 = expf(v3 - m);
    float s = e0 + e1 + e2 + e3;
    p.lbs[i] = 0.f; p.lbs[256 + i] = e1 / s; p.lbs[512 + i] = (e1 + e2) / s; p.lbs[768 + i] = (e1 + e2 + e3) / s;
  }
  for (int i = gtid; i < CNT_TOTAL; i += gsz) p.cnt[i] = 0u;
}

template <int EPI>
DI void gemm_tile(const Params& p, int l, const bfu* A, const bfu* Bt, int m0, int n0, const float* hin, unsigned char* smem) {
  bfu* sA = (bfu*)smem; bfu* sB = sA + 128 * 72;
  const int tid = threadIdx.x, lane = tid & 63, w = tid >> 6, wm = w >> 1, wn = w & 1;
  const int r = lane & 15, q = lane >> 4;
  f32x4 acc[4][4];
#pragma unroll
  for (int i = 0; i < 4; ++i)
#pragma unroll
    for (int j = 0; j < 4; ++j) acc[i][j] = (f32x4){0.f, 0.f, 0.f, 0.f};
  const int lrow = tid >> 3, lkc = tid & 7;
  const bfu* ga = A + (size_t)(m0 + lrow) * 1024 + lkc * 8;
  const bfu* gb = Bt + (size_t)(n0 + lrow) * 1024 + lkc * 8;
  uint4 ra0 = *(const uint4*)(ga), ra1 = *(const uint4*)(ga + 32 * 1024), ra2 = *(const uint4*)(ga + 64 * 1024), ra3 = *(const uint4*)(ga + 96 * 1024);
  uint4 rb0 = *(const uint4*)(gb), rb1 = *(const uint4*)(gb + 32 * 1024), rb2 = *(const uint4*)(gb + 64 * 1024), rb3 = *(const uint4*)(gb + 96 * 1024);
  bfu* wa = sA + lrow * 72 + lkc * 8;
  bfu* wb = sB + lrow * 72 + lkc * 8;
  for (int kt = 0; kt < 16; ++kt) {
    __syncthreads();
    *(uint4*)(wa) = ra0; *(uint4*)(wa + 32 * 72) = ra1; *(uint4*)(wa + 64 * 72) = ra2; *(uint4*)(wa + 96 * 72) = ra3;
    *(uint4*)(wb) = rb0; *(uint4*)(wb + 32 * 72) = rb1; *(uint4*)(wb + 64 * 72) = rb2; *(uint4*)(wb + 96 * 72) = rb3;
    __syncthreads();
    if (kt + 1 < 16) {
      const bfu* ga2 = ga + (kt + 1) * 64; const bfu* gb2 = gb + (kt + 1) * 64;
      ra0 = *(const uint4*)(ga2); ra1 = *(const uint4*)(ga2 + 32 * 1024); ra2 = *(const uint4*)(ga2 + 64 * 1024); ra3 = *(const uint4*)(ga2 + 96 * 1024);
      rb0 = *(const uint4*)(gb2); rb1 = *(const uint4*)(gb2 + 32 * 1024); rb2 = *(const uint4*)(gb2 + 64 * 1024); rb3 = *(const uint4*)(gb2 + 96 * 1024);
    }
#pragma unroll
    for (int ks = 0; ks < 2; ++ks) {
      bf16x8 af[4], bfr[4];
#pragma unroll
      for (int mt = 0; mt < 4; ++mt) af[mt] = *(const bf16x8*)(sA + (wm * 64 + mt * 16 + r) * 72 + ks * 32 + q * 8);
#pragma unroll
      for (int nt = 0; nt < 4; ++nt) bfr[nt] = *(const bf16x8*)(sB + (wn * 64 + nt * 16 + r) * 72 + ks * 32 + q * 8);
#pragma unroll
      for (int mt = 0; mt < 4; ++mt)
#pragma unroll
        for (int nt = 0; nt < 4; ++nt) acc[mt][nt] = __builtin_amdgcn_mfma_f32_16x16x32_bf16(af[mt], bfr[nt], acc[mt][nt], 0, 0, 0);
    }
  }
#pragma unroll
  for (int nt = 0; nt < 4; ++nt) {
    const int col = n0 + wn * 64 + nt * 16 + r;
    if (EPI == 1) {
      const float bias = (col < DIN) ? p.b_in[l * DIN + col] : 0.f;
#pragma unroll
      for (int mt = 0; mt < 4; ++mt)
#pragma unroll
        for (int j = 0; j < 4; ++j) {
          const int row = m0 + wm * 64 + mt * 16 + q * 4 + j;
          p.proj[(size_t)row * PS + col] = f2bf(acc[mt][nt][j] + bias);
        }
    } else {
      const float bias = p.b_out[l * 1024 + col];
#pragma unroll
      for (int mt = 0; mt < 4; ++mt)
#pragma unroll
        for (int j = 0; j < 4; ++j) {
          const int row = m0 + wm * 64 + mt * 16 + q * 4 + j;
          const size_t o = (size_t)row * 1024 + col;
          p.out[o] = DN_ALPHA * hin[o] + acc[mt][nt][j] + bias;
        }
    }
  }
}

DI void phase1(const Params& p, int l, unsigned char* smem) {
  const bfu* Bt = p.wt_in + (size_t)l * PS * 1024;
  for (int tile = blockIdx.x; tile < 128 * 25; tile += gridDim.x) {
    int mt = tile / 25, nt = tile % 25;
    gemm_tile<1>(p, l, p.hb, Bt, mt * 128, nt * 128, nullptr, smem);
  }
}

DI void phase5(const Params& p, int l, unsigned char* smem) {
  const bfu* Bt = p.wt_out + (size_t)l * 1048576;
  const float* hin = (l == 0) ? p.x : p.out;
  unsigned* s_flag = (unsigned*)(smem + SMEM_BYTES - 16);
  const int tid = threadIdx.x, lane = tid & 63, w = tid >> 6;
  for (int tile = blockIdx.x; tile < 128 * 8; tile += gridDim.x) {
    int mt = tile >> 3, nt = tile & 7;
    gemm_tile<2>(p, l, p.mixed, Bt, mt * 128, nt * 128, hin, smem);
    if (last_arriver(p.cnt + CNT_LN + l * 128 + mt, 8u, s_flag)) {
      for (int rr = 0; rr < 32; ++rr) {
        const int row = mt * 128 + w * 32 + rr;
        float4 v[4];
        float s = 0.f;
#pragma unroll
        for (int i = 0; i < 4; ++i) {
          v[i] = *(const float4*)(p.out + (size_t)row * 1024 + i * 256 + lane * 4);
          s += v[i].x + v[i].y + v[i].z + v[i].w;
        }
        const float mu = wave_sum(s) * (1.f / 1024.f);
        float ss = 0.f;
#pragma unroll
        for (int i = 0; i < 4; ++i) {
          v[i].x -= mu; v[i].y -= mu; v[i].z -= mu; v[i].w -= mu;
          ss += v[i].x * v[i].x + v[i].y * v[i].y + v[i].z * v[i].z + v[i].w * v[i].w;
        }
        const float rs = rsqrtf(wave_sum(ss) * (1.f / 1024.f) + 1e-5f);
#pragma unroll
        for (int i = 0; i < 4; ++i) {
          const int c = i * 256 + lane * 4;
          const float4 g = *(const float4*)(p.ln_g + l * 1024 + c);
          const float4 bb = *(const float4*)(p.ln_b + l * 1024 + c);
          float4 o;
          o.x = v[i].x * rs * g.x + bb.x; o.y = v[i].y * rs * g.y + bb.y;
          o.z = v[i].z * rs * g.z + bb.z; o.w = v[i].w * rs * g.w + bb.w;
          *(float4*)(p.out + (size_t)row * 1024 + c) = o;
          uint2 ob; ob.x = pack2(o.x, o.y); ob.y = pack2(o.z, o.w);
          *(uint2*)(p.hb + (size_t)row * 1024 + c) = ob;
        }
      }
    }
  }
}

DI void hg_gate(float x, float lb, float& lf, float& k) {
  const float sneg = 1.f / (1.f + expf(x));
  k = (1.f - lb) * sneg;
  if (lb > 0.f) lf = log1pf(-k); else lf = logsig_(x);
}

DI void hg_local(const Params& p, int l, int b, int c, int hd, unsigned char* smem) {
  const int tid = threadIdx.x, lane = tid & 63, w = tid >> 6;
  bfu* At = (bfu*)smem;
  bfu* Bt = At + 64 * 72;
  float* segtot = (float*)(smem + 2 * 64 * 72 * 2);
  const int tok0 = b * SEQ + c * 64;
  const int d = lane;
  const float lb = p.lbs[l * 256 + hd * 64 + d];
  const bfu* pf = p.proj + (size_t)tok0 * PS + COL_AF + hd * 64 + d;
  const bfu* pv = p.proj + (size_t)tok0 * PS + COL_AI + hd * 64 + d;
  float bl[16], kk[16];
  float run = 0.f;
  __syncthreads();
#pragma unroll
  for (int i = 0; i < 16; ++i) {
    const int t = w * 16 + i;
    float lf, k; hg_gate(bf2f(pf[(size_t)t * PS]), lb, lf, k);
    run += lf; bl[i] = run; kk[i] = k;
    At[d * 72 + t] = pv[(size_t)t * PS];
  }
  segtot[w * 64 + d] = run;
  __syncthreads();
  float off = 0.f, tot = 0.f;
#pragma unroll
  for (int s = 0; s < 4; ++s) { float v = segtot[s * 64 + d]; tot += v; if (s < w) off += v; }
#pragma unroll
  for (int i = 0; i < 16; ++i) { const int t = w * 16 + i; Bt[d * 72 + t] = f2bf(kk[i] * expf(tot - (bl[i] + off))); }
  const int base = (b * NCH + c) * 4 + hd;
  if (w == 0) p.hg_decay[base * 64 + d] = expf(tot);
  __syncthreads();
  f32x4 acc[4];
#pragma unroll
  for (int i = 0; i < 4; ++i) acc[i] = (f32x4){0.f, 0.f, 0.f, 0.f};
  wave_mma<4, 2>(acc, At + w * 16 * 72, 72, Bt, 72, lane);
  float* st = p.hg_state + (size_t)base * 4096;
  const int r = lane & 15, q = lane >> 4;
#pragma unroll
  for (int nt = 0; nt < 4; ++nt)
#pragma unroll
    for (int j = 0; j < 4; ++j) st[(w * 16 + q * 4 + j) * 64 + nt * 16 + r] = acc[nt][j];
}

constexpr int O_A = 0, O_BT = 17408, O_QP = 34816, O_KP = 44032, O_MISC = 53248;

DI void hg_out(const Params& p, int l, int b, int c, int hd, unsigned char* smem) {
  const int tid = threadIdx.x, lane = tid & 63, w = tid >> 6;
  bfu* A = (bfu*)(smem + O_A); bfu* Bt = (bfu*)(smem + O_BT); bfu* Qp = (bfu*)(smem + O_QP); bfu* Kp = (bfu*)(smem + O_KP);
  float* segtot = (float*)(smem + O_MISC);
  const int tok0 = b * SEQ + c * 64;
  const int d = lane;
  const float lb = p.lbs[l * 256 + hd * 64 + d];
  const bfu* pq = p.proj + (size_t)tok0 * PS + COL_AQ + hd * 64 + d;
  const bfu* pf = p.proj + (size_t)tok0 * PS + COL_AF + hd * 64 + d;
  const bfu* pv = p.proj + (size_t)tok0 * PS + COL_AI + hd * 64 + d;
  const int base = (b * NCH + c) * 4 + hd;
  const float* st = p.hg_state + (size_t)base * 4096;
  float bl[16], kk[16];
  float run = 0.f;
  __syncthreads();
#pragma unroll
  for (int i = 0; i < 16; ++i) {
    const int t = w * 16 + i;
    float lf, k; hg_gate(bf2f(pf[(size_t)t * PS]), lb, lf, k);
    run += lf; bl[i] = run; kk[i] = k;
    Bt[d * 136 + t] = pv[(size_t)t * PS];
    const int e = w + 4 * i;
    Bt[e * 136 + 64 + d] = f2bf(st[e * 64 + d]);
  }
  segtot[w * 64 + d] = run;
  __syncthreads();
  float off = 0.f;
#pragma unroll
  for (int s = 0; s < 4; ++s) { float v = segtot[s * 64 + d]; if (s < w) off += v; }
  const float bm = segtot[d] + segtot[64 + d];
#pragma unroll
  for (int i = 0; i < 16; ++i) {
    const int t = w * 16 + i;
    const float bt = bl[i] + off;
    const float qv = silu_(bf2f(pq[(size_t)t * PS]));
    Qp[t * 72 + d] = f2bf(qv * expf(fmaxf(bt - bm, -80.f)));
    Kp[t * 72 + d] = f2bf(kk[i] * expf(fminf(bm - bt, 80.f)));
    A[t * 136 + 64 + d] = f2bf(qv * expf(bt));
  }
  __syncthreads();
  const int r = lane & 15, q = lane >> 4;
  f32x4 acc[4];
#pragma unroll
  for (int i = 0; i < 4; ++i) acc[i] = (f32x4){0.f, 0.f, 0.f, 0.f};
  wave_mma<4, 2>(acc, Qp + w * 16 * 72, 72, Kp, 72, lane);
#pragma unroll
  for (int nt = 0; nt < 4; ++nt)
#pragma unroll
    for (int j = 0; j < 4; ++j) {
      const int t = w * 16 + q * 4 + j, s = nt * 16 + r;
      A[t * 136 + s] = f2bf(s <= t ? acc[nt][j] : 0.f);
    }
  __syncthreads();
  f32x4 o[4];
#pragma unroll
  for (int i = 0; i < 4; ++i) o[i] = (f32x4){0.f, 0.f, 0.f, 0.f};
  wave_mma<4, 4>(o, A + w * 16 * 136, 136, Bt, 136, lane);
#pragma unroll
  for (int j = 0; j < 4; ++j) {
    float ss = 0.f;
#pragma unroll
    for (int nt = 0; nt < 4; ++nt) ss += o[nt][j] * o[nt][j];
    ss = group16_sum(ss);
    const float sc = rsqrtf(ss * (1.f / 64.f) + 1e-6f);
    const int t = w * 16 + q * 4 + j;
    const bfu* prow = p.proj + (size_t)(tok0 + t) * PS + COL_AG + hd * 64;
    bfu* mrow = p.mixed + (size_t)(tok0 + t) * 1024 + hd * 64;
#pragma unroll
    for (int nt = 0; nt < 4; ++nt) {
      const int e = nt * 16 + r;
      mrow[e] = f2bf(o[nt][j] * sc * p.hg_g[l * 256 + hd * 64 + e] * silu_(bf2f(prow[e])));
    }
  }
}

DI void ml_gates(const Params& p, int l, int tok0, int hd, float* bs, float* igs, int tid) {
  if (tid < 64) {
    const bfu* row = p.proj + (size_t)(tok0 + tid) * PS;
    const float ig = bf2f(row[COL_BIG + hd]);
    const float fg = bf2f(row[COL_BFG + hd]) + p.ml_fb[l * 4 + hd];
    float lf = logsig_(fg);
#pragma unroll
    for (int o = 1; o < 64; o <<= 1) { float v = __shfl_up(lf, o); if (tid >= o) lf += v; }
    bs[tid] = lf; igs[tid] = ig;
  }
}

DI void ml_local(const Params& p, int l, int b, int c, int hd, unsigned char* smem) {
  const int tid = threadIdx.x, lane = tid & 63, w = tid >> 6;
  bfu* At = (bfu*)smem;
  bfu* Bt = At + 64 * 72;
  float* bs = (float*)(smem + 2 * 64 * 72 * 2);
  float* igs = bs + 64; float* nseg = igs + 64;
  const int tok0 = b * SEQ + c * 64;
  const int d = lane;
  __syncthreads();
  ml_gates(p, l, tok0, hd, bs, igs, tid);
  __syncthreads();
  const float blast = bs[63];
  const bfu* pk = p.proj + (size_t)tok0 * PS + COL_BK + hd * 64 + d;
  const bfu* pv = p.proj + (size_t)tok0 * PS + COL_BV + hd * 64 + d;
  float nacc = 0.f;
#pragma unroll
  for (int i = 0; i < 16; ++i) {
    const int s = w * 16 + i;
    const float ws = expf(blast - bs[s] + igs[s]);
    const float kw = bf2f(pk[(size_t)s * PS]) * 0.125f * ws;
    Bt[d * 72 + s] = f2bf(kw); nacc += kw;
    At[d * 72 + s] = pv[(size_t)s * PS];
  }
  nseg[w * 64 + d] = nacc;
  __syncthreads();
  const int base = (b * NCH + c) * 4 + hd;
  if (w == 0) p.ml_n[base * 64 + d] = nseg[d] + nseg[64 + d] + nseg[128 + d] + nseg[192 + d];
  if (tid == 0) p.ml_decay[base] = expf(blast);
  f32x4 acc[4];
#pragma unroll
  for (int i = 0; i < 4; ++i) acc[i] = (f32x4){0.f, 0.f, 0.f, 0.f};
  wave_mma<4, 2>(acc, At + w * 16 * 72, 72, Bt, 72, lane);
  float* st = p.ml_state + (size_t)base * 4096;
  const int r = lane & 15, q = lane >> 4;
#pragma unroll
  for (int nt = 0; nt < 4; ++nt)
#pragma unroll
    for (int j = 0; j < 4; ++j) st[(w * 16 + q * 4 + j) * 64 + nt * 16 + r] = acc[nt][j];
}

DI void ml_out(const Params& p, int l, int b, int c, int hd, unsigned char* smem) {
  const int tid = threadIdx.x, lane = tid & 63, w = tid >> 6;
  bfu* A = (bfu*)(smem + O_A); bfu* Bt = (bfu*)(smem + O_BT); bfu* Qp = (bfu*)(smem + O_QP); bfu* Kp = (bfu*)(smem + O_KP);
  float* bs = (float*)(smem + O_MISC); float* igs = bs + 64; float* npv = igs + 64; float* den2 = npv + 64;
  const int tok0 = b * SEQ + c * 64;
  const int d = lane;
  const int base = (b * NCH + c) * 4 + hd;
  const float* st = p.ml_state + (size_t)base * 4096;
  __syncthreads();
  ml_gates(p, l, tok0, hd, bs, igs, tid);
  if (tid >= 64 && tid < 128) npv[tid - 64] = p.ml_n[base * 64 + tid - 64];
  __syncthreads();
  const bfu* pq = p.proj + (size_t)tok0 * PS + COL_BQ + hd * 64 + d;
  const bfu* pk = p.proj + (size_t)tok0 * PS + COL_BK + hd * 64 + d;
  const bfu* pv = p.proj + (size_t)tok0 * PS + COL_BV + hd * 64 + d;
#pragma unroll
  for (int i = 0; i < 16; ++i) {
    const int t = w * 16 + i;
    const bfu qraw = pq[(size_t)t * PS];
    Qp[t * 72 + d] = qraw;
    Kp[t * 72 + d] = pk[(size_t)t * PS];
    A[t * 136 + 64 + d] = f2bf(bf2f(qraw) * expf(bs[t]));
    Bt[d * 136 + t] = pv[(size_t)t * PS];
    const int e = w + 4 * i;
    Bt[e * 136 + 64 + d] = f2bf(st[e * 64 + d]);
  }
  __syncthreads();
  if (tid < 64) {
    float s = 0.f;
    for (int dd = 0; dd < 64; ++dd) s += bf2f(A[tid * 136 + 64 + dd]) * npv[dd];
    den2[tid] = s;
  }
  const int r = lane & 15, q = lane >> 4;
  f32x4 acc[4];
#pragma unroll
  for (int i = 0; i < 4; ++i) acc[i] = (f32x4){0.f, 0.f, 0.f, 0.f};
  wave_mma<4, 2>(acc, Qp + w * 16 * 72, 72, Kp, 72, lane);
  float den1[4];
#pragma unroll
  for (int j = 0; j < 4; ++j) {
    const int t = w * 16 + q * 4 + j;
    const float bt = bs[t];
    float rs = 0.f;
#pragma unroll
    for (int nt = 0; nt < 4; ++nt) {
      const int s = nt * 16 + r;
      float wv = 0.f;
      if (s <= t) wv = expf(bt - bs[s] + igs[s]) * acc[nt][j] * 0.125f;
      rs += wv;
      A[t * 136 + s] = f2bf(wv);
    }
    den1[j] = group16_sum(rs);
  }
  __syncthreads();
  f32x4 o[4];
#pragma unroll
  for (int i = 0; i < 4; ++i) o[i] = (f32x4){0.f, 0.f, 0.f, 0.f};
  wave_mma<4, 4>(o, A + w * 16 * 136, 136, Bt, 136, lane);
#pragma unroll
  for (int j = 0; j < 4; ++j) {
    const int t = w * 16 + q * 4 + j;
    const float den = den1[j] + den2[t];
    const float inv = 1.f / fmaxf(fabsf(den), 1.f);
    float hv[4];
    float ss = 0.f;
#pragma unroll
    for (int nt = 0; nt < 4; ++nt) { hv[nt] = o[nt][j] * inv; ss += hv[nt] * hv[nt]; }
    ss = group16_sum(ss);
    const float sc = rsqrtf(ss * (1.f / 64.f) + 1e-6f);
    const bfu* prow = p.proj + (size_t)(tok0 + t) * PS + COL_BG + hd * 64;
    bfu* mrow = p.mixed + (size_t)(tok0 + t) * 1024 + 256 + hd * 64;
#pragma unroll
    for (int nt = 0; nt < 4; ++nt) {
      const int e = nt * 16 + r;
      mrow[e] = f2bf(hv[nt] * sc * p.ml_g[l * 256 + hd * 64 + e] * silu_(bf2f(prow[e])));
    }
  }
}

template <bool FINAL>
DI void lru_item(const Params& p, int l, int b, int c, int n, unsigned char* smem) {
  const int tid = threadIdx.x, lane = tid & 63, w = tid >> 6;
  bfu* xcb = (bfu*)smem;
  float* xcf = (float*)(smem + 9216);
  float* af = (float*)(smem + 9216 + 17408);
  float* segH = (float*)(smem + 9216 + 2 * 17408);
  float* segA = segH + 256;
  const int tok0 = b * SEQ + c * 64;
  const int ch = n * 64 + lane;
  __syncthreads();
  {
    const float cw0 = p.conv_w[(l * 4 + 0) * 256 + ch], cw1 = p.conv_w[(l * 4 + 1) * 256 + ch];
    const float cw2 = p.conv_w[(l * 4 + 2) * 256 + ch], cw3 = p.conv_w[(l * 4 + 3) * 256 + ch];
    const float cb = p.conv_b[l * 256 + ch];
    const bfu* px = p.proj + (size_t)tok0 * PS + COL_CX + ch;
#pragma unroll
    for (int i = 0; i < 16; ++i) {
      const int t = w * 16 + i;
      const int sp = c * 64 + t;
      float x0 = (sp >= 3) ? bf2f(px[(ptrdiff_t)(t - 3) * PS]) : 0.f;
      float x1 = (sp >= 2) ? bf2f(px[(ptrdiff_t)(t - 2) * PS]) : 0.f;
      float x2 = (sp >= 1) ? bf2f(px[(ptrdiff_t)(t - 1) * PS]) : 0.f;
      float x3 = bf2f(px[(ptrdiff_t)t * PS]);
      const float xc = cb + cw0 * x0 + cw1 * x1 + cw2 * x2 + cw3 * x3;
      xcf[t * 68 + lane] = xc;
      xcb[t * 72 + lane] = f2bf(xc);
    }
  }
  __syncthreads();
  const int r = lane & 15, q = lane >> 4;
  f32x4 aa[4], ax[4];
#pragma unroll
  for (int i = 0; i < 4; ++i) { aa[i] = (f32x4){0.f, 0.f, 0.f, 0.f}; ax[i] = (f32x4){0.f, 0.f, 0.f, 0.f}; }
  wave_mma<4, 2>(aa, xcb + w * 16 * 72, 72, p.wt_a + (l * 4 + n) * 4096, 64, lane);
  wave_mma<4, 2>(ax, xcb + w * 16 * 72, 72, p.wt_x + (l * 4 + n) * 4096, 64, lane);
#pragma unroll
  for (int nt = 0; nt < 4; ++nt) {
    const int e = nt * 16 + r, che = n * 64 + e;
    const float ba = p.b_a[l * 256 + che], bx = p.b_x[l * 256 + che];
    const float lsl = 8.f * logsig_(p.lam[l * 256 + che]);
#pragma unroll
    for (int j = 0; j < 4; ++j) {
      const int t = w * 16 + q * 4 + j;
      const float rg = sigmoid_(aa[nt][j] + ba), ig = sigmoid_(ax[nt][j] + bx);
      const float la = lsl * rg;
      const float a = expf(la);
      const float bv = sqrtf(fmaxf(-expm1f(2.f * la), 0.f)) * ig * xcf[t * 68 + e];
      af[t * 68 + e] = a; xcf[t * 68 + e] = bv;
    }
  }
  __syncthreads();
  float hl[16], al[16];
  float h = 0.f, ap = 1.f;
#pragma unroll
  for (int i = 0; i < 16; ++i) {
    const int t = w * 16 + i;
    const float a = af[t * 68 + lane], bv = xcf[t * 68 + lane];
    h = a * h + bv; ap *= a; hl[i] = h; al[i] = ap;
  }
  segH[w * 64 + lane] = h; segA[w * 64 + lane] = ap;
  __syncthreads();
  const int sidx = (b * NCH + c) * 256 + ch;
  if (!FINAL) {
    if (w == 0) {
      float H = 0.f, Ap = 1.f;
#pragma unroll
      for (int s = 0; s < 4; ++s) { H = segA[s * 64 + lane] * H + segH[s * 64 + lane]; Ap *= segA[s * 64 + lane]; }
      p.lru_h[sidx] = H; p.lru_a[sidx] = Ap;
    }
  } else {
    float H = p.lru_h[sidx];
#pragma unroll
    for (int s = 0; s < 4; ++s) if (s < w) H = segA[s * 64 + lane] * H + segH[s * 64 + lane];
    const bfu* pg = p.proj + (size_t)tok0 * PS + COL_CG + ch;
    bfu* pm = p.mixed + (size_t)tok0 * 1024 + 512 + ch;
#pragma unroll
    for (int i = 0; i < 16; ++i) {
      const int t = w * 16 + i;
      const float hv = hl[i] + al[i] * H;
      pm[(size_t)t * 1024] = f2bf(hv * silu_(bf2f(pg[(size_t)t * PS])));
    }
  }
}

template <bool FINAL>
DI void s5_item(const Params& p, int l, int b, int c, int g4, unsigned char* smem) {
  const int tid = threadIdx.x, lane = tid & 63, w = tid >> 6;
  const int g = g4 * 4 + w;
  float* buw = (float*)(smem + w * 13312);
  bfu* stw = (bfu*)(smem + w * 13312 + 8448);
  const int tok0 = b * SEQ + c * 64;
  const int r = lane & 15, q = lane >> 4;
  const int lg = l * 16 + g;
  bf16x8 bfr[8], yfr[4];
#pragma unroll
  for (int nt = 0; nt < 8; ++nt) bfr[nt] = *(const bf16x8*)(p.bt_bu + ((size_t)lg * 128 + nt * 16 + r) * 32 + q * 8);
  if (FINAL) {
#pragma unroll
    for (int ks = 0; ks < 4; ++ks) yfr[ks] = *(const bf16x8*)(p.bt_y + ((size_t)lg * 16 + r) * 128 + ks * 32 + q * 8);
  }
  const float ar = p.abar[(lg * 64 + lane) * 2], ai = p.abar[(lg * 64 + lane) * 2 + 1];
  const size_t sbase = ((size_t)(b * NCH + c) * 16 + g) * 128;
  float xr = 0.f, xi = 0.f;
  if (FINAL) { xr = p.s5_state[sbase + lane]; xi = p.s5_state[sbase + 64 + lane]; }
  const float dsk = FINAL ? p.s5_d[l * 256 + g * 16 + r] : 0.f;
  __syncthreads();
  for (int mt = 0; mt < 4; ++mt) {
    bf16x8 a = (bf16x8){0, 0, 0, 0, 0, 0, 0, 0};
    if (q < 2) a = *(const bf16x8*)(p.proj + (size_t)(tok0 + mt * 16 + r) * PS + COL_DU + g * 16 + q * 8);
#pragma unroll
    for (int nt = 0; nt < 8; ++nt) {
      f32x4 acc = (f32x4){0.f, 0.f, 0.f, 0.f};
      acc = __builtin_amdgcn_mfma_f32_16x16x32_bf16(a, bfr[nt], acc, 0, 0, 0);
#pragma unroll
      for (int j = 0; j < 4; ++j) buw[(q * 4 + j) * 132 + nt * 16 + r] = acc[j];
    }
    __syncthreads();
#pragma unroll
    for (int tt = 0; tt < 16; ++tt) {
      const float br = buw[tt * 132 + lane], bi = buw[tt * 132 + 64 + lane];
      const float nr = ar * xr - ai * xi + br;
      const float ni = ar * xi + ai * xr + bi;
      xr = nr; xi = ni;
      if (FINAL) { stw[tt * 136 + lane] = f2bf(xr); stw[tt * 136 + 64 + lane] = f2bf(xi); }
    }
    __syncthreads();
    if (FINAL) {
      f32x4 y = (f32x4){0.f, 0.f, 0.f, 0.f};
#pragma unroll
      for (int ks = 0; ks < 4; ++ks) {
        bf16x8 a2 = *(const bf16x8*)(stw + r * 136 + ks * 32 + q * 8);
        y = __builtin_amdgcn_mfma_f32_16x16x32_bf16(a2, yfr[ks], y, 0, 0, 0);
      }
#pragma unroll
      for (int j = 0; j < 4; ++j) {
        const int t = mt * 16 + q * 4 + j;
        const float u = bf2f(p.proj[(size_t)(tok0 + t) * PS + COL_DU + g * 16 + r]);
        const float z = gelu_tanh_(y[j] + dsk * u);
        p.zbuf[(size_t)(tok0 + t) * 256 + g * 16 + r] = f2bf(z);
      }
      __syncthreads();
    }
  }
  if (!FINAL) { p.s5_state[sbase + lane] = xr; p.s5_state[sbase + 64 + lane] = xi; }
}

DI void s5_glu(const Params& p, int l, int b, int c, unsigned char* smem) {
  const int tid = threadIdx.x, lane = tid & 63, w = tid >> 6;
  bfu* zs = (bfu*)smem;
  const int tok0 = b * SEQ + c * 64;
  __syncthreads();
  for (int i = tid; i < 64 * 32; i += 256) {
    const int t = i >> 5, kc = i & 31;
    *(uint4*)(zs + t * 264 + kc * 8) = *(const uint4*)(p.zbuf + (size_t)(tok0 + t) * 256 + kc * 8);
  }
  __syncthreads();
  const int r = lane & 15, q = lane >> 4;
  for (int nc = 0; nc < 4; ++nc) {
    f32x4 acc[4];
#pragma unroll
    for (int i = 0; i < 4; ++i) acc[i] = (f32x4){0.f, 0.f, 0.f, 0.f};
#pragma unroll 1
    for (int kh = 0; kh < 4; ++kh)
      wave_mma<4, 2>(acc, zs + w * 16 * 264 + kh * 64, 264, p.wt_glu + l * 65536 + nc * 64 * 256 + kh * 64, 256, lane);
#pragma unroll
    for (int nt = 0; nt < 4; ++nt) {
      const int n = nc * 64 + nt * 16 + r;
      const float bg = p.b_glu[l * 256 + n];
#pragma unroll
      for (int j = 0; j < 4; ++j) {
        const int t = w * 16 + q * 4 + j;
        const float zv = bf2f(zs[t * 264 + n]);
        const float gate = silu_(bf2f(p.proj[(size_t)(tok0 + t) * PS + COL_DG + n]));
        p.mixed[(size_t)(tok0 + t) * 1024 + 768 + n] = f2bf(zv * sigmoid_(acc[nt][j] + bg) * gate);
      }
    }
  }
}

DI void phase2(const Params& p, int l, unsigned char* smem) {
  for (int item = blockIdx.x; item < 1024; item += gridDim.x) hg_local(p, l, item >> 7, (item >> 2) & 31, item & 3, smem);
  for (int item = blockIdx.x; item < 1024; item += gridDim.x) ml_local(p, l, item >> 7, (item >> 2) & 31, item & 3, smem);
  for (int item = blockIdx.x; item < 1024; item += gridDim.x) lru_item<false>(p, l, item >> 7, (item >> 2) & 31, item & 3, smem);
  for (int item = blockIdx.x; item < 1024; item += gridDim.x) s5_item<false>(p, l, item >> 7, (item >> 2) & 31, item & 3, smem);
}

DI void phase3(const Params& p, int l) {
  const int gtid = blockIdx.x * 256 + threadIdx.x, gsz = gridDim.x * 256;
  constexpr int N1 = 131072, N2 = 131072, N3 = 2048, N4 = 2048, N5 = 8192;
  for (int i = gtid; i < N1 + N2 + N3 + N4 + N5; i += gsz) {
    if (i < N1 + N2) {
      const bool ml = i >= N1;
      const int j = ml ? i - N1 : i;
      const int b = j >> 14, rem = j & 16383, hd = rem >> 12, ed = rem & 4095, d = ed & 63;
      float* stp = ml ? p.ml_state : p.hg_state;
      float S = 0.f;
      for (int c = 0; c < NCH; ++c) {
        const int base = (b * NCH + c) * 4 + hd;
        const float dec = ml ? p.ml_decay[base] : p.hg_decay[base * 64 + d];
        const size_t idx = (size_t)base * 4096 + ed;
        const float loc = stp[idx];
        stp[idx] = S; S = dec * S + loc;
      }
    } else if (i < N1 + N2 + N3) {
      const int j = i - N1 - N2, b = j >> 8, rem = j & 255, hd = rem >> 6, d = rem & 63;
      float S = 0.f;
      for (int c = 0; c < NCH; ++c) {
        const int base = (b * NCH + c) * 4 + hd;
        const float dec = p.ml_decay[base];
        const float loc = p.ml_n[base * 64 + d];
        p.ml_n[base * 64 + d] = S; S = dec * S + loc;
      }
    } else if (i < N1 + N2 + N3 + N4) {
      const int j = i - N1 - N2 - N3, b = j >> 8, ch = j & 255;
      float H = 0.f;
      for (int c = 0; c < NCH; ++c) {
        const int idx = (b * NCH + c) * 256 + ch;
        const float a = p.lru_a[idx], hl = p.lru_h[idx];
        p.lru_h[idx] = H; H = a * H + hl;
      }
    } else {
      const int j = i - N1 - N2 - N3 - N4, b = j >> 10, g = (j >> 6) & 15, pp = j & 63;
      const float ar = p.abar64[((l * 16 + g) * 64 + pp) * 2], ai = p.abar64[((l * 16 + g) * 64 + pp) * 2 + 1];
      float xr = 0.f, xi = 0.f;
      for (int c = 0; c < NCH; ++c) {
        const size_t sb = ((size_t)(b * NCH + c) * 16 + g) * 128;
        const float lr = p.s5_state[sb + pp], li = p.s5_state[sb + 64 + pp];
        p.s5_state[sb + pp] = xr; p.s5_state[sb + 64 + pp] = xi;
        const float nr = ar * xr - ai * xi + lr, ni = ar * xi + ai * xr + li;
        xr = nr; xi = ni;
      }
    }
  }
}

DI void phase4(const Params& p, int l, unsigned char* smem) {
  unsigned* s_flag = (unsigned*)(smem + SMEM_BYTES - 16);
  for (int item = blockIdx.x; item < 1024; item += gridDim.x) {
    const int bc = item >> 2;
    s5_item<true>(p, l, bc >> 5, bc & 31, item & 3, smem);
    if (last_arriver(p.cnt + CNT_GLU + l * 256 + bc, 4u, s_flag)) s5_glu(p, l, bc >> 5, bc & 31, smem);
  }
  for (int item = blockIdx.x; item < 1024; item += gridDim.x) hg_out(p, l, item >> 7, (item >> 2) & 31, item & 3, smem);
  for (int item = blockIdx.x; item < 1024; item += gridDim.x) ml_out(p, l, item >> 7, (item >> 2) & 31, item & 3, smem);
  for (int item = blockIdx.x; item < 1024; item += gridDim.x) lru_item<true>(p, l, item >> 7, (item >> 2) & 31, item & 3, smem);
}

#define RUN_PHASE(PH, CALL)                                       \
  if (ph0 <= (PH) && (PH) < ph1) {                                \
    CALL;                                                         \
    if (COOP) { if ((PH) + 1 < ph1) cg::this_grid().sync(); }     \
  }

template <bool COOP, int L>
DI void run_layer(const Params& p, int ph0, int ph1, unsigned char* smem) {
  RUN_PHASE(1 + 5 * L, phase1(p, L, smem))
  RUN_PHASE(2 + 5 * L, phase2(p, L, smem))
  RUN_PHASE(3 + 5 * L, phase3(p, L))
  RUN_PHASE(4 + 5 * L, phase4(p, L, smem))
  RUN_PHASE(5 + 5 * L, phase5(p, L, smem))
}

template <bool COOP>
__global__ void __launch_bounds__(256, 2) mk_fwd(Params p, int ph0, int ph1) {
  __shared__ __attribute__((aligned(16))) unsigned char smem[SMEM_BYTES];
  RUN_PHASE(0, phase0(p, smem))
  run_layer<COOP, 0>(p, ph0, ph1, smem);
  run_layer<COOP, 1>(p, ph0, ph1, smem);
  run_layer<COOP, 2>(p, ph0, ph1, smem);
  run_layer<COOP, 3>(p, ph0, ph1, smem);
}

extern "C" void kernel_launch(void* const* d_in, const int* in_sizes, int n_in, void* d_out, int out_size, void* d_ws,
                              size_t ws_size, hipStream_t stream) {
  static int grid_blocks = 0;
  if (!grid_blocks) {
    int dev = 0, cus = 0, per_cu = 0;
    hipGetDevice(&dev);
    hipDeviceGetAttribute(&cus, hipDeviceAttributeMultiprocessorCount, dev);
    hipOccupancyMaxActiveBlocksPerMultiprocessor(&per_cu, mk_fwd<(MEGA != 0)>, 256, 0);
    if (per_cu < 1) per_cu = 1;
    if (per_cu > 2) per_cu = 2;
    grid_blocks = cus * per_cu;
  }
  Params p{};
  const float** pin = (const float**)&p;
  for (int i = 0; i < 28; ++i) pin[i] = (const float*)d_in[i];
  p.out = (float*)d_out;
  unsigned char* ws = (unsigned char*)d_ws;
  size_t off = 0;
  auto take = [&](size_t bytes) { unsigned char* r = ws + off; off += (bytes + 255) & ~(size_t)255; return r; };
  p.wt_in = (bfu*)take((size_t)4 * PS * 1024 * 2);
  p.wt_out = (bfu*)take((size_t)4 * 1024 * 1024 * 2);
  p.wt_a = (bfu*)take(16 * 4096 * 2);
  p.wt_x = (bfu*)take(16 * 4096 * 2);
  p.wt_glu = (bfu*)take(4 * 65536 * 2);
  p.bt_bu = (bfu*)take(64 * 128 * 32 * 2);
  p.bt_y = (bfu*)take(64 * 16 * 128 * 2);
  p.hb = (bfu*)take((size_t)NTOK * 1024 * 2);
  p.proj = (bfu*)take((size_t)NTOK * PS * 2);
  p.mixed = (bfu*)take((size_t)NTOK * 1024 * 2);
  p.zbuf = (bfu*)take((size_t)NTOK * 256 * 2);
  p.abar = (float*)take(4096 * 2 * 4);
  p.abar64 = (float*)take(4096 * 2 * 4);
  p.lbs = (float*)take(1024 * 4);
  p.hg_state = (float*)take((size_t)BATCH * NCH * 4 * 4096 * 4);
  p.hg_decay = (float*)take((size_t)BATCH * NCH * 4 * 64 * 4);
  p.ml_state = (float*)take((size_t)BATCH * NCH * 4 * 4096 * 4);
  p.ml_n = (float*)take((size_t)BATCH * NCH * 4 * 64 * 4);
  p.ml_decay = (float*)take((size_t)BATCH * NCH * 4 * 4);
  p.lru_h = (float*)take((size_t)BATCH * NCH * 256 * 4);
  p.lru_a = (float*)take((size_t)BATCH * NCH * 256 * 4);
  p.s5_state = (float*)take((size_t)BATCH * NCH * 16 * 128 * 4);
  p.cnt = (unsigned*)take(CNT_TOTAL * 4);
  if (off > ws_size) { fprintf(stderr, "workspace too small: need %zu have %zu\n", off, ws_size); return; }
  const int NPH = 1 + 5 * DEPTH;
#if MEGA
  int ph0 = 0, ph1 = NPH;
  void* args[] = {&p, &ph0, &ph1};
  hipError_t e = hipLaunchCooperativeKernel((void*)mk_fwd<true>, dim3(grid_blocks), dim3(256), args, 0, stream);
  if (e != hipSuccess) fprintf(stderr, "cooperative launch failed: %s (grid %d)\n", hipGetErrorString(e), grid_blocks);
#else
  for (int ph = 0; ph < NPH; ++ph) hipLaunchKernelGGL(mk_fwd<false>, dim3(grid_blocks), dim3(256), 0, stream, p, ph, ph + 1);
#endif
}
```

```cpp
#include <hip/hip_runtime.h>
#include <hip/hip_cooperative_groups.h>
#include <stdint.h>
#include <stdio.h>
namespace cg = cooperative_groups;

#ifndef MEGA
#define MEGA 1
#endif

typedef unsigned short bfu;
using bf16x8 = __attribute__((ext_vector_type(8))) short;
using f32x4  = __attribute__((ext_vector_type(4))) float;
#define DI __device__ __forceinline__

constexpr int BATCH = 8, SEQ = 2048, DM = 1024, DEPTH = 4, NTOK = BATCH * SEQ, NCH = SEQ / 64;
constexpr int DIN = 3080, PS = 3200;
constexpr int COL_AQ = 0, COL_AF = 256, COL_AI = 512, COL_AG = 768;
constexpr int COL_BQ = 1024, COL_BK = 1280, COL_BV = 1536, COL_BIG = 1792, COL_BFG = 1796, COL_BG = 1800;
constexpr int COL_CX = 2056, COL_CG = 2312, COL_DU = 2568, COL_DG = 2824;
constexpr float DN_ALPHA = 1.681792830507429f;
constexpr int SMEM_BYTES = 56 * 1024;
constexpr int CNT_LN = 0, CNT_GLU = 4 * 128, CNT_TOTAL = 4 * 128 + 4 * 256;

struct Params {
  const float *x, *w_in, *b_in, *lb_logits, *hg_g, *ml_fb, *ml_g, *conv_w, *conv_b, *w_a, *b_a, *w_x, *b_x, *lam,
      *a_re, *a_im, *log_dt, *sb_re, *sb_im, *c_re, *c_im, *s5_d, *w_glu, *b_glu, *w_out, *b_out, *ln_g, *ln_b;
  float* out;
  bfu *wt_in, *wt_out, *wt_a, *wt_x, *wt_glu, *bt_bu, *bt_y, *hb, *proj, *mixed, *zbuf;
  float *abar, *abar64, *lbs, *hg_state, *hg_decay, *ml_state, *ml_n, *ml_decay, *lru_h, *lru_a, *s5_state;
  unsigned* cnt;
};

DI bfu f2bf(float x) { unsigned u = __float_as_uint(x); u += 0x7fffu + ((u >> 16) & 1u); return (bfu)(u >> 16); }
DI float bf2f(bfu h) { return __uint_as_float(((unsigned)h) << 16); }
DI unsigned pack2(float a, float b) { return (unsigned)f2bf(a) | ((unsigned)f2bf(b) << 16); }
DI float sigmoid_(float x) { return 1.f / (1.f + expf(-x)); }
DI float silu_(float x) { return x / (1.f + expf(-x)); }
DI float logsig_(float x) { return fminf(x, 0.f) - log1pf(expf(-fabsf(x))); }
DI float gelu_tanh_(float x) {
  float u = 0.7978845608028654f * (x + 0.044715f * x * x * x);
  float th = 1.f - 2.f / (expf(2.f * u) + 1.f);
  return 0.5f * x * (1.f + th);
}

template <int NT, int KS>
DI void wave_mma(f32x4 (&acc)[NT], const bfu* A, int lda, const bfu* Bt, int ldb, int lane) {
  const int r = lane & 15, q = lane >> 4;
#pragma unroll
  for (int ks = 0; ks < KS; ++ks) {
    bf16x8 a = *(const bf16x8*)(A + r * lda + ks * 32 + q * 8);
#pragma unroll
    for (int nt = 0; nt < NT; ++nt) {
      bf16x8 b = *(const bf16x8*)(Bt + (nt * 16 + r) * ldb + ks * 32 + q * 8);
      acc[nt] = __builtin_amdgcn_mfma_f32_16x16x32_bf16(a, b, acc[nt], 0, 0, 0);
    }
  }
}

DI float group16_sum(float v) {
  v += __shfl_xor(v, 1); v += __shfl_xor(v, 2); v += __shfl_xor(v, 4); v += __shfl_xor(v, 8);
  return v;
}
DI float wave_sum(float v) {
  v += __shfl_xor(v, 1); v += __shfl_xor(v, 2); v += __shfl_xor(v, 4); v += __shfl_xor(v, 8);
  v += __shfl_xor(v, 16); v += __shfl_xor(v, 32);
  return v;
}

DI bool last_arriver(unsigned* ctr, unsigned total, unsigned* s_flag) {
  __threadfence();
  __syncthreads();
  if (threadIdx.x == 0) { unsigned old = atomicAdd(ctr, 1u); *s_flag = (old == total - 1u) ? 1u : 0u; }
  __syncthreads();
  bool last = (*s_flag != 0u);
  if (last) __threadfence();
  return last;
}

DI void transpose_tile(const float* src, int sld, int cv, bfu* dst, int dld, float* tile) {
  const int tid = threadIdx.x;
  __syncthreads();
  for (int i = tid; i < 4096; i += 256) {
    int r = i >> 6, c = i & 63;
    tile[r * 65 + c] = (c < cv) ? src[(size_t)r * sld + c] : 0.f;
  }
  __syncthreads();
  for (int i = tid; i < 4096; i += 256) {
    int n = i >> 6, k = i & 63;
    dst[(size_t)n * dld + k] = f2bf(tile[k * 65 + n]);
  }
}

DI void phase0(const Params& p, unsigned char* smem) {
  const int tid = threadIdx.x;
  const int gtid = blockIdx.x * 256 + tid, gsz = gridDim.x * 256;
  for (int i = gtid; i < NTOK * DM / 8; i += gsz) {
    float4 a = ((const float4*)p.x)[2 * i], b = ((const float4*)p.x)[2 * i + 1];
    uint4 o; o.x = pack2(a.x, a.y); o.y = pack2(a.z, a.w); o.z = pack2(b.x, b.y); o.w = pack2(b.z, b.w);
    ((uint4*)p.hb)[i] = o;
  }
  float* tile = (float*)smem;
  const int NJ = 3200 + 1024 + 16 + 16 + 64;
  for (int job = blockIdx.x; job < NJ; job += gridDim.x) {
    const float* src; int sld, cv = 64, dld; bfu* dst;
    if (job < 3200) {
      int l = job / 800, rem = job % 800, kt = rem / 50, nt = rem % 50;
      src = p.w_in + (size_t)l * 1024 * DIN + (size_t)kt * 64 * DIN + nt * 64; sld = DIN;
      cv = DIN - nt * 64; cv = cv < 0 ? 0 : (cv > 64 ? 64 : cv);
      dst = p.wt_in + (size_t)l * PS * 1024 + (size_t)nt * 64 * 1024 + kt * 64; dld = 1024;
    } else if (job < 4224) {
      int j = job - 3200, l = j / 256, rem = j % 256, kt = rem / 16, nt = rem % 16;
      src = p.w_out + (size_t)l * 1048576 + (size_t)kt * 64 * 1024 + nt * 64; sld = 1024;
      dst = p.wt_out + (size_t)l * 1048576 + (size_t)nt * 64 * 1024 + kt * 64; dld = 1024;
    } else if (job < 4240) {
      int j = job - 4224; src = p.w_a + j * 4096; sld = 64; dst = p.wt_a + j * 4096; dld = 64;
    } else if (job < 4256) {
      int j = job - 4240; src = p.w_x + j * 4096; sld = 64; dst = p.wt_x + j * 4096; dld = 64;
    } else {
      int j = job - 4256, l = j / 16, rem = j % 16, kt = rem / 4, nt = rem % 4;
      src = p.w_glu + l * 65536 + kt * 64 * 256 + nt * 64; sld = 256;
      dst = p.wt_glu + l * 65536 + nt * 64 * 256 + kt * 64; dld = 256;
    }
    transpose_tile(src, sld, cv, dst, dld, tile);
  }
  for (int i = gtid; i < 4096; i += gsz) {
    int lg = i >> 6, pp = i & 63;
    double dt = exp((double)p.log_dt[lg]);
    double are = p.a_re[lg * 64 + pp], aim = p.a_im[lg * 64 + pp];
    double mag = exp(dt * are), ang = dt * aim;
    double abr = mag * cos(ang), abi = mag * sin(ang);
    double den = are * are + aim * aim;
    double xr = abr - 1.0, xi = abi;
    double zr = (xr * are + xi * aim) / den, zi = (xi * are - xr * aim) / den;
    bfu* o_re = p.bt_bu + ((size_t)lg * 128 + pp) * 32;
    bfu* o_im = p.bt_bu + ((size_t)lg * 128 + 64 + pp) * 32;
    for (int h = 0; h < 16; ++h) {
      double br = p.sb_re[(lg * 64 + pp) * 16 + h], bi = p.sb_im[(lg * 64 + pp) * 16 + h];
      o_re[h] = f2bf((float)(zr * br - zi * bi));
      o_im[h] = f2bf((float)(zr * bi + zi * br));
      o_re[16 + h] = 0; o_im[16 + h] = 0;
    }
    p.abar[(lg * 64 + pp) * 2 + 0] = (float)abr; p.abar[(lg * 64 + pp) * 2 + 1] = (float)abi;
    double mag64 = exp(64.0 * dt * are), ang64 = 64.0 * ang;
    p.abar64[(lg * 64 + pp) * 2 + 0] = (float)(mag64 * cos(ang64));
    p.abar64[(lg * 64 + pp) * 2 + 1] = (float)(mag64 * sin(ang64));
  }
  for (int i = gtid; i < 4 * 16 * 16 * 128; i += gsz) {
    int k = i & 127, lgn = i >> 7;
    p.bt_y[i] = (k < 64) ? f2bf(p.c_re[lgn * 64 + k]) : f2bf(-p.c_im[lgn * 64 + (k - 64)]);
  }
  for (int i = gtid; i < 256; i += gsz) {
    float v0 = p.lb_logits[i], v1 = p.lb_logits[256 + i], v2 = p.lb_logits[512 + i], v3 = p.lb_logits[768 + i];
    float m = fmaxf(fmaxf(v0, v1), fmaxf(v2, v3));
    float e0 = expf(v0 - m), e1 = expf(v1 - m), e2 = expf(v2 - m), e3 = expf(v3 - m);
    float s = e0 + e1 + e2 + e3;
    p.lbs[i] = 0.f; p.lbs[256 + i] = e1 / s; p.lbs[512 + i] = (e1 + e2) / s; p.lbs[768 + i] = (e1 + e2 + e3) / s;
  }
  for (int i = gtid; i < CNT_TOTAL; i += gsz) p.cnt[i] = 0u;
}

template <int EPI>
DI void gemm_tile(const Params& p, int l, const bfu* A, const bfu* Bt, int m0, int n0, const float* hin, unsigned char* smem) {
  bfu* sA = (bfu*)smem; bfu* sB = sA + 128 * 72;
  const int tid = threadIdx.x, lane = tid & 63, w = tid >> 6, wm = w >> 1, wn = w & 1;
  const int r = lane & 15, q = lane >> 4;
  f32x4 acc[4][4];
#pragma unroll
  for (int i = 0; i < 4; ++i)
#pragma unroll
    for (int j = 0; j < 4; ++j) acc[i][j] = (f32x4){0.f, 0.f, 0.f, 0.f};
  const int lrow = tid >> 3, lkc = tid & 7;
  const bfu* ga = A + (size_t)(m0 + lrow) * 1024 + lkc * 8;
  const bfu* gb = Bt + (size_t)(n0 + lrow) * 1024 + lkc * 8;
  uint4 ra0 = *(const uint4*)(ga), ra1 = *(const uint4*)(ga + 32 * 1024), ra2 = *(const uint4*)(ga + 64 * 1024), ra3 = *(const uint4*)(ga + 96 * 1024);
  uint4 rb0 = *(const uint4*)(gb), rb1 = *(const uint4*)(gb + 32 * 1024), rb2 = *(const uint4*)(gb + 64 * 1024), rb3 = *(const uint4*)(gb + 96 * 1024);
  bfu* wa = sA + lrow * 72 + lkc * 8;
  bfu* wb = sB + lrow * 72 + lkc * 8;
  for (int kt = 0; kt < 16; ++kt) {
    __syncthreads();
    *(uint4*)(wa) = ra0; *(uint4*)(wa + 32 * 72) = ra1; *(uint4*)(wa + 64 * 72) = ra2; *(uint4*)(wa + 96 * 72) = ra3;
    *(uint4*)(wb) = rb0; *(uint4*)(wb + 32 * 72) = rb1; *(uint4*)(wb + 64 * 72) = rb2; *(uint4*)(wb + 96 * 72) = rb3;
    __syncthreads();
    if (kt + 1 < 16) {
      const bfu* ga2 = ga + (kt + 1) * 64; const bfu* gb2 = gb + (kt + 1) * 64;
      ra0 = *(const uint4*)(ga2); ra1 = *(const uint4*)(ga2 + 32 * 1024); ra2 = *(const uint4*)(ga2 + 64 * 1024); ra3 = *(const uint4*)(ga2 + 96 * 1024);
      rb0 = *(const uint4*)(gb2); rb1 = *(const uint4*)(gb2 + 32 * 1024); rb2 = *(const uint4*)(gb2 + 64 * 1024); rb3 = *(const uint4*)(gb2 + 96 * 1024);
    }
#pragma unroll
    for (int ks = 0; ks < 2; ++ks) {
      bf16x8 af[4], bfr[4];
#pragma unroll
      for (int mt = 0; mt < 4; ++mt) af[mt] = *(const bf16x8*)(sA + (wm * 64 + mt * 16 + r) * 72 + ks * 32 + q * 8);
#pragma unroll
      for (int nt = 0; nt < 4; ++nt) bfr[nt] = *(const bf16x8*)(sB + (wn * 64 + nt * 16 + r) * 72 + ks * 32 + q * 8);
#pragma unroll
      for (int mt = 0; mt < 4; ++mt)
#pragma unroll
        for (int nt = 0; nt < 4; ++nt) acc[mt][nt] = __builtin_amdgcn_mfma_f32_16x16x32_bf16(af[mt], bfr[nt], acc[mt][nt], 0, 0, 0);
    }
  }
#pragma unroll
  for (int nt = 0; nt < 4; ++nt) {
    const int col = n0 + wn * 64 + nt * 16 + r;
    if (EPI == 1) {
      const float bias = (col < DIN) ? p.b_in[l * DIN + col] : 0.f;
#pragma unroll
      for (int mt = 0; mt < 4; ++mt)
#pragma unroll
        for (int j = 0; j < 4; ++j) {
          const int row = m0 + wm * 64 + mt * 16 + q * 4 + j;
          p.proj[(size_t)row * PS + col] = f2bf(acc[mt][nt][j] + bias);
        }
    } else {
      const float bias = p.b_out[l * 1024 + col];
#pragma unroll
      for (int mt = 0; mt < 4; ++mt)
#pragma unroll
        for (int j = 0; j < 4; ++j) {
          const int row = m0 + wm * 64 + mt * 16 + q * 4 + j;
          const size_t o = (size_t)row * 1024 + col;
          p.out[o] = DN_ALPHA * hin[o] + acc[mt][nt][j] + bias;
        }
    }
  }
}

DI void phase1(const Params& p, int l, unsigned char* smem) {
  const bfu* Bt = p.wt_in + (size_t)l * PS * 1024;
  for (int tile = blockIdx.x; tile < 128 * 25; tile += gridDim.x) {
    int mt = tile / 25, nt = tile % 25;
    gemm_tile<1>(p, l, p.hb, Bt, mt * 128, nt * 128, nullptr, smem);
  }
}

DI void phase5(const Params& p, int l, unsigned char* smem) {
  const bfu* Bt = p.wt_out + (size_t)l * 1048576;
  const float* hin = (l == 0) ? p.x : p.out;
  unsigned* s_flag = (unsigned*)(smem + SMEM_BYTES - 16);
  const int tid = threadIdx.x, lane = tid & 63, w = tid >> 6;
  for (int tile = blockIdx.x; tile < 128 * 8; tile += gridDim.x) {
    int mt = tile >> 3, nt = tile & 7;
    gemm_tile<2>(p, l, p.mixed, Bt, mt * 128, nt * 128, hin, smem);
    if (last_arriver(p.cnt + CNT_LN + l * 128 + mt, 8u, s_flag)) {
      for (int rr = 0; rr < 32; ++rr) {
        const int row = mt * 128 + w * 32 + rr;
        float4 v[4];
        float s = 0.f;
#pragma unroll
        for (int i = 0; i < 4; ++i) {
          v[i] = *(const float4*)(p.out + (size_t)row * 1024 + i * 256 + lane * 4);
          s += v[i].x + v[i].y + v[i].z + v[i].w;
        }
        const float mu = wave_sum(s) * (1.f / 1024.f);
        float ss = 0.f;
#pragma unroll
        for (int i = 0; i < 4; ++i) {
          v[i].x -= mu; v[i].y -= mu; v[i].z -= mu; v[i].w -= mu;
          ss += v[i].x * v[i].x + v[i].y * v[i].y + v[i].z * v[i].z + v[i].w * v[i].w;
        }
        const float rs = rsqrtf(wave_sum(ss) * (1.f / 1024.f) + 1e-5f);
#pragma unroll
        for (int i = 0; i < 4; ++i) {
          const int c = i * 256 + lane * 4;
          const float4 g = *(const float4*)(p.ln_g + l * 1024 + c);
          const float4 bb = *(const float4*)(p.ln_b + l * 1024 + c);
          float4 o;
          o.x = v[i].x * rs * g.x + bb.x; o.y = v[i].y * rs * g.y + bb.y;
          o.z = v[i].z * rs * g.z + bb.z; o.w = v[i].w * rs * g.w + bb.w;
          *(float4*)(p.out + (size_t)row * 1024 + c) = o;
          uint2 ob; ob.x = pack2(o.x, o.y); ob.y = pack2(o.z, o.w);
          *(uint2*)(p.hb + (size_t)row * 1024 + c) = ob;
        }
      }
    }
  }
}

DI void hg_gate(float x, float lb, float& lf, float& k) {
  const float sneg = 1.f / (1.f + expf(x));
  k = (1.f - lb) * sneg;
  if (lb > 0.f) lf = log1pf(-k); else lf = logsig_(x);
}

DI void hg_local(const Params& p, int l, int b, int c, int hd, unsigned char* smem) {
  const int tid = threadIdx.x, lane = tid & 63, w = tid >> 6;
  bfu* At = (bfu*)smem;
  bfu* Bt = At + 64 * 72;
  float* segtot = (float*)(smem + 2 * 64 * 72 * 2);
  const int tok0 = b * SEQ + c * 64;
  const int d = lane;
  const float lb = p.lbs[l * 256 + hd * 64 + d];
  const bfu* pf = p.proj + (size_t)tok0 * PS + COL_AF + hd * 64 + d;
  const bfu* pv = p.proj + (size_t)tok0 * PS + COL_AI + hd * 64 + d;
  float bl[16], kk[16];
  float run = 0.f;
  __syncthreads();
#pragma unroll
  for (int i = 0; i < 16; ++i) {
    const int t = w * 16 + i;
    float lf, k; hg_gate(bf2f(pf[(size_t)t * PS]), lb, lf, k);
    run += lf; bl[i] = run; kk[i] = k;
    At[d * 72 + t] = pv[(size_t)t * PS];
  }
  segtot[w * 64 + d] = run;
  __syncthreads();
  float off = 0.f, tot = 0.f;
#pragma unroll
  for (int s = 0; s < 4; ++s) { float v = segtot[s * 64 + d]; tot += v; if (s < w) off += v; }
#pragma unroll
  for (int i = 0; i < 16; ++i) { const int t = w * 16 + i; Bt[d * 72 + t] = f2bf(kk[i] * expf(tot - (bl[i] + off))); }
  const int base = (b * NCH + c) * 4 + hd;
  if (w == 0) p.hg_decay[base * 64 + d] = expf(tot);
  __syncthreads();
  f32x4 acc[4];
#pragma unroll
  for (int i = 0; i < 4; ++i) acc[i] = (f32x4){0.f, 0.f, 0.f, 0.f};
  wave_mma<4, 2>(acc, At + w * 16 * 72, 72, Bt, 72, lane);
  float* st = p.hg_state + (size_t)base * 4096;
  const int r = lane & 15, q = lane >> 4;
#pragma unroll
  for (int nt = 0; nt < 4; ++nt)
#pragma unroll
    for (int j = 0; j < 4; ++j) st[(w * 16 + q * 4 + j) * 64 + nt * 16 + r] = acc[nt][j];
}

constexpr int O_A = 0, O_BT = 17408, O_QP = 34816, O_KP = 44032, O_MISC = 53248;

DI void hg_out(const Params& p, int l, int b, int c, int hd, unsigned char* smem) {
  const int tid = threadIdx.x, lane = tid & 63, w = tid >> 6;
  bfu* A = (bfu*)(smem + O_A); bfu* Bt = (bfu*)(smem + O_BT); bfu* Qp = (bfu*)(smem + O_QP); bfu* Kp = (bfu*)(smem + O_KP);
  float* segtot = (float*)(smem + O_MISC);
  const int tok0 = b * SEQ + c * 64;
  const int d = lane;
  const float lb = p.lbs[l * 256 + hd * 64 + d];
  const bfu* pq = p.proj + (size_t)tok0 * PS + COL_AQ + hd * 64 + d;
  const bfu* pf = p.proj + (size_t)tok0 * PS + COL_AF + hd * 64 + d;
  const bfu* pv = p.proj + (size_t)tok0 * PS + COL_AI + hd * 64 + d;
  const int base = (b * NCH + c) * 4 + hd;
  const float* st = p.hg_state + (size_t)base * 4096;
  float bl[16], kk[16];
  float run = 0.f;
  __syncthreads();
#pragma unroll
  for (int i = 0; i < 16; ++i) {
    const int t = w * 16 + i;
    float lf, k; hg_gate(bf2f(pf[(size_t)t * PS]), lb, lf, k);
    run += lf; bl[i] = run; kk[i] = k;
    Bt[d * 136 + t] = pv[(size_t)t * PS];
    const int e = w + 4 * i;
    Bt[e * 136 + 64 + d] = f2bf(st[e * 64 + d]);
  }
  segtot[w * 64 + d] = run;
  __syncthreads();
  float off = 0.f;
#pragma unroll
  for (int s = 0; s < 4; ++s) { float v = segtot[s * 64 + d]; if (s < w) off += v; }
  const float bm = segtot[d] + segtot[64 + d];
#pragma unroll
  for (int i = 0; i < 16; ++i) {
    const int t = w * 16 + i;
    const float bt = bl[i] + off;
    const float qv = silu_(bf2f(pq[(size_t)t * PS]));
    Qp[t * 72 + d] = f2bf(qv * expf(fmaxf(bt - bm, -80.f)));
    Kp[t * 72 + d] = f2bf(kk[i] * expf(fminf(bm - bt, 80.f)));
    A[t * 136 + 64 + d] = f2bf(qv * expf(bt));
  }
  __syncthreads();
  const int r = lane & 15, q = lane >> 4;
  f32x4 acc[4];
#pragma unroll
  for (int i = 0; i < 4; ++i) acc[i] = (f32x4){0.f, 0.f, 0.f, 0.f};
  wave_mma<4, 2>(acc, Qp + w * 16 * 72, 72, Kp, 72, lane);
#pragma unroll
  for (int nt = 0; nt < 4; ++nt)
#pragma unroll
    for (int j = 0; j < 4; ++j) {
      const int t = w * 16 + q * 4 + j, s = nt * 16 + r;
      A[t * 136 + s] = f2bf(s <= t ? acc[nt][j] : 0.f);
    }
  __syncthreads();
  f32x4 o[4];
#pragma unroll
  for (int i = 0; i < 4; ++i) o[i] = (f32x4){0.f, 0.f, 0.f, 0.f};
  wave_mma<4, 4>(o, A + w * 16 * 136, 136, Bt, 136, lane);
#pragma unroll
  for (int j = 0; j < 4; ++j) {
    float ss = 0.f;
#pragma unroll
    for (int nt = 0; nt < 4; ++nt) ss += o[nt][j] * o[nt][j];
    ss = group16_sum(ss);
    const float sc = rsqrtf(ss * (1.f / 64.f) + 1e-6f);
    const int t = w * 16 + q * 4 + j;
    const bfu* prow = p.proj + (size_t)(tok0 + t) * PS + COL_AG + hd * 64;
    bfu* mrow = p.mixed + (size_t)(tok0 + t) * 1024 + hd * 64;
#pragma unroll
    for (int nt = 0; nt < 4; ++nt) {
      const int e = nt * 16 + r;
      mrow[e] = f2bf(o[nt][j] * sc * p.hg_g[l * 256 + hd * 64 + e] * silu_(bf2f(prow[e])));
    }
  }
}

DI void ml_gates(const Params& p, int l, int tok0, int hd, float* bs, float* igs, int tid) {
  if (tid < 64) {
    const bfu* row = p.proj + (size_t)(tok0 + tid) * PS;
    const float ig = bf2f(row[COL_BIG + hd]);
    const float fg = bf2f(row[COL_BFG + hd]) + p.ml_fb[l * 4 + hd];
    float lf = logsig_(fg);
#pragma unroll
    for (int o = 1; o < 64; o <<= 1) { float v = __shfl_up(lf, o); if (tid >= o) lf += v; }
    bs[tid] = lf; igs[tid] = ig;
  }
}

DI void ml_local(const Params& p, int l, int b, int c, int hd, unsigned char* smem) {
  const int tid = threadIdx.x, lane = tid & 63, w = tid >> 6;
  bfu* At = (bfu*)smem;
  bfu* Bt = At + 64 * 72;
  float* bs = (float*)(smem + 2 * 64 * 72 * 2);
  float* igs = bs + 64; float* nseg = igs + 64;
  const int tok0 = b * SEQ + c * 64;
  const int d = lane;
  __syncthreads();
  ml_gates(p, l, tok0, hd, bs, igs, tid);
  __syncthreads();
  const float blast = bs[63];
  const bfu* pk = p.proj + (size_t)tok0 * PS + COL_BK + hd * 64 + d;
  const bfu* pv = p.proj + (size_t)tok0 * PS + COL_BV + hd * 64 + d;
  float nacc = 0.f;
#pragma unroll
  for (int i = 0; i < 16; ++i) {
    const int s = w * 16 + i;
    const float ws = expf(blast - bs[s] + igs[s]);
    const float kw = bf2f(pk[(size_t)s * PS]) * 0.125f * ws;
    Bt[d * 72 + s] = f2bf(kw); nacc += kw;
    At[d * 72 + s] = pv[(size_t)s * PS];
  }
  nseg[w * 64 + d] = nacc;
  __syncthreads();
  const int base = (b * NCH + c) * 4 + hd;
  if (w == 0) p.ml_n[base * 64 + d] = nseg[d] + nseg[64 + d] + nseg[128 + d] + nseg[192 + d];
  if (tid == 0) p.ml_decay[base] = expf(blast);
  f32x4 acc[4];
#pragma unroll
  for (int i = 0; i < 4; ++i) acc[i] = (f32x4){0.f, 0.f, 0.f, 0.f};
  wave_mma<4, 2>(acc, At + w * 16 * 72, 72, Bt, 72, lane);
  float* st = p.ml_state + (size_t)base * 4096;
  const int r = lane & 15, q = lane >> 4;
#pragma unroll
  for (int nt = 0; nt < 4; ++nt)
#pragma unroll
    for (int j = 0; j < 4; ++j) st[(w * 16 + q * 4 + j) * 64 + nt * 16 + r] = acc[nt][j];
}

DI void ml_out(const Params& p, int l, int b, int c, int hd, unsigned char* smem) {
  const int tid = threadIdx.x, lane = tid & 63, w = tid >> 6;
  bfu* A = (bfu*)(smem + O_A); bfu* Bt = (bfu*)(smem + O_BT); bfu* Qp = (bfu*)(smem + O_QP); bfu* Kp = (bfu*)(smem + O_KP);
  float* bs = (float*)(smem + O_MISC); float* igs = bs + 64; float* npv = igs + 64; float* den2 = npv + 64;
  const int tok0 = b * SEQ + c * 64;
  const int d = lane;
  const int base = (b * NCH + c) * 4 + hd;
  const float* st = p.ml_state + (size_t)base * 4096;
  __syncthreads();
  ml_gates(p, l, tok0, hd, bs, igs, tid);
  if (tid >= 64 && tid < 128) npv[tid - 64] = p.ml_n[base * 64 + tid - 64];
  __syncthreads();
  const bfu* pq = p.proj + (size_t)tok0 * PS + COL_BQ + hd * 64 + d;
  const bfu* pk = p.proj + (size_t)tok0 * PS + COL_BK + hd * 64 + d;
  const bfu* pv = p.proj + (size_t)tok0 * PS + COL_BV + hd * 64 + d;
#pragma unroll
  for (int i = 0; i < 16; ++i) {
    const int t = w * 16 + i;
    const bfu qraw = pq[(size_t)t * PS];
    Qp[t * 72 + d] = qraw;
    Kp[t * 72 + d] = pk[(size_t)t * PS];
    A[t * 136 + 64 + d] = f2bf(bf2f(qraw) * expf(bs[t]));
    Bt[d * 136 + t] = pv[(size_t)t * PS];
    const int e = w + 4 * i;
    Bt[e * 136 + 64 + d] = f2bf(st[e * 64 + d]);
  }
  __syncthreads();
  if (tid < 64) {
    float s = 0.f;
    for (int dd = 0; dd < 64; ++dd) s += bf2f(A[tid * 136 + 64 + dd]) * npv[dd];
    den2[tid] = s;
  }
  const int r = lane & 15, q = lane >> 4;
  f32x4 acc[4];
#pragma unroll
  for (int i = 0; i < 4; ++i) acc[i] = (f32x4){0.f, 0.f, 0.f, 0.f};
  wave_mma<4, 2>(acc, Qp + w * 16 * 72, 72, Kp, 72, lane);
  float den1[4];
#pragma unroll
  for (int j = 0; j < 4; ++j) {
    const int t = w * 16 + q * 4 + j;
    const float bt = bs[t];
    float rs = 0.f;
#pragma unroll
    for (int nt = 0; nt < 4; ++nt) {
      const int s = nt * 16 + r;
      float wv = 0.f;
      if (s <= t) wv = expf(bt - bs[s] + igs[s]) * acc[nt][j] * 0.125f;
      rs += wv;
      A[t * 136 + s] = f2bf(wv);
    }
    den1[j] = group16_sum(rs);
  }
  __syncthreads();
  f32x4 o[4];
#pragma unroll
  for (int i = 0; i < 4; ++i) o[i] = (f32x4){0.f, 0.f, 0.f, 0.f};
  wave_mma<4, 4>(o, A + w * 16 * 136, 136, Bt, 136, lane);
#pragma unroll
  for (int j = 0; j < 4; ++j) {
    const int t = w * 16 + q * 4 + j;
    const float den = den1[j] + den2[t];
    const float inv = 1.f / fmaxf(fabsf(den), 1.f);
    float hv[4];
    float ss = 0.f;
#pragma unroll
    for (int nt = 0; nt < 4; ++nt) { hv[nt] = o[nt][j] * inv; ss += hv[nt] * hv[nt]; }
    ss = group16_sum(ss);
    const float sc = rsqrtf(ss * (1.f / 64.f) + 1e-6f);
    const bfu* prow = p.proj + (size_t)(tok0 + t) * PS + COL_BG + hd * 64;
    bfu* mrow = p.mixed + (size_t)(tok0 + t) * 1024 + 256 + hd * 64;
#pragma unroll
    for (int nt = 0; nt < 4; ++nt) {
      const int e = nt * 16 + r;
      mrow[e] = f2bf(hv[nt] * sc * p.ml_g[l * 256 + hd * 64 + e] * silu_(bf2f(prow[e])));
    }
  }
}

template <bool FINAL>
DI void lru_item(const Params& p, int l, int b, int c, int n, unsigned char* smem) {
  const int tid = threadIdx.x, lane = tid & 63, w = tid >> 6;
  bfu* xcb = (bfu*)smem;
  float* xcf = (float*)(smem + 9216);
  float* af = (float*)(smem + 9216 + 17408);
  float* segH = (float*)(smem + 9216 + 2 * 17408);
  float* segA = segH + 256;
  const int tok0 = b * SEQ + c * 64;
  const int ch = n * 64 + lane;
  __syncthreads();
  {
    const float cw0 = p.conv_w[(l * 4 + 0) * 256 + ch], cw1 = p.conv_w[(l * 4 + 1) * 256 + ch];
    const float cw2 = p.conv_w[(l * 4 + 2) * 256 + ch], cw3 = p.conv_w[(l * 4 + 3) * 256 + ch];
    const float cb = p.conv_b[l * 256 + ch];
    const bfu* px = p.proj + (size_t)tok0 * PS + COL_CX + ch;
#pragma unroll
    for (int i = 0; i < 16; ++i) {
      const int t = w * 16 + i;
      const int sp = c * 64 + t;
      float x0 = (sp >= 3) ? bf2f(px[(ptrdiff_t)(t - 3) * PS]) : 0.f;
      float x1 = (sp >= 2) ? bf2f(px[(ptrdiff_t)(t - 2) * PS]) : 0.f;
      float x2 = (sp >= 1) ? bf2f(px[(ptrdiff_t)(t - 1) * PS]) : 0.f;
      float x3 = bf2f(px[(ptrdiff_t)t * PS]);
      const float xc = cb + cw0 * x0 + cw1 * x1 + cw2 * x2 + cw3 * x3;
      xcf[t * 68 + lane] = xc;
      xcb[t * 72 + lane] = f2bf(xc);
    }
  }
  __syncthreads();
  const int r = lane & 15, q = lane >> 4;
  f32x4 aa[4], ax[4];
#pragma unroll
  for (int i = 0; i < 4; ++i) { aa[i] = (f32x4){0.f, 0.f, 0.f, 0.f}; ax[i] = (f32x4){0.f, 0.f, 0.f, 0.f}; }
  wave_mma<4, 2>(aa, xcb + w * 16 * 72, 72, p.wt_a + (l * 4 + n) * 4096, 64, lane);
  wave_mma<4, 2>(ax, xcb + w * 16 * 72, 72, p.wt_x + (l * 4 + n) * 4096, 64, lane);
#pragma unroll
  for (int nt = 0; nt < 4; ++nt) {
    const int e = nt * 16 + r, che = n * 64 + e;
    const float ba = p.b_a[l * 256 + che], bx = p.b_x[l * 256 + che];
    const float lsl = 8.f * logsig_(p.lam[l * 256 + che]);
#pragma unroll
    for (int j = 0; j < 4; ++j) {
      const int t = w * 16 + q * 4 + j;
      const float rg = sigmoid_(aa[nt][j] + ba), ig = sigmoid_(ax[nt][j] + bx);
      const float la = lsl * rg;
      const float a = expf(la);
      const float bv = sqrtf(fmaxf(-expm1f(2.f * la), 0.f)) * ig * xcf[t * 68 + e];
      af[t * 68 + e] = a; xcf[t * 68 + e] = bv;
    }
  }
  __syncthreads();
  float hl[16], al[16];
  float h = 0.f, ap = 1.f;
#pragma unroll
  for (int i = 0; i < 16; ++i) {
    const int t = w * 16 + i;
    const float a = af[t * 68 + lane], bv = xcf[t * 68 + lane];
    h = a * h + bv; ap *= a; hl[i] = h; al[i] = ap;
  }
  segH[w * 64 + lane] = h; segA[w * 64 + lane] = ap;
  __syncthreads();
  const int sidx = (b * NCH + c) * 256 + ch;
  if (!FINAL) {
    if (w == 0) {
      float H = 0.f, Ap = 1.f;
#pragma unroll
      for (int s = 0; s < 4; ++s) { H = segA[s * 64 + lane] * H + segH[s * 64 + lane]; Ap *= segA[s * 64 + lane]; }
      p.lru_h[sidx] = H; p.lru_a[sidx] = Ap;
    }
  } else {
    float H = p.lru_h[sidx];
#pragma unroll
    for (int s = 0; s < 4; ++s) if (s < w) H = segA[s * 64 + lane] * H + segH[s * 64 + lane];
    const bfu* pg = p.proj + (size_t)tok0 * PS + COL_CG + ch;
    bfu* pm = p.mixed + (size_t)tok0 * 1024 + 512 + ch;
#pragma unroll
    for (int i = 0; i < 16; ++i) {
      const int t = w * 16 + i;
      const float hv = hl[i] + al[i] * H;
      pm[(size_t)t * 1024] = f2bf(hv * silu_(bf2f(pg[(size_t)t * PS])));
    }
  }
}

template <bool FINAL>
DI void s5_item(const Params& p, int l, int b, int c, int g4, unsigned char* smem) {
  const int tid = threadIdx.x, lane = tid & 63, w = tid >> 6;
  const int g = g4 * 4 + w;
  float* buw = (float*)(smem + w * 13312);
  bfu* stw = (bfu*)(smem + w * 13312 + 8448);
  const int tok0 = b * SEQ + c * 64;
  const int r = lane & 15, q = lane >> 4;
  const int lg = l * 16 + g;
  bf16x8 bfr[8], yfr[4];
#pragma unroll
  for (int nt = 0; nt < 8; ++nt) bfr[nt] = *(const bf16x8*)(p.bt_bu + ((size_t)lg * 128 + nt * 16 + r) * 32 + q * 8);
  if (FINAL) {
#pragma unroll
    for (int ks = 0; ks < 4; ++ks) yfr[ks] = *(const bf16x8*)(p.bt_y + ((size_t)lg * 16 + r) * 128 + ks * 32 + q * 8);
  }
  const float ar = p.abar[(lg * 64 + lane) * 2], ai = p.abar[(lg * 64 + lane) * 2 + 1];
  const size_t sbase = ((size_t)(b * NCH + c) * 16 + g) * 128;
  float xr = 0.f, xi = 0.f;
  if (FINAL) { xr = p.s5_state[sbase + lane]; xi = p.s5_state[sbase + 64 + lane]; }
  const float dsk = FINAL ? p.s5_d[l * 256 + g * 16 + r] : 0.f;
  __syncthreads();
  for (int mt = 0; mt < 4; ++mt) {
    bf16x8 a = (bf16x8){0, 0, 0, 0, 0, 0, 0, 0};
    if (q < 2) a = *(const bf16x8*)(p.proj + (size_t)(tok0 + mt * 16 + r) * PS + COL_DU + g * 16 + q * 8);
#pragma unroll
    for (int nt = 0; nt < 8; ++nt) {
      f32x4 acc = (f32x4){0.f, 0.f, 0.f, 0.f};
      acc = __builtin_amdgcn_mfma_f32_16x16x32_bf16(a, bfr[nt], acc, 0, 0, 0);
#pragma unroll
      for (int j = 0; j < 4; ++j) buw[(q * 4 + j) * 132 + nt * 16 + r] = acc[j];
    }
    __syncthreads();
#pragma unroll
    for (int tt = 0; tt < 16; ++tt) {
      const float br = buw[tt * 132 + lane], bi = buw[tt * 132 + 64 + lane];
      const float nr = ar * xr - ai * xi + br;
      const float ni = ar * xi + ai * xr + bi;
      xr = nr; xi = ni;
      if (FINAL) { stw[tt * 136 + lane] = f2bf(xr); stw[tt * 136 + 64 + lane] = f2bf(xi); }
    }
    __syncthreads();
    if (FINAL) {
      f32x4 y = (f32x4){0.f, 0.f, 0.f, 0.f};
#pragma unroll
      for (int ks = 0; ks < 4; ++ks) {
        bf16x8 a2 = *(const bf16x8*)(stw + r * 136 + ks * 32 + q * 8);
        y = __builtin_amdgcn_mfma_f32_16x16x32_bf16(a2, yfr[ks], y, 0, 0, 0);
      }
#pragma unroll
      for (int j = 0; j < 4; ++j) {
        const int t = mt * 16 + q * 4 + j;
        const float u = bf2f(p.proj[(size_t)(tok0 + t) * PS + COL_DU + g * 16 + r]);
        const float z = gelu_tanh_(y[j] + dsk * u);
        p.zbuf[(size_t)(tok0 + t) * 256 + g * 16 + r] = f2bf(z);
      }
      __syncthreads();
    }
  }
  if (!FINAL) { p.s5_state[sbase + lane] = xr; p.s5_state[sbase + 64 + lane] = xi; }
}

DI void s5_glu(const Params& p, int l, int b, int c, unsigned char* smem) {
  const int tid = threadIdx.x, lane = tid & 63, w = tid >> 6;
  bfu* zs = (bfu*)smem;
  const int tok0 = b * SEQ + c * 64;
  __syncthreads();
  for (int i = tid; i < 64 * 32; i += 256) {
    const int t = i >> 5, kc = i & 31;
    *(uint4*)(zs + t * 264 + kc * 8) = *(const uint4*)(p.zbuf + (size_t)(tok0 + t) * 256 + kc * 8);
  }
  __syncthreads();
  const int r = lane & 15, q = lane >> 4;
  for (int nc = 0; nc < 4; ++nc) {
    f32x4 acc[4];
#pragma unroll
    for (int i = 0; i < 4; ++i) acc[i] = (f32x4){0.f, 0.f, 0.f, 0.f};
#pragma unroll 1
    for (int kh = 0; kh < 4; ++kh)
      wave_mma<4, 2>(acc, zs + w * 16 * 264 + kh * 64, 264, p.wt_glu + l * 65536 + nc * 64 * 256 + kh * 64, 256, lane);
#pragma unroll
    for (int nt = 0; nt < 4; ++nt) {
      const int n = nc * 64 + nt * 16 + r;
      const float bg = p.b_glu[l * 256 + n];
#pragma unroll
      for (int j = 0; j < 4; ++j) {
        const int t = w * 16 + q * 4 + j;
        const float zv = bf2f(zs[t * 264 + n]);
        const float gate = silu_(bf2f(p.proj[(size_t)(tok0 + t) * PS + COL_DG + n]));
        p.mixed[(size_t)(tok0 + t) * 1024 + 768 + n] = f2bf(zv * sigmoid_(acc[nt][j] + bg) * gate);
      }
    }
  }
}

DI void phase2(const Params& p, int l, unsigned char* smem) {
  for (int item = blockIdx.x; item < 1024; item += gridDim.x) hg_local(p, l, item >> 7, (item >> 2) & 31, item & 3, smem);
  for (int item = blockIdx.x; item < 1024; item += gridDim.x) ml_local(p, l, item >> 7, (item >> 2) & 31, item & 3, smem);
  for (int item = blockIdx.x; item < 1024; item += gridDim.x) lru_item<false>(p, l, item >> 7, (item >> 2) & 31, item & 3, smem);
  for (int item = blockIdx.x; item < 1024; item += gridDim.x) s5_item<false>(p, l, item >> 7, (item >> 2) & 31, item & 3, smem);
}

DI void phase3(const Params& p, int l) {
  const int gtid = blockIdx.x * 256 + threadIdx.x, gsz = gridDim.x * 256;
  constexpr int N1 = 131072, N2 = 131072, N3 = 2048, N4 = 2048, N5 = 8192;
  for (int i = gtid; i < N1 + N2 + N3 + N4 + N5; i += gsz) {
    if (i < N1 + N2) {
      const bool ml = i >= N1;
      const int j = ml ? i - N1 : i;
      const int b = j >> 14, rem = j & 16383, hd = rem >> 12, ed = rem & 4095, d = ed & 63;
      float* stp = ml ? p.ml_state : p.hg_state;
      float S = 0.f;
      for (int c = 0; c < NCH; ++c) {
        const int base = (b * NCH + c) * 4 + hd;
        const float dec = ml ? p.ml_decay[base] : p.hg_decay[base * 64 + d];
        const size_t idx = (size_t)base * 4096 + ed;
        const float loc = stp[idx];
        stp[idx] = S; S = dec * S + loc;
      }
    } else if (i < N1 + N2 + N3) {
      const int j = i - N1 - N2, b = j >> 8, rem = j & 255, hd = rem >> 6, d = rem & 63;
      float S = 0.f;
      for (int c = 0; c < NCH; ++c) {
        const int base = (b * NCH + c) * 4 + hd;
        const float dec = p.ml_decay[base];
        const float loc = p.ml_n[base * 64 + d];
        p.ml_n[base * 64 + d] = S; S = dec * S + loc;
      }
    } else if (i < N1 + N2 + N3 + N4) {
      const int j = i - N1 - N2 - N3, b = j >> 8, ch = j & 255;
      float H = 0.f;
      for (int c = 0; c < NCH; ++c) {
        const int idx = (b * NCH + c) * 256 + ch;
        const float a = p.lru_a[idx], hl = p.lru_h[idx];
        p.lru_h[idx] = H; H = a * H + hl;
      }
    } else {
      const int j = i - N1 - N2 - N3 - N4, b = j >> 10, g = (j >> 6) & 15, pp = j & 63;
      const float ar = p.abar64[((l * 16 + g) * 64 + pp) * 2], ai = p.abar64[((l * 16 + g) * 64 + pp) * 2 + 1];
      float xr = 0.f, xi = 0.f;
      for (int c = 0; c < NCH; ++c) {
        const size_t sb = ((size_t)(b * NCH + c) * 16 + g) * 128;
        const float lr = p.s5_state[sb + pp], li = p.s5_state[sb + 64 + pp];
        p.s5_state[sb + pp] = xr; p.s5_state[sb + 64 + pp] = xi;
        const float nr = ar * xr - ai * xi + lr, ni = ar * xi + ai * xr + li;
        xr = nr; xi = ni;
      }
    }
  }
}

DI void phase4(const Params& p, int l, unsigned char* smem) {
  unsigned* s_flag = (unsigned*)(smem + SMEM_BYTES - 16);
  for (int item = blockIdx.x; item < 1024; item += gridDim.x) {
    const int bc = item >> 2;
    s5_item<true>(p, l, bc >> 5, bc & 31, item & 3, smem);
    if (last_arriver(p.cnt + CNT_GLU + l * 256 + bc, 4u, s_flag)) s5_glu(p, l, bc >> 5, bc & 31, smem);
  }
  for (int item = blockIdx.x; item < 1024; item += gridDim.x) hg_out(p, l, item >> 7, (item >> 2) & 31, item & 3, smem);
  for (int item = blockIdx.x; item < 1024; item += gridDim.x) ml_out(p, l, item >> 7, (item >> 2) & 31, item & 3, smem);
  for (int item = blockIdx.x; item < 1024; item += gridDim.x) lru_item<true>(p, l, item >> 7, (item >> 2) & 31, item & 3, smem);
}

#define RUN_PHASE(PH, CALL)                                       \
  if (ph0 <= (PH) && (PH) < ph1) {                                \
    CALL;                                                         \
    if (COOP) { if ((PH) + 1 < ph1) cg::this_grid().sync(); }     \
  }

template <bool COOP, int L>
DI void run_layer(const Params& p, int ph0, int ph1, unsigned char* smem) {
  RUN_PHASE(1 + 5 * L, phase1(p, L, smem))
  RUN_PHASE(2 + 5 * L, phase2(p, L, smem))
  RUN_PHASE(3 + 5 * L, phase3(p, L))
  RUN_PHASE(4 + 5 * L, phase4(p, L, smem))
  RUN_PHASE(5 + 5 * L, phase5(p, L, smem))
}

template <bool COOP>
__global__ void __launch_bounds__(256, 2) mk_fwd(Params p, int ph0, int ph1) {
  __shared__ __attribute__((aligned(16))) unsigned char smem[SMEM_BYTES];
  RUN_PHASE(0, phase0(p, smem))
  run_layer<COOP, 0>(p, ph0, ph1, smem);
  run_layer<COOP, 1>(p, ph0, ph1, smem);
  run_layer<COOP, 2>(p, ph0, ph1, smem);
  run_layer<COOP, 3>(p, ph0, ph1, smem);
}

extern "C" void kernel_launch(void* const* d_in, const int* in_sizes, int n_in, void* d_out, int out_size, void* d_ws,
                              size_t ws_size, hipStream_t stream) {
  static int grid_blocks = 0;
  if (!grid_blocks) {
    int dev = 0, cus = 0, per_cu = 0;
    hipGetDevice(&dev);
    hipDeviceGetAttribute(&cus, hipDeviceAttributeMultiprocessorCount, dev);
    hipOccupancyMaxActiveBlocksPerMultiprocessor(&per_cu, mk_fwd<(MEGA != 0)>, 256, 0);
    if (per_cu < 1) per_cu = 1;
    if (per_cu > 2) per_cu = 2;
    grid_blocks = cus * per_cu;
  }
  Params p{};
  const float** pin = (const float**)&p;
  for (int i = 0; i < 28; ++i) pin[i] = (const float*)d_in[i];
  p.out = (float*)d_out;
  unsigned char* ws = (unsigned char*)d_ws;
  size_t off = 0;
  auto take = [&](size_t bytes) { unsigned char* r = ws + off; off += (bytes + 255) & ~(size_t)255; return r; };
  p.wt_in = (bfu*)take((size_t)4 * PS * 1024 * 2);
  p.wt_out = (bfu*)take((size_t)4 * 1024 * 1024 * 2);
  p.wt_a = (bfu*)take(16 * 4096 * 2);
  p.wt_x = (bfu*)take(16 * 4096 * 2);
  p.wt_glu = (bfu*)take(4 * 65536 * 2);
  p.bt_bu = (bfu*)take(64 * 128 * 32 * 2);
  p.bt_y = (bfu*)take(64 * 16 * 128 * 2);
  p.hb = (bfu*)take((size_t)NTOK * 1024 * 2);
  p.proj = (bfu*)take((size_t)NTOK * PS * 2);
  p.mixed = (bfu*)take((size_t)NTOK * 1024 * 2);
  p.zbuf = (bfu*)take((size_t)NTOK * 256 * 2);
  p.abar = (float*)take(4096 * 2 * 4);
  p.abar64 = (float*)take(4096 * 2 * 4);
  p.lbs = (float*)take(1024 * 4);
  p.hg_state = (float*)take((size_t)BATCH * NCH * 4 * 4096 * 4);
  p.hg_decay = (float*)take((size_t)BATCH * NCH * 4 * 64 * 4);
  p.ml_state = (float*)take((size_t)BATCH * NCH * 4 * 4096 * 4);
  p.ml_n = (float*)take((size_t)BATCH * NCH * 4 * 64 * 4);
  p.ml_decay = (float*)take((size_t)BATCH * NCH * 4 * 4);
  p.lru_h = (float*)take((size_t)BATCH * NCH * 256 * 4);
  p.lru_a = (float*)take((size_t)BATCH * NCH * 256 * 4);
  p.s5_state = (float*)take((size_t)BATCH * NCH * 16 * 128 * 4);
  p.cnt = (unsigned*)take(CNT_TOTAL * 4);
  if (off > ws_size) { fprintf(stderr, "workspace too small: need %zu have %zu\n", off, ws_size); return; }
  const int NPH = 1 + 5 * DEPTH;
#if MEGA
  int ph0 = 0, ph1 = NPH;
  void* args[] = {&p, &ph0, &ph1};
  hipError_t e = hipLaunchCooperativeKernel((void*)mk_fwd<true>, dim3(grid_blocks), dim3(256), args, 0, stream);
  if (e != hipSuccess) fprintf(stderr, "cooperative launch failed: %s (grid %d)\n", hipGetErrorString(e), grid_blocks);
#else
  for (int ph = 0; ph < NPH; ++ph) hipLaunchKernelGGL(mk_fwd<false>, dim3(grid_blocks), dim3(256), 0, stream, p, ph, ph + 1);
#endif
}
```

```cpp
#include <hip/hip_runtime.h>
#include <hip/hip_cooperative_groups.h>
#include <stdint.h>
#include <stdio.h>
namespace cg = cooperative_groups;

#ifndef MEGA
#define MEGA 1
#endif

typedef unsigned short bfu;
using bf16x8 = __attribute__((ext_vector_type(8))) short;
using f32x4  = __attribute__((ext_vector_type(4))) float;
#define DI __device__ __forceinline__

constexpr int BATCH = 8, SEQ = 2048, DM = 1024, DEPTH = 4, NTOK = BATCH * SEQ, NCH = SEQ / 64;
constexpr int DIN = 3080, PS = 3200;
constexpr int COL_AQ = 0, COL_AF = 256, COL_AI = 512, COL_AG = 768;
constexpr int COL_BQ = 1024, COL_BK = 1280, COL_BV = 1536, COL_BIG = 1792, COL_BFG = 1796, COL_BG = 1800;
constexpr int COL_CX = 2056, COL_CG = 2312, COL_DU = 2568, COL_DG = 2824;
constexpr float DN_ALPHA = 1.681792830507429f;
constexpr int SMEM_BYTES = 56 * 1024;
constexpr int CNT_LN = 0, CNT_GLU = 4 * 128, CNT_TOTAL = 4 * 128 + 4 * 256;

struct Params {
  const float *x, *w_in, *b_in, *lb_logits, *hg_g, *ml_fb, *ml_g, *conv_w, *conv_b, *w_a, *b_a, *w_x, *b_x, *lam,
      *a_re, *a_im, *log_dt, *sb_re, *sb_im, *c_re, *c_im, *s5_d, *w_glu, *b_glu, *w_out, *b_out, *ln_g, *ln_b;
  float* out;
  bfu *wt_in, *wt_out, *wt_a, *wt_x, *wt_glu, *bt_bu, *bt_y, *hb, *proj, *mixed, *zbuf;
  float *abar, *abar64, *lbs, *hg_state, *hg_decay, *ml_state, *ml_n, *ml_decay, *lru_h, *lru_a, *s5_state;
  unsigned* cnt;
  unsigned* bar;
};

DI bfu f2bf(float x) { unsigned u = __float_as_uint(x); u += 0x7fffu + ((u >> 16) & 1u); return (bfu)(u >> 16); }
DI float bf2f(bfu h) { return __uint_as_float(((unsigned)h) << 16); }
DI unsigned pack2(float a, float b) { return (unsigned)f2bf(a) | ((unsigned)f2bf(b) << 16); }
DI float sigmoid_(float x) { return 1.f / (1.f + expf(-x)); }
DI float silu_(float x) { return x / (1.f + expf(-x)); }
DI float logsig_(float x) { return fminf(x, 0.f) - log1pf(expf(-fabsf(x))); }
DI float gelu_tanh_(float x) {
  float u = 0.7978845608028654f * (x + 0.044715f * x * x * x);
  float th = 1.f - 2.f / (expf(2.f * u) + 1.f);
  return 0.5f * x * (1.f + th);
}

template <int NT, int KS>
DI void wave_mma(f32x4 (&acc)[NT], const bfu* A, int lda, const bfu* Bt, int ldb, int lane) {
  const int r = lane & 15, q = lane >> 4;
#pragma unroll
  for (int ks = 0; ks < KS; ++ks) {
    bf16x8 a = *(const bf16x8*)(A + r * lda + ks * 32 + q * 8);
#pragma unroll
    for (int nt = 0; nt < NT; ++nt) {
      bf16x8 b = *(const bf16x8*)(Bt + (nt * 16 + r) * ldb + ks * 32 + q * 8);
      acc[nt] = __builtin_amdgcn_mfma_f32_16x16x32_bf16(a, b, acc[nt], 0, 0, 0);
    }
  }
}

DI float group16_sum(float v) {
  v += __shfl_xor(v, 1); v += __shfl_xor(v, 2); v += __shfl_xor(v, 4); v += __shfl_xor(v, 8);
  return v;
}
DI float wave_sum(float v) {
  v += __shfl_xor(v, 1); v += __shfl_xor(v, 2); v += __shfl_xor(v, 4); v += __shfl_xor(v, 8);
  v += __shfl_xor(v, 16); v += __shfl_xor(v, 32);
  return v;
}

DI bool last_arriver(unsigned* ctr, unsigned total, unsigned* s_flag) {
  __threadfence();
  __syncthreads();
  if (threadIdx.x == 0) { unsigned old = atomicAdd(ctr, 1u); *s_flag = (old == total - 1u) ? 1u : 0u; }
  __syncthreads();
  bool last = (*s_flag != 0u);
  if (last) __threadfence();
  return last;
}

#define XB_TMO      128
#define XB_XCNT(j)  (256  + 64 * (j))
#define XB_XSUB(j)  (1280 + 64 * (j))
#define XB_XGEN(j)  (2304 + 64 * (j))
#define XB_TOP      3328
#define XB_TOPGEN   3392
#define XCD_BAR_WORDS 3456
#define XB_SPIN_CAP (1u << 22)
#define LAS __attribute__((address_space(3)))
DI unsigned xb_ld(unsigned* p) { return __hip_atomic_load(p, __ATOMIC_RELAXED, __HIP_MEMORY_SCOPE_AGENT); }
DI unsigned xb_add(unsigned* p, unsigned v) { return __hip_atomic_fetch_add(p, v, __ATOMIC_RELAXED, __HIP_MEMORY_SCOPE_AGENT); }
DI unsigned xb_xcc_id() { return (unsigned)__builtin_amdgcn_s_getreg((3 << 11) | 20) & 0xFu; }
#define XB_SPIN(cond, bar) do { unsigned _sp = 0; while (cond) { __builtin_amdgcn_s_sleep(1); \
    if ((++_sp & 255u) == 0u) { if (xb_ld(&(bar)[XB_TMO])) break; if (_sp > XB_SPIN_CAP) { atomicAdd(&(bar)[XB_TMO], 1u); break; } } } } while (0)
struct XcdBarrier { unsigned* bar; unsigned x; volatile LAS unsigned* st; };
DI XcdBarrier xcd_barrier_post(unsigned* bar, volatile LAS unsigned* st) {
  XcdBarrier b; b.bar = bar; b.x = xb_xcc_id(); b.st = st;
  if (threadIdx.x == 0) (void)xb_add(&bar[XB_XCNT(b.x)], 1u);
  return b;
}
DI void xcd_barrier_complete(unsigned* bar, unsigned x, unsigned& nloc, unsigned& nx) {
  const unsigned G = gridDim.x * gridDim.y * gridDim.z;
  unsigned sum, cnt, mine, sp = 0u;
  for (;;) {
    sum = 0u; cnt = 0u; mine = 0u;
#pragma unroll
    for (unsigned j = 0; j < 16; ++j) { const unsigned c = xb_ld(&bar[XB_XCNT(j)]); sum += c; cnt += (c > 0u) ? 1u : 0u; mine = (j == x) ? c : mine; }
    if (sum == G) break;
    __builtin_amdgcn_s_sleep(1);
    if ((++sp & 255u) == 0u) { if (xb_ld(&bar[XB_TMO])) break; if (sp > XB_SPIN_CAP) { atomicAdd(&bar[XB_TMO], 1u); break; } }
  }
  nloc = mine > 0u ? mine : 1u; nx = cnt > 0u ? cnt : 1u;
}
DI void xcd_barrier(const XcdBarrier& b) {
  asm volatile("s_waitcnt vmcnt(0)" ::: "memory");
  __syncthreads();
  if (threadIdx.x == 0) {
    unsigned* bar = b.bar;
    __builtin_amdgcn_s_waitcnt(0);
    unsigned nloc = b.st[0], nx = b.st[1];
    if (nloc == 0u) { xcd_barrier_complete(bar, b.x, nloc, nx); b.st[0] = nloc; b.st[1] = nx; }
    const unsigned old = xb_add(&bar[XB_XSUB(b.x)], 1u);
    const unsigned gen = old / nloc;
    if (old + 1u == (gen + 1u) * nloc) {
      __builtin_amdgcn_fence(__ATOMIC_RELEASE, "agent");
      asm volatile("s_waitcnt vmcnt(0)" ::: "memory");
      const unsigned og = xb_add(&bar[XB_TOP], 1u);
      const unsigned tg = og / nx;
      if (og + 1u == (tg + 1u) * nx) xb_add(&bar[XB_TOPGEN], 1u);
      else XB_SPIN(xb_ld(&bar[XB_TOPGEN]) == tg, bar);
      __builtin_amdgcn_fence(__ATOMIC_ACQUIRE, "agent");
      xb_add(&bar[XB_XGEN(b.x)], 1u);
      asm volatile("s_waitcnt vmcnt(0)" ::: "memory");
    } else {
      XB_SPIN(xb_ld(&bar[XB_XGEN(b.x)]) == gen, bar);
      __builtin_amdgcn_fence(__ATOMIC_ACQUIRE, "agent");
      asm volatile("s_waitcnt vmcnt(0)" ::: "memory");
    }
  }
  __syncthreads();
}

DI void transpose_tile(const float* src, int sld, int cv, bfu* dst, int dld, float* tile) {
  const int tid = threadIdx.x;
  __syncthreads();
  for (int i = tid; i < 4096; i += 256) {
    int r = i >> 6, c = i & 63;
    tile[r * 65 + c] = (c < cv) ? src[(size_t)r * sld + c] : 0.f;
  }
  __syncthreads();
  for (int i = tid; i < 4096; i += 256) {
    int n = i >> 6, k = i & 63;
    dst[(size_t)n * dld + k] = f2bf(tile[k * 65 + n]);
  }
}

DI void phase0(const Params& p, unsigned char* smem) {
  const int tid = threadIdx.x;
  const int gtid = blockIdx.x * 256 + tid, gsz = gridDim.x * 256;
  for (int i = gtid; i < NTOK * DM / 8; i += gsz) {
    float4 a = ((const float4*)p.x)[2 * i], b = ((const float4*)p.x)[2 * i + 1];
    uint4 o; o.x = pack2(a.x, a.y); o.y = pack2(a.z, a.w); o.z = pack2(b.x, b.y); o.w = pack2(b.z, b.w);
    ((uint4*)p.hb)[i] = o;
  }
  float* tile = (float*)smem;
  const int NJ = 3200 + 1024 + 16 + 16 + 64;
  for (int job = blockIdx.x; job < NJ; job += gridDim.x) {
    const float* src; int sld, cv = 64, dld; bfu* dst;
    if (job < 3200) {
      int l = job / 800, rem = job % 800, kt = rem / 50, nt = rem % 50;
      src = p.w_in + (size_t)l * 1024 * DIN + (size_t)kt * 64 * DIN + nt * 64; sld = DIN;
      cv = DIN - nt * 64; cv = cv < 0 ? 0 : (cv > 64 ? 64 : cv);
      dst = p.wt_in + (size_t)l * PS * 1024 + (size_t)nt * 64 * 1024 + kt * 64; dld = 1024;
    } else if (job < 4224) {
      int j = job - 3200, l = j / 256, rem = j % 256, kt = rem / 16, nt = rem % 16;
      src = p.w_out + (size_t)l * 1048576 + (size_t)kt * 64 * 1024 + nt * 64; sld = 1024;
      dst = p.wt_out + (size_t)l * 1048576 + (size_t)nt * 64 * 1024 + kt * 64; dld = 1024;
    } else if (job < 4240) {
      int j = job - 4224; src = p.w_a + j * 4096; sld = 64; dst = p.wt_a + j * 4096; dld = 64;
    } else if (job < 4256) {
      int j = job - 4240; src = p.w_x + j * 4096; sld = 64; dst = p.wt_x + j * 4096; dld = 64;
    } else {
      int j = job - 4256, l = j / 16, rem = j % 16, kt = rem / 4, nt = rem % 4;
      src = p.w_glu + l * 65536 + kt * 64 * 256 + nt * 64; sld = 256;
      dst = p.wt_glu + l * 65536 + nt * 64 * 256 + kt * 64; dld = 256;
    }
    transpose_tile(src, sld, cv, dst, dld, tile);
  }
  for (int i = gtid; i < 4096; i += gsz) {
    int lg = i >> 6, pp = i & 63;
    double dt = exp((double)p.log_dt[lg]);
    double are = p.a_re[lg * 64 + pp], aim = p.a_im[lg * 64 + pp];
    double mag = exp(dt * are), ang = dt * aim;
    double abr = mag * cos(ang), abi = mag * sin(ang);
    double den = are * are + aim * aim;
    double xr = abr - 1.0, xi = abi;
    double zr = (xr * are + xi * aim) / den, zi = (xi * are - xr * aim) / den;
    bfu* o_re = p.bt_bu + ((size_t)lg * 128 + pp) * 32;
    bfu* o_im = p.bt_bu + ((size_t)lg * 128 + 64 + pp) * 32;
    for (int h = 0; h < 16; ++h) {
      double br = p.sb_re[(lg * 64 + pp) * 16 + h], bi = p.sb_im[(lg * 64 + pp) * 16 + h];
      o_re[h] = f2bf((float)(zr * br - zi * bi));
      o_im[h] = f2bf((float)(zr * bi + zi * br));
      o_re[16 + h] = 0; o_im[16 + h] = 0;
    }
    p.abar[(lg * 64 + pp) * 2 + 0] = (float)abr; p.abar[(lg * 64 + pp) * 2 + 1] = (float)abi;
    double mag64 = exp(64.0 * dt * are), ang64 = 64.0 * ang;
    p.abar64[(lg * 64 + pp) * 2 + 0] = (float)(mag64 * cos(ang64));
    p.abar64[(lg * 64 + pp) * 2 + 1] = (float)(mag64 * sin(ang64));
  }
  for (int i = gtid; i < 4 * 16 * 16 * 128; i += gsz) {
    int k = i & 127, lgn = i >> 7;
    p.bt_y[i] = (k < 64) ? f2bf(p.c_re[lgn * 64 + k]) : f2bf(-p.c_im[lgn * 64 + (k - 64)]);
  }
  for (int i = gtid; i < 256; i += gsz) {
    float v0 = p.lb_logits[i], v1 = p.lb_logits[256 + i], v2 = p.lb_logits[512 + i], v3 = p.lb_logits[768 + i];
    float m = fmaxf(fmaxf(v0, v1), fmaxf(v2, v3));
    float e0 = expf(v0 - m), e1 = expf(v1 - m), e2 = expf(v2 - m), e3 = expf(v3 - m);
    float s = e0 + e1 + e2 + e3;
    p.lbs[i] = 0.f; p.lbs[256 + i] = e1 / s; p.lbs[512 + i] = (e1 + e2) / s; p.lbs[768 + i] = (e1 + e2 + e3) / s;
  }
  for (int i = gtid; i < CNT_TOTAL; i += gsz) p.cnt[i] = 0u;
}

template <int EPI>
DI void gemm_tile(const Params& p, int l, const bfu* A, const bfu* Bt, int m0, int n0, const float* hin, unsigned char* smem) {
  bfu* sA = (bfu*)smem; bfu* sB = sA + 128 * 72;
  const int tid = threadIdx.x, lane = tid & 63, w = tid >> 6, wm = w >> 1, wn = w & 1;
  const int r = lane & 15, q = lane >> 4;
  f32x4 acc[4][4];
#pragma unroll
  for (int i = 0; i < 4; ++i)
#pragma unroll
    for (int j = 0; j < 4; ++j) acc[i][j] = (f32x4){0.f, 0.f, 0.f, 0.f};
  const int lrow = tid >> 3, lkc = tid & 7;
  const bfu* ga = A + (size_t)(m0 + lrow) * 1024 + lkc * 8;
  const bfu* gb = Bt + (size_t)(n0 + lrow) * 1024 + lkc * 8;
  uint4 ra0 = *(const uint4*)(ga), ra1 = *(const uint4*)(ga + 32 * 1024), ra2 = *(const uint4*)(ga + 64 * 1024), ra3 = *(const uint4*)(ga + 96 * 1024);
  uint4 rb0 = *(const uint4*)(gb), rb1 = *(const uint4*)(gb + 32 * 1024), rb2 = *(const uint4*)(gb + 64 * 1024), rb3 = *(const uint4*)(gb + 96 * 1024);
  bfu* wa = sA + lrow * 72 + lkc * 8;
  bfu* wb = sB + lrow * 72 + lkc * 8;
  for (int kt = 0; kt < 16; ++kt) {
    __syncthreads();
    *(uint4*)(wa) = ra0; *(uint4*)(wa + 32 * 72) = ra1; *(uint4*)(wa + 64 * 72) = ra2; *(uint4*)(wa + 96 * 72) = ra3;
    *(uint4*)(wb) = rb0; *(uint4*)(wb + 32 * 72) = rb1; *(uint4*)(wb + 64 * 72) = rb2; *(uint4*)(wb + 96 * 72) = rb3;
    __syncthreads();
    if (kt + 1 < 16) {
      const bfu* ga2 = ga + (kt + 1) * 64; const bfu* gb2 = gb + (kt + 1) * 64;
      ra0 = *(const uint4*)(ga2); ra1 = *(const uint4*)(ga2 + 32 * 1024); ra2 = *(const uint4*)(ga2 + 64 * 1024); ra3 = *(const uint4*)(ga2 + 96 * 1024);
      rb0 = *(const uint4*)(gb2); rb1 = *(const uint4*)(gb2 + 32 * 1024); rb2 = *(const uint4*)(gb2 + 64 * 1024); rb3 = *(const uint4*)(gb2 + 96 * 1024);
    }
#pragma unroll
    for (int ks = 0; ks < 2; ++ks) {
      bf16x8 af[4], bfr[4];
#pragma unroll
      for (int mt = 0; mt < 4; ++mt) af[mt] = *(const bf16x8*)(sA + (wm * 64 + mt * 16 + r) * 72 + ks * 32 + q * 8);
#pragma unroll
      for (int nt = 0; nt < 4; ++nt) bfr[nt] = *(const bf16x8*)(sB + (wn * 64 + nt * 16 + r) * 72 + ks * 32 + q * 8);
#pragma unroll
      for (int mt = 0; mt < 4; ++mt)
#pragma unroll
        for (int nt = 0; nt < 4; ++nt) acc[mt][nt] = __builtin_amdgcn_mfma_f32_16x16x32_bf16(af[mt], bfr[nt], acc[mt][nt], 0, 0, 0);
    }
  }
#pragma unroll
  for (int nt = 0; nt < 4; ++nt) {
    const int col = n0 + wn * 64 + nt * 16 + r;
    if (EPI == 1) {
      const float bias = (col < DIN) ? p.b_in[l * DIN + col] : 0.f;
#pragma unroll
      for (int mt = 0; mt < 4; ++mt)
#pragma unroll
        for (int j = 0; j < 4; ++j) {
          const int row = m0 + wm * 64 + mt * 16 + q * 4 + j;
          p.proj[(size_t)row * PS + col] = f2bf(acc[mt][nt][j] + bias);
        }
    } else {
      const float bias = p.b_out[l * 1024 + col];
#pragma unroll
      for (int mt = 0; mt < 4; ++mt)
#pragma unroll
        for (int j = 0; j < 4; ++j) {
          const int row = m0 + wm * 64 + mt * 16 + q * 4 + j;
          const size_t o = (size_t)row * 1024 + col;
          p.out[o] = DN_ALPHA * hin[o] + acc[mt][nt][j] + bias;
        }
    }
  }
}

DI void phase1(const Params& p, int l, unsigned char* smem) {
  const bfu* Bt = p.wt_in + (size_t)l * PS * 1024;
  for (int tile = blockIdx.x; tile < 128 * 25; tile += gridDim.x) {
    int mt = tile / 25, nt = tile % 25;
    gemm_tile<1>(p, l, p.hb, Bt, mt * 128, nt * 128, nullptr, smem);
  }
}

DI void phase5(const Params& p, int l, unsigned char* smem) {
  const bfu* Bt = p.wt_out + (size_t)l * 1048576;
  const float* hin = (l == 0) ? p.x : p.out;
  unsigned* s_flag = (unsigned*)(smem + SMEM_BYTES - 16);
  const int tid = threadIdx.x, lane = tid & 63, w = tid >> 6;
  for (int tile = blockIdx.x; tile < 128 * 8; tile += gridDim.x) {
    int mt = tile >> 3, nt = tile & 7;
    gemm_tile<2>(p, l, p.mixed, Bt, mt * 128, nt * 128, hin, smem);
    if (last_arriver(p.cnt + CNT_LN + l * 128 + mt, 8u, s_flag)) {
      for (int rr = 0; rr < 32; ++rr) {
        const int row = mt * 128 + w * 32 + rr;
        float4 v[4];
        float s = 0.f;
#pragma unroll
        for (int i = 0; i < 4; ++i) {
          v[i] = *(const float4*)(p.out + (size_t)row * 1024 + i * 256 + lane * 4);
          s += v[i].x + v[i].y + v[i].z + v[i].w;
        }
        const float mu = wave_sum(s) * (1.f / 1024.f);
        float ss = 0.f;
#pragma unroll
        for (int i = 0; i < 4; ++i) {
          v[i].x -= mu; v[i].y -= mu; v[i].z -= mu; v[i].w -= mu;
          ss += v[i].x * v[i].x + v[i].y * v[i].y + v[i].z * v[i].z + v[i].w * v[i].w;
        }
        const float rs = rsqrtf(wave_sum(ss) * (1.f / 1024.f) + 1e-5f);
#pragma unroll
        for (int i = 0; i < 4; ++i) {
          const int c = i * 256 + lane * 4;
          const float4 g = *(const float4*)(p.ln_g + l * 1024 + c);
          const float4 bb = *(const float4*)(p.ln_b + l * 1024 + c);
          float4 o;
          o.x = v[i].x * rs * g.x + bb.x; o.y = v[i].y * rs * g.y + bb.y;
          o.z = v[i].z * rs * g.z + bb.z; o.w = v[i].w * rs * g.w + bb.w;
          *(float4*)(p.out + (size_t)row * 1024 + c) = o;
          uint2 ob; ob.x = pack2(o.x, o.y); ob.y = pack2(o.z, o.w);
          *(uint2*)(p.hb + (size_t)row * 1024 + c) = ob;
        }
      }
    }
  }
}

DI void hg_gate(float x, float lb, float& lf, float& k) {
  const float sneg = 1.f / (1.f + expf(x));
  k = (1.f - lb) * sneg;
  if (lb > 0.f) lf = log1pf(-k); else lf = logsig_(x);
}

DI void hg_local(const Params& p, int l, int b, int c, int hd, unsigned char* smem) {
  const int tid = threadIdx.x, lane = tid & 63, w = tid >> 6;
  bfu* At = (bfu*)smem;
  bfu* Bt = At + 64 * 72;
  float* segtot = (float*)(smem + 2 * 64 * 72 * 2);
  const int tok0 = b * SEQ + c * 64;
  const int d = lane;
  const float lb = p.lbs[l * 256 + hd * 64 + d];
  const bfu* pf = p.proj + (size_t)tok0 * PS + COL_AF + hd * 64 + d;
  const bfu* pv = p.proj + (size_t)tok0 * PS + COL_AI + hd * 64 + d;
  float bl[16], kk[16];
  float run = 0.f;
  __syncthreads();
#pragma unroll
  for (int i = 0; i < 16; ++i) {
    const int t = w * 16 + i;
    float lf, k; hg_gate(bf2f(pf[(size_t)t * PS]), lb, lf, k);
    run += lf; bl[i] = run; kk[i] = k;
    At[d * 72 + t] = pv[(size_t)t * PS];
  }
  segtot[w * 64 + d] = run;
  __syncthreads();
  float off = 0.f, tot = 0.f;
#pragma unroll
  for (int s = 0; s < 4; ++s) { float v = segtot[s * 64 + d]; tot += v; if (s < w) off += v; }
#pragma unroll
  for (int i = 0; i < 16; ++i) { const int t = w * 16 + i; Bt[d * 72 + t] = f2bf(kk[i] * expf(tot - (bl[i] + off))); }
  const int base = (b * NCH + c) * 4 + hd;
  if (w == 0) p.hg_decay[base * 64 + d] = expf(tot);
  __syncthreads();
  f32x4 acc[4];
#pragma unroll
  for (int i = 0; i < 4; ++i) acc[i] = (f32x4){0.f, 0.f, 0.f, 0.f};
  wave_mma<4, 2>(acc, At + w * 16 * 72, 72, Bt, 72, lane);
  float* st = p.hg_state + (size_t)base * 4096;
  const int r = lane & 15, q = lane >> 4;
#pragma unroll
  for (int nt = 0; nt < 4; ++nt)
#pragma unroll
    for (int j = 0; j < 4; ++j) st[(w * 16 + q * 4 + j) * 64 + nt * 16 + r] = acc[nt][j];
}

constexpr int O_A = 0, O_BT = 17408, O_QP = 34816, O_KP = 44032, O_MISC = 53248;

DI void hg_out(const Params& p, int l, int b, int c, int hd, unsigned char* smem) {
  const int tid = threadIdx.x, lane = tid & 63, w = tid >> 6;
  bfu* A = (bfu*)(smem + O_A); bfu* Bt = (bfu*)(smem + O_BT); bfu* Qp = (bfu*)(smem + O_QP); bfu* Kp = (bfu*)(smem + O_KP);
  float* segtot = (float*)(smem + O_MISC);
  const int tok0 = b * SEQ + c * 64;
  const int d = lane;
  const float lb = p.lbs[l * 256 + hd * 64 + d];
  const bfu* pq = p.proj + (size_t)tok0 * PS + COL_AQ + hd * 64 + d;
  const bfu* pf = p.proj + (size_t)tok0 * PS + COL_AF + hd * 64 + d;
  const bfu* pv = p.proj + (size_t)tok0 * PS + COL_AI + hd * 64 + d;
  const int base = (b * NCH + c) * 4 + hd;
  const float* st = p.hg_state + (size_t)base * 4096;
  float bl[16], kk[16];
  float run = 0.f;
  __syncthreads();
#pragma unroll
  for (int i = 0; i < 16; ++i) {
    const int t = w * 16 + i;
    float lf, k; hg_gate(bf2f(pf[(size_t)t * PS]), lb, lf, k);
    run += lf; bl[i] = run; kk[i] = k;
    Bt[d * 136 + t] = pv[(size_t)t * PS];
    const int e = w + 4 * i;
    Bt[e * 136 + 64 + d] = f2bf(st[e * 64 + d]);
  }
  segtot[w * 64 + d] = run;
  __syncthreads();
  float off = 0.f;
#pragma unroll
  for (int s = 0; s < 4; ++s) { float v = segtot[s * 64 + d]; if (s < w) off += v; }
  const float bm = segtot[d] + segtot[64 + d];
#pragma unroll
  for (int i = 0; i < 16; ++i) {
    const int t = w * 16 + i;
    const float bt = bl[i] + off;
    const float qv = silu_(bf2f(pq[(size_t)t * PS]));
    Qp[t * 72 + d] = f2bf(qv * expf(fmaxf(bt - bm, -80.f)));
    Kp[t * 72 + d] = f2bf(kk[i] * expf(fminf(bm - bt, 80.f)));
    A[t * 136 + 64 + d] = f2bf(qv * expf(bt));
  }
  __syncthreads();
  const int r = lane & 15, q = lane >> 4;
  f32x4 acc[4];
#pragma unroll
  for (int i = 0; i < 4; ++i) acc[i] = (f32x4){0.f, 0.f, 0.f, 0.f};
  wave_mma<4, 2>(acc, Qp + w * 16 * 72, 72, Kp, 72, lane);
#pragma unroll
  for (int nt = 0; nt < 4; ++nt)
#pragma unroll
    for (int j = 0; j < 4; ++j) {
      const int t = w * 16 + q * 4 + j, s = nt * 16 + r;
      A[t * 136 + s] = f2bf(s <= t ? acc[nt][j] : 0.f);
    }
  __syncthreads();
  f32x4 o[4];
#pragma unroll
  for (int i = 0; i < 4; ++i) o[i] = (f32x4){0.f, 0.f, 0.f, 0.f};
  wave_mma<4, 4>(o, A + w * 16 * 136, 136, Bt, 136, lane);
#pragma unroll
  for (int j = 0; j < 4; ++j) {
    float ss = 0.f;
#pragma unroll
    for (int nt = 0; nt < 4; ++nt) ss += o[nt][j] * o[nt][j];
    ss = group16_sum(ss);
    const float sc = rsqrtf(ss * (1.f / 64.f) + 1e-6f);
    const int t = w * 16 + q * 4 + j;
    const bfu* prow = p.proj + (size_t)(tok0 + t) * PS + COL_AG + hd * 64;
    bfu* mrow = p.mixed + (size_t)(tok0 + t) * 1024 + hd * 64;
#pragma unroll
    for (int nt = 0; nt < 4; ++nt) {
      const int e = nt * 16 + r;
      mrow[e] = f2bf(o[nt][j] * sc * p.hg_g[l * 256 + hd * 64 + e] * silu_(bf2f(prow[e])));
    }
  }
}

DI void ml_gates(const Params& p, int l, int tok0, int hd, float* bs, float* igs, int tid) {
  if (tid < 64) {
    const bfu* row = p.proj + (size_t)(tok0 + tid) * PS;
    const float ig = bf2f(row[COL_BIG + hd]);
    const float fg = bf2f(row[COL_BFG + hd]) + p.ml_fb[l * 4 + hd];
    float lf = logsig_(fg);
#pragma unroll
    for (int o = 1; o < 64; o <<= 1) { float v = __shfl_up(lf, o); if (tid >= o) lf += v; }
    bs[tid] = lf; igs[tid] = ig;
  }
}

DI void ml_local(const Params& p, int l, int b, int c, int hd, unsigned char* smem) {
  const int tid = threadIdx.x, lane = tid & 63, w = tid >> 6;
  bfu* At = (bfu*)smem;
  bfu* Bt = At + 64 * 72;
  float* bs = (float*)(smem + 2 * 64 * 72 * 2);
  float* igs = bs + 64; float* nseg = igs + 64;
  const int tok0 = b * SEQ + c * 64;
  const int d = lane;
  __syncthreads();
  ml_gates(p, l, tok0, hd, bs, igs, tid);
  __syncthreads();
  const float blast = bs[63];
  const bfu* pk = p.proj + (size_t)tok0 * PS + COL_BK + hd * 64 + d;
  const bfu* pv = p.proj + (size_t)tok0 * PS + COL_BV + hd * 64 + d;
  float nacc = 0.f;
#pragma unroll
  for (int i = 0; i < 16; ++i) {
    const int s = w * 16 + i;
    const float ws = expf(blast - bs[s] + igs[s]);
    const float kw = bf2f(pk[(size_t)s * PS]) * 0.125f * ws;
    Bt[d * 72 + s] = f2bf(kw); nacc += kw;
    At[d * 72 + s] = pv[(size_t)s * PS];
  }
  nseg[w * 64 + d] = nacc;
  __syncthreads();
  const int base = (b * NCH + c) * 4 + hd;
  if (w == 0) p.ml_n[base * 64 + d] = nseg[d] + nseg[64 + d] + nseg[128 + d] + nseg[192 + d];
  if (tid == 0) p.ml_decay[base] = expf(blast);
  f32x4 acc[4];
#pragma unroll
  for (int i = 0; i < 4; ++i) acc[i] = (f32x4){0.f, 0.f, 0.f, 0.f};
  wave_mma<4, 2>(acc, At + w * 16 * 72, 72, Bt, 72, lane);
  float* st = p.ml_state + (size_t)base * 4096;
  const int r = lane & 15, q = lane >> 4;
#pragma unroll
  for (int nt = 0; nt < 4; ++nt)
#pragma unroll
    for (int j = 0; j < 4; ++j) st[(w * 16 + q * 4 + j) * 64 + nt * 16 + r] = acc[nt][j];
}

DI void ml_out(const Params& p, int l, int b, int c, int hd, unsigned char* smem) {
  const int tid = threadIdx.x, lane = tid & 63, w = tid >> 6;
  bfu* A = (bfu*)(smem + O_A); bfu* Bt = (bfu*)(smem + O_BT); bfu* Qp = (bfu*)(smem + O_QP); bfu* Kp = (bfu*)(smem + O_KP);
  float* bs = (float*)(smem + O_MISC); float* igs = bs + 64; float* npv = igs + 64; float* den2 = npv + 64;
  const int tok0 = b * SEQ + c * 64;
  const int d = lane;
  const int base = (b * NCH + c) * 4 + hd;
  const float* st = p.ml_state + (size_t)base * 4096;
  __syncthreads();
  ml_gates(p, l, tok0, hd, bs, igs, tid);
  if (tid >= 64 && tid < 128) npv[tid - 64] = p.ml_n[base * 64 + tid - 64];
  __syncthreads();
  const bfu* pq = p.proj + (size_t)tok0 * PS + COL_BQ + hd * 64 + d;
  const bfu* pk = p.proj + (size_t)tok0 * PS + COL_BK + hd * 64 + d;
  const bfu* pv = p.proj + (size_t)tok0 * PS + COL_BV + hd * 64 + d;
#pragma unroll
  for (int i = 0; i < 16; ++i) {
    const int t = w * 16 + i;
    const bfu qraw = pq[(size_t)t * PS];
    Qp[t * 72 + d] = qraw;
    Kp[t * 72 + d] = pk[(size_t)t * PS];
    A[t * 136 + 64 + d] = f2bf(bf2f(qraw) * expf(bs[t]));
    Bt[d * 136 + t] = pv[(size_t)t * PS];
    const int e = w + 4 * i;
    Bt[e * 136 + 64 + d] = f2bf(st[e * 64 + d]);
  }
  __syncthreads();
  if (tid < 64) {
    float s = 0.f;
    for (int dd = 0; dd < 64; ++dd) s += bf2f(A[tid * 136 + 64 + dd]) * npv[dd];
    den2[tid] = s;
  }
  const int r = lane & 15, q = lane >> 4;
  f32x4 acc[4];
#pragma unroll
  for (int i = 0; i < 4; ++i) acc[i] = (f32x4){0.f, 0.f, 0.f, 0.f};
  wave_mma<4, 2>(acc, Qp + w * 16 * 72, 72, Kp, 72, lane);
  float den1[4];
#pragma unroll
  for (int j = 0; j < 4; ++j) {
    const int t = w * 16 + q * 4 + j;
    const float bt = bs[t];
    float rs = 0.f;
#pragma unroll
    for (int nt = 0; nt < 4; ++nt) {
      const int s = nt * 16 + r;
      float wv = 0.f;
      if (s <= t) wv = expf(bt - bs[s] + igs[s]) * acc[nt][j] * 0.125f;
      rs += wv;
      A[t * 136 + s] = f2bf(wv);
    }
    den1[j] = group16_sum(rs);
  }
  __syncthreads();
  f32x4 o[4];
#pragma unroll
  for (int i = 0; i < 4; ++i) o[i] = (f32x4){0.f, 0.f, 0.f, 0.f};
  wave_mma<4, 4>(o, A + w * 16 * 136, 136, Bt, 136, lane);
#pragma unroll
  for (int j = 0; j < 4; ++j) {
    const int t = w * 16 + q * 4 + j;
    const float den = den1[j] + den2[t];
    const float inv = 1.f / fmaxf(fabsf(den), 1.f);
    float hv[4];
    float ss = 0.f;
#pragma unroll
    for (int nt = 0; nt < 4; ++nt) { hv[nt] = o[nt][j] * inv; ss += hv[nt] * hv[nt]; }
    ss = group16_sum(ss);
    const float sc = rsqrtf(ss * (1.f / 64.f) + 1e-6f);
    const bfu* prow = p.proj + (size_t)(tok0 + t) * PS + COL_BG + hd * 64;
    bfu* mrow = p.mixed + (size_t)(tok0 + t) * 1024 + 256 + hd * 64;
#pragma unroll
    for (int nt = 0; nt < 4; ++nt) {
      const int e = nt * 16 + r;
      mrow[e] = f2bf(hv[nt] * sc * p.ml_g[l * 256 + hd * 64 + e] * silu_(bf2f(prow[e])));
    }
  }
}

template <bool FINAL>
DI void lru_item(const Params& p, int l, int b, int c, int n, unsigned char* smem) {
  const int tid = threadIdx.x, lane = tid & 63, w = tid >> 6;
  bfu* xcb = (bfu*)smem;
  float* xcf = (float*)(smem + 9216);
  float* af = (float*)(smem + 9216 + 17408);
  float* segH = (float*)(smem + 9216 + 2 * 17408);
  float* segA = segH + 256;
  const int tok0 = b * SEQ + c * 64;
  const int ch = n * 64 + lane;
  __syncthreads();
  {
    const float cw0 = p.conv_w[(l * 4 + 0) * 256 + ch], cw1 = p.conv_w[(l * 4 + 1) * 256 + ch];
    const float cw2 = p.conv_w[(l * 4 + 2) * 256 + ch], cw3 = p.conv_w[(l * 4 + 3) * 256 + ch];
    const float cb = p.conv_b[l * 256 + ch];
    const bfu* px = p.proj + (size_t)tok0 * PS + COL_CX + ch;
#pragma unroll
    for (int i = 0; i < 16; ++i) {
      const int t = w * 16 + i;
      const int sp = c * 64 + t;
      float x0 = (sp >= 3) ? bf2f(px[(ptrdiff_t)(t - 3) * PS]) : 0.f;
      float x1 = (sp >= 2) ? bf2f(px[(ptrdiff_t)(t - 2) * PS]) : 0.f;
      float x2 = (sp >= 1) ? bf2f(px[(ptrdiff_t)(t - 1) * PS]) : 0.f;
      float x3 = bf2f(px[(ptrdiff_t)t * PS]);
      const float xc = cb + cw0 * x0 + cw1 * x1 + cw2 * x2 + cw3 * x3;
      xcf[t * 68 + lane] = xc;
      xcb[t * 72 + lane] = f2bf(xc);
    }
  }
  __syncthreads();
  const int r = lane & 15, q = lane >> 4;
  f32x4 aa[4], ax[4];
#pragma unroll
  for (int i = 0; i < 4; ++i) { aa[i] = (f32x4){0.f, 0.f, 0.f, 0.f}; ax[i] = (f32x4){0.f, 0.f, 0.f, 0.f}; }
  wave_mma<4, 2>(aa, xcb + w * 16 * 72, 72, p.wt_a + (l * 4 + n) * 4096, 64, lane);
  wave_mma<4, 2>(ax, xcb + w * 16 * 72, 72, p.wt_x + (l * 4 + n) * 4096, 64, lane);
#pragma unroll
  for (int nt = 0; nt < 4; ++nt) {
    const int e = nt * 16 + r, che = n * 64 + e;
    const float ba = p.b_a[l * 256 + che], bx = p.b_x[l * 256 + che];
    const float lsl = 8.f * logsig_(p.lam[l * 256 + che]);
#pragma unroll
    for (int j = 0; j < 4; ++j) {
      const int t = w * 16 + q * 4 + j;
      const float rg = sigmoid_(aa[nt][j] + ba), ig = sigmoid_(ax[nt][j] + bx);
      const float la = lsl * rg;
      const float a = expf(la);
      const float bv = sqrtf(fmaxf(-expm1f(2.f * la), 0.f)) * ig * xcf[t * 68 + e];
      af[t * 68 + e] = a; xcf[t * 68 + e] = bv;
    }
  }
  __syncthreads();
  float hl[16], al[16];
  float h = 0.f, ap = 1.f;
#pragma unroll
  for (int i = 0; i < 16; ++i) {
    const int t = w * 16 + i;
    const float a = af[t * 68 + lane], bv = xcf[t * 68 + lane];
    h = a * h + bv; ap *= a; hl[i] = h; al[i] = ap;
  }
  segH[w * 64 + lane] = h; segA[w * 64 + lane] = ap;
  __syncthreads();
  const int sidx = (b * NCH + c) * 256 + ch;
  if (!FINAL) {
    if (w == 0) {
      float H = 0.f, Ap = 1.f;
#pragma unroll
      for (int s = 0; s < 4; ++s) { H = segA[s * 64 + lane] * H + segH[s * 64 + lane]; Ap *= segA[s * 64 + lane]; }
      p.lru_h[sidx] = H; p.lru_a[sidx] = Ap;
    }
  } else {
    float H = p.lru_h[sidx];
#pragma unroll
    for (int s = 0; s < 4; ++s) if (s < w) H = segA[s * 64 + lane] * H + segH[s * 64 + lane];
    const bfu* pg = p.proj + (size_t)tok0 * PS + COL_CG + ch;
    bfu* pm = p.mixed + (size_t)tok0 * 1024 + 512 + ch;
#pragma unroll
    for (int i = 0; i < 16; ++i) {
      const int t = w * 16 + i;
      const float hv = hl[i] + al[i] * H;
      pm[(size_t)t * 1024] = f2bf(hv * silu_(bf2f(pg[(size_t)t * PS])));
    }
  }
}

template <bool FINAL>
DI void s5_item(const Params& p, int l, int b, int c, int g4, unsigned char* smem) {
  const int tid = threadIdx.x, lane = tid & 63, w = tid >> 6;
  const int g = g4 * 4 + w;
  float* buw = (float*)(smem + w * 13312);
  bfu* stw = (bfu*)(smem + w * 13312 + 8448);
  const int tok0 = b * SEQ + c * 64;
  const int r = lane & 15, q = lane >> 4;
  const int lg = l * 16 + g;
  bf16x8 bfr[8], yfr[4];
#pragma unroll
  for (int nt = 0; nt < 8; ++nt) bfr[nt] = *(const bf16x8*)(p.bt_bu + ((size_t)lg * 128 + nt * 16 + r) * 32 + q * 8);
  if (FINAL) {
#pragma unroll
    for (int ks = 0; ks < 4; ++ks) yfr[ks] = *(const bf16x8*)(p.bt_y + ((size_t)lg * 16 + r) * 128 + ks * 32 + q * 8);
  }
  const float ar = p.abar[(lg * 64 + lane) * 2], ai = p.abar[(lg * 64 + lane) * 2 + 1];
  const size_t sbase = ((size_t)(b * NCH + c) * 16 + g) * 128;
  float xr = 0.f, xi = 0.f;
  if (FINAL) { xr = p.s5_state[sbase + lane]; xi = p.s5_state[sbase + 64 + lane]; }
  const float dsk = FINAL ? p.s5_d[l * 256 + g * 16 + r] : 0.f;
  __syncthreads();
  for (int mt = 0; mt < 4; ++mt) {
    bf16x8 a = (bf16x8){0, 0, 0, 0, 0, 0, 0, 0};
    if (q < 2) a = *(const bf16x8*)(p.proj + (size_t)(tok0 + mt * 16 + r) * PS + COL_DU + g * 16 + q * 8);
#pragma unroll
    for (int nt = 0; nt < 8; ++nt) {
      f32x4 acc = (f32x4){0.f, 0.f, 0.f, 0.f};
      acc = __builtin_amdgcn_mfma_f32_16x16x32_bf16(a, bfr[nt], acc, 0, 0, 0);
#pragma unroll
      for (int j = 0; j < 4; ++j) buw[(q * 4 + j) * 132 + nt * 16 + r] = acc[j];
    }
    __syncthreads();
#pragma unroll
    for (int tt = 0; tt < 16; ++tt) {
      const float br = buw[tt * 132 + lane], bi = buw[tt * 132 + 64 + lane];
      const float nr = ar * xr - ai * xi + br;
      const float ni = ar * xi + ai * xr + bi;
      xr = nr; xi = ni;
      if (FINAL) { stw[tt * 136 + lane] = f2bf(xr); stw[tt * 136 + 64 + lane] = f2bf(xi); }
    }
    __syncthreads();
    if (FINAL) {
      f32x4 y = (f32x4){0.f, 0.f, 0.f, 0.f};
#pragma unroll
      for (int ks = 0; ks < 4; ++ks) {
        bf16x8 a2 = *(const bf16x8*)(stw + r * 136 + ks * 32 + q * 8);
        y = __builtin_amdgcn_mfma_f32_16x16x32_bf16(a2, yfr[ks], y, 0, 0, 0);
      }
#pragma unroll
      for (int j = 0; j < 4; ++j) {
        const int t = mt * 16 + q * 4 + j;
        const float u = bf2f(p.proj[(size_t)(tok0 + t) * PS + COL_DU + g * 16 + r]);
        const float z = gelu_tanh_(y[j] + dsk * u);
        p.zbuf[(size_t)(tok0 + t) * 256 + g * 16 + r] = f2bf(z);
      }
      __syncthreads();
    }
  }
  if (!FINAL) { p.s5_state[sbase + lane] = xr; p.s5_state[sbase + 64 + lane] = xi; }
}

DI void s5_glu(const Params& p, int l, int b, int c, unsigned char* smem) {
  const int tid = threadIdx.x, lane = tid & 63, w = tid >> 6;
  bfu* zs = (bfu*)smem;
  const int tok0 = b * SEQ + c * 64;
  __syncthreads();
  for (int i = tid; i < 64 * 32; i += 256) {
    const int t = i >> 5, kc = i & 31;
    *(uint4*)(zs + t * 264 + kc * 8) = *(const uint4*)(p.zbuf + (size_t)(tok0 + t) * 256 + kc * 8);
  }
  __syncthreads();
  const int r = lane & 15, q = lane >> 4;
  for (int nc = 0; nc < 4; ++nc) {
    f32x4 acc[4];
#pragma unroll
    for (int i = 0; i < 4; ++i) acc[i] = (f32x4){0.f, 0.f, 0.f, 0.f};
#pragma unroll 1
    for (int kh = 0; kh < 4; ++kh)
      wave_mma<4, 2>(acc, zs + w * 16 * 264 + kh * 64, 264, p.wt_glu + l * 65536 + nc * 64 * 256 + kh * 64, 256, lane);
#pragma unroll
    for (int nt = 0; nt < 4; ++nt) {
      const int n = nc * 64 + nt * 16 + r;
      const float bg = p.b_glu[l * 256 + n];
#pragma unroll
      for (int j = 0; j < 4; ++j) {
        const int t = w * 16 + q * 4 + j;
        const float zv = bf2f(zs[t * 264 + n]);
        const float gate = silu_(bf2f(p.proj[(size_t)(tok0 + t) * PS + COL_DG + n]));
        p.mixed[(size_t)(tok0 + t) * 1024 + 768 + n] = f2bf(zv * sigmoid_(acc[nt][j] + bg) * gate);
      }
    }
  }
}

DI void phase2(const Params& p, int l, unsigned char* smem) {
  for (int item = blockIdx.x; item < 1024; item += gridDim.x) hg_local(p, l, item >> 7, (item >> 2) & 31, item & 3, smem);
  for (int item = blockIdx.x; item < 1024; item += gridDim.x) ml_local(p, l, item >> 7, (item >> 2) & 31, item & 3, smem);
  for (int item = blockIdx.x; item < 1024; item += gridDim.x) lru_item<false>(p, l, item >> 7, (item >> 2) & 31, item & 3, smem);
  for (int item = blockIdx.x; item < 1024; item += gridDim.x) s5_item<false>(p, l, item >> 7, (item >> 2) & 31, item & 3, smem);
}

DI void phase3(const Params& p, int l) {
  const int gtid = blockIdx.x * 256 + threadIdx.x, gsz = gridDim.x * 256;
  constexpr int N1 = 131072, N2 = 131072, N3 = 2048, N4 = 2048, N5 = 8192;
  for (int i = gtid; i < N1 + N2 + N3 + N4 + N5; i += gsz) {
    if (i < N1 + N2) {
      const bool ml = i >= N1;
      const int j = ml ? i - N1 : i;
      const int b = j >> 14, rem = j & 16383, hd = rem >> 12, ed = rem & 4095, d = ed & 63;
      float* stp = ml ? p.ml_state : p.hg_state;
      float S = 0.f;
      for (int c = 0; c < NCH; ++c) {
        const int base = (b * NCH + c) * 4 + hd;
        const float dec = ml ? p.ml_decay[base] : p.hg_decay[base * 64 + d];
        const size_t idx = (size_t)base * 4096 + ed;
        const float loc = stp[idx];
        stp[idx] = S; S = dec * S + loc;
      }
    } else if (i < N1 + N2 + N3) {
      const int j = i - N1 - N2, b = j >> 8, rem = j & 255, hd = rem >> 6, d = rem & 63;
      float S = 0.f;
      for (int c = 0; c < NCH; ++c) {
        const int base = (b * NCH + c) * 4 + hd;
        const float dec = p.ml_decay[base];
        const float loc = p.ml_n[base * 64 + d];
        p.ml_n[base * 64 + d] = S; S = dec * S + loc;
      }
    } else if (i < N1 + N2 + N3 + N4) {
      const int j = i - N1 - N2 - N3, b = j >> 8, ch = j & 255;
      float H = 0.f;
      for (int c = 0; c < NCH; ++c) {
        const int idx = (b * NCH + c) * 256 + ch;
        const float a = p.lru_a[idx], hl = p.lru_h[idx];
        p.lru_h[idx] = H; H = a * H + hl;
      }
    } else {
      const int j = i - N1 - N2 - N3 - N4, b = j >> 10, g = (j >> 6) & 15, pp = j & 63;
      const float ar = p.abar64[((l * 16 + g) * 64 + pp) * 2], ai = p.abar64[((l * 16 + g) * 64 + pp) * 2 + 1];
      float xr = 0.f, xi = 0.f;
      for (int c = 0; c < NCH; ++c) {
        const size_t sb = ((size_t)(b * NCH + c) * 16 + g) * 128;
        const float lr = p.s5_state[sb + pp], li = p.s5_state[sb + 64 + pp];
        p.s5_state[sb + pp] = xr; p.s5_state[sb + 64 + pp] = xi;
        const float nr = ar * xr - ai * xi + lr, ni = ar * xi + ai * xr + li;
        xr = nr; xi = ni;
      }
    }
  }
}

DI void phase4(const Params& p, int l, unsigned char* smem) {
  unsigned* s_flag = (unsigned*)(smem + SMEM_BYTES - 16);
  for (int item = blockIdx.x; item < 1024; item += gridDim.x) {
    const int bc = item >> 2;
    s5_item<true>(p, l, bc >> 5, bc & 31, item & 3, smem);
    if (last_arriver(p.cnt + CNT_GLU + l * 256 + bc, 4u, s_flag)) s5_glu(p, l, bc >> 5, bc & 31, smem);
  }
  for (int item = blockIdx.x; item < 1024; item += gridDim.x) hg_out(p, l, item >> 7, (item >> 2) & 31, item & 3, smem);
  for (int item = blockIdx.x; item < 1024; item += gridDim.x) ml_out(p, l, item >> 7, (item >> 2) & 31, item & 3, smem);
  for (int item = blockIdx.x; item < 1024; item += gridDim.x) lru_item<true>(p, l, item >> 7, (item >> 2) & 31, item & 3, smem);
}

#define RUN_PHASE(PH, CALL)                                       \
  if (ph0 <= (PH) && (PH) < ph1) {                                \
    CALL;                                                         \
    if (COOP) { if ((PH) + 1 < ph1) xcd_barrier(xb); }            \
  }

template <bool COOP, int L>
DI void run_layer(const Params& p, int ph0, int ph1, unsigned char* smem, const XcdBarrier& xb) {
  RUN_PHASE(1 + 5 * L, phase1(p, L, smem))
  RUN_PHASE(2 + 5 * L, phase2(p, L, smem))
  RUN_PHASE(3 + 5 * L, phase3(p, L))
  RUN_PHASE(4 + 5 * L, phase4(p, L, smem))
  RUN_PHASE(5 + 5 * L, phase5(p, L, smem))
}

template <bool COOP>
__global__ void __launch_bounds__(256, 2) mk_fwd(Params p, int ph0, int ph1) {
  __shared__ __attribute__((aligned(16))) unsigned char smem[SMEM_BYTES];
  __shared__ uint4 xb_words;
  XcdBarrier xb; xb.bar = p.bar; xb.x = 0; xb.st = nullptr;
  if (COOP) {
    if (ph1 < 0) cg::this_grid().sync();
    if (threadIdx.x == 0) xb_words = make_uint4(0u, 0u, 0u, 0u);
    __syncthreads();
    xb = xcd_barrier_post(p.bar, (volatile LAS unsigned*)&xb_words);
  }
  RUN_PHASE(0, phase0(p, smem))
  run_layer<COOP, 0>(p, ph0, ph1, smem, xb);
  run_layer<COOP, 1>(p, ph0, ph1, smem, xb);
  run_layer<COOP, 2>(p, ph0, ph1, smem, xb);
  run_layer<COOP, 3>(p, ph0, ph1, smem, xb);
}

extern "C" void kernel_launch(void* const* d_in, const int* in_sizes, int n_in, void* d_out, int out_size, void* d_ws,
                              size_t ws_size, hipStream_t stream) {
  static int grid_blocks = 0;
  if (!grid_blocks) {
    int dev = 0, cus = 0, per_cu = 0;
    hipGetDevice(&dev);
    hipDeviceGetAttribute(&cus, hipDeviceAttributeMultiprocessorCount, dev);
    hipOccupancyMaxActiveBlocksPerMultiprocessor(&per_cu, mk_fwd<(MEGA != 0)>, 256, 0);
    if (per_cu < 1) per_cu = 1;
    if (per_cu > 2) per_cu = 2;
    grid_blocks = cus * per_cu;
  }
  Params p{};
  const float** pin = (const float**)&p;
  for (int i = 0; i < 28; ++i) pin[i] = (const float*)d_in[i];
  p.out = (float*)d_out;
  unsigned char* ws = (unsigned char*)d_ws;
  size_t off = 0;
  auto take = [&](size_t bytes) { unsigned char* r = ws + off; off += (bytes + 255) & ~(size_t)255; return r; };
  p.wt_in = (bfu*)take((size_t)4 * PS * 1024 * 2);
  p.wt_out = (bfu*)take((size_t)4 * 1024 * 1024 * 2);
  p.wt_a = (bfu*)take(16 * 4096 * 2);
  p.wt_x = (bfu*)take(16 * 4096 * 2);
  p.wt_glu = (bfu*)take(4 * 65536 * 2);
  p.bt_bu = (bfu*)take(64 * 128 * 32 * 2);
  p.bt_y = (bfu*)take(64 * 16 * 128 * 2);
  p.hb = (bfu*)take((size_t)NTOK * 1024 * 2);
  p.proj = (bfu*)take((size_t)NTOK * PS * 2);
  p.mixed = (bfu*)take((size_t)NTOK * 1024 * 2);
  p.zbuf = (bfu*)take((size_t)NTOK * 256 * 2);
  p.abar = (float*)take(4096 * 2 * 4);
  p.abar64 = (float*)take(4096 * 2 * 4);
  p.lbs = (float*)take(1024 * 4);
  p.hg_state = (float*)take((size_t)BATCH * NCH * 4 * 4096 * 4);
  p.hg_decay = (float*)take((size_t)BATCH * NCH * 4 * 64 * 4);
  p.ml_state = (float*)take((size_t)BATCH * NCH * 4 * 4096 * 4);
  p.ml_n = (float*)take((size_t)BATCH * NCH * 4 * 64 * 4);
  p.ml_decay = (float*)take((size_t)BATCH * NCH * 4 * 4);
  p.lru_h = (float*)take((size_t)BATCH * NCH * 256 * 4);
  p.lru_a = (float*)take((size_t)BATCH * NCH * 256 * 4);
  p.s5_state = (float*)take((size_t)BATCH * NCH * 16 * 128 * 4);
  p.cnt = (unsigned*)take(CNT_TOTAL * 4);
  p.bar = (unsigned*)take(XCD_BAR_WORDS * 4);
  if (off > ws_size) { fprintf(stderr, "workspace too small: need %zu have %zu\n", off, ws_size); return; }
  const int NPH = 1 + 5 * DEPTH;
#if MEGA
  (void)hipMemsetAsync(p.bar, 0, XCD_BAR_WORDS * 4, stream);
  int ph0 = 0, ph1 = NPH;
  void* args[] = {&p, &ph0, &ph1};
  hipError_t e = hipLaunchCooperativeKernel((void*)mk_fwd<true>, dim3(grid_blocks), dim3(256), args, 0, stream);
  if (e != hipSuccess) fprintf(stderr, "cooperative launch failed: %s (grid %d)\n", hipGetErrorString(e), grid_blocks);
#else
  for (int ph = 0; ph < NPH; ++ph) hipLaunchKernelGGL(mk_fwd<false>, dim3(grid_blocks), dim3(256), 0, stream, p, ph, ph + 1);
#endif
}
```

```cpp
#include <hip/hip_runtime.h>
#include <hip/hip_cooperative_groups.h>
#include <stdint.h>
#include <stdio.h>
namespace cg = cooperative_groups;

#ifndef MEGA
#define MEGA 1
#endif

typedef unsigned short bfu;
using bf16x8 = __attribute__((ext_vector_type(8))) short;
using f32x4  = __attribute__((ext_vector_type(4))) float;
#define DI __device__ __forceinline__

constexpr int BATCH = 8, SEQ = 2048, DM = 1024, DEPTH = 4, NTOK = BATCH * SEQ, NCH = SEQ / 64;
constexpr int DIN = 3080, PS = 3200;
constexpr int COL_AQ = 0, COL_AF = 256, COL_AI = 512, COL_AG = 768;
constexpr int COL_BQ = 1024, COL_BK = 1280, COL_BV = 1536, COL_BIG = 1792, COL_BFG = 1796, COL_BG = 1800;
constexpr int COL_CX = 2056, COL_CG = 2312, COL_DU = 2568, COL_DG = 2824;
constexpr float DN_ALPHA = 1.681792830507429f;
constexpr int SMEM_BYTES = 56 * 1024;
constexpr int CNT_LN = 0, CNT_GLU = 4 * 128, CNT_TOTAL = 4 * 128 + 4 * 256;

struct Params {
  const float *x, *w_in, *b_in, *lb_logits, *hg_g, *ml_fb, *ml_g, *conv_w, *conv_b, *w_a, *b_a, *w_x, *b_x, *lam,
      *a_re, *a_im, *log_dt, *sb_re, *sb_im, *c_re, *c_im, *s5_d, *w_glu, *b_glu, *w_out, *b_out, *ln_g, *ln_b;
  float* out;
  bfu *wt_in, *wt_out, *wt_a, *wt_x, *wt_glu, *bt_bu, *bt_y, *hb, *proj, *mixed, *zbuf;
  float *abar, *abar64, *lbs, *hg_state, *hg_decay, *ml_state, *ml_n, *ml_decay, *lru_h, *lru_a, *s5_state;
  unsigned* cnt;
  unsigned* bar;
};

DI bfu f2bf(float x) { unsigned u = __float_as_uint(x); u += 0x7fffu + ((u >> 16) & 1u); return (bfu)(u >> 16); }
DI float bf2f(bfu h) { return __uint_as_float(((unsigned)h) << 16); }
DI unsigned pack2(float a, float b) { return (unsigned)f2bf(a) | ((unsigned)f2bf(b) << 16); }
DI float sigmoid_(float x) { return 1.f / (1.f + expf(-x)); }
DI float silu_(float x) { return x / (1.f + expf(-x)); }
DI float logsig_(float x) { return fminf(x, 0.f) - log1pf(expf(-fabsf(x))); }
DI float gelu_tanh_(float x) {
  float u = 0.7978845608028654f * (x + 0.044715f * x * x * x);
  float th = 1.f - 2.f / (expf(2.f * u) + 1.f);
  return 0.5f * x * (1.f + th);
}

template <int NT, int KS>
DI void wave_mma(f32x4 (&acc)[NT], const bfu* A, int lda, const bfu* Bt, int ldb, int lane) {
  const int r = lane & 15, q = lane >> 4;
#pragma unroll
  for (int ks = 0; ks < KS; ++ks) {
    bf16x8 a = *(const bf16x8*)(A + r * lda + ks * 32 + q * 8);
#pragma unroll
    for (int nt = 0; nt < NT; ++nt) {
      bf16x8 b = *(const bf16x8*)(Bt + (nt * 16 + r) * ldb + ks * 32 + q * 8);
      acc[nt] = __builtin_amdgcn_mfma_f32_16x16x32_bf16(a, b, acc[nt], 0, 0, 0);
    }
  }
}

DI float group16_sum(float v) {
  v += __shfl_xor(v, 1); v += __shfl_xor(v, 2); v += __shfl_xor(v, 4); v += __shfl_xor(v, 8);
  return v;
}
DI float wave_sum(float v) {
  v += __shfl_xor(v, 1); v += __shfl_xor(v, 2); v += __shfl_xor(v, 4); v += __shfl_xor(v, 8);
  v += __shfl_xor(v, 16); v += __shfl_xor(v, 32);
  return v;
}

DI bool last_arriver(unsigned* ctr, unsigned total, unsigned* s_flag) {
  asm volatile("s_waitcnt vmcnt(0)" ::: "memory");
  __syncthreads();
  if (threadIdx.x == 0) {
    __builtin_amdgcn_fence(__ATOMIC_RELEASE, "agent");
    asm volatile("s_waitcnt vmcnt(0)" ::: "memory");
    const unsigned old = __hip_atomic_fetch_add(ctr, 1u, __ATOMIC_RELAXED, __HIP_MEMORY_SCOPE_AGENT);
    const unsigned last = (old == total - 1u) ? 1u : 0u;
    if (last) { __builtin_amdgcn_fence(__ATOMIC_ACQUIRE, "agent"); asm volatile("s_waitcnt vmcnt(0)" ::: "memory"); }
    *s_flag = last;
  }
  __syncthreads();
  return (*s_flag != 0u);
}

#define XB_TMO      128
#define XB_XCNT(j)  (256  + 64 * (j))
#define XB_XSUB(j)  (1280 + 64 * (j))
#define XB_XGEN(j)  (2304 + 64 * (j))
#define XB_TOP      3328
#define XB_TOPGEN   3392
#define XCD_BAR_WORDS 3456
#define XB_SPIN_CAP (1u << 22)
#define LAS __attribute__((address_space(3)))
DI unsigned xb_ld(unsigned* p) { return __hip_atomic_load(p, __ATOMIC_RELAXED, __HIP_MEMORY_SCOPE_AGENT); }
DI unsigned xb_add(unsigned* p, unsigned v) { return __hip_atomic_fetch_add(p, v, __ATOMIC_RELAXED, __HIP_MEMORY_SCOPE_AGENT); }
DI unsigned xb_xcc_id() { return (unsigned)__builtin_amdgcn_s_getreg((3 << 11) | 20) & 0xFu; }
#define XB_SPIN(cond, bar) do { unsigned _sp = 0; while (cond) { __builtin_amdgcn_s_sleep(1); \
    if ((++_sp & 255u) == 0u) { if (xb_ld(&(bar)[XB_TMO])) break; if (_sp > XB_SPIN_CAP) { atomicAdd(&(bar)[XB_TMO], 1u); break; } } } } while (0)
struct XcdBarrier { unsigned* bar; unsigned x; volatile LAS unsigned* st; };
DI XcdBarrier xcd_barrier_post(unsigned* bar, volatile LAS unsigned* st) {
  XcdBarrier b; b.bar = bar; b.x = xb_xcc_id(); b.st = st;
  if (threadIdx.x == 0) (void)xb_add(&bar[XB_XCNT(b.x)], 1u);
  return b;
}
DI void xcd_barrier_complete(unsigned* bar, unsigned x, unsigned& nloc, unsigned& nx) {
  const unsigned G = gridDim.x * gridDim.y * gridDim.z;
  unsigned sum, cnt, mine, sp = 0u;
  for (;;) {
    sum = 0u; cnt = 0u; mine = 0u;
#pragma unroll
    for (unsigned j = 0; j < 16; ++j) { const unsigned c = xb_ld(&bar[XB_XCNT(j)]); sum += c; cnt += (c > 0u) ? 1u : 0u; mine = (j == x) ? c : mine; }
    if (sum == G) break;
    __builtin_amdgcn_s_sleep(1);
    if ((++sp & 255u) == 0u) { if (xb_ld(&bar[XB_TMO])) break; if (sp > XB_SPIN_CAP) { atomicAdd(&bar[XB_TMO], 1u); break; } }
  }
  nloc = mine > 0u ? mine : 1u; nx = cnt > 0u ? cnt : 1u;
}
DI void xcd_barrier(const XcdBarrier& b) {
  asm volatile("s_waitcnt vmcnt(0)" ::: "memory");
  __syncthreads();
  if (threadIdx.x == 0) {
    unsigned* bar = b.bar;
    __builtin_amdgcn_s_waitcnt(0);
    unsigned nloc = b.st[0], nx = b.st[1];
    if (nloc == 0u) { xcd_barrier_complete(bar, b.x, nloc, nx); b.st[0] = nloc; b.st[1] = nx; }
    const unsigned old = xb_add(&bar[XB_XSUB(b.x)], 1u);
    const unsigned gen = old / nloc;
    if (old + 1u == (gen + 1u) * nloc) {
      __builtin_amdgcn_fence(__ATOMIC_RELEASE, "agent");
      asm volatile("s_waitcnt vmcnt(0)" ::: "memory");
      const unsigned og = xb_add(&bar[XB_TOP], 1u);
      const unsigned tg = og / nx;
      if (og + 1u == (tg + 1u) * nx) xb_add(&bar[XB_TOPGEN], 1u);
      else XB_SPIN(xb_ld(&bar[XB_TOPGEN]) == tg, bar);
      __builtin_amdgcn_fence(__ATOMIC_ACQUIRE, "agent");
      xb_add(&bar[XB_XGEN(b.x)], 1u);
      asm volatile("s_waitcnt vmcnt(0)" ::: "memory");
    } else {
      XB_SPIN(xb_ld(&bar[XB_XGEN(b.x)]) == gen, bar);
      __builtin_amdgcn_fence(__ATOMIC_ACQUIRE, "agent");
      asm volatile("s_waitcnt vmcnt(0)" ::: "memory");
    }
  }
  __syncthreads();
}

DI void transpose_tile(const float* src, int sld, int cv, bfu* dst, int dld, float* tile) {
  const int tid = threadIdx.x;
  __syncthreads();
  for (int i = tid; i < 4096; i += 256) {
    int r = i >> 6, c = i & 63;
    tile[r * 65 + c] = (c < cv) ? src[(size_t)r * sld + c] : 0.f;
  }
  __syncthreads();
  for (int i = tid; i < 4096; i += 256) {
    int n = i >> 6, k = i & 63;
    dst[(size_t)n * dld + k] = f2bf(tile[k * 65 + n]);
  }
}

DI void phase0(const Params& p, unsigned char* smem) {
  const int tid = threadIdx.x;
  const int gtid = blockIdx.x * 256 + tid, gsz = gridDim.x * 256;
  for (int i = gtid; i < NTOK * DM / 8; i += gsz) {
    float4 a = ((const float4*)p.x)[2 * i], b = ((const float4*)p.x)[2 * i + 1];
    uint4 o; o.x = pack2(a.x, a.y); o.y = pack2(a.z, a.w); o.z = pack2(b.x, b.y); o.w = pack2(b.z, b.w);
    ((uint4*)p.hb)[i] = o;
  }
  float* tile = (float*)smem;
  const int NJ = 3200 + 1024 + 16 + 16 + 64;
  for (int job = blockIdx.x; job < NJ; job += gridDim.x) {
    const float* src; int sld, cv = 64, dld; bfu* dst;
    if (job < 3200) {
      int l = job / 800, rem = job % 800, kt = rem / 50, nt = rem % 50;
      src = p.w_in + (size_t)l * 1024 * DIN + (size_t)kt * 64 * DIN + nt * 64; sld = DIN;
      cv = DIN - nt * 64; cv = cv < 0 ? 0 : (cv > 64 ? 64 : cv);
      dst = p.wt_in + (size_t)l * PS * 1024 + (size_t)nt * 64 * 1024 + kt * 64; dld = 1024;
    } else if (job < 4224) {
      int j = job - 3200, l = j / 256, rem = j % 256, kt = rem / 16, nt = rem % 16;
      src = p.w_out + (size_t)l * 1048576 + (size_t)kt * 64 * 1024 + nt * 64; sld = 1024;
      dst = p.wt_out + (size_t)l * 1048576 + (size_t)nt * 64 * 1024 + kt * 64; dld = 1024;
    } else if (job < 4240) {
      int j = job - 4224; src = p.w_a + j * 4096; sld = 64; dst = p.wt_a + j * 4096; dld = 64;
    } else if (job < 4256) {
      int j = job - 4240; src = p.w_x + j * 4096; sld = 64; dst = p.wt_x + j * 4096; dld = 64;
    } else {
      int j = job - 4256, l = j / 16, rem = j % 16, kt = rem / 4, nt = rem % 4;
      src = p.w_glu + l * 65536 + kt * 64 * 256 + nt * 64; sld = 256;
      dst = p.wt_glu + l * 65536 + nt * 64 * 256 + kt * 64; dld = 256;
    }
    transpose_tile(src, sld, cv, dst, dld, tile);
  }
  for (int i = gtid; i < 4096; i += gsz) {
    int lg = i >> 6, pp = i & 63;
    double dt = exp((double)p.log_dt[lg]);
    double are = p.a_re[lg * 64 + pp], aim = p.a_im[lg * 64 + pp];
    double mag = exp(dt * are), ang = dt * aim;
    double abr = mag * cos(ang), abi = mag * sin(ang);
    double den = are * are + aim * aim;
    double xr = abr - 1.0, xi = abi;
    double zr = (xr * are + xi * aim) / den, zi = (xi * are - xr * aim) / den;
    bfu* o_re = p.bt_bu + ((size_t)lg * 128 + pp) * 32;
    bfu* o_im = p.bt_bu + ((size_t)lg * 128 + 64 + pp) * 32;
    for (int h = 0; h < 16; ++h) {
      double br = p.sb_re[(lg * 64 + pp) * 16 + h], bi = p.sb_im[(lg * 64 + pp) * 16 + h];
      o_re[h] = f2bf((float)(zr * br - zi * bi));
      o_im[h] = f2bf((float)(zr * bi + zi * br));
      o_re[16 + h] = 0; o_im[16 + h] = 0;
    }
    p.abar[(lg * 64 + pp) * 2 + 0] = (float)abr; p.abar[(lg * 64 + pp) * 2 + 1] = (float)abi;
    double mag64 = exp(64.0 * dt * are), ang64 = 64.0 * ang;
    p.abar64[(lg * 64 + pp) * 2 + 0] = (float)(mag64 * cos(ang64));
    p.abar64[(lg * 64 + pp) * 2 + 1] = (float)(mag64 * sin(ang64));
  }
  for (int i = gtid; i < 4 * 16 * 16 * 128; i += gsz) {
    int k = i & 127, lgn = i >> 7;
    p.bt_y[i] = (k < 64) ? f2bf(p.c_re[lgn * 64 + k]) : f2bf(-p.c_im[lgn * 64 + (k - 64)]);
  }
  for (int i = gtid; i < 256; i += gsz) {
    float v0 = p.lb_logits[i], v1 = p.lb_logits[256 + i], v2 = p.lb_logits[512 + i], v3 = p.lb_logits[768 + i];
    float m = fmaxf(fmaxf(v0, v1), fmaxf(v2, v3));
    float e0 = expf(v0 - m), e1 = expf(v1 - m), e2 = expf(v2 - m), e3 = expf(v3 - m);
    float s = e0 + e1 + e2 + e3;
    p.lbs[i] = 0.f; p.lbs[256 + i] = e1 / s; p.lbs[512 + i] = (e1 + e2) / s; p.lbs[768 + i] = (e1 + e2 + e3) / s;
  }
  for (int i = gtid; i < CNT_TOTAL; i += gsz) p.cnt[i] = 0u;
}

template <int EPI>
DI void gemm_tile(const Params& p, int l, const bfu* A, const bfu* Bt, int m0, int n0, const float* hin, unsigned char* smem) {
  bfu* sA = (bfu*)smem; bfu* sB = sA + 128 * 72;
  const int tid = threadIdx.x, lane = tid & 63, w = tid >> 6, wm = w >> 1, wn = w & 1;
  const int r = lane & 15, q = lane >> 4;
  f32x4 acc[4][4];
#pragma unroll
  for (int i = 0; i < 4; ++i)
#pragma unroll
    for (int j = 0; j < 4; ++j) acc[i][j] = (f32x4){0.f, 0.f, 0.f, 0.f};
  const int lrow = tid >> 3, lkc = tid & 7;
  const bfu* ga = A + (size_t)(m0 + lrow) * 1024 + lkc * 8;
  const bfu* gb = Bt + (size_t)(n0 + lrow) * 1024 + lkc * 8;
  uint4 ra0 = *(const uint4*)(ga), ra1 = *(const uint4*)(ga + 32 * 1024), ra2 = *(const uint4*)(ga + 64 * 1024), ra3 = *(const uint4*)(ga + 96 * 1024);
  uint4 rb0 = *(const uint4*)(gb), rb1 = *(const uint4*)(gb + 32 * 1024), rb2 = *(const uint4*)(gb + 64 * 1024), rb3 = *(const uint4*)(gb + 96 * 1024);
  bfu* wa = sA + lrow * 72 + lkc * 8;
  bfu* wb = sB + lrow * 72 + lkc * 8;
  for (int kt = 0; kt < 16; ++kt) {
    __syncthreads();
    *(uint4*)(wa) = ra0; *(uint4*)(wa + 32 * 72) = ra1; *(uint4*)(wa + 64 * 72) = ra2; *(uint4*)(wa + 96 * 72) = ra3;
    *(uint4*)(wb) = rb0; *(uint4*)(wb + 32 * 72) = rb1; *(uint4*)(wb + 64 * 72) = rb2; *(uint4*)(wb + 96 * 72) = rb3;
    __syncthreads();
    if (kt + 1 < 16) {
      const bfu* ga2 = ga + (kt + 1) * 64; const bfu* gb2 = gb + (kt + 1) * 64;
      ra0 = *(const uint4*)(ga2); ra1 = *(const uint4*)(ga2 + 32 * 1024); ra2 = *(const uint4*)(ga2 + 64 * 1024); ra3 = *(const uint4*)(ga2 + 96 * 1024);
      rb0 = *(const uint4*)(gb2); rb1 = *(const uint4*)(gb2 + 32 * 1024); rb2 = *(const uint4*)(gb2 + 64 * 1024); rb3 = *(const uint4*)(gb2 + 96 * 1024);
    }
#pragma unroll
    for (int ks = 0; ks < 2; ++ks) {
      bf16x8 af[4], bfr[4];
#pragma unroll
      for (int mt = 0; mt < 4; ++mt) af[mt] = *(const bf16x8*)(sA + (wm * 64 + mt * 16 + r) * 72 + ks * 32 + q * 8);
#pragma unroll
      for (int nt = 0; nt < 4; ++nt) bfr[nt] = *(const bf16x8*)(sB + (wn * 64 + nt * 16 + r) * 72 + ks * 32 + q * 8);
#pragma unroll
      for (int mt = 0; mt < 4; ++mt)
#pragma unroll
        for (int nt = 0; nt < 4; ++nt) acc[mt][nt] = __builtin_amdgcn_mfma_f32_16x16x32_bf16(af[mt], bfr[nt], acc[mt][nt], 0, 0, 0);
    }
  }
#pragma unroll
  for (int nt = 0; nt < 4; ++nt) {
    const int col = n0 + wn * 64 + nt * 16 + r;
    if (EPI == 1) {
      const float bias = (col < DIN) ? p.b_in[l * DIN + col] : 0.f;
#pragma unroll
      for (int mt = 0; mt < 4; ++mt)
#pragma unroll
        for (int j = 0; j < 4; ++j) {
          const int row = m0 + wm * 64 + mt * 16 + q * 4 + j;
          p.proj[(size_t)row * PS + col] = f2bf(acc[mt][nt][j] + bias);
        }
    } else {
      const float bias = p.b_out[l * 1024 + col];
#pragma unroll
      for (int mt = 0; mt < 4; ++mt)
#pragma unroll
        for (int j = 0; j < 4; ++j) {
          const int row = m0 + wm * 64 + mt * 16 + q * 4 + j;
          const size_t o = (size_t)row * 1024 + col;
          p.out[o] = DN_ALPHA * hin[o] + acc[mt][nt][j] + bias;
        }
    }
  }
}

DI void phase1(const Params& p, int l, unsigned char* smem) {
  const bfu* Bt = p.wt_in + (size_t)l * PS * 1024;
  for (int tile = blockIdx.x; tile < 128 * 25; tile += gridDim.x) {
    int mt = tile / 25, nt = tile % 25;
    gemm_tile<1>(p, l, p.hb, Bt, mt * 128, nt * 128, nullptr, smem);
  }
}

DI void phase5(const Params& p, int l, unsigned char* smem) {
  const bfu* Bt = p.wt_out + (size_t)l * 1048576;
  const float* hin = (l == 0) ? p.x : p.out;
  unsigned* s_flag = (unsigned*)(smem + SMEM_BYTES - 16);
  const int tid = threadIdx.x, lane = tid & 63, w = tid >> 6;
  for (int tile = blockIdx.x; tile < 128 * 8; tile += gridDim.x) {
    int mt = tile >> 3, nt = tile & 7;
    gemm_tile<2>(p, l, p.mixed, Bt, mt * 128, nt * 128, hin, smem);
    if (last_arriver(p.cnt + CNT_LN + l * 128 + mt, 8u, s_flag)) {
      for (int rr = 0; rr < 32; ++rr) {
        const int row = mt * 128 + w * 32 + rr;
        float4 v[4];
        float s = 0.f;
#pragma unroll
        for (int i = 0; i < 4; ++i) {
          v[i] = *(const float4*)(p.out + (size_t)row * 1024 + i * 256 + lane * 4);
          s += v[i].x + v[i].y + v[i].z + v[i].w;
        }
        const float mu = wave_sum(s) * (1.f / 1024.f);
        float ss = 0.f;
#pragma unroll
        for (int i = 0; i < 4; ++i) {
          v[i].x -= mu; v[i].y -= mu; v[i].z -= mu; v[i].w -= mu;
          ss += v[i].x * v[i].x + v[i].y * v[i].y + v[i].z * v[i].z + v[i].w * v[i].w;
        }
        const float rs = rsqrtf(wave_sum(ss) * (1.f / 1024.f) + 1e-5f);
#pragma unroll
        for (int i = 0; i < 4; ++i) {
          const int c = i * 256 + lane * 4;
          const float4 g = *(const float4*)(p.ln_g + l * 1024 + c);
          const float4 bb = *(const float4*)(p.ln_b + l * 1024 + c);
          float4 o;
          o.x = v[i].x * rs * g.x + bb.x; o.y = v[i].y * rs * g.y + bb.y;
          o.z = v[i].z * rs * g.z + bb.z; o.w = v[i].w * rs * g.w + bb.w;
          *(float4*)(p.out + (size_t)row * 1024 + c) = o;
          uint2 ob; ob.x = pack2(o.x, o.y); ob.y = pack2(o.z, o.w);
          *(uint2*)(p.hb + (size_t)row * 1024 + c) = ob;
        }
      }
    }
  }
}

DI void hg_gate(float x, float lb, float& lf, float& k) {
  const float sneg = 1.f / (1.f + expf(x));
  k = (1.f - lb) * sneg;
  if (lb > 0.f) lf = log1pf(-k); else lf = logsig_(x);
}

DI void hg_local(const Params& p, int l, int b, int c, int hd, unsigned char* smem) {
  const int tid = threadIdx.x, lane = tid & 63, w = tid >> 6;
  bfu* At = (bfu*)smem;
  bfu* Bt = At + 64 * 72;
  float* segtot = (float*)(smem + 2 * 64 * 72 * 2);
  const int tok0 = b * SEQ + c * 64;
  const int d = lane;
  const float lb = p.lbs[l * 256 + hd * 64 + d];
  const bfu* pf = p.proj + (size_t)tok0 * PS + COL_AF + hd * 64 + d;
  const bfu* pv = p.proj + (size_t)tok0 * PS + COL_AI + hd * 64 + d;
  float bl[16], kk[16];
  float run = 0.f;
  __syncthreads();
#pragma unroll
  for (int i = 0; i < 16; ++i) {
    const int t = w * 16 + i;
    float lf, k; hg_gate(bf2f(pf[(size_t)t * PS]), lb, lf, k);
    run += lf; bl[i] = run; kk[i] = k;
    At[d * 72 + t] = pv[(size_t)t * PS];
  }
  segtot[w * 64 + d] = run;
  __syncthreads();
  float off = 0.f, tot = 0.f;
#pragma unroll
  for (int s = 0; s < 4; ++s) { float v = segtot[s * 64 + d]; tot += v; if (s < w) off += v; }
#pragma unroll
  for (int i = 0; i < 16; ++i) { const int t = w * 16 + i; Bt[d * 72 + t] = f2bf(kk[i] * expf(tot - (bl[i] + off))); }
  const int base = (b * NCH + c) * 4 + hd;
  if (w == 0) p.hg_decay[base * 64 + d] = expf(tot);
  __syncthreads();
  f32x4 acc[4];
#pragma unroll
  for (int i = 0; i < 4; ++i) acc[i] = (f32x4){0.f, 0.f, 0.f, 0.f};
  wave_mma<4, 2>(acc, At + w * 16 * 72, 72, Bt, 72, lane);
  float* st = p.hg_state + (size_t)base * 4096;
  const int r = lane & 15, q = lane >> 4;
#pragma unroll
  for (int nt = 0; nt < 4; ++nt)
#pragma unroll
    for (int j = 0; j < 4; ++j) st[(w * 16 + q * 4 + j) * 64 + nt * 16 + r] = acc[nt][j];
}

constexpr int O_A = 0, O_BT = 17408, O_QP = 34816, O_KP = 44032, O_MISC = 53248;

DI void hg_out(const Params& p, int l, int b, int c, int hd, unsigned char* smem) {
  const int tid = threadIdx.x, lane = tid & 63, w = tid >> 6;
  bfu* A = (bfu*)(smem + O_A); bfu* Bt = (bfu*)(smem + O_BT); bfu* Qp = (bfu*)(smem + O_QP); bfu* Kp = (bfu*)(smem + O_KP);
  float* segtot = (float*)(smem + O_MISC);
  const int tok0 = b * SEQ + c * 64;
  const int d = lane;
  const float lb = p.lbs[l * 256 + hd * 64 + d];
  const bfu* pq = p.proj + (size_t)tok0 * PS + COL_AQ + hd * 64 + d;
  const bfu* pf = p.proj + (size_t)tok0 * PS + COL_AF + hd * 64 + d;
  const bfu* pv = p.proj + (size_t)tok0 * PS + COL_AI + hd * 64 + d;
  const int base = (b * NCH + c) * 4 + hd;
  const float* st = p.hg_state + (size_t)base * 4096;
  float bl[16], kk[16];
  float run = 0.f;
  __syncthreads();
#pragma unroll
  for (int i = 0; i < 16; ++i) {
    const int t = w * 16 + i;
    float lf, k; hg_gate(bf2f(pf[(size_t)t * PS]), lb, lf, k);
    run += lf; bl[i] = run; kk[i] = k;
    Bt[d * 136 + t] = pv[(size_t)t * PS];
    const int e = w + 4 * i;
    Bt[e * 136 + 64 + d] = f2bf(st[e * 64 + d]);
  }
  segtot[w * 64 + d] = run;
  __syncthreads();
  float off = 0.f;
#pragma unroll
  for (int s = 0; s < 4; ++s) { float v = segtot[s * 64 + d]; if (s < w) off += v; }
  const float bm = segtot[d] + segtot[64 + d];
#pragma unroll
  for (int i = 0; i < 16; ++i) {
    const int t = w * 16 + i;
    const float bt = bl[i] + off;
    const float qv = silu_(bf2f(pq[(size_t)t * PS]));
    Qp[t * 72 + d] = f2bf(qv * expf(fmaxf(bt - bm, -80.f)));
    Kp[t * 72 + d] = f2bf(kk[i] * expf(fminf(bm - bt, 80.f)));
    A[t * 136 + 64 + d] = f2bf(qv * expf(bt));
  }
  __syncthreads();
  const int r = lane & 15, q = lane >> 4;
  f32x4 acc[4];
#pragma unroll
  for (int i = 0; i < 4; ++i) acc[i] = (f32x4){0.f, 0.f, 0.f, 0.f};
  wave_mma<4, 2>(acc, Qp + w * 16 * 72, 72, Kp, 72, lane);
#pragma unroll
  for (int nt = 0; nt < 4; ++nt)
#pragma unroll
    for (int j = 0; j < 4; ++j) {
      const int t = w * 16 + q * 4 + j, s = nt * 16 + r;
      A[t * 136 + s] = f2bf(s <= t ? acc[nt][j] : 0.f);
    }
  __syncthreads();
  f32x4 o[4];
#pragma unroll
  for (int i = 0; i < 4; ++i) o[i] = (f32x4){0.f, 0.f, 0.f, 0.f};
  wave_mma<4, 4>(o, A + w * 16 * 136, 136, Bt, 136, lane);
#pragma unroll
  for (int j = 0; j < 4; ++j) {
    float ss = 0.f;
#pragma unroll
    for (int nt = 0; nt < 4; ++nt) ss += o[nt][j] * o[nt][j];
    ss = group16_sum(ss);
    const float sc = rsqrtf(ss * (1.f / 64.f) + 1e-6f);
    const int t = w * 16 + q * 4 + j;
    const bfu* prow = p.proj + (size_t)(tok0 + t) * PS + COL_AG + hd * 64;
    bfu* mrow = p.mixed + (size_t)(tok0 + t) * 1024 + hd * 64;
#pragma unroll
    for (int nt = 0; nt < 4; ++nt) {
      const int e = nt * 16 + r;
      mrow[e] = f2bf(o[nt][j] * sc * p.hg_g[l * 256 + hd * 64 + e] * silu_(bf2f(prow[e])));
    }
  }
}

DI void ml_gates(const Params& p, int l, int tok0, int hd, float* bs, float* igs, int tid) {
  if (tid < 64) {
    const bfu* row = p.proj + (size_t)(tok0 + tid) * PS;
    const float ig = bf2f(row[COL_BIG + hd]);
    const float fg = bf2f(row[COL_BFG + hd]) + p.ml_fb[l * 4 + hd];
    float lf = logsig_(fg);
#pragma unroll
    for (int o = 1; o < 64; o <<= 1) { float v = __shfl_up(lf, o); if (tid >= o) lf += v; }
    bs[tid] = lf; igs[tid] = ig;
  }
}

DI void ml_local(const Params& p, int l, int b, int c, int hd, unsigned char* smem) {
  const int tid = threadIdx.x, lane = tid & 63, w = tid >> 6;
  bfu* At = (bfu*)smem;
  bfu* Bt = At + 64 * 72;
  float* bs = (float*)(smem + 2 * 64 * 72 * 2);
  float* igs = bs + 64; float* nseg = igs + 64;
  const int tok0 = b * SEQ + c * 64;
  const int d = lane;
  __syncthreads();
  ml_gates(p, l, tok0, hd, bs, igs, tid);
  __syncthreads();
  const float blast = bs[63];
  const bfu* pk = p.proj + (size_t)tok0 * PS + COL_BK + hd * 64 + d;
  const bfu* pv = p.proj + (size_t)tok0 * PS + COL_BV + hd * 64 + d;
  float nacc = 0.f;
#pragma unroll
  for (int i = 0; i < 16; ++i) {
    const int s = w * 16 + i;
    const float ws = expf(blast - bs[s] + igs[s]);
    const float kw = bf2f(pk[(size_t)s * PS]) * 0.125f * ws;
    Bt[d * 72 + s] = f2bf(kw); nacc += kw;
    At[d * 72 + s] = pv[(size_t)s * PS];
  }
  nseg[w * 64 + d] = nacc;
  __syncthreads();
  const int base = (b * NCH + c) * 4 + hd;
  if (w == 0) p.ml_n[base * 64 + d] = nseg[d] + nseg[64 + d] + nseg[128 + d] + nseg[192 + d];
  if (tid == 0) p.ml_decay[base] = expf(blast);
  f32x4 acc[4];
#pragma unroll
  for (int i = 0; i < 4; ++i) acc[i] = (f32x4){0.f, 0.f, 0.f, 0.f};
  wave_mma<4, 2>(acc, At + w * 16 * 72, 72, Bt, 72, lane);
  float* st = p.ml_state + (size_t)base * 4096;
  const int r = lane & 15, q = lane >> 4;
#pragma unroll
  for (int nt = 0; nt < 4; ++nt)
#pragma unroll
    for (int j = 0; j < 4; ++j) st[(w * 16 + q * 4 + j) * 64 + nt * 16 + r] = acc[nt][j];
}

DI void ml_out(const Params& p, int l, int b, int c, int hd, unsigned char* smem) {
  const int tid = threadIdx.x, lane = tid & 63, w = tid >> 6;
  bfu* A = (bfu*)(smem + O_A); bfu* Bt = (bfu*)(smem + O_BT); bfu* Qp = (bfu*)(smem + O_QP); bfu* Kp = (bfu*)(smem + O_KP);
  float* bs = (float*)(smem + O_MISC); float* igs = bs + 64; float* npv = igs + 64; float* den2 = npv + 64;
  const int tok0 = b * SEQ + c * 64;
  const int d = lane;
  const int base = (b * NCH + c) * 4 + hd;
  const float* st = p.ml_state + (size_t)base * 4096;
  __syncthreads();
  ml_gates(p, l, tok0, hd, bs, igs, tid);
  if (tid >= 64 && tid < 128) npv[tid - 64] = p.ml_n[base * 64 + tid - 64];
  __syncthreads();
  const bfu* pq = p.proj + (size_t)tok0 * PS + COL_BQ + hd * 64 + d;
  const bfu* pk = p.proj + (size_t)tok0 * PS + COL_BK + hd * 64 + d;
  const bfu* pv = p.proj + (size_t)tok0 * PS + COL_BV + hd * 64 + d;
#pragma unroll
  for (int i = 0; i < 16; ++i) {
    const int t = w * 16 + i;
    const bfu qraw = pq[(size_t)t * PS];
    Qp[t * 72 + d] = qraw;
    Kp[t * 72 + d] = pk[(size_t)t * PS];
    A[t * 136 + 64 + d] = f2bf(bf2f(qraw) * expf(bs[t]));
    Bt[d * 136 + t] = pv[(size_t)t * PS];
    const int e = w + 4 * i;
    Bt[e * 136 + 64 + d] = f2bf(st[e * 64 + d]);
  }
  __syncthreads();
  if (tid < 64) {
    float s = 0.f;
    for (int dd = 0; dd < 64; ++dd) s += bf2f(A[tid * 136 + 64 + dd]) * npv[dd];
    den2[tid] = s;
  }
  const int r = lane & 15, q = lane >> 4;
  f32x4 acc[4];
#pragma unroll
  for (int i = 0; i < 4; ++i) acc[i] = (f32x4){0.f, 0.f, 0.f, 0.f};
  wave_mma<4, 2>(acc, Qp + w * 16 * 72, 72, Kp, 72, lane);
  float den1[4];
#pragma unroll
  for (int j = 0; j < 4; ++j) {
    const int t = w * 16 + q * 4 + j;
    const float bt = bs[t];
    float rs = 0.f;
#pragma unroll
    for (int nt = 0; nt < 4; ++nt) {
      const int s = nt * 16 + r;
      float wv = 0.f;
      if (s <= t) wv = expf(bt - bs[s] + igs[s]) * acc[nt][j] * 0.125f;
      rs += wv;
      A[t * 136 + s] = f2bf(wv);
    }
    den1[j] = group16_sum(rs);
  }
  __syncthreads();
  f32x4 o[4];
#pragma unroll
  for (int i = 0; i < 4; ++i) o[i] = (f32x4){0.f, 0.f, 0.f, 0.f};
  wave_mma<4, 4>(o, A + w * 16 * 136, 136, Bt, 136, lane);
#pragma unroll
  for (int j = 0; j < 4; ++j) {
    const int t = w * 16 + q * 4 + j;
    const float den = den1[j] + den2[t];
    const float inv = 1.f / fmaxf(fabsf(den), 1.f);
    float hv[4];
    float ss = 0.f;
#pragma unroll
    for (int nt = 0; nt < 4; ++nt) { hv[nt] = o[nt][j] * inv; ss += hv[nt] * hv[nt]; }
    ss = group16_sum(ss);
    const float sc = rsqrtf(ss * (1.f / 64.f) + 1e-6f);
    const bfu* prow = p.proj + (size_t)(tok0 + t) * PS + COL_BG + hd * 64;
    bfu* mrow = p.mixed + (size_t)(tok0 + t) * 1024 + 256 + hd * 64;
#pragma unroll
    for (int nt = 0; nt < 4; ++nt) {
      const int e = nt * 16 + r;
      mrow[e] = f2bf(hv[nt] * sc * p.ml_g[l * 256 + hd * 64 + e] * silu_(bf2f(prow[e])));
    }
  }
}

template <bool FINAL>
DI void lru_item(const Params& p, int l, int b, int c, int n, unsigned char* smem) {
  const int tid = threadIdx.x, lane = tid & 63, w = tid >> 6;
  bfu* xcb = (bfu*)smem;
  float* xcf = (float*)(smem + 9216);
  float* af = (float*)(smem + 9216 + 17408);
  float* segH = (float*)(smem + 9216 + 2 * 17408);
  float* segA = segH + 256;
  const int tok0 = b * SEQ + c * 64;
  const int ch = n * 64 + lane;
  __syncthreads();
  {
    const float cw0 = p.conv_w[(l * 4 + 0) * 256 + ch], cw1 = p.conv_w[(l * 4 + 1) * 256 + ch];
    const float cw2 = p.conv_w[(l * 4 + 2) * 256 + ch], cw3 = p.conv_w[(l * 4 + 3) * 256 + ch];
    const float cb = p.conv_b[l * 256 + ch];
    const bfu* px = p.proj + (size_t)tok0 * PS + COL_CX + ch;
#pragma unroll
    for (int i = 0; i < 16; ++i) {
      const int t = w * 16 + i;
      const int sp = c * 64 + t;
      float x0 = (sp >= 3) ? bf2f(px[(ptrdiff_t)(t - 3) * PS]) : 0.f;
      float x1 = (sp >= 2) ? bf2f(px[(ptrdiff_t)(t - 2) * PS]) : 0.f;
      float x2 = (sp >= 1) ? bf2f(px[(ptrdiff_t)(t - 1) * PS]) : 0.f;
      float x3 = bf2f(px[(ptrdiff_t)t * PS]);
      const float xc = cb + cw0 * x0 + cw1 * x1 + cw2 * x2 + cw3 * x3;
      xcf[t * 68 + lane] = xc;
      xcb[t * 72 + lane] = f2bf(xc);
    }
  }
  __syncthreads();
  const int r = lane & 15, q = lane >> 4;
  f32x4 aa[4], ax[4];
#pragma unroll
  for (int i = 0; i < 4; ++i) { aa[i] = (f32x4){0.f, 0.f, 0.f, 0.f}; ax[i] = (f32x4){0.f, 0.f, 0.f, 0.f}; }
  wave_mma<4, 2>(aa, xcb + w * 16 * 72, 72, p.wt_a + (l * 4 + n) * 4096, 64, lane);
  wave_mma<4, 2>(ax, xcb + w * 16 * 72, 72, p.wt_x + (l * 4 + n) * 4096, 64, lane);
#pragma unroll
  for (int nt = 0; nt < 4; ++nt) {
    const int e = nt * 16 + r, che = n * 64 + e;
    const float ba = p.b_a[l * 256 + che], bx = p.b_x[l * 256 + che];
    const float lsl = 8.f * logsig_(p.lam[l * 256 + che]);
#pragma unroll
    for (int j = 0; j < 4; ++j) {
      const int t = w * 16 + q * 4 + j;
      const float rg = sigmoid_(aa[nt][j] + ba), ig = sigmoid_(ax[nt][j] + bx);
      const float la = lsl * rg;
      const float a = expf(la);
      const float bv = sqrtf(fmaxf(-expm1f(2.f * la), 0.f)) * ig * xcf[t * 68 + e];
      af[t * 68 + e] = a; xcf[t * 68 + e] = bv;
    }
  }
  __syncthreads();
  float hl[16], al[16];
  float h = 0.f, ap = 1.f;
#pragma unroll
  for (int i = 0; i < 16; ++i) {
    const int t = w * 16 + i;
    const float a = af[t * 68 + lane], bv = xcf[t * 68 + lane];
    h = a * h + bv; ap *= a; hl[i] = h; al[i] = ap;
  }
  segH[w * 64 + lane] = h; segA[w * 64 + lane] = ap;
  __syncthreads();
  const int sidx = (b * NCH + c) * 256 + ch;
  if (!FINAL) {
    if (w == 0) {
      float H = 0.f, Ap = 1.f;
#pragma unroll
      for (int s = 0; s < 4; ++s) { H = segA[s * 64 + lane] * H + segH[s * 64 + lane]; Ap *= segA[s * 64 + lane]; }
      p.lru_h[sidx] = H; p.lru_a[sidx] = Ap;
    }
  } else {
    float H = p.lru_h[sidx];
#pragma unroll
    for (int s = 0; s < 4; ++s) if (s < w) H = segA[s * 64 + lane] * H + segH[s * 64 + lane];
    const bfu* pg = p.proj + (size_t)tok0 * PS + COL_CG + ch;
    bfu* pm = p.mixed + (size_t)tok0 * 1024 + 512 + ch;
#pragma unroll
    for (int i = 0; i < 16; ++i) {
      const int t = w * 16 + i;
      const float hv = hl[i] + al[i] * H;
      pm[(size_t)t * 1024] = f2bf(hv * silu_(bf2f(pg[(size_t)t * PS])));
    }
  }
}

template <bool FINAL>
DI void s5_item(const Params& p, int l, int b, int c, int g4, unsigned char* smem) {
  const int tid = threadIdx.x, lane = tid & 63, w = tid >> 6;
  const int g = g4 * 4 + w;
  float* buw = (float*)(smem + w * 13312);
  bfu* stw = (bfu*)(smem + w * 13312 + 8448);
  const int tok0 = b * SEQ + c * 64;
  const int r = lane & 15, q = lane >> 4;
  const int lg = l * 16 + g;
  bf16x8 bfr[8], yfr[4];
#pragma unroll
  for (int nt = 0; nt < 8; ++nt) bfr[nt] = *(const bf16x8*)(p.bt_bu + ((size_t)lg * 128 + nt * 16 + r) * 32 + q * 8);
  if (FINAL) {
#pragma unroll
    for (int ks = 0; ks < 4; ++ks) yfr[ks] = *(const bf16x8*)(p.bt_y + ((size_t)lg * 16 + r) * 128 + ks * 32 + q * 8);
  }
  const float ar = p.abar[(lg * 64 + lane) * 2], ai = p.abar[(lg * 64 + lane) * 2 + 1];
  const size_t sbase = ((size_t)(b * NCH + c) * 16 + g) * 128;
  float xr = 0.f, xi = 0.f;
  if (FINAL) { xr = p.s5_state[sbase + lane]; xi = p.s5_state[sbase + 64 + lane]; }
  const float dsk = FINAL ? p.s5_d[l * 256 + g * 16 + r] : 0.f;
  __syncthreads();
  for (int mt = 0; mt < 4; ++mt) {
    bf16x8 a = (bf16x8){0, 0, 0, 0, 0, 0, 0, 0};
    if (q < 2) a = *(const bf16x8*)(p.proj + (size_t)(tok0 + mt * 16 + r) * PS + COL_DU + g * 16 + q * 8);
#pragma unroll
    for (int nt = 0; nt < 8; ++nt) {
      f32x4 acc = (f32x4){0.f, 0.f, 0.f, 0.f};
      acc = __builtin_amdgcn_mfma_f32_16x16x32_bf16(a, bfr[nt], acc, 0, 0, 0);
#pragma unroll
      for (int j = 0; j < 4; ++j) buw[(q * 4 + j) * 132 + nt * 16 + r] = acc[j];
    }
    __syncthreads();
#pragma unroll
    for (int tt = 0; tt < 16; ++tt) {
      const float br = buw[tt * 132 + lane], bi = buw[tt * 132 + 64 + lane];
      const float nr = ar * xr - ai * xi + br;
      const float ni = ar * xi + ai * xr + bi;
      xr = nr; xi = ni;
      if (FINAL) { stw[tt * 136 + lane] = f2bf(xr); stw[tt * 136 + 64 + lane] = f2bf(xi); }
    }
    __syncthreads();
    if (FINAL) {
      f32x4 y = (f32x4){0.f, 0.f, 0.f, 0.f};
#pragma unroll
      for (int ks = 0; ks < 4; ++ks) {
        bf16x8 a2 = *(const bf16x8*)(stw + r * 136 + ks * 32 + q * 8);
        y = __builtin_amdgcn_mfma_f32_16x16x32_bf16(a2, yfr[ks], y, 0, 0, 0);
      }
#pragma unroll
      for (int j = 0; j < 4; ++j) {
        const int t = mt * 16 + q * 4 + j;
        const float u = bf2f(p.proj[(size_t)(tok0 + t) * PS + COL_DU + g * 16 + r]);
        const float z = gelu_tanh_(y[j] + dsk * u);
        p.zbuf[(size_t)(tok0 + t) * 256 + g * 16 + r] = f2bf(z);
      }
      __syncthreads();
    }
  }
  if (!FINAL) { p.s5_state[sbase + lane] = xr; p.s5_state[sbase + 64 + lane] = xi; }
}

DI void s5_glu(const Params& p, int l, int b, int c, unsigned char* smem) {
  const int tid = threadIdx.x, lane = tid & 63, w = tid >> 6;
  bfu* zs = (bfu*)smem;
  const int tok0 = b * SEQ + c * 64;
  __syncthreads();
  for (int i = tid; i < 64 * 32; i += 256) {
    const int t = i >> 5, kc = i & 31;
    *(uint4*)(zs + t * 264 + kc * 8) = *(const uint4*)(p.zbuf + (size_t)(tok0 + t) * 256 + kc * 8);
  }
  __syncthreads();
  const int r = lane & 15, q = lane >> 4;
  for (int nc = 0; nc < 4; ++nc) {
    f32x4 acc[4];
#pragma unroll
    for (int i = 0; i < 4; ++i) acc[i] = (f32x4){0.f, 0.f, 0.f, 0.f};
#pragma unroll 1
    for (int kh = 0; kh < 4; ++kh)
      wave_mma<4, 2>(acc, zs + w * 16 * 264 + kh * 64, 264, p.wt_glu + l * 65536 + nc * 64 * 256 + kh * 64, 256, lane);
#pragma unroll
    for (int nt = 0; nt < 4; ++nt) {
      const int n = nc * 64 + nt * 16 + r;
      const float bg = p.b_glu[l * 256 + n];
#pragma unroll
      for (int j = 0; j < 4; ++j) {
        const int t = w * 16 + q * 4 + j;
        const float zv = bf2f(zs[t * 264 + n]);
        const float gate = silu_(bf2f(p.proj[(size_t)(tok0 + t) * PS + COL_DG + n]));
        p.mixed[(size_t)(tok0 + t) * 1024 + 768 + n] = f2bf(zv * sigmoid_(acc[nt][j] + bg) * gate);
      }
    }
  }
}

DI void phase2(const Params& p, int l, unsigned char* smem) {
  for (int item = blockIdx.x; item < 1024; item += gridDim.x) hg_local(p, l, item >> 7, (item >> 2) & 31, item & 3, smem);
  for (int item = blockIdx.x; item < 1024; item += gridDim.x) ml_local(p, l, item >> 7, (item >> 2) & 31, item & 3, smem);
  for (int item = blockIdx.x; item < 1024; item += gridDim.x) lru_item<false>(p, l, item >> 7, (item >> 2) & 31, item & 3, smem);
  for (int item = blockIdx.x; item < 1024; item += gridDim.x) s5_item<false>(p, l, item >> 7, (item >> 2) & 31, item & 3, smem);
}

DI void phase3(const Params& p, int l) {
  const int gtid = blockIdx.x * 256 + threadIdx.x, gsz = gridDim.x * 256;
  constexpr int N1 = 131072, N2 = 131072, N3 = 2048, N4 = 2048, N5 = 8192;
  for (int i = gtid; i < N1 + N2 + N3 + N4 + N5; i += gsz) {
    if (i < N1 + N2) {
      const bool ml = i >= N1;
      const int j = ml ? i - N1 : i;
      const int b = j >> 14, rem = j & 16383, hd = rem >> 12, ed = rem & 4095, d = ed & 63;
      float* stp = (ml ? p.ml_state : p.hg_state) + (size_t)(b * NCH * 4 + hd) * 4096 + ed;
      const float* dcp = ml ? (p.ml_decay + b * NCH * 4 + hd) : (p.hg_decay + (b * NCH * 4 + hd) * 64 + d);
      const int dstride = ml ? 4 : 256;
      float S = 0.f;
#pragma unroll
      for (int c0 = 0; c0 < NCH; c0 += 16) {
        float loc[16], dec[16];
#pragma unroll
        for (int c = 0; c < 16; ++c) { loc[c] = stp[(size_t)(c0 + c) * 16384]; dec[c] = dcp[(c0 + c) * dstride]; }
#pragma unroll
        for (int c = 0; c < 16; ++c) { stp[(size_t)(c0 + c) * 16384] = S; S = dec[c] * S + loc[c]; }
      }
    } else if (i < N1 + N2 + N3) {
      const int j = i - N1 - N2, b = j >> 8, rem = j & 255, hd = rem >> 6, d = rem & 63;
      float S = 0.f;
      for (int c = 0; c < NCH; ++c) {
        const int base = (b * NCH + c) * 4 + hd;
        const float dec = p.ml_decay[base];
        const float loc = p.ml_n[base * 64 + d];
        p.ml_n[base * 64 + d] = S; S = dec * S + loc;
      }
    } else if (i < N1 + N2 + N3 + N4) {
      const int j = i - N1 - N2 - N3, b = j >> 8, ch = j & 255;
      float H = 0.f;
      for (int c = 0; c < NCH; ++c) {
        const int idx = (b * NCH + c) * 256 + ch;
        const float a = p.lru_a[idx], hl = p.lru_h[idx];
        p.lru_h[idx] = H; H = a * H + hl;
      }
    } else {
      const int j = i - N1 - N2 - N3 - N4, b = j >> 10, g = (j >> 6) & 15, pp = j & 63;
      const float ar = p.abar64[((l * 16 + g) * 64 + pp) * 2], ai = p.abar64[((l * 16 + g) * 64 + pp) * 2 + 1];
      float xr = 0.f, xi = 0.f;
      for (int c = 0; c < NCH; ++c) {
        const size_t sb = ((size_t)(b * NCH + c) * 16 + g) * 128;
        const float lr = p.s5_state[sb + pp], li = p.s5_state[sb + 64 + pp];
        p.s5_state[sb + pp] = xr; p.s5_state[sb + 64 + pp] = xi;
        const float nr = ar * xr - ai * xi + lr, ni = ar * xi + ai * xr + li;
        xr = nr; xi = ni;
      }
    }
  }
}

DI void phase4(const Params& p, int l, unsigned char* smem) {
  unsigned* s_flag = (unsigned*)(smem + SMEM_BYTES - 16);
  for (int item = blockIdx.x; item < 1024; item += gridDim.x) {
    const int bc = item >> 2;
    s5_item<true>(p, l, bc >> 5, bc & 31, item & 3, smem);
    if (last_arriver(p.cnt + CNT_GLU + l * 256 + bc, 4u, s_flag)) s5_glu(p, l, bc >> 5, bc & 31, smem);
  }
  for (int item = blockIdx.x; item < 1024; item += gridDim.x) hg_out(p, l, item >> 7, (item >> 2) & 31, item & 3, smem);
  for (int item = blockIdx.x; item < 1024; item += gridDim.x) ml_out(p, l, item >> 7, (item >> 2) & 31, item & 3, smem);
  for (int item = blockIdx.x; item < 1024; item += gridDim.x) lru_item<true>(p, l, item >> 7, (item >> 2) & 31, item & 3, smem);
}

#define RUN_PHASE(PH, CALL)                                       \
  if (ph0 <= (PH) && (PH) < ph1) {                                \
    CALL;                                                         \
    if (COOP) { if ((PH) + 1 < ph1) xcd_barrier(xb); }            \
  }

template <bool COOP, int L>
DI void run_layer(const Params& p, int ph0, int ph1, unsigned char* smem, const XcdBarrier& xb) {
#ifdef DUP1
  RUN_PHASE(1 + 5 * L, phase1(p, L, smem))
#endif
  RUN_PHASE(1 + 5 * L, phase1(p, L, smem))
#ifdef DUP2
  RUN_PHASE(2 + 5 * L, phase2(p, L, smem))
#endif
  RUN_PHASE(2 + 5 * L, phase2(p, L, smem))
  RUN_PHASE(3 + 5 * L, phase3(p, L))
#ifdef DUP4
  RUN_PHASE(4 + 5 * L, phase4(p, L, smem))
#endif
  RUN_PHASE(4 + 5 * L, phase4(p, L, smem))
  RUN_PHASE(5 + 5 * L, phase5(p, L, smem))
}

template <bool COOP>
__global__ void __launch_bounds__(256, 2) mk_fwd(Params p, int ph0, int ph1) {
  __shared__ __attribute__((aligned(16))) unsigned char smem[SMEM_BYTES];
  __shared__ uint4 xb_words;
  XcdBarrier xb; xb.bar = p.bar; xb.x = 0; xb.st = nullptr;
  if (COOP) {
    if (ph1 < 0) cg::this_grid().sync();
    if (threadIdx.x == 0) xb_words = make_uint4(0u, 0u, 0u, 0u);
    __syncthreads();
    xb = xcd_barrier_post(p.bar, (volatile LAS unsigned*)&xb_words);
  }
  RUN_PHASE(0, phase0(p, smem))
  run_layer<COOP, 0>(p, ph0, ph1, smem, xb);
  run_layer<COOP, 1>(p, ph0, ph1, smem, xb);
  run_layer<COOP, 2>(p, ph0, ph1, smem, xb);
  run_layer<COOP, 3>(p, ph0, ph1, smem, xb);
}

extern "C" void kernel_launch(void* const* d_in, const int* in_sizes, int n_in, void* d_out, int out_size, void* d_ws,
                              size_t ws_size, hipStream_t stream) {
  static int grid_blocks = 0;
  if (!grid_blocks) {
    int dev = 0, cus = 0, per_cu = 0;
    hipGetDevice(&dev);
    hipDeviceGetAttribute(&cus, hipDeviceAttributeMultiprocessorCount, dev);
    hipOccupancyMaxActiveBlocksPerMultiprocessor(&per_cu, mk_fwd<(MEGA != 0)>, 256, 0);
    if (per_cu < 1) per_cu = 1;
    if (per_cu > 2) per_cu = 2;
    grid_blocks = cus * per_cu;
  }
  Params p{};
  const float** pin = (const float**)&p;
  for (int i = 0; i < 28; ++i) pin[i] = (const float*)d_in[i];
  p.out = (float*)d_out;
  unsigned char* ws = (unsigned char*)d_ws;
  size_t off = 0;
  auto take = [&](size_t bytes) { unsigned char* r = ws + off; off += (bytes + 255) & ~(size_t)255; return r; };
  p.wt_in = (bfu*)take((size_t)4 * PS * 1024 * 2);
  p.wt_out = (bfu*)take((size_t)4 * 1024 * 1024 * 2);
  p.wt_a = (bfu*)take(16 * 4096 * 2);
  p.wt_x = (bfu*)take(16 * 4096 * 2);
  p.wt_glu = (bfu*)take(4 * 65536 * 2);
  p.bt_bu = (bfu*)take(64 * 128 * 32 * 2);
  p.bt_y = (bfu*)take(64 * 16 * 128 * 2);
  p.hb = (bfu*)take((size_t)NTOK * 1024 * 2);
  p.proj = (bfu*)take((size_t)NTOK * PS * 2);
  p.mixed = (bfu*)take((size_t)NTOK * 1024 * 2);
  p.zbuf = (bfu*)take((size_t)NTOK * 256 * 2);
  p.abar = (float*)take(4096 * 2 * 4);
  p.abar64 = (float*)take(4096 * 2 * 4);
  p.lbs = (float*)take(1024 * 4);
  p.hg_state = (float*)take((size_t)BATCH * NCH * 4 * 4096 * 4);
  p.hg_decay = (float*)take((size_t)BATCH * NCH * 4 * 64 * 4);
  p.ml_state = (float*)take((size_t)BATCH * NCH * 4 * 4096 * 4);
  p.ml_n = (float*)take((size_t)BATCH * NCH * 4 * 64 * 4);
  p.ml_decay = (float*)take((size_t)BATCH * NCH * 4 * 4);
  p.lru_h = (float*)take((size_t)BATCH * NCH * 256 * 4);
  p.lru_a = (float*)take((size_t)BATCH * NCH * 256 * 4);
  p.s5_state = (float*)take((size_t)BATCH * NCH * 16 * 128 * 4);
  p.cnt = (unsigned*)take(CNT_TOTAL * 4);
  p.bar = (unsigned*)take(XCD_BAR_WORDS * 4);
  if (off > ws_size) { fprintf(stderr, "workspace too small: need %zu have %zu\n", off, ws_size); return; }
  const int NPH = 1 + 5 * DEPTH;
#if MEGA
  (void)hipMemsetAsync(p.bar, 0, XCD_BAR_WORDS * 4, stream);
  int ph0 = 0, ph1 = NPH;
  void* args[] = {&p, &ph0, &ph1};
  hipError_t e = hipLaunchCooperativeKernel((void*)mk_fwd<true>, dim3(grid_blocks), dim3(256), args, 0, stream);
  if (e != hipSuccess) fprintf(stderr, "cooperative launch failed: %s (grid %d)\n", hipGetErrorString(e), grid_blocks);
#else
  for (int ph = 0; ph < NPH; ++ph) hipLaunchKernelGGL(mk_fwd<false>, dim3(grid_blocks), dim3(256), 0, stream, p, ph, ph + 1);
#endif
}
```

```cpp
#include <hip/hip_runtime.h>
#include <hip/hip_cooperative_groups.h>
#include <stdint.h>
#include <stdio.h>
namespace cg = cooperative_groups;

#ifndef MEGA
#define MEGA 1
#endif

typedef unsigned short bfu;
using bf16x8 = __attribute__((ext_vector_type(8))) short;
using f32x4  = __attribute__((ext_vector_type(4))) float;
#define DI __device__ __forceinline__

constexpr int BATCH = 8, SEQ = 2048, DM = 1024, DEPTH = 4, NTOK = BATCH * SEQ, NCH = SEQ / 64;
constexpr int DIN = 3080, PS = 3200;
constexpr int COL_AQ = 0, COL_AF = 256, COL_AI = 512, COL_AG = 768;
constexpr int COL_BQ = 1024, COL_BK = 1280, COL_BV = 1536, COL_BIG = 1792, COL_BFG = 1796, COL_BG = 1800;
constexpr int COL_CX = 2056, COL_CG = 2312, COL_DU = 2568, COL_DG = 2824;
constexpr float DN_ALPHA = 1.681792830507429f;
constexpr int SMEM_BYTES = 56 * 1024;
constexpr int CNT_LN = 0, CNT_GLU = 4 * 128, CNT_TOTAL = 4 * 128 + 4 * 256;

struct Params {
  const float *x, *w_in, *b_in, *lb_logits, *hg_g, *ml_fb, *ml_g, *conv_w, *conv_b, *w_a, *b_a, *w_x, *b_x, *lam,
      *a_re, *a_im, *log_dt, *sb_re, *sb_im, *c_re, *c_im, *s5_d, *w_glu, *b_glu, *w_out, *b_out, *ln_g, *ln_b;
  float* out;
  bfu *wt_in, *wt_out, *wt_a, *wt_x, *wt_glu, *bt_bu, *bt_y, *hb, *proj, *mixed, *zbuf;
  float *abar, *abar64, *lbs, *hg_state, *hg_decay, *ml_state, *ml_n, *ml_decay, *lru_h, *lru_a, *s5_state;
  unsigned* cnt;
  unsigned* bar;
};

DI bfu f2bf(float x) { unsigned u = __float_as_uint(x); u += 0x7fffu + ((u >> 16) & 1u); return (bfu)(u >> 16); }
DI float bf2f(bfu h) { return __uint_as_float(((unsigned)h) << 16); }
DI unsigned pack2(float a, float b) { return (unsigned)f2bf(a) | ((unsigned)f2bf(b) << 16); }
DI float fexp(float x) { return __expf(x); }
DI float frcp(float x) { return __builtin_amdgcn_rcpf(x); }
DI float flog(float x) { return __logf(x); }
DI float sigmoid_(float x) { return frcp(1.f + fexp(-x)); }
DI float silu_(float x) { return x * frcp(1.f + fexp(-x)); }
DI float logsig_(float x) { return fminf(x, 0.f) - flog(1.f + fexp(-fabsf(x))); }
DI float logsig_acc(float x) { return fminf(x, 0.f) - log1pf(expf(-fabsf(x))); }
DI float gelu_tanh_(float x) {
  float u = 0.7978845608028654f * (x + 0.044715f * x * x * x);
  float th = 1.f - 2.f * frcp(fexp(2.f * u) + 1.f);
  return 0.5f * x * (1.f + th);
}

template <int NT, int KS>
DI void wave_mma(f32x4 (&acc)[NT], const bfu* A, int lda, const bfu* Bt, int ldb, int lane) {
  const int r = lane & 15, q = lane >> 4;
#pragma unroll
  for (int ks = 0; ks < KS; ++ks) {
    bf16x8 a = *(const bf16x8*)(A + r * lda + ks * 32 + q * 8);
#pragma unroll
    for (int nt = 0; nt < NT; ++nt) {
      bf16x8 b = *(const bf16x8*)(Bt + (nt * 16 + r) * ldb + ks * 32 + q * 8);
      acc[nt] = __builtin_amdgcn_mfma_f32_16x16x32_bf16(a, b, acc[nt], 0, 0, 0);
    }
  }
}

DI float group16_sum(float v) {
  v += __shfl_xor(v, 1); v += __shfl_xor(v, 2); v += __shfl_xor(v, 4); v += __shfl_xor(v, 8);
  return v;
}
DI float wave_sum(float v) {
  v += __shfl_xor(v, 1); v += __shfl_xor(v, 2); v += __shfl_xor(v, 4); v += __shfl_xor(v, 8);
  v += __shfl_xor(v, 16); v += __shfl_xor(v, 32);
  return v;
}

DI bool last_arriver(unsigned* ctr, unsigned total, unsigned* s_flag) {
  asm volatile("s_waitcnt vmcnt(0)" ::: "memory");
  __syncthreads();
  if (threadIdx.x == 0) {
    __builtin_amdgcn_fence(__ATOMIC_RELEASE, "agent");
    asm volatile("s_waitcnt vmcnt(0)" ::: "memory");
    const unsigned old = __hip_atomic_fetch_add(ctr, 1u, __ATOMIC_RELAXED, __HIP_MEMORY_SCOPE_AGENT);
    const unsigned last = (old == total - 1u) ? 1u : 0u;
    if (last) { __builtin_amdgcn_fence(__ATOMIC_ACQUIRE, "agent"); asm volatile("s_waitcnt vmcnt(0)" ::: "memory"); }
    *s_flag = last;
  }
  __syncthreads();
  return (*s_flag != 0u);
}

#define XB_TMO      128
#define XB_XCNT(j)  (256  + 64 * (j))
#define XB_XSUB(j)  (1280 + 64 * (j))
#define XB_XGEN(j)  (2304 + 64 * (j))
#define XB_TOP      3328
#define XB_TOPGEN   3392
#define XCD_BAR_WORDS 3456
#define XB_SPIN_CAP (1u << 22)
#define LAS __attribute__((address_space(3)))
DI unsigned xb_ld(unsigned* p) { return __hip_atomic_load(p, __ATOMIC_RELAXED, __HIP_MEMORY_SCOPE_AGENT); }
DI unsigned xb_add(unsigned* p, unsigned v) { return __hip_atomic_fetch_add(p, v, __ATOMIC_RELAXED, __HIP_MEMORY_SCOPE_AGENT); }
DI unsigned xb_xcc_id() { return (unsigned)__builtin_amdgcn_s_getreg((3 << 11) | 20) & 0xFu; }
#define XB_SPIN(cond, bar) do { unsigned _sp = 0; while (cond) { __builtin_amdgcn_s_sleep(1); \
    if ((++_sp & 255u) == 0u) { if (xb_ld(&(bar)[XB_TMO])) break; if (_sp > XB_SPIN_CAP) { atomicAdd(&(bar)[XB_TMO], 1u); break; } } } } while (0)
struct XcdBarrier { unsigned* bar; unsigned x; volatile LAS unsigned* st; };
DI XcdBarrier xcd_barrier_post(unsigned* bar, volatile LAS unsigned* st) {
  XcdBarrier b; b.bar = bar; b.x = xb_xcc_id(); b.st = st;
  if (threadIdx.x == 0) (void)xb_add(&bar[XB_XCNT(b.x)], 1u);
  return b;
}
DI void xcd_barrier_complete(unsigned* bar, unsigned x, unsigned& nloc, unsigned& nx) {
  const unsigned G = gridDim.x * gridDim.y * gridDim.z;
  unsigned sum, cnt, mine, sp = 0u;
  for (;;) {
    sum = 0u; cnt = 0u; mine = 0u;
#pragma unroll
    for (unsigned j = 0; j < 16; ++j) { const unsigned c = xb_ld(&bar[XB_XCNT(j)]); sum += c; cnt += (c > 0u) ? 1u : 0u; mine = (j == x) ? c : mine; }
    if (sum == G) break;
    __builtin_amdgcn_s_sleep(1);
    if ((++sp & 255u) == 0u) { if (xb_ld(&bar[XB_TMO])) break; if (sp > XB_SPIN_CAP) { atomicAdd(&bar[XB_TMO], 1u); break; } }
  }
  nloc = mine > 0u ? mine : 1u; nx = cnt > 0u ? cnt : 1u;
}
DI void xcd_barrier(const XcdBarrier& b) {
  asm volatile("s_waitcnt vmcnt(0)" ::: "memory");
  __syncthreads();
  if (threadIdx.x == 0) {
    unsigned* bar = b.bar;
    __builtin_amdgcn_s_waitcnt(0);
    unsigned nloc = b.st[0], nx = b.st[1];
    if (nloc == 0u) { xcd_barrier_complete(bar, b.x, nloc, nx); b.st[0] = nloc; b.st[1] = nx; }
    const unsigned old = xb_add(&bar[XB_XSUB(b.x)], 1u);
    const unsigned gen = old / nloc;
    if (old + 1u == (gen + 1u) * nloc) {
      __builtin_amdgcn_fence(__ATOMIC_RELEASE, "agent");
      asm volatile("s_waitcnt vmcnt(0)" ::: "memory");
      const unsigned og = xb_add(&bar[XB_TOP], 1u);
      const unsigned tg = og / nx;
      if (og + 1u == (tg + 1u) * nx) xb_add(&bar[XB_TOPGEN], 1u);
      else XB_SPIN(xb_ld(&bar[XB_TOPGEN]) == tg, bar);
      __builtin_amdgcn_fence(__ATOMIC_ACQUIRE, "agent");
      xb_add(&bar[XB_XGEN(b.x)], 1u);
      asm volatile("s_waitcnt vmcnt(0)" ::: "memory");
    } else {
      XB_SPIN(xb_ld(&bar[XB_XGEN(b.x)]) == gen, bar);
      __builtin_amdgcn_fence(__ATOMIC_ACQUIRE, "agent");
      asm volatile("s_waitcnt vmcnt(0)" ::: "memory");
    }
  }
  __syncthreads();
}

DI void transpose_tile(const float* src, int sld, int cv, bfu* dst, int dld, float* tile) {
  const int tid = threadIdx.x;
  __syncthreads();
  for (int i = tid; i < 4096; i += 256) {
    int r = i >> 6, c = i & 63;
    tile[r * 65 + c] = (c < cv) ? src[(size_t)r * sld + c] : 0.f;
  }
  __syncthreads();
  for (int i = tid; i < 4096; i += 256) {
    int n = i >> 6, k = i & 63;
    dst[(size_t)n * dld + k] = f2bf(tile[k * 65 + n]);
  }
}

DI void phase0(const Params& p, unsigned char* smem) {
  const int tid = threadIdx.x;
  const int gtid = blockIdx.x * 256 + tid, gsz = gridDim.x * 256;
  for (int i = gtid; i < NTOK * DM / 8; i += gsz) {
    float4 a = ((const float4*)p.x)[2 * i], b = ((const float4*)p.x)[2 * i + 1];
    uint4 o; o.x = pack2(a.x, a.y); o.y = pack2(a.z, a.w); o.z = pack2(b.x, b.y); o.w = pack2(b.z, b.w);
    ((uint4*)p.hb)[i] = o;
  }
  float* tile = (float*)smem;
  const int NJ = 3200 + 1024 + 16 + 16 + 64;
  for (int job = blockIdx.x; job < NJ; job += gridDim.x) {
    const float* src; int sld, cv = 64, dld; bfu* dst;
    if (job < 3200) {
      int l = job / 800, rem = job % 800, kt = rem / 50, nt = rem % 50;
      src = p.w_in + (size_t)l * 1024 * DIN + (size_t)kt * 64 * DIN + nt * 64; sld = DIN;
      cv = DIN - nt * 64; cv = cv < 0 ? 0 : (cv > 64 ? 64 : cv);
      dst = p.wt_in + (size_t)l * PS * 1024 + (size_t)nt * 64 * 1024 + kt * 64; dld = 1024;
    } else if (job < 4224) {
      int j = job - 3200, l = j / 256, rem = j % 256, kt = rem / 16, nt = rem % 16;
      src = p.w_out + (size_t)l * 1048576 + (size_t)kt * 64 * 1024 + nt * 64; sld = 1024;
      dst = p.wt_out + (size_t)l * 1048576 + (size_t)nt * 64 * 1024 + kt * 64; dld = 1024;
    } else if (job < 4240) {
      int j = job - 4224; src = p.w_a + j * 4096; sld = 64; dst = p.wt_a + j * 4096; dld = 64;
    } else if (job < 4256) {
      int j = job - 4240; src = p.w_x + j * 4096; sld = 64; dst = p.wt_x + j * 4096; dld = 64;
    } else {
      int j = job - 4256, l = j / 16, rem = j % 16, kt = rem / 4, nt = rem % 4;
      src = p.w_glu + l * 65536 + kt * 64 * 256 + nt * 64; sld = 256;
      dst = p.wt_glu + l * 65536 + nt * 64 * 256 + kt * 64; dld = 256;
    }
    transpose_tile(src, sld, cv, dst, dld, tile);
  }
  for (int i = gtid; i < 4096; i += gsz) {
    int lg = i >> 6, pp = i & 63;
    double dt = exp((double)p.log_dt[lg]);
    double are = p.a_re[lg * 64 + pp], aim = p.a_im[lg * 64 + pp];
    double mag = exp(dt * are), ang = dt * aim;
    double abr = mag * cos(ang), abi = mag * sin(ang);
    double den = are * are + aim * aim;
    double xr = abr - 1.0, xi = abi;
    double zr = (xr * are + xi * aim) / den, zi = (xi * are - xr * aim) / den;
    bfu* o_re = p.bt_bu + ((size_t)lg * 128 + pp) * 32;
    bfu* o_im = p.bt_bu + ((size_t)lg * 128 + 64 + pp) * 32;
    for (int h = 0; h < 16; ++h) {
      double br = p.sb_re[(lg * 64 + pp) * 16 + h], bi = p.sb_im[(lg * 64 + pp) * 16 + h];
      o_re[h] = f2bf((float)(zr * br - zi * bi));
      o_im[h] = f2bf((float)(zr * bi + zi * br));
      o_re[16 + h] = 0; o_im[16 + h] = 0;
    }
    p.abar[(lg * 64 + pp) * 2 + 0] = (float)abr; p.abar[(lg * 64 + pp) * 2 + 1] = (float)abi;
    double mag64 = exp(64.0 * dt * are), ang64 = 64.0 * ang;
    p.abar64[(lg * 64 + pp) * 2 + 0] = (float)(mag64 * cos(ang64));
    p.abar64[(lg * 64 + pp) * 2 + 1] = (float)(mag64 * sin(ang64));
  }
  for (int i = gtid; i < 4 * 16 * 16 * 128; i += gsz) {
    int k = i & 127, lgn = i >> 7;
    p.bt_y[i] = (k < 64) ? f2bf(p.c_re[lgn * 64 + k]) : f2bf(-p.c_im[lgn * 64 + (k - 64)]);
  }
  for (int i = gtid; i < 256; i += gsz) {
    float v0 = p.lb_logits[i], v1 = p.lb_logits[256 + i], v2 = p.lb_logits[512 + i], v3 = p.lb_logits[768 + i];
    float m = fmaxf(fmaxf(v0, v1), fmaxf(v2, v3));
    float e0 = expf(v0 - m), e1 = expf(v1 - m), e2 = expf(v2 - m), e3 = expf(v3 - m);
    float s = e0 + e1 + e2 + e3;
    p.lbs[i] = 0.f; p.lbs[256 + i] = e1 / s; p.lbs[512 + i] = (e1 + e2) / s; p.lbs[768 + i] = (e1 + e2 + e3) / s;
  }
  for (int i = gtid; i < CNT_TOTAL; i += gsz) p.cnt[i] = 0u;
}

template <int EPI>
DI void gemm_tile(const Params& p, int l, const bfu* A, const bfu* Bt, int m0, int n0, const float* hin, unsigned char* smem) {
  bfu* sA = (bfu*)smem; bfu* sB = sA + 128 * 72;
  const int tid = threadIdx.x, lane = tid & 63, w = tid >> 6, wm = w >> 1, wn = w & 1;
  const int r = lane & 15, q = lane >> 4;
  f32x4 acc[4][4];
#pragma unroll
  for (int i = 0; i < 4; ++i)
#pragma unroll
    for (int j = 0; j < 4; ++j) acc[i][j] = (f32x4){0.f, 0.f, 0.f, 0.f};
  const int lrow = tid >> 3, lkc = tid & 7;
  const bfu* ga = A + (size_t)(m0 + lrow) * 1024 + lkc * 8;
  const bfu* gb = Bt + (size_t)(n0 + lrow) * 1024 + lkc * 8;
  uint4 ra0 = *(const uint4*)(ga), ra1 = *(const uint4*)(ga + 32 * 1024), ra2 = *(const uint4*)(ga + 64 * 1024), ra3 = *(const uint4*)(ga + 96 * 1024);
  uint4 rb0 = *(const uint4*)(gb), rb1 = *(const uint4*)(gb + 32 * 1024), rb2 = *(const uint4*)(gb + 64 * 1024), rb3 = *(const uint4*)(gb + 96 * 1024);
  bfu* wa = sA + lrow * 72 + lkc * 8;
  bfu* wb = sB + lrow * 72 + lkc * 8;
  for (int kt = 0; kt < 16; ++kt) {
    __syncthreads();
    *(uint4*)(wa) = ra0; *(uint4*)(wa + 32 * 72) = ra1; *(uint4*)(wa + 64 * 72) = ra2; *(uint4*)(wa + 96 * 72) = ra3;
    *(uint4*)(wb) = rb0; *(uint4*)(wb + 32 * 72) = rb1; *(uint4*)(wb + 64 * 72) = rb2; *(uint4*)(wb + 96 * 72) = rb3;
    __syncthreads();
    if (kt + 1 < 16) {
      const bfu* ga2 = ga + (kt + 1) * 64; const bfu* gb2 = gb + (kt + 1) * 64;
      ra0 = *(const uint4*)(ga2); ra1 = *(const uint4*)(ga2 + 32 * 1024); ra2 = *(const uint4*)(ga2 + 64 * 1024); ra3 = *(const uint4*)(ga2 + 96 * 1024);
      rb0 = *(const uint4*)(gb2); rb1 = *(const uint4*)(gb2 + 32 * 1024); rb2 = *(const uint4*)(gb2 + 64 * 1024); rb3 = *(const uint4*)(gb2 + 96 * 1024);
    }
#pragma unroll
    for (int ks = 0; ks < 2; ++ks) {
      bf16x8 af[4], bfr[4];
#pragma unroll
      for (int mt = 0; mt < 4; ++mt) af[mt] = *(const bf16x8*)(sA + (wm * 64 + mt * 16 + r) * 72 + ks * 32 + q * 8);
#pragma unroll
      for (int nt = 0; nt < 4; ++nt) bfr[nt] = *(const bf16x8*)(sB + (wn * 64 + nt * 16 + r) * 72 + ks * 32 + q * 8);
#pragma unroll
      for (int mt = 0; mt < 4; ++mt)
#pragma unroll
        for (int nt = 0; nt < 4; ++nt) acc[mt][nt] = __builtin_amdgcn_mfma_f32_16x16x32_bf16(af[mt], bfr[nt], acc[mt][nt], 0, 0, 0);
    }
  }
#pragma unroll
  for (int nt = 0; nt < 4; ++nt) {
    const int col = n0 + wn * 64 + nt * 16 + r;
    if (EPI == 1) {
      const float bias = (col < DIN) ? p.b_in[l * DIN + col] : 0.f;
#pragma unroll
      for (int mt = 0; mt < 4; ++mt)
#pragma unroll
        for (int j = 0; j < 4; ++j) {
          const int row = m0 + wm * 64 + mt * 16 + q * 4 + j;
          p.proj[(size_t)row * PS + col] = f2bf(acc[mt][nt][j] + bias);
        }
    } else {
      const float bias = p.b_out[l * 1024 + col];
#pragma unroll
      for (int mt = 0; mt < 4; ++mt)
#pragma unroll
        for (int j = 0; j < 4; ++j) {
          const int row = m0 + wm * 64 + mt * 16 + q * 4 + j;
          const size_t o = (size_t)row * 1024 + col;
          p.out[o] = DN_ALPHA * hin[o] + acc[mt][nt][j] + bias;
        }
    }
  }
}

DI void phase1(const Params& p, int l, unsigned char* smem) {
  const bfu* Bt = p.wt_in + (size_t)l * PS * 1024;
  for (int tile = blockIdx.x; tile < 128 * 25; tile += gridDim.x) {
    int mt = tile / 25, nt = tile % 25;
    gemm_tile<1>(p, l, p.hb, Bt, mt * 128, nt * 128, nullptr, smem);
  }
}

DI void phase5(const Params& p, int l, unsigned char* smem) {
  const bfu* Bt = p.wt_out + (size_t)l * 1048576;
  const float* hin = (l == 0) ? p.x : p.out;
  const int tid = threadIdx.x, lane = tid & 63, w = tid >> 6;
  for (int tile = blockIdx.x; tile < 128 * 8; tile += gridDim.x) {
    const int mt = tile >> 3, nt = tile & 7;
    gemm_tile<2>(p, l, p.mixed, Bt, mt * 128, nt * 128, hin, smem);
    asm volatile("s_waitcnt vmcnt(0)" ::: "memory");
    __syncthreads();
    if (tid == 0) {
      unsigned* ctr = p.cnt + CNT_LN + l * 128 + mt;
      __builtin_amdgcn_fence(__ATOMIC_RELEASE, "agent");
      asm volatile("s_waitcnt vmcnt(0)" ::: "memory");
      (void)__hip_atomic_fetch_add(ctr, 1u, __ATOMIC_RELAXED, __HIP_MEMORY_SCOPE_AGENT);
      unsigned sp = 0;
      while (__hip_atomic_load(ctr, __ATOMIC_RELAXED, __HIP_MEMORY_SCOPE_AGENT) < 8u) { __builtin_amdgcn_s_sleep(1); if (++sp > (1u << 24)) break; }
      __builtin_amdgcn_fence(__ATOMIC_ACQUIRE, "agent");
      asm volatile("s_waitcnt vmcnt(0)" ::: "memory");
    }
    __syncthreads();
    const int row0 = mt * 128 + nt * 16 + w * 4;
    float4 v[4][4];
#pragma unroll
    for (int rr = 0; rr < 4; ++rr)
#pragma unroll
      for (int i = 0; i < 4; ++i) v[rr][i] = *(const float4*)(p.out + (size_t)(row0 + rr) * 1024 + i * 256 + lane * 4);
    float4 g[4], bb[4];
#pragma unroll
    for (int i = 0; i < 4; ++i) { g[i] = *(const float4*)(p.ln_g + l * 1024 + i * 256 + lane * 4); bb[i] = *(const float4*)(p.ln_b + l * 1024 + i * 256 + lane * 4); }
#pragma unroll
    for (int rr = 0; rr < 4; ++rr) {
      float sm = 0.f;
#pragma unroll
      for (int i = 0; i < 4; ++i) sm += v[rr][i].x + v[rr][i].y + v[rr][i].z + v[rr][i].w;
      const float mu = wave_sum(sm) * (1.f / 1024.f);
      float ss = 0.f;
#pragma unroll
      for (int i = 0; i < 4; ++i) {
        v[rr][i].x -= mu; v[rr][i].y -= mu; v[rr][i].z -= mu; v[rr][i].w -= mu;
        ss += v[rr][i].x * v[rr][i].x + v[rr][i].y * v[rr][i].y + v[rr][i].z * v[rr][i].z + v[rr][i].w * v[rr][i].w;
      }
      const float rs = rsqrtf(wave_sum(ss) * (1.f / 1024.f) + 1e-5f);
#pragma unroll
      for (int i = 0; i < 4; ++i) {
        const int c = i * 256 + lane * 4;
        float4 o;
        o.x = v[rr][i].x * rs * g[i].x + bb[i].x; o.y = v[rr][i].y * rs * g[i].y + bb[i].y;
        o.z = v[rr][i].z * rs * g[i].z + bb[i].z; o.w = v[rr][i].w * rs * g[i].w + bb[i].w;
        *(float4*)(p.out + (size_t)(row0 + rr) * 1024 + c) = o;
        uint2 ob; ob.x = pack2(o.x, o.y); ob.y = pack2(o.z, o.w);
        *(uint2*)(p.hb + (size_t)(row0 + rr) * 1024 + c) = ob;
      }
    }
  }
}

DI void hg_gate(float x, float lb, float& lf, float& k) {
  x = fmaxf(x, -80.f);
  const float E = fexp(-x);
  const float sg = frcp(1.f + E);
  k = (1.f - lb) * (E * sg);
  lf = flog(lb + (1.f - lb) * sg);
}

DI void hg_local(const Params& p, int l, int b, int c, int hd, unsigned char* smem) {
  const int tid = threadIdx.x, lane = tid & 63, w = tid >> 6;
  bfu* At = (bfu*)smem;
  bfu* Bt = At + 64 * 72;
  float* segtot = (float*)(smem + 2 * 64 * 72 * 2);
  const int tok0 = b * SEQ + c * 64;
  const int d = lane;
  const float lb = p.lbs[l * 256 + hd * 64 + d];
  const bfu* pf = p.proj + (size_t)tok0 * PS + COL_AF + hd * 64 + d;
  const bfu* pv = p.proj + (size_t)tok0 * PS + COL_AI + hd * 64 + d;
  float bl[16], kk[16];
  float run = 0.f;
  __syncthreads();
#pragma unroll
  for (int i = 0; i < 16; ++i) {
    const int t = w * 16 + i;
    float lf, k; hg_gate(bf2f(pf[(size_t)t * PS]), lb, lf, k);
    run += lf; bl[i] = run; kk[i] = k;
    At[d * 72 + t] = pv[(size_t)t * PS];
  }
  segtot[w * 64 + d] = run;
  __syncthreads();
  float off = 0.f, tot = 0.f;
#pragma unroll
  for (int s = 0; s < 4; ++s) { float v = segtot[s * 64 + d]; tot += v; if (s < w) off += v; }
#pragma unroll
  for (int i = 0; i < 16; ++i) { const int t = w * 16 + i; Bt[d * 72 + t] = f2bf(kk[i] * fexp(tot - (bl[i] + off))); }
  const int base = (b * NCH + c) * 4 + hd;
  if (w == 0) p.hg_decay[base * 64 + d] = fexp(tot);
  __syncthreads();
  f32x4 acc[4];
#pragma unroll
  for (int i = 0; i < 4; ++i) acc[i] = (f32x4){0.f, 0.f, 0.f, 0.f};
  wave_mma<4, 2>(acc, At + w * 16 * 72, 72, Bt, 72, lane);
  float* st = p.hg_state + (size_t)base * 4096;
  const int r = lane & 15, q = lane >> 4;
#pragma unroll
  for (int nt = 0; nt < 4; ++nt)
#pragma unroll
    for (int j = 0; j < 4; ++j) st[(w * 16 + q * 4 + j) * 64 + nt * 16 + r] = acc[nt][j];
}

constexpr int O_A = 0, O_BT = 17408, O_QP = 34816, O_KP = 44032, O_MISC = 53248;

DI void hg_out(const Params& p, int l, int b, int c, int hd, unsigned char* smem) {
  const int tid = threadIdx.x, lane = tid & 63, w = tid >> 6;
  bfu* A = (bfu*)(smem + O_A); bfu* Bt = (bfu*)(smem + O_BT); bfu* Qp = (bfu*)(smem + O_QP); bfu* Kp = (bfu*)(smem + O_KP);
  float* segtot = (float*)(smem + O_MISC);
  const int tok0 = b * SEQ + c * 64;
  const int d = lane;
  const float lb = p.lbs[l * 256 + hd * 64 + d];
  const bfu* pq = p.proj + (size_t)tok0 * PS + COL_AQ + hd * 64 + d;
  const bfu* pf = p.proj + (size_t)tok0 * PS + COL_AF + hd * 64 + d;
  const bfu* pv = p.proj + (size_t)tok0 * PS + COL_AI + hd * 64 + d;
  const int base = (b * NCH + c) * 4 + hd;
  const float* st = p.hg_state + (size_t)base * 4096;
  float bl[16], kk[16];
  float run = 0.f;
  __syncthreads();
#pragma unroll
  for (int i = 0; i < 16; ++i) {
    const int t = w * 16 + i;
    float lf, k; hg_gate(bf2f(pf[(size_t)t * PS]), lb, lf, k);
    run += lf; bl[i] = run; kk[i] = k;
    Bt[d * 136 + t] = pv[(size_t)t * PS];
    const int e = w + 4 * i;
    Bt[e * 136 + 64 + d] = f2bf(st[e * 64 + d]);
  }
  segtot[w * 64 + d] = run;
  __syncthreads();
  float off = 0.f;
#pragma unroll
  for (int s = 0; s < 4; ++s) { float v = segtot[s * 64 + d]; if (s < w) off += v; }
  const float bm = segtot[d] + segtot[64 + d];
#pragma unroll
  for (int i = 0; i < 16; ++i) {
    const int t = w * 16 + i;
    const float bt = bl[i] + off;
    const float qv = silu_(bf2f(pq[(size_t)t * PS]));
    Qp[t * 72 + d] = f2bf(qv * fexp(fmaxf(bt - bm, -80.f)));
    Kp[t * 72 + d] = f2bf(kk[i] * fexp(fminf(bm - bt, 80.f)));
    A[t * 136 + 64 + d] = f2bf(qv * fexp(bt));
  }
  __syncthreads();
  const int r = lane & 15, q = lane >> 4;
  f32x4 acc[4];
#pragma unroll
  for (int i = 0; i < 4; ++i) acc[i] = (f32x4){0.f, 0.f, 0.f, 0.f};
  wave_mma<4, 2>(acc, Qp + w * 16 * 72, 72, Kp, 72, lane);
#pragma unroll
  for (int nt = 0; nt < 4; ++nt)
#pragma unroll
    for (int j = 0; j < 4; ++j) {
      const int t = w * 16 + q * 4 + j, s = nt * 16 + r;
      A[t * 136 + s] = f2bf(s <= t ? acc[nt][j] : 0.f);
    }
  __syncthreads();
  f32x4 o[4];
#pragma unroll
  for (int i = 0; i < 4; ++i) o[i] = (f32x4){0.f, 0.f, 0.f, 0.f};
  wave_mma<4, 4>(o, A + w * 16 * 136, 136, Bt, 136, lane);
#pragma unroll
  for (int j = 0; j < 4; ++j) {
    float ss = 0.f;
#pragma unroll
    for (int nt = 0; nt < 4; ++nt) ss += o[nt][j] * o[nt][j];
    ss = group16_sum(ss);
    const float sc = rsqrtf(ss * (1.f / 64.f) + 1e-6f);
    const int t = w * 16 + q * 4 + j;
    const bfu* prow = p.proj + (size_t)(tok0 + t) * PS + COL_AG + hd * 64;
    bfu* mrow = p.mixed + (size_t)(tok0 + t) * 1024 + hd * 64;
#pragma unroll
    for (int nt = 0; nt < 4; ++nt) {
      const int e = nt * 16 + r;
      mrow[e] = f2bf(o[nt][j] * sc * p.hg_g[l * 256 + hd * 64 + e] * silu_(bf2f(prow[e])));
    }
  }
}

DI void ml_gates(const Params& p, int l, int tok0, int hd, float* bs, float* igs, int tid) {
  if (tid < 64) {
    const bfu* row = p.proj + (size_t)(tok0 + tid) * PS;
    const float ig = bf2f(row[COL_BIG + hd]);
    const float fg = bf2f(row[COL_BFG + hd]) + p.ml_fb[l * 4 + hd];
    float lf = logsig_(fg);
#pragma unroll
    for (int o = 1; o < 64; o <<= 1) { float v = __shfl_up(lf, o); if (tid >= o) lf += v; }
    bs[tid] = lf; igs[tid] = ig;
  }
}

DI void ml_local(const Params& p, int l, int b, int c, int hd, unsigned char* smem) {
  const int tid = threadIdx.x, lane = tid & 63, w = tid >> 6;
  bfu* At = (bfu*)smem;
  bfu* Bt = At + 64 * 72;
  float* bs = (float*)(smem + 2 * 64 * 72 * 2);
  float* igs = bs + 64; float* nseg = igs + 64;
  const int tok0 = b * SEQ + c * 64;
  const int d = lane;
  __syncthreads();
  ml_gates(p, l, tok0, hd, bs, igs, tid);
  __syncthreads();
  const float blast = bs[63];
  const bfu* pk = p.proj + (size_t)tok0 * PS + COL_BK + hd * 64 + d;
  const bfu* pv = p.proj + (size_t)tok0 * PS + COL_BV + hd * 64 + d;
  float nacc = 0.f;
#pragma unroll
  for (int i = 0; i < 16; ++i) {
    const int s = w * 16 + i;
    const float ws = fexp(blast - bs[s] + igs[s]);
    const float kw = bf2f(pk[(size_t)s * PS]) * 0.125f * ws;
    Bt[d * 72 + s] = f2bf(kw); nacc += kw;
    At[d * 72 + s] = pv[(size_t)s * PS];
  }
  nseg[w * 64 + d] = nacc;
  __syncthreads();
  const int base = (b * NCH + c) * 4 + hd;
  if (w == 0) p.ml_n[base * 64 + d] = nseg[d] + nseg[64 + d] + nseg[128 + d] + nseg[192 + d];
  if (tid == 0) p.ml_decay[base] = fexp(blast);
  f32x4 acc[4];
#pragma unroll
  for (int i = 0; i < 4; ++i) acc[i] = (f32x4){0.f, 0.f, 0.f, 0.f};
  wave_mma<4, 2>(acc, At + w * 16 * 72, 72, Bt, 72, lane);
  float* st = p.ml_state + (size_t)base * 4096;
  const int r = lane & 15, q = lane >> 4;
#pragma unroll
  for (int nt = 0; nt < 4; ++nt)
#pragma unroll
    for (int j = 0; j < 4; ++j) st[(w * 16 + q * 4 + j) * 64 + nt * 16 + r] = acc[nt][j];
}

DI void ml_out(const Params& p, int l, int b, int c, int hd, unsigned char* smem) {
  const int tid = threadIdx.x, lane = tid & 63, w = tid >> 6;
  bfu* A = (bfu*)(smem + O_A); bfu* Bt = (bfu*)(smem + O_BT); bfu* Qp = (bfu*)(smem + O_QP); bfu* Kp = (bfu*)(smem + O_KP);
  float* bs = (float*)(smem + O_MISC); float* igs = bs + 64; float* npv = igs + 64; float* den2 = npv + 64;
  const int tok0 = b * SEQ + c * 64;
  const int d = lane;
  const int base = (b * NCH + c) * 4 + hd;
  const float* st = p.ml_state + (size_t)base * 4096;
  __syncthreads();
  ml_gates(p, l, tok0, hd, bs, igs, tid);
  if (tid >= 64 && tid < 128) npv[tid - 64] = p.ml_n[base * 64 + tid - 64];
  __syncthreads();
  const bfu* pq = p.proj + (size_t)tok0 * PS + COL_BQ + hd * 64 + d;
  const bfu* pk = p.proj + (size_t)tok0 * PS + COL_BK + hd * 64 + d;
  const bfu* pv = p.proj + (size_t)tok0 * PS + COL_BV + hd * 64 + d;
#pragma unroll
  for (int i = 0; i < 16; ++i) {
    const int t = w * 16 + i;
    const bfu qraw = pq[(size_t)t * PS];
    Qp[t * 72 + d] = qraw;
    Kp[t * 72 + d] = pk[(size_t)t * PS];
    A[t * 136 + 64 + d] = f2bf(bf2f(qraw) * fexp(bs[t]));
    Bt[d * 136 + t] = pv[(size_t)t * PS];
    const int e = w + 4 * i;
    Bt[e * 136 + 64 + d] = f2bf(st[e * 64 + d]);
  }
  __syncthreads();
  if (tid < 64) {
    float s = 0.f;
    for (int dd = 0; dd < 64; ++dd) s += bf2f(A[tid * 136 + 64 + dd]) * npv[dd];
    den2[tid] = s;
  }
  const int r = lane & 15, q = lane >> 4;
  f32x4 acc[4];
#pragma unroll
  for (int i = 0; i < 4; ++i) acc[i] = (f32x4){0.f, 0.f, 0.f, 0.f};
  wave_mma<4, 2>(acc, Qp + w * 16 * 72, 72, Kp, 72, lane);
  float den1[4];
#pragma unroll
  for (int j = 0; j < 4; ++j) {
    const int t = w * 16 + q * 4 + j;
    const float bt = bs[t];
    float rs = 0.f;
#pragma unroll
    for (int nt = 0; nt < 4; ++nt) {
      const int s = nt * 16 + r;
      float wv = 0.f;
      if (s <= t) wv = fexp(bt - bs[s] + igs[s]) * acc[nt][j] * 0.125f;
      rs += wv;
      A[t * 136 + s] = f2bf(wv);
    }
    den1[j] = group16_sum(rs);
  }
  __syncthreads();
  f32x4 o[4];
#pragma unroll
  for (int i = 0; i < 4; ++i) o[i] = (f32x4){0.f, 0.f, 0.f, 0.f};
  wave_mma<4, 4>(o, A + w * 16 * 136, 136, Bt, 136, lane);
#pragma unroll
  for (int j = 0; j < 4; ++j) {
    const int t = w * 16 + q * 4 + j;
    const float den = den1[j] + den2[t];
    const float inv = frcp(fmaxf(fabsf(den), 1.f));
    float hv[4];
    float ss = 0.f;
#pragma unroll
    for (int nt = 0; nt < 4; ++nt) { hv[nt] = o[nt][j] * inv; ss += hv[nt] * hv[nt]; }
    ss = group16_sum(ss);
    const float sc = rsqrtf(ss * (1.f / 64.f) + 1e-6f);
    const bfu* prow = p.proj + (size_t)(tok0 + t) * PS + COL_BG + hd * 64;
    bfu* mrow = p.mixed + (size_t)(tok0 + t) * 1024 + 256 + hd * 64;
#pragma unroll
    for (int nt = 0; nt < 4; ++nt) {
      const int e = nt * 16 + r;
      mrow[e] = f2bf(hv[nt] * sc * p.ml_g[l * 256 + hd * 64 + e] * silu_(bf2f(prow[e])));
    }
  }
}

template <bool FINAL>
DI void lru_item(const Params& p, int l, int b, int c, int n, unsigned char* smem) {
  const int tid = threadIdx.x, lane = tid & 63, w = tid >> 6;
  bfu* xcb = (bfu*)smem;
  float* xcf = (float*)(smem + 9216);
  float* af = (float*)(smem + 9216 + 17408);
  float* segH = (float*)(smem + 9216 + 2 * 17408);
  float* segA = segH + 256;
  const int tok0 = b * SEQ + c * 64;
  const int ch = n * 64 + lane;
  __syncthreads();
  {
    const float cw0 = p.conv_w[(l * 4 + 0) * 256 + ch], cw1 = p.conv_w[(l * 4 + 1) * 256 + ch];
    const float cw2 = p.conv_w[(l * 4 + 2) * 256 + ch], cw3 = p.conv_w[(l * 4 + 3) * 256 + ch];
    const float cb = p.conv_b[l * 256 + ch];
    const bfu* px = p.proj + (size_t)tok0 * PS + COL_CX + ch;
#pragma unroll
    for (int i = 0; i < 16; ++i) {
      const int t = w * 16 + i;
      const int sp = c * 64 + t;
      float x0 = (sp >= 3) ? bf2f(px[(ptrdiff_t)(t - 3) * PS]) : 0.f;
      float x1 = (sp >= 2) ? bf2f(px[(ptrdiff_t)(t - 2) * PS]) : 0.f;
      float x2 = (sp >= 1) ? bf2f(px[(ptrdiff_t)(t - 1) * PS]) : 0.f;
      float x3 = bf2f(px[(ptrdiff_t)t * PS]);
      const float xc = cb + cw0 * x0 + cw1 * x1 + cw2 * x2 + cw3 * x3;
      xcf[t * 68 + lane] = xc;
      xcb[t * 72 + lane] = f2bf(xc);
    }
  }
  __syncthreads();
  const int r = lane & 15, q = lane >> 4;
  f32x4 aa[4], ax[4];
#pragma unroll
  for (int i = 0; i < 4; ++i) { aa[i] = (f32x4){0.f, 0.f, 0.f, 0.f}; ax[i] = (f32x4){0.f, 0.f, 0.f, 0.f}; }
  wave_mma<4, 2>(aa, xcb + w * 16 * 72, 72, p.wt_a + (l * 4 + n) * 4096, 64, lane);
  wave_mma<4, 2>(ax, xcb + w * 16 * 72, 72, p.wt_x + (l * 4 + n) * 4096, 64, lane);
#pragma unroll
  for (int nt = 0; nt < 4; ++nt) {
    const int e = nt * 16 + r, che = n * 64 + e;
    const float ba = p.b_a[l * 256 + che], bx = p.b_x[l * 256 + che];
    const float lsl = 8.f * logsig_acc(p.lam[l * 256 + che]);
#pragma unroll
    for (int j = 0; j < 4; ++j) {
      const int t = w * 16 + q * 4 + j;
      const float rg = sigmoid_(aa[nt][j] + ba), ig = sigmoid_(ax[nt][j] + bx);
      const float la = lsl * rg;
      const float a = fexp(la);
      const float y2 = 2.f * la;
      const float em = (y2 > -0.05f) ? -y2 * (1.f + y2 * (0.5f + y2 * (0.16666667f + y2 * 0.041666668f))) : 1.f - a * a;
      const float bv = __builtin_amdgcn_sqrtf(fmaxf(em, 0.f)) * ig * xcf[t * 68 + e];
      af[t * 68 + e] = a; xcf[t * 68 + e] = bv;
    }
  }
  __syncthreads();
  float hl[16], al[16];
  float h = 0.f, ap = 1.f;
#pragma unroll
  for (int i = 0; i < 16; ++i) {
    const int t = w * 16 + i;
    const float a = af[t * 68 + lane], bv = xcf[t * 68 + lane];
    h = a * h + bv; ap *= a; hl[i] = h; al[i] = ap;
  }
  segH[w * 64 + lane] = h; segA[w * 64 + lane] = ap;
  __syncthreads();
  const int sidx = (b * NCH + c) * 256 + ch;
  if (!FINAL) {
    if (w == 0) {
      float H = 0.f, Ap = 1.f;
#pragma unroll
      for (int s = 0; s < 4; ++s) { H = segA[s * 64 + lane] * H + segH[s * 64 + lane]; Ap *= segA[s * 64 + lane]; }
      p.lru_h[sidx] = H; p.lru_a[sidx] = Ap;
    }
  } else {
    float H = p.lru_h[sidx];
#pragma unroll
    for (int s = 0; s < 4; ++s) if (s < w) H = segA[s * 64 + lane] * H + segH[s * 64 + lane];
    const bfu* pg = p.proj + (size_t)tok0 * PS + COL_CG + ch;
    bfu* pm = p.mixed + (size_t)tok0 * 1024 + 512 + ch;
#pragma unroll
    for (int i = 0; i < 16; ++i) {
      const int t = w * 16 + i;
      const float hv = hl[i] + al[i] * H;
      pm[(size_t)t * 1024] = f2bf(hv * silu_(bf2f(pg[(size_t)t * PS])));
    }
  }
}

template <bool FINAL>
DI void s5_item(const Params& p, int l, int b, int c, int g4, unsigned char* smem) {
  const int tid = threadIdx.x, lane = tid & 63, w = tid >> 6;
  const int g = g4 * 4 + w;
  float* buw = (float*)(smem + w * 13312);
  bfu* stw = (bfu*)(smem + w * 13312 + 8448);
  const int tok0 = b * SEQ + c * 64;
  const int r = lane & 15, q = lane >> 4;
  const int lg = l * 16 + g;
  bf16x8 bfr[8], yfr[4];
#pragma unroll
  for (int nt = 0; nt < 8; ++nt) bfr[nt] = *(const bf16x8*)(p.bt_bu + ((size_t)lg * 128 + nt * 16 + r) * 32 + q * 8);
  if (FINAL) {
#pragma unroll
    for (int ks = 0; ks < 4; ++ks) yfr[ks] = *(const bf16x8*)(p.bt_y + ((size_t)lg * 16 + r) * 128 + ks * 32 + q * 8);
  }
  const float ar = p.abar[(lg * 64 + lane) * 2], ai = p.abar[(lg * 64 + lane) * 2 + 1];
  const size_t sbase = ((size_t)(b * NCH + c) * 16 + g) * 128;
  float xr = 0.f, xi = 0.f;
  if (FINAL) { xr = p.s5_state[sbase + lane]; xi = p.s5_state[sbase + 64 + lane]; }
  const float dsk = FINAL ? p.s5_d[l * 256 + g * 16 + r] : 0.f;
  __syncthreads();
  for (int mt = 0; mt < 4; ++mt) {
    bf16x8 a = (bf16x8){0, 0, 0, 0, 0, 0, 0, 0};
    if (q < 2) a = *(const bf16x8*)(p.proj + (size_t)(tok0 + mt * 16 + r) * PS + COL_DU + g * 16 + q * 8);
#pragma unroll
    for (int nt = 0; nt < 8; ++nt) {
      f32x4 acc = (f32x4){0.f, 0.f, 0.f, 0.f};
      acc = __builtin_amdgcn_mfma_f32_16x16x32_bf16(a, bfr[nt], acc, 0, 0, 0);
#pragma unroll
      for (int j = 0; j < 4; ++j) buw[(q * 4 + j) * 132 + nt * 16 + r] = acc[j];
    }
    __syncthreads();
#pragma unroll
    for (int tt = 0; tt < 16; ++tt) {
      const float br = buw[tt * 132 + lane], bi = buw[tt * 132 + 64 + lane];
      const float nr = ar * xr - ai * xi + br;
      const float ni = ar * xi + ai * xr + bi;
      xr = nr; xi = ni;
      if (FINAL) { stw[tt * 136 + lane] = f2bf(xr); stw[tt * 136 + 64 + lane] = f2bf(xi); }
    }
    __syncthreads();
    if (FINAL) {
      f32x4 y = (f32x4){0.f, 0.f, 0.f, 0.f};
#pragma unroll
      for (int ks = 0; ks < 4; ++ks) {
        bf16x8 a2 = *(const bf16x8*)(stw + r * 136 + ks * 32 + q * 8);
        y = __builtin_amdgcn_mfma_f32_16x16x32_bf16(a2, yfr[ks], y, 0, 0, 0);
      }
#pragma unroll
      for (int j = 0; j < 4; ++j) {
        const int t = mt * 16 + q * 4 + j;
        const float u = bf2f(p.proj[(size_t)(tok0 + t) * PS + COL_DU + g * 16 + r]);
        const float z = gelu_tanh_(y[j] + dsk * u);
        p.zbuf[(size_t)(tok0 + t) * 256 + g * 16 + r] = f2bf(z);
      }
      __syncthreads();
    }
  }
  if (!FINAL) { p.s5_state[sbase + lane] = xr; p.s5_state[sbase + 64 + lane] = xi; }
}

DI void s5_glu(const Params& p, int l, int b, int c, unsigned char* smem) {
  const int tid = threadIdx.x, lane = tid & 63, w = tid >> 6;
  bfu* zs = (bfu*)smem;
  const int tok0 = b * SEQ + c * 64;
  __syncthreads();
  for (int i = tid; i < 64 * 32; i += 256) {
    const int t = i >> 5, kc = i & 31;
    *(uint4*)(zs + t * 264 + kc * 8) = *(const uint4*)(p.zbuf + (size_t)(tok0 + t) * 256 + kc * 8);
  }
  __syncthreads();
  const int r = lane & 15, q = lane >> 4;
  for (int nc = 0; nc < 4; ++nc) {
    f32x4 acc[4];
#pragma unroll
    for (int i = 0; i < 4; ++i) acc[i] = (f32x4){0.f, 0.f, 0.f, 0.f};
#pragma unroll 1
    for (int kh = 0; kh < 4; ++kh)
      wave_mma<4, 2>(acc, zs + w * 16 * 264 + kh * 64, 264, p.wt_glu + l * 65536 + nc * 64 * 256 + kh * 64, 256, lane);
#pragma unroll
    for (int nt = 0; nt < 4; ++nt) {
      const int n = nc * 64 + nt * 16 + r;
      const float bg = p.b_glu[l * 256 + n];
#pragma unroll
      for (int j = 0; j < 4; ++j) {
        const int t = w * 16 + q * 4 + j;
        const float zv = bf2f(zs[t * 264 + n]);
        const float gate = silu_(bf2f(p.proj[(size_t)(tok0 + t) * PS + COL_DG + n]));
        p.mixed[(size_t)(tok0 + t) * 1024 + 768 + n] = f2bf(zv * sigmoid_(acc[nt][j] + bg) * gate);
      }
    }
  }
}

DI void phase2(const Params& p, int l, unsigned char* smem) {
  for (int item = blockIdx.x; item < 1024; item += gridDim.x) hg_local(p, l, item >> 7, (item >> 2) & 31, item & 3, smem);
  for (int item = blockIdx.x; item < 1024; item += gridDim.x) ml_local(p, l, item >> 7, (item >> 2) & 31, item & 3, smem);
  for (int item = blockIdx.x; item < 1024; item += gridDim.x) lru_item<false>(p, l, item >> 7, (item >> 2) & 31, item & 3, smem);
  for (int item = blockIdx.x; item < 1024; item += gridDim.x) s5_item<false>(p, l, item >> 7, (item >> 2) & 31, item & 3, smem);
}

DI void phase3(const Params& p, int l) {
  const int gtid = blockIdx.x * 256 + threadIdx.x, gsz = gridDim.x * 256;
  constexpr int N1 = 131072, N2 = 131072, N3 = 2048, N4 = 2048, N5 = 8192;
  for (int i = gtid; i < N1 + N2 + N3 + N4 + N5; i += gsz) {
    if (i < N1 + N2) {
      const bool ml = i >= N1;
      const int j = ml ? i - N1 : i;
      const int b = j >> 14, rem = j & 16383, hd = rem >> 12, ed = rem & 4095, d = ed & 63;
      float* stp = (ml ? p.ml_state : p.hg_state) + (size_t)(b * NCH * 4 + hd) * 4096 + ed;
      const float* dcp = ml ? (p.ml_decay + b * NCH * 4 + hd) : (p.hg_decay + (b * NCH * 4 + hd) * 64 + d);
      const int dstride = ml ? 4 : 256;
      float S = 0.f;
#pragma unroll
      for (int c0 = 0; c0 < NCH; c0 += 16) {
        float loc[16], dec[16];
#pragma unroll
        for (int c = 0; c < 16; ++c) { loc[c] = stp[(size_t)(c0 + c) * 16384]; dec[c] = dcp[(c0 + c) * dstride]; }
#pragma unroll
        for (int c = 0; c < 16; ++c) { stp[(size_t)(c0 + c) * 16384] = S; S = dec[c] * S + loc[c]; }
      }
    } else if (i < N1 + N2 + N3) {
      const int j = i - N1 - N2, b = j >> 8, rem = j & 255, hd = rem >> 6, d = rem & 63;
      float S = 0.f;
      for (int c = 0; c < NCH; ++c) {
        const int base = (b * NCH + c) * 4 + hd;
        const float dec = p.ml_decay[base];
        const float loc = p.ml_n[base * 64 + d];
        p.ml_n[base * 64 + d] = S; S = dec * S + loc;
      }
    } else if (i < N1 + N2 + N3 + N4) {
      const int j = i - N1 - N2 - N3, b = j >> 8, ch = j & 255;
      float H = 0.f;
      for (int c = 0; c < NCH; ++c) {
        const int idx = (b * NCH + c) * 256 + ch;
        const float a = p.lru_a[idx], hl = p.lru_h[idx];
        p.lru_h[idx] = H; H = a * H + hl;
      }
    } else {
      const int j = i - N1 - N2 - N3 - N4, b = j >> 10, g = (j >> 6) & 15, pp = j & 63;
      const float ar = p.abar64[((l * 16 + g) * 64 + pp) * 2], ai = p.abar64[((l * 16 + g) * 64 + pp) * 2 + 1];
      float xr = 0.f, xi = 0.f;
      for (int c = 0; c < NCH; ++c) {
        const size_t sb = ((size_t)(b * NCH + c) * 16 + g) * 128;
        const float lr = p.s5_state[sb + pp], li = p.s5_state[sb + 64 + pp];
        p.s5_state[sb + pp] = xr; p.s5_state[sb + 64 + pp] = xi;
        const float nr = ar * xr - ai * xi + lr, ni = ar * xi + ai * xr + li;
        xr = nr; xi = ni;
      }
    }
  }
}

DI void phase4(const Params& p, int l, unsigned char* smem) {
  unsigned* s_flag = (unsigned*)(smem + SMEM_BYTES - 16);
  for (int item = blockIdx.x; item < 1024; item += gridDim.x) {
    const int bc = item >> 2;
    s5_item<true>(p, l, bc >> 5, bc & 31, item & 3, smem);
    if (last_arriver(p.cnt + CNT_GLU + l * 256 + bc, 4u, s_flag)) s5_glu(p, l, bc >> 5, bc & 31, smem);
  }
  for (int item = blockIdx.x; item < 1024; item += gridDim.x) hg_out(p, l, item >> 7, (item >> 2) & 31, item & 3, smem);
  for (int item = blockIdx.x; item < 1024; item += gridDim.x) ml_out(p, l, item >> 7, (item >> 2) & 31, item & 3, smem);
  for (int item = blockIdx.x; item < 1024; item += gridDim.x) lru_item<true>(p, l, item >> 7, (item >> 2) & 31, item & 3, smem);
}

#ifdef TPROBE
#define TP_CLASS(PH) ((PH) == 0 ? 0 : (((PH) - 1) % 5) + 1)
#define TP_BEGIN(PH) unsigned long long tp_t0 = 0; if (TP_CLASS(PH) == TPROBE) tp_t0 = __builtin_amdgcn_s_memrealtime();
#define TP_END(PH) if (TP_CLASS(PH) == TPROBE) tp_acc += __builtin_amdgcn_s_memrealtime() - tp_t0;
#else
#define TP_BEGIN(PH)
#define TP_END(PH)
#endif
#define RUN_PHASE(PH, CALL)                                       \
  if (ph0 <= (PH) && (PH) < ph1) {                                \
    TP_BEGIN(PH)                                                  \
    CALL;                                                         \
    if (COOP) { if ((PH) + 1 < ph1) xcd_barrier(xb); }            \
    TP_END(PH)                                                    \
  }

template <bool COOP, int L>
DI void run_layer(const Params& p, int ph0, int ph1, unsigned char* smem, const XcdBarrier& xb, unsigned long long& tp_acc) {
#ifdef DUP1
  RUN_PHASE(1 + 5 * L, phase1(p, L, smem))
#endif
  RUN_PHASE(1 + 5 * L, phase1(p, L, smem))
#ifdef DUP2
  RUN_PHASE(2 + 5 * L, phase2(p, L, smem))
#endif
  RUN_PHASE(2 + 5 * L, phase2(p, L, smem))
  RUN_PHASE(3 + 5 * L, phase3(p, L))
#ifdef DUP4
  RUN_PHASE(4 + 5 * L, phase4(p, L, smem))
#endif
  RUN_PHASE(4 + 5 * L, phase4(p, L, smem))
  RUN_PHASE(5 + 5 * L, phase5(p, L, smem))
}

template <bool COOP>
__global__ void __launch_bounds__(256, 2) mk_fwd(Params p, int ph0, int ph1) {
  __shared__ __attribute__((aligned(16))) unsigned char smem[SMEM_BYTES];
  __shared__ uint4 xb_words;
  XcdBarrier xb; xb.bar = p.bar; xb.x = 0; xb.st = nullptr;
  if (COOP) {
    if (ph1 < 0) cg::this_grid().sync();
    if (threadIdx.x == 0) xb_words = make_uint4(0u, 0u, 0u, 0u);
    __syncthreads();
    xb = xcd_barrier_post(p.bar, (volatile LAS unsigned*)&xb_words);
  }
  unsigned long long tp_acc = 0;
  RUN_PHASE(0, phase0(p, smem))
  run_layer<COOP, 0>(p, ph0, ph1, smem, xb, tp_acc);
  run_layer<COOP, 1>(p, ph0, ph1, smem, xb, tp_acc);
  run_layer<COOP, 2>(p, ph0, ph1, smem, xb, tp_acc);
  run_layer<COOP, 3>(p, ph0, ph1, smem, xb, tp_acc);
#ifdef TPROBE
  if (blockIdx.x == 0 && threadIdx.x == 0) {
    const unsigned long long t0 = __builtin_amdgcn_s_memrealtime();
    while (__builtin_amdgcn_s_memrealtime() - t0 < tp_acc) __builtin_amdgcn_s_sleep(8);
  }
#endif
}

extern "C" void kernel_launch(void* const* d_in, const int* in_sizes, int n_in, void* d_out, int out_size, void* d_ws,
                              size_t ws_size, hipStream_t stream) {
  static int grid_blocks = 0;
  if (!grid_blocks) {
    int dev = 0, cus = 0, per_cu = 0;
    hipGetDevice(&dev);
    hipDeviceGetAttribute(&cus, hipDeviceAttributeMultiprocessorCount, dev);
    hipOccupancyMaxActiveBlocksPerMultiprocessor(&per_cu, mk_fwd<(MEGA != 0)>, 256, 0);
    if (per_cu < 1) per_cu = 1;
    if (per_cu > 2) per_cu = 2;
    grid_blocks = cus * per_cu;
  }
  Params p{};
  const float** pin = (const float**)&p;
  for (int i = 0; i < 28; ++i) pin[i] = (const float*)d_in[i];
  p.out = (float*)d_out;
  unsigned char* ws = (unsigned char*)d_ws;
  size_t off = 0;
  auto take = [&](size_t bytes) { unsigned char* r = ws + off; off += (bytes + 255) & ~(size_t)255; return r; };
  p.wt_in = (bfu*)take((size_t)4 * PS * 1024 * 2);
  p.wt_out = (bfu*)take((size_t)4 * 1024 * 1024 * 2);
  p.wt_a = (bfu*)take(16 * 4096 * 2);
  p.wt_x = (bfu*)take(16 * 4096 * 2);
  p.wt_glu = (bfu*)take(4 * 65536 * 2);
  p.bt_bu = (bfu*)take(64 * 128 * 32 * 2);
  p.bt_y = (bfu*)take(64 * 16 * 128 * 2);
  p.hb = (bfu*)take((size_t)NTOK * 1024 * 2);
  p.proj = (bfu*)take((size_t)NTOK * PS * 2);
  p.mixed = (bfu*)take((size_t)NTOK * 1024 * 2);
  p.zbuf = (bfu*)take((size_t)NTOK * 256 * 2);
  p.abar = (float*)take(4096 * 2 * 4);
  p.abar64 = (float*)take(4096 * 2 * 4);
  p.lbs = (float*)take(1024 * 4);
  p.hg_state = (float*)take((size_t)BATCH * NCH * 4 * 4096 * 4);
  p.hg_decay = (float*)take((size_t)BATCH * NCH * 4 * 64 * 4);
  p.ml_state = (float*)take((size_t)BATCH * NCH * 4 * 4096 * 4);
  p.ml_n = (float*)take((size_t)BATCH * NCH * 4 * 64 * 4);
  p.ml_decay = (float*)take((size_t)BATCH * NCH * 4 * 4);
  p.lru_h = (float*)take((size_t)BATCH * NCH * 256 * 4);
  p.lru_a = (float*)take((size_t)BATCH * NCH * 256 * 4);
  p.s5_state = (float*)take((size_t)BATCH * NCH * 16 * 128 * 4);
  p.cnt = (unsigned*)take(CNT_TOTAL * 4);
  p.bar = (unsigned*)take(XCD_BAR_WORDS * 4);
  if (off > ws_size) { fprintf(stderr, "workspace too small: need %zu have %zu\n", off, ws_size); return; }
  const int NPH = 1 + 5 * DEPTH;
#if MEGA
  (void)hipMemsetAsync(p.bar, 0, XCD_BAR_WORDS * 4, stream);
  int ph0 = 0, ph1 = NPH;
  void* args[] = {&p, &ph0, &ph1};
  hipError_t e = hipLaunchCooperativeKernel((void*)mk_fwd<true>, dim3(grid_blocks), dim3(256), args, 0, stream);
  if (e != hipSuccess) fprintf(stderr, "cooperative launch failed: %s (grid %d)\n", hipGetErrorString(e), grid_blocks);
#else
  for (int ph = 0; ph < NPH; ++ph) hipLaunchKernelGGL(mk_fwd<false>, dim3(grid_blocks), dim3(256), 0, stream, p, ph, ph + 1);
#endif
}
```

```cpp
#include <hip/hip_runtime.h>
#include <hip/hip_cooperative_groups.h>
#include <stdint.h>
#include <stdio.h>
namespace cg = cooperative_groups;

#ifndef MEGA
#define MEGA 1
#endif

typedef unsigned short bfu;
using bf16x8 = __attribute__((ext_vector_type(8))) short;
using f32x4  = __attribute__((ext_vector_type(4))) float;
#define DI __device__ __forceinline__

constexpr int BATCH = 8, SEQ = 2048, DM = 1024, DEPTH = 4, NTOK = BATCH * SEQ, NCH = SEQ / 64;
constexpr int DIN = 3080, PS = 3200;
constexpr int COL_AQ = 0, COL_AF = 256, COL_AI = 512, COL_AG = 768;
constexpr int COL_BQ = 1024, COL_BK = 1280, COL_BV = 1536, COL_BG = 1792, COL_BIG = 3072, COL_BFG = 3076;
constexpr int COL_CX = 2048, COL_CG = 2304, COL_DU = 2560, COL_DG = 2816;
constexpr float DN_ALPHA = 1.681792830507429f;
constexpr int SMEM_BYTES = 56 * 1024;
constexpr int CNT_LN = 0, CNT_GLU = 4 * 128, CNT_Q = 4 * 128 + 4 * 256, CNT_TOTAL = CNT_Q + 32 * 32;

struct Params {
  const float *x, *w_in, *b_in, *lb_logits, *hg_g, *ml_fb, *ml_g, *conv_w, *conv_b, *w_a, *b_a, *w_x, *b_x, *lam,
      *a_re, *a_im, *log_dt, *sb_re, *sb_im, *c_re, *c_im, *s5_d, *w_glu, *b_glu, *w_out, *b_out, *ln_g, *ln_b;
  float* out;
  bfu *wt_in, *wt_out, *wt_a, *wt_x, *wt_glu, *bt_bu, *bt_y, *hb, *proj, *mixed, *zbuf;
  float *abar, *abar64, *lbs, *hg_state, *hg_decay, *ml_state, *ml_n, *ml_decay, *lru_h, *lru_a, *s5_state;
  unsigned* cnt;
  unsigned* bar;
};

DI bfu f2bf(float x) { unsigned u = __float_as_uint(x); u += 0x7fffu + ((u >> 16) & 1u); return (bfu)(u >> 16); }
DI float bf2f(bfu h) { return __uint_as_float(((unsigned)h) << 16); }
DI unsigned pack2(float a, float b) { return (unsigned)f2bf(a) | ((unsigned)f2bf(b) << 16); }
DI float fexp(float x) { return __expf(x); }
DI float frcp(float x) { return __builtin_amdgcn_rcpf(x); }
DI float flog(float x) { return __logf(x); }
DI float sigmoid_(float x) { return frcp(1.f + fexp(-x)); }
DI float silu_(float x) { return x * frcp(1.f + fexp(-x)); }
DI float logsig_(float x) { return fminf(x, 0.f) - flog(1.f + fexp(-fabsf(x))); }
DI float logsig_acc(float x) { return fminf(x, 0.f) - log1pf(expf(-fabsf(x))); }
DI float gelu_tanh_(float x) {
  float u = 0.7978845608028654f * (x + 0.044715f * x * x * x);
  float th = 1.f - 2.f * frcp(fexp(2.f * u) + 1.f);
  return 0.5f * x * (1.f + th);
}

template <int NT, int KS>
DI void wave_mma(f32x4 (&acc)[NT], const bfu* A, int lda, const bfu* Bt, int ldb, int lane) {
  const int r = lane & 15, q = lane >> 4;
#pragma unroll
  for (int ks = 0; ks < KS; ++ks) {
    bf16x8 a = *(const bf16x8*)(A + r * lda + ks * 32 + q * 8);
#pragma unroll
    for (int nt = 0; nt < NT; ++nt) {
      bf16x8 b = *(const bf16x8*)(Bt + (nt * 16 + r) * ldb + ks * 32 + q * 8);
      acc[nt] = __builtin_amdgcn_mfma_f32_16x16x32_bf16(a, b, acc[nt], 0, 0, 0);
    }
  }
}

DI float group16_sum(float v) {
  v += __shfl_xor(v, 1); v += __shfl_xor(v, 2); v += __shfl_xor(v, 4); v += __shfl_xor(v, 8);
  return v;
}
DI float wave_sum(float v) {
  v += __shfl_xor(v, 1); v += __shfl_xor(v, 2); v += __shfl_xor(v, 4); v += __shfl_xor(v, 8);
  v += __shfl_xor(v, 16); v += __shfl_xor(v, 32);
  return v;
}

DI bool last_arriver(unsigned* ctr, unsigned total, unsigned* s_flag) {
  asm volatile("s_waitcnt vmcnt(0)" ::: "memory");
  __syncthreads();
  if (threadIdx.x == 0) {
    __builtin_amdgcn_fence(__ATOMIC_RELEASE, "agent");
    asm volatile("s_waitcnt vmcnt(0)" ::: "memory");
    const unsigned old = __hip_atomic_fetch_add(ctr, 1u, __ATOMIC_RELAXED, __HIP_MEMORY_SCOPE_AGENT);
    const unsigned last = (old == total - 1u) ? 1u : 0u;
    if (last) { __builtin_amdgcn_fence(__ATOMIC_ACQUIRE, "agent"); asm volatile("s_waitcnt vmcnt(0)" ::: "memory"); }
    *s_flag = last;
  }
  __syncthreads();
  return (*s_flag != 0u);
}

#ifdef TPROBE
#define TPS(ID) unsigned long long tps_##ID = 0; if (TPROBE == (ID)) tps_##ID = __builtin_amdgcn_s_memrealtime();
#define TPE(ID) if (TPROBE == (ID)) tp_acc += __builtin_amdgcn_s_memrealtime() - tps_##ID;
#else
#define TPS(ID)
#define TPE(ID)
#endif

#define XB_TMO      128
#define XB_XCNT(j)  (256  + 64 * (j))
#define XB_XSUB(j)  (1280 + 64 * (j))
#define XB_XGEN(j)  (2304 + 64 * (j))
#define XB_TOP      3328
#define XB_TOPGEN   3392
#define XCD_BAR_WORDS 3456
#define XB_SPIN_CAP (1u << 22)
#define LAS __attribute__((address_space(3)))
DI unsigned xb_ld(unsigned* p) { return __hip_atomic_load(p, __ATOMIC_RELAXED, __HIP_MEMORY_SCOPE_AGENT); }
DI unsigned xb_add(unsigned* p, unsigned v) { return __hip_atomic_fetch_add(p, v, __ATOMIC_RELAXED, __HIP_MEMORY_SCOPE_AGENT); }
DI unsigned xb_xcc_id() { return (unsigned)__builtin_amdgcn_s_getreg((3 << 11) | 20) & 0xFu; }
#define XB_SPIN(cond, bar) do { unsigned _sp = 0; while (cond) { __builtin_amdgcn_s_sleep(1); \
    if ((++_sp & 255u) == 0u) { if (xb_ld(&(bar)[XB_TMO])) break; if (_sp > XB_SPIN_CAP) { atomicAdd(&(bar)[XB_TMO], 1u); break; } } } } while (0)
struct XcdBarrier { unsigned* bar; unsigned x; volatile LAS unsigned* st; };
DI XcdBarrier xcd_barrier_post(unsigned* bar, volatile LAS unsigned* st) {
  XcdBarrier b; b.bar = bar; b.x = xb_xcc_id(); b.st = st;
  if (threadIdx.x == 0) (void)xb_add(&bar[XB_XCNT(b.x)], 1u);
  return b;
}
DI void xcd_barrier_complete(unsigned* bar, unsigned x, unsigned& nloc, unsigned& nx) {
  const unsigned G = gridDim.x * gridDim.y * gridDim.z;
  unsigned sum, cnt, mine, sp = 0u;
  for (;;) {
    sum = 0u; cnt = 0u; mine = 0u;
#pragma unroll
    for (unsigned j = 0; j < 16; ++j) { const unsigned c = xb_ld(&bar[XB_XCNT(j)]); sum += c; cnt += (c > 0u) ? 1u : 0u; mine = (j == x) ? c : mine; }
    if (sum == G) break;
    __builtin_amdgcn_s_sleep(1);
    if ((++sp & 255u) == 0u) { if (xb_ld(&bar[XB_TMO])) break; if (sp > XB_SPIN_CAP) { atomicAdd(&bar[XB_TMO], 1u); break; } }
  }
  nloc = mine > 0u ? mine : 1u; nx = cnt > 0u ? cnt : 1u;
}
DI void xcd_barrier(const XcdBarrier& b) {
  asm volatile("s_waitcnt vmcnt(0)" ::: "memory");
  __syncthreads();
  if (threadIdx.x == 0) {
    unsigned* bar = b.bar;
    __builtin_amdgcn_s_waitcnt(0);
    unsigned nloc = b.st[0], nx = b.st[1];
    if (nloc == 0u) { xcd_barrier_complete(bar, b.x, nloc, nx); b.st[0] = nloc; b.st[1] = nx; }
    const unsigned old = xb_add(&bar[XB_XSUB(b.x)], 1u);
    const unsigned gen = old / nloc;
    if (old + 1u == (gen + 1u) * nloc) {
      __builtin_amdgcn_fence(__ATOMIC_RELEASE, "agent");
      asm volatile("s_waitcnt vmcnt(0)" ::: "memory");
      const unsigned og = xb_add(&bar[XB_TOP], 1u);
      const unsigned tg = og / nx;
      if (og + 1u == (tg + 1u) * nx) xb_add(&bar[XB_TOPGEN], 1u);
      else XB_SPIN(xb_ld(&bar[XB_TOPGEN]) == tg, bar);
      __builtin_amdgcn_fence(__ATOMIC_ACQUIRE, "agent");
      xb_add(&bar[XB_XGEN(b.x)], 1u);
      asm volatile("s_waitcnt vmcnt(0)" ::: "memory");
    } else {
      XB_SPIN(xb_ld(&bar[XB_XGEN(b.x)]) == gen, bar);
      __builtin_amdgcn_fence(__ATOMIC_ACQUIRE, "agent");
      asm volatile("s_waitcnt vmcnt(0)" ::: "memory");
    }
  }
  __syncthreads();
}

DI void transpose_tile(const float* src, int sld, int cv, bfu* dst, int dld, float* tile) {
  const int tid = threadIdx.x;
  __syncthreads();
  for (int i = tid; i < 4096; i += 256) {
    int r = i >> 6, c = i & 63;
    tile[r * 65 + c] = (c < cv) ? src[(size_t)r * sld + c] : 0.f;
  }
  __syncthreads();
  for (int i = tid; i < 4096; i += 256) {
    int n = i >> 6, k = i & 63;
    dst[(size_t)n * dld + k] = f2bf(tile[k * 65 + n]);
  }
}

template <int LSEL>
DI void convert_weights(const Params& p, unsigned char* smem) {
  const int tid = threadIdx.x;
  float* tile = (float*)smem;
  const int NJ = 3200 + 1024 + 16 + 16 + 64;
  for (int job = blockIdx.x; job < NJ; job += gridDim.x) {
    const float* src; int sld, cv = 64, dld; bfu* dst;
    if (job < 3200) {
      int l = job / 800, rem = job % 800, kt = rem / 50, nt = rem % 50;
      if (l != LSEL) continue;
      const int c0 = nt < 28 ? nt * 64 : (nt < 48 ? nt * 64 + 8 : 1792);
      src = p.w_in + (size_t)l * 1024 * DIN + (size_t)kt * 64 * DIN + c0; sld = DIN;
      cv = nt < 48 ? 64 : (nt == 48 ? 8 : 0);
      dst = p.wt_in + (size_t)l * PS * 1024 + (size_t)nt * 64 * 1024 + kt * 64; dld = 1024;
    } else if (job < 4224) {
      int j = job - 3200, l = j / 256, rem = j % 256, kt = rem / 16, nt = rem % 16;
      if (l != LSEL) continue;
      src = p.w_out + (size_t)l * 1048576 + (size_t)kt * 64 * 1024 + nt * 64;
      bfu* dl = p.wt_out + (size_t)l * 1048576;
      __syncthreads();
      for (int i = tid; i < 4096; i += 256) { int rr = i >> 6, c = i & 63; tile[rr * 65 + c] = src[(size_t)rr * 1024 + c]; }
      __syncthreads();
      for (int i = tid; i < 4096; i += 256) {
        int nn = i >> 6, kk = i & 63, n = nt * 64 + nn;
        dl[((((n >> 4) * 16 + kt) * 64) + (n & 15) * 4 + (kk >> 4)) * 16 + (kk & 15)] = f2bf(tile[kk * 65 + nn]);
      }
      continue;
    } else if (LSEL != 0) {
      continue;
    } else if (job < 4240) {
      int j = job - 4224; src = p.w_a + j * 4096; sld = 64; dst = p.wt_a + j * 4096; dld = 64;
    } else if (job < 4256) {
      int j = job - 4240; src = p.w_x + j * 4096; sld = 64; dst = p.wt_x + j * 4096; dld = 64;
    } else {
      int j = job - 4256, l = j / 16, rem = j % 16, kt = rem / 4, nt = rem % 4;
      src = p.w_glu + l * 65536 + kt * 64 * 256 + nt * 64; sld = 256;
      dst = p.wt_glu + l * 65536 + nt * 64 * 256 + kt * 64; dld = 256;
    }
    transpose_tile(src, sld, cv, dst, dld, tile);
  }
}

DI void phase0(const Params& p, unsigned char* smem) {
  const int tid = threadIdx.x;
  const int gtid = blockIdx.x * 256 + tid, gsz = gridDim.x * 256;
  for (int i = gtid; i < NTOK * DM / 8; i += gsz) {
    float4 a = ((const float4*)p.x)[2 * i], b = ((const float4*)p.x)[2 * i + 1];
    uint4 o; o.x = pack2(a.x, a.y); o.y = pack2(a.z, a.w); o.z = pack2(b.x, b.y); o.w = pack2(b.z, b.w);
    ((uint4*)p.hb)[i] = o;
  }
  convert_weights<0>(p, smem);
  for (int i = gtid; i < 4096; i += gsz) {
    int lg = i >> 6, pp = i & 63;
    double dt = exp((double)p.log_dt[lg]);
    double are = p.a_re[lg * 64 + pp], aim = p.a_im[lg * 64 + pp];
    double mag = exp(dt * are), ang = dt * aim;
    double abr = mag * cos(ang), abi = mag * sin(ang);
    double den = are * are + aim * aim;
    double xr = abr - 1.0, xi = abi;
    double zr = (xr * are + xi * aim) / den, zi = (xi * are - xr * aim) / den;
    bfu* o_re = p.bt_bu + ((size_t)lg * 128 + pp) * 32;
    bfu* o_im = p.bt_bu + ((size_t)lg * 128 + 64 + pp) * 32;
    for (int h = 0; h < 16; ++h) {
      double br = p.sb_re[(lg * 64 + pp) * 16 + h], bi = p.sb_im[(lg * 64 + pp) * 16 + h];
      o_re[h] = f2bf((float)(zr * br - zi * bi));
      o_im[h] = f2bf((float)(zr * bi + zi * br));
      o_re[16 + h] = 0; o_im[16 + h] = 0;
    }
    p.abar[(lg * 64 + pp) * 2 + 0] = (float)abr; p.abar[(lg * 64 + pp) * 2 + 1] = (float)abi;
    double mag64 = exp(64.0 * dt * are), ang64 = 64.0 * ang;
    p.abar64[(lg * 64 + pp) * 2 + 0] = (float)(mag64 * cos(ang64));
    p.abar64[(lg * 64 + pp) * 2 + 1] = (float)(mag64 * sin(ang64));
  }
  for (int i = gtid; i < 4 * 16 * 16 * 128; i += gsz) {
    int k = i & 127, lgn = i >> 7;
    p.bt_y[i] = (k < 64) ? f2bf(p.c_re[lgn * 64 + k]) : f2bf(-p.c_im[lgn * 64 + (k - 64)]);
  }
  for (int i = gtid; i < 256; i += gsz) {
    float v0 = p.lb_logits[i], v1 = p.lb_logits[256 + i], v2 = p.lb_logits[512 + i], v3 = p.lb_logits[768 + i];
    float m = fmaxf(fmaxf(v0, v1), fmaxf(v2, v3));
    float e0 = expf(v0 - m), e1 = expf(v1 - m), e2 = expf(v2 - m), e3 = expf(v3 - m);
    float s = e0 + e1 + e2 + e3;
    p.lbs[i] = 0.f; p.lbs[256 + i] = e1 / s; p.lbs[512 + i] = (e1 + e2) / s; p.lbs[768 + i] = (e1 + e2 + e3) / s;
  }
  for (int i = gtid; i < CNT_TOTAL; i += gsz) p.cnt[i] = 0u;
}

DI void gemm1_tile(const Params& p, int l, const bfu* A, const bfu* Bt, int m0, int n0, unsigned char* smem) {
  bfu* sA = (bfu*)smem; bfu* sB = sA + 128 * 72;
  bfu* sC = (bfu*)smem;
  const int tid = threadIdx.x, lane = tid & 63, w = tid >> 6, wm = w >> 1, wn = w & 1;
  const int r = lane & 15, q = lane >> 4;
  f32x4 acc[4][6];
#pragma unroll
  for (int i = 0; i < 4; ++i)
#pragma unroll
    for (int j = 0; j < 6; ++j) acc[i][j] = (f32x4){0.f, 0.f, 0.f, 0.f};
  const int lrow = tid >> 3, lkc = tid & 7;
  const bfu* ga = A + (size_t)(m0 + lrow) * 1024 + lkc * 8;
  const bfu* gb = Bt + (size_t)(n0 + lrow) * 1024 + lkc * 8;
  uint4 ra0 = *(const uint4*)(ga), ra1 = *(const uint4*)(ga + 32 * 1024), ra2 = *(const uint4*)(ga + 64 * 1024), ra3 = *(const uint4*)(ga + 96 * 1024);
  uint4 rb0 = *(const uint4*)(gb), rb1 = *(const uint4*)(gb + 32 * 1024), rb2 = *(const uint4*)(gb + 64 * 1024), rb3 = *(const uint4*)(gb + 96 * 1024);
  uint4 rb4 = *(const uint4*)(gb + 128 * 1024), rb5 = *(const uint4*)(gb + 160 * 1024);
  bfu* wa = sA + lrow * 72 + lkc * 8;
  bfu* wb = sB + lrow * 72 + lkc * 8;
  for (int kt = 0; kt < 16; ++kt) {
    __syncthreads();
    *(uint4*)(wa) = ra0; *(uint4*)(wa + 32 * 72) = ra1; *(uint4*)(wa + 64 * 72) = ra2; *(uint4*)(wa + 96 * 72) = ra3;
    *(uint4*)(wb) = rb0; *(uint4*)(wb + 32 * 72) = rb1; *(uint4*)(wb + 64 * 72) = rb2; *(uint4*)(wb + 96 * 72) = rb3;
    *(uint4*)(wb + 128 * 72) = rb4; *(uint4*)(wb + 160 * 72) = rb5;
    __syncthreads();
    if (kt + 1 < 16) {
      const bfu* ga2 = ga + (kt + 1) * 64; const bfu* gb2 = gb + (kt + 1) * 64;
      ra0 = *(const uint4*)(ga2); ra1 = *(const uint4*)(ga2 + 32 * 1024); ra2 = *(const uint4*)(ga2 + 64 * 1024); ra3 = *(const uint4*)(ga2 + 96 * 1024);
      rb0 = *(const uint4*)(gb2); rb1 = *(const uint4*)(gb2 + 32 * 1024); rb2 = *(const uint4*)(gb2 + 64 * 1024); rb3 = *(const uint4*)(gb2 + 96 * 1024);
      rb4 = *(const uint4*)(gb2 + 128 * 1024); rb5 = *(const uint4*)(gb2 + 160 * 1024);
    }
#pragma unroll
    for (int ks = 0; ks < 2; ++ks) {
      bf16x8 af[4], bfr[6];
#pragma unroll
      for (int mt = 0; mt < 4; ++mt) af[mt] = *(const bf16x8*)(sA + (wm * 64 + mt * 16 + r) * 72 + ks * 32 + q * 8);
#pragma unroll
      for (int nt = 0; nt < 6; ++nt) bfr[nt] = *(const bf16x8*)(sB + (wn * 96 + nt * 16 + r) * 72 + ks * 32 + q * 8);
#pragma unroll
      for (int mt = 0; mt < 4; ++mt)
#pragma unroll
        for (int nt = 0; nt < 6; ++nt) acc[mt][nt] = __builtin_amdgcn_mfma_f32_16x16x32_bf16(af[mt], bfr[nt], acc[mt][nt], 0, 0, 0);
    }
  }
  float bias[6];
#pragma unroll
  for (int nt = 0; nt < 6; ++nt) {
    const int col = n0 + wn * 96 + nt * 16 + r;
    bias[nt] = p.b_in[l * DIN + (col < 1792 ? col : col + 8)];
  }
  __syncthreads();
#pragma unroll
  for (int mt = 0; mt < 4; ++mt)
#pragma unroll
    for (int nt = 0; nt < 6; ++nt)
#pragma unroll
      for (int j = 0; j < 4; ++j)
        sC[(wm * 64 + mt * 16 + q * 4 + j) * 200 + wn * 96 + nt * 16 + r] = f2bf(acc[mt][nt][j] + bias[nt]);
  __syncthreads();
#pragma unroll
  for (int i = 0; i < 12; ++i) {
    const int id = tid + i * 256, row = id / 24, ch = id % 24;
    *(uint4*)(p.proj + (size_t)(m0 + row) * PS + n0 + ch * 8) = *(const uint4*)(sC + row * 200 + ch * 8);
  }
}

DI void gemm1_gates(const Params& p, int l, const bfu* A, const bfu* Bt, int m0) {
  const int tid = threadIdx.x, lane = tid & 63, w = tid >> 6, r = lane & 15, q = lane >> 4;
  const bfu* a0 = A + (size_t)(m0 + w * 32 + r) * 1024 + q * 8;
  const bfu* a1 = a0 + 16 * 1024;
  const bfu* bp = Bt + (size_t)(3072 + r) * 1024 + q * 8;
  f32x4 c0 = (f32x4){0.f, 0.f, 0.f, 0.f}, c1 = (f32x4){0.f, 0.f, 0.f, 0.f};
#pragma unroll 4
  for (int ks = 0; ks < 32; ++ks) {
    const bf16x8 b = *(const bf16x8*)(bp + ks * 32);
    const bf16x8 x0 = *(const bf16x8*)(a0 + ks * 32);
    const bf16x8 x1 = *(const bf16x8*)(a1 + ks * 32);
    c0 = __builtin_amdgcn_mfma_f32_16x16x32_bf16(x0, b, c0, 0, 0, 0);
    c1 = __builtin_amdgcn_mfma_f32_16x16x32_bf16(x1, b, c1, 0, 0, 0);
  }
  if (r < 8) {
    const float bias = p.b_in[l * DIN + 1792 + r];
#pragma unroll
    for (int j = 0; j < 4; ++j) {
      p.proj[(size_t)(m0 + w * 32 + q * 4 + j) * PS + 3072 + r] = f2bf(c0[j] + bias);
      p.proj[(size_t)(m0 + w * 32 + 16 + q * 4 + j) * PS + 3072 + r] = f2bf(c1[j] + bias);
    }
  }
}

DI void phase1(const Params& p, int l, unsigned char* smem) {
  const bfu* Bt = p.wt_in + (size_t)l * PS * 1024;
  for (int tile = blockIdx.x; tile < 128 * 16; tile += gridDim.x) { const int mt = tile >> 4, nt = tile & 15; gemm1_tile(p, l, p.hb, Bt, mt * 128, nt * 192, smem); }
  for (int job = blockIdx.x; job < 128; job += gridDim.x) gemm1_gates(p, l, p.hb, Bt, job * 128);
}

using u32x4 = __attribute__((ext_vector_type(4))) unsigned;
DI void p5_loadB(bf16x8 (&dst)[2][2], __amdgpu_buffer_rsrc_t rs, unsigned loff, int sbase, int step) {
  const int kt = step >> 2, g = step & 3;
#pragma unroll
  for (int n = 0; n < 2; ++n)
#pragma unroll
    for (int h = 0; h < 2; ++h) {
      const u32x4 v = __builtin_amdgcn_raw_buffer_load_b128(rs, loff, sbase + (((g * 2 + n) * 16 + kt) * 1024 + h * 8) * 2, 0);
      dst[n][h] = __builtin_bit_cast(bf16x8, v);
    }
}

DI void phase5(const Params& p, int l, unsigned char* smem, unsigned long long& tp_acc) {
  const bfu* Wt = p.wt_out + (size_t)l * 1048576;
  const float* hin = (l == 0) ? p.x : p.out;
  const int tid = threadIdx.x, lane = tid & 63, w = tid >> 6, r = lane & 15, q = lane >> 4;
  const int ws = __builtin_amdgcn_readfirstlane(w);
  bfu* sA = (bfu*)smem;
  float* red = (float*)(smem + 32 * 520 * 2);
  float* red2 = red + 128;
  float* stat = red2 + 128;
  const __amdgpu_buffer_rsrc_t rsB = __builtin_amdgcn_make_buffer_rsrc((void*)Wt, 0, 1024 * 1024 * 2, 0x00020000);
  const unsigned loff = (unsigned)(r * 4 + q) * 32u;
  for (int tile = blockIdx.x; tile < NTOK / 32; tile += gridDim.x) {
    const int row0 = tile * 32;
    float ssum[2][4], ssq[2][4];
#pragma unroll
    for (int mt = 0; mt < 2; ++mt)
#pragma unroll
      for (int j = 0; j < 4; ++j) { ssum[mt][j] = 0.f; ssq[mt][j] = 0.f; }
#pragma unroll 1
    for (int np = 0; np < 2; ++np) {
      const int cbase = np * 512 + ws * 128;
      const int sbase = (cbase >> 4) * 16 * 1024 * 2;
      f32x4 acc[2][8];
#pragma unroll
      for (int mt = 0; mt < 2; ++mt)
#pragma unroll
        for (int nt = 0; nt < 8; ++nt) acc[mt][nt] = (f32x4){0.f, 0.f, 0.f, 0.f};
      TPS(51)
      bf16x8 bfb[4][2][2];
      p5_loadB(bfb[0], rsB, loff, sbase, 0); p5_loadB(bfb[1], rsB, loff, sbase, 1); p5_loadB(bfb[2], rsB, loff, sbase, 2);
#pragma unroll 1
      for (int kh = 0; kh < 2; ++kh) {
        __syncthreads();
#pragma unroll
        for (int i = 0; i < 8; ++i) {
          const int id = tid + i * 256, rw = id >> 6, kc = id & 63;
          *(uint4*)(sA + rw * 520 + kc * 8) = *(const uint4*)(p.mixed + (size_t)(row0 + rw) * 1024 + kh * 512 + kc * 8);
        }
        __syncthreads();
#pragma unroll
        for (int kk = 0; kk < 8; ++kk) {
          const int kt = kh * 8 + kk;
          bf16x8 af[2][2];
#pragma unroll
          for (int mt = 0; mt < 2; ++mt)
#pragma unroll
            for (int h = 0; h < 2; ++h) af[mt][h] = *(const bf16x8*)(sA + (mt * 16 + r) * 520 + kk * 64 + q * 16 + h * 8);
#pragma unroll
          for (int g = 0; g < 4; ++g) {
            const int step = kt * 4 + g;
            p5_loadB(bfb[(g + 3) & 3], rsB, loff, sbase, (step + 3 < 64) ? step + 3 : 63);
            __builtin_amdgcn_sched_barrier(0);
#pragma unroll
            for (int n = 0; n < 2; ++n)
#pragma unroll
              for (int h = 0; h < 2; ++h)
#pragma unroll
                for (int mt = 0; mt < 2; ++mt)
                  acc[mt][g * 2 + n] = __builtin_amdgcn_mfma_f32_16x16x32_bf16(af[mt][h], bfb[g & 3][n][h], acc[mt][g * 2 + n], 0, 0, 0);
            __builtin_amdgcn_sched_barrier(0);
          }
        }
      }
      asm volatile("" ::: "memory");
      TPE(51)
      TPS(52)
      float hv[8][2][4], bias[8];
#pragma unroll
      for (int nt = 0; nt < 8; ++nt) {
        const int col = cbase + nt * 16 + r;
        bias[nt] = p.b_out[l * 1024 + col];
#pragma unroll
        for (int mt = 0; mt < 2; ++mt)
#pragma unroll
          for (int j = 0; j < 4; ++j) hv[nt][mt][j] = hin[(size_t)(row0 + mt * 16 + q * 4 + j) * 1024 + col];
      }
#pragma unroll
      for (int nt = 0; nt < 8; ++nt) {
        const int col = cbase + nt * 16 + r;
#pragma unroll
        for (int mt = 0; mt < 2; ++mt)
#pragma unroll
          for (int j = 0; j < 4; ++j) {
            const float v = acc[mt][nt][j] + DN_ALPHA * hv[nt][mt][j] + bias[nt];
            ssum[mt][j] += v; ssq[mt][j] += v * v;
            p.out[(size_t)(row0 + mt * 16 + q * 4 + j) * 1024 + col] = v;
          }
      }
      asm volatile("s_waitcnt vmcnt(0)" ::: "memory");
      TPE(52)
    }
    TPS(53)
#pragma unroll
    for (int mt = 0; mt < 2; ++mt)
#pragma unroll
      for (int j = 0; j < 4; ++j) {
        const float a1 = group16_sum(ssum[mt][j]), a2 = group16_sum(ssq[mt][j]);
        if (r == 0) { red[w * 32 + mt * 16 + q * 4 + j] = a1; red2[w * 32 + mt * 16 + q * 4 + j] = a2; }
      }
    __syncthreads();
    if (tid < 32) {
      const float s1 = red[tid] + red[32 + tid] + red[64 + tid] + red[96 + tid];
      const float s2 = red2[tid] + red2[32 + tid] + red2[64 + tid] + red2[96 + tid];
      const float mu = s1 * (1.f / 1024.f);
      const float var = fmaxf(s2 * (1.f / 1024.f) - mu * mu, 0.f);
      stat[tid * 2] = mu; stat[tid * 2 + 1] = rsqrtf(var + 1e-5f);
    }
    __syncthreads();
    {
      const float4 g4 = *(const float4*)(p.ln_g + l * 1024 + tid * 4);
      const float4 b4 = *(const float4*)(p.ln_b + l * 1024 + tid * 4);
#pragma unroll
      for (int i0 = 0; i0 < 32; i0 += 16) {
        float4 vv[16];
#pragma unroll
        for (int i = 0; i < 16; ++i) vv[i] = *(const float4*)(p.out + (size_t)(row0 + i0 + i) * 1024 + tid * 4);
#pragma unroll
        for (int i = 0; i < 16; ++i) {
          const float mu = stat[(i0 + i) * 2], rs = stat[(i0 + i) * 2 + 1];
          const float4 v = vv[i];
          float4 o;
          o.x = (v.x - mu) * rs * g4.x + b4.x; o.y = (v.y - mu) * rs * g4.y + b4.y;
          o.z = (v.z - mu) * rs * g4.z + b4.z; o.w = (v.w - mu) * rs * g4.w + b4.w;
          *(float4*)(p.out + (size_t)(row0 + i0 + i) * 1024 + tid * 4) = o;
          uint2 ob; ob.x = pack2(o.x, o.y); ob.y = pack2(o.z, o.w);
          *(uint2*)(p.hb + (size_t)(row0 + i0 + i) * 1024 + tid * 4) = ob;
        }
      }
    }
    asm volatile("s_waitcnt vmcnt(0)" ::: "memory");
    TPE(53)
  }
}

DI void hg_gate(float x, float lb, float& lf, float& k) {
  x = fmaxf(x, -80.f);
  const float E = fexp(-x);
  const float sg = frcp(1.f + E);
  k = (1.f - lb) * (E * sg);
  lf = flog(lb + (1.f - lb) * sg);
}

DI void hg_local(const Params& p, int l, int b, int c, int hd, unsigned char* smem) {
  const int tid = threadIdx.x, lane = tid & 63, w = tid >> 6;
  bfu* At = (bfu*)smem;
  bfu* Bt = At + 64 * 72;
  float* segtot = (float*)(smem + 2 * 64 * 72 * 2);
  const int tok0 = b * SEQ + c * 64;
  const int d = lane;
  const float lb = p.lbs[l * 256 + hd * 64 + d];
  const bfu* pf = p.proj + (size_t)tok0 * PS + COL_AF + hd * 64 + d;
  const bfu* pv = p.proj + (size_t)tok0 * PS + COL_AI + hd * 64 + d;
  float bl[16], kk[16];
  float run = 0.f;
  __syncthreads();
#pragma unroll
  for (int i = 0; i < 16; ++i) {
    const int t = w * 16 + i;
    float lf, k; hg_gate(bf2f(pf[(size_t)t * PS]), lb, lf, k);
    run += lf; bl[i] = run; kk[i] = k;
    At[d * 72 + t] = pv[(size_t)t * PS];
  }
  segtot[w * 64 + d] = run;
  __syncthreads();
  float off = 0.f, tot = 0.f;
#pragma unroll
  for (int s = 0; s < 4; ++s) { float v = segtot[s * 64 + d]; tot += v; if (s < w) off += v; }
#pragma unroll
  for (int i = 0; i < 16; ++i) { const int t = w * 16 + i; Bt[d * 72 + t] = f2bf(kk[i] * fexp(tot - (bl[i] + off))); }
  const int base = (b * NCH + c) * 4 + hd;
  if (w == 0) p.hg_decay[base * 64 + d] = fexp(tot);
  __syncthreads();
  f32x4 acc[4];
#pragma unroll
  for (int i = 0; i < 4; ++i) acc[i] = (f32x4){0.f, 0.f, 0.f, 0.f};
  wave_mma<4, 2>(acc, At + w * 16 * 72, 72, Bt, 72, lane);
  float* st = p.hg_state + (size_t)base * 4096;
  const int r = lane & 15, q = lane >> 4;
#pragma unroll
  for (int nt = 0; nt < 4; ++nt)
#pragma unroll
    for (int j = 0; j < 4; ++j) st[(w * 16 + q * 4 + j) * 64 + nt * 16 + r] = acc[nt][j];
}

constexpr int O_A = 0, O_BT = 17408, O_QP = 34816, O_KP = 44032, O_MISC = 53248;

DI void hg_out(const Params& p, int l, int b, int c, int hd, unsigned char* smem) {
  const int tid = threadIdx.x, lane = tid & 63, w = tid >> 6;
  bfu* A = (bfu*)(smem + O_A); bfu* Bt = (bfu*)(smem + O_BT); bfu* Qp = (bfu*)(smem + O_QP); bfu* Kp = (bfu*)(smem + O_KP);
  float* segtot = (float*)(smem + O_MISC);
  const int tok0 = b * SEQ + c * 64;
  const int d = lane;
  const float lb = p.lbs[l * 256 + hd * 64 + d];
  const bfu* pq = p.proj + (size_t)tok0 * PS + COL_AQ + hd * 64 + d;
  const bfu* pf = p.proj + (size_t)tok0 * PS + COL_AF + hd * 64 + d;
  const bfu* pv = p.proj + (size_t)tok0 * PS + COL_AI + hd * 64 + d;
  const int base = (b * NCH + c) * 4 + hd;
  const float* st = p.hg_state + (size_t)base * 4096;
  float bl[16], kk[16];
  float run = 0.f;
  const int r = lane & 15, q = lane >> 4;
  bfu fraw[16], vraw[16], qraw[16]; float sraw[16];
#pragma unroll
  for (int i = 0; i < 16; ++i) {
    const int t = w * 16 + i;
    fraw[i] = pf[(size_t)t * PS]; vraw[i] = pv[(size_t)t * PS]; qraw[i] = pq[(size_t)t * PS]; sraw[i] = st[(w + 4 * i) * 64 + d];
  }
  bfu gt[4][4]; float gw[4];
#pragma unroll
  for (int nt = 0; nt < 4; ++nt) {
    gw[nt] = p.hg_g[l * 256 + hd * 64 + nt * 16 + r];
#pragma unroll
    for (int j = 0; j < 4; ++j) gt[j][nt] = p.proj[(size_t)(tok0 + w * 16 + q * 4 + j) * PS + COL_AG + hd * 64 + nt * 16 + r];
  }
  __syncthreads();
#pragma unroll
  for (int i = 0; i < 16; ++i) {
    const int t = w * 16 + i;
    float lf, k; hg_gate(bf2f(fraw[i]), lb, lf, k);
    run += lf; bl[i] = run; kk[i] = k;
    Bt[d * 136 + t] = vraw[i];
    const int e = w + 4 * i;
    Bt[e * 136 + 64 + d] = f2bf(sraw[i]);
  }
  segtot[w * 64 + d] = run;
  __syncthreads();
  float off = 0.f;
#pragma unroll
  for (int s = 0; s < 4; ++s) { float v = segtot[s * 64 + d]; if (s < w) off += v; }
  const float bm = segtot[d] + segtot[64 + d];
#pragma unroll
  for (int i = 0; i < 16; ++i) {
    const int t = w * 16 + i;
    const float bt = bl[i] + off;
    const float qv = silu_(bf2f(qraw[i]));
    Qp[t * 72 + d] = f2bf(qv * fexp(fmaxf(bt - bm, -80.f)));
    Kp[t * 72 + d] = f2bf(kk[i] * fexp(fminf(bm - bt, 80.f)));
    A[t * 136 + 64 + d] = f2bf(qv * fexp(bt));
  }
  __syncthreads();
  f32x4 acc[4];
#pragma unroll
  for (int i = 0; i < 4; ++i) acc[i] = (f32x4){0.f, 0.f, 0.f, 0.f};
  wave_mma<4, 2>(acc, Qp + w * 16 * 72, 72, Kp, 72, lane);
#pragma unroll
  for (int nt = 0; nt < 4; ++nt)
#pragma unroll
    for (int j = 0; j < 4; ++j) {
      const int t = w * 16 + q * 4 + j, s = nt * 16 + r;
      A[t * 136 + s] = f2bf(s <= t ? acc[nt][j] : 0.f);
    }
  __syncthreads();
  f32x4 o[4];
#pragma unroll
  for (int i = 0; i < 4; ++i) o[i] = (f32x4){0.f, 0.f, 0.f, 0.f};
  wave_mma<4, 4>(o, A + w * 16 * 136, 136, Bt, 136, lane);
#pragma unroll
  for (int j = 0; j < 4; ++j) {
    float ss = 0.f;
#pragma unroll
    for (int nt = 0; nt < 4; ++nt) ss += o[nt][j] * o[nt][j];
    ss = group16_sum(ss);
    const float sc = rsqrtf(ss * (1.f / 64.f) + 1e-6f);
    const int t = w * 16 + q * 4 + j;
    bfu* mrow = p.mixed + (size_t)(tok0 + t) * 1024 + hd * 64;
#pragma unroll
    for (int nt = 0; nt < 4; ++nt) {
      const int e = nt * 16 + r;
      mrow[e] = f2bf(o[nt][j] * sc * gw[nt] * silu_(bf2f(gt[j][nt])));
    }
  }
}

DI void ml_gates(const Params& p, int l, int tok0, int hd, float* bs, float* igs, int tid) {
  if (tid < 64) {
    const bfu* row = p.proj + (size_t)(tok0 + tid) * PS;
    const float ig = bf2f(row[COL_BIG + hd]);
    const float fg = bf2f(row[COL_BFG + hd]) + p.ml_fb[l * 4 + hd];
    float lf = logsig_(fg);
#pragma unroll
    for (int o = 1; o < 64; o <<= 1) { float v = __shfl_up(lf, o); if (tid >= o) lf += v; }
    bs[tid] = lf; igs[tid] = ig;
  }
}

DI void ml_local(const Params& p, int l, int b, int c, int hd, unsigned char* smem) {
  const int tid = threadIdx.x, lane = tid & 63, w = tid >> 6;
  bfu* At = (bfu*)smem;
  bfu* Bt = At + 64 * 72;
  float* bs = (float*)(smem + 2 * 64 * 72 * 2);
  float* igs = bs + 64; float* nseg = igs + 64;
  const int tok0 = b * SEQ + c * 64;
  const int d = lane;
  const bfu* pk = p.proj + (size_t)tok0 * PS + COL_BK + hd * 64 + d;
  const bfu* pv = p.proj + (size_t)tok0 * PS + COL_BV + hd * 64 + d;
  bfu kraw[16], vraw[16];
#pragma unroll
  for (int i = 0; i < 16; ++i) { kraw[i] = pk[(size_t)(w * 16 + i) * PS]; vraw[i] = pv[(size_t)(w * 16 + i) * PS]; }
  __syncthreads();
  ml_gates(p, l, tok0, hd, bs, igs, tid);
  __syncthreads();
  const float blast = bs[63];
  float nacc = 0.f;
#pragma unroll
  for (int i = 0; i < 16; ++i) {
    const int s = w * 16 + i;
    const float ws = fexp(blast - bs[s] + igs[s]);
    const float kw = bf2f(kraw[i]) * 0.125f * ws;
    Bt[d * 72 + s] = f2bf(kw); nacc += kw;
    At[d * 72 + s] = vraw[i];
  }
  nseg[w * 64 + d] = nacc;
  __syncthreads();
  const int base = (b * NCH + c) * 4 + hd;
  if (w == 0) p.ml_n[base * 64 + d] = nseg[d] + nseg[64 + d] + nseg[128 + d] + nseg[192 + d];
  if (tid == 0) p.ml_decay[base] = fexp(blast);
  f32x4 acc[4];
#pragma unroll
  for (int i = 0; i < 4; ++i) acc[i] = (f32x4){0.f, 0.f, 0.f, 0.f};
  wave_mma<4, 2>(acc, At + w * 16 * 72, 72, Bt, 72, lane);
  float* st = p.ml_state + (size_t)base * 4096;
  const int r = lane & 15, q = lane >> 4;
#pragma unroll
  for (int nt = 0; nt < 4; ++nt)
#pragma unroll
    for (int j = 0; j < 4; ++j) st[(w * 16 + q * 4 + j) * 64 + nt * 16 + r] = acc[nt][j];
}

DI void ml_out(const Params& p, int l, int b, int c, int hd, unsigned char* smem) {
  const int tid = threadIdx.x, lane = tid & 63, w = tid >> 6;
  bfu* A = (bfu*)(smem + O_A); bfu* Bt = (bfu*)(smem + O_BT); bfu* Qp = (bfu*)(smem + O_QP); bfu* Kp = (bfu*)(smem + O_KP);
  float* bs = (float*)(smem + O_MISC); float* igs = bs + 64; float* npv = igs + 64; float* den2 = npv + 64;
  const int tok0 = b * SEQ + c * 64;
  const int d = lane;
  const int base = (b * NCH + c) * 4 + hd;
  const float* st = p.ml_state + (size_t)base * 4096;
  const int r = lane & 15, q = lane >> 4;
  const bfu* pq = p.proj + (size_t)tok0 * PS + COL_BQ + hd * 64 + d;
  const bfu* pk = p.proj + (size_t)tok0 * PS + COL_BK + hd * 64 + d;
  const bfu* pv = p.proj + (size_t)tok0 * PS + COL_BV + hd * 64 + d;
  bfu qraw[16], kraw[16], vraw[16]; float sraw[16];
#pragma unroll
  for (int i = 0; i < 16; ++i) {
    const int t = w * 16 + i;
    qraw[i] = pq[(size_t)t * PS]; kraw[i] = pk[(size_t)t * PS]; vraw[i] = pv[(size_t)t * PS]; sraw[i] = st[(w + 4 * i) * 64 + d];
  }
  bfu gt[4][4]; float gw[4];
#pragma unroll
  for (int nt = 0; nt < 4; ++nt) {
    gw[nt] = p.ml_g[l * 256 + hd * 64 + nt * 16 + r];
#pragma unroll
    for (int j = 0; j < 4; ++j) gt[j][nt] = p.proj[(size_t)(tok0 + w * 16 + q * 4 + j) * PS + COL_BG + hd * 64 + nt * 16 + r];
  }
  __syncthreads();
  ml_gates(p, l, tok0, hd, bs, igs, tid);
  if (tid >= 64 && tid < 128) npv[tid - 64] = p.ml_n[base * 64 + tid - 64];
  __syncthreads();
#pragma unroll
  for (int i = 0; i < 16; ++i) {
    const int t = w * 16 + i;
    Qp[t * 72 + d] = qraw[i];
    Kp[t * 72 + d] = kraw[i];
    A[t * 136 + 64 + d] = f2bf(bf2f(qraw[i]) * fexp(bs[t]));
    Bt[d * 136 + t] = vraw[i];
    const int e = w + 4 * i;
    Bt[e * 136 + 64 + d] = f2bf(sraw[i]);
  }
  __syncthreads();
  if (tid < 64) {
    float s = 0.f;
    for (int dd = 0; dd < 64; ++dd) s += bf2f(A[tid * 136 + 64 + dd]) * npv[dd];
    den2[tid] = s;
  }
  f32x4 acc[4];
#pragma unroll
  for (int i = 0; i < 4; ++i) acc[i] = (f32x4){0.f, 0.f, 0.f, 0.f};
  wave_mma<4, 2>(acc, Qp + w * 16 * 72, 72, Kp, 72, lane);
  float den1[4];
#pragma unroll
  for (int j = 0; j < 4; ++j) {
    const int t = w * 16 + q * 4 + j;
    const float bt = bs[t];
    float rs = 0.f;
#pragma unroll
    for (int nt = 0; nt < 4; ++nt) {
      const int s = nt * 16 + r;
      float wv = 0.f;
      if (s <= t) wv = fexp(bt - bs[s] + igs[s]) * acc[nt][j] * 0.125f;
      rs += wv;
      A[t * 136 + s] = f2bf(wv);
    }
    den1[j] = group16_sum(rs);
  }
  __syncthreads();
  f32x4 o[4];
#pragma unroll
  for (int i = 0; i < 4; ++i) o[i] = (f32x4){0.f, 0.f, 0.f, 0.f};
  wave_mma<4, 4>(o, A + w * 16 * 136, 136, Bt, 136, lane);
#pragma unroll
  for (int j = 0; j < 4; ++j) {
    const int t = w * 16 + q * 4 + j;
    const float den = den1[j] + den2[t];
    const float inv = frcp(fmaxf(fabsf(den), 1.f));
    float hv[4];
    float ss = 0.f;
#pragma unroll
    for (int nt = 0; nt < 4; ++nt) { hv[nt] = o[nt][j] * inv; ss += hv[nt] * hv[nt]; }
    ss = group16_sum(ss);
    const float sc = rsqrtf(ss * (1.f / 64.f) + 1e-6f);
    bfu* mrow = p.mixed + (size_t)(tok0 + t) * 1024 + 256 + hd * 64;
#pragma unroll
    for (int nt = 0; nt < 4; ++nt) {
      const int e = nt * 16 + r;
      mrow[e] = f2bf(hv[nt] * sc * gw[nt] * silu_(bf2f(gt[j][nt])));
    }
  }
}

template <bool FINAL>
DI void lru_item(const Params& p, int l, int b, int c, int n, unsigned char* smem) {
  const int tid = threadIdx.x, lane = tid & 63, w = tid >> 6;
  bfu* xcb = (bfu*)smem;
  float* xcf = (float*)(smem + 9216);
  float* af = (float*)(smem + 9216 + 17408);
  float* segH = (float*)(smem + 9216 + 2 * 17408);
  float* segA = segH + 256;
  const int tok0 = b * SEQ + c * 64;
  const int ch = n * 64 + lane;
  const int r = lane & 15, q = lane >> 4;
  bf16x8 wfa[2][4], wfx[2][4];
#pragma unroll
  for (int ks = 0; ks < 2; ++ks)
#pragma unroll
    for (int nt = 0; nt < 4; ++nt) {
      wfa[ks][nt] = *(const bf16x8*)(p.wt_a + (l * 4 + n) * 4096 + (nt * 16 + r) * 64 + ks * 32 + q * 8);
      wfx[ks][nt] = *(const bf16x8*)(p.wt_x + (l * 4 + n) * 4096 + (nt * 16 + r) * 64 + ks * 32 + q * 8);
    }
  float e_ba[4], e_bx[4], e_lam[4];
#pragma unroll
  for (int nt = 0; nt < 4; ++nt) {
    const int che = n * 64 + nt * 16 + r;
    e_ba[nt] = p.b_a[l * 256 + che]; e_bx[nt] = p.b_x[l * 256 + che]; e_lam[nt] = p.lam[l * 256 + che];
  }
  const int sidx = (b * NCH + c) * 256 + ch;
  float Hprev = 0.f;
  bfu gq[16];
  if (FINAL) {
    Hprev = p.lru_h[sidx];
    const bfu* pg0 = p.proj + (size_t)tok0 * PS + COL_CG + ch;
#pragma unroll
    for (int i = 0; i < 16; ++i) gq[i] = pg0[(size_t)(w * 16 + i) * PS];
  }
  __syncthreads();
  {
    const float cw0 = p.conv_w[(l * 4 + 0) * 256 + ch], cw1 = p.conv_w[(l * 4 + 1) * 256 + ch];
    const float cw2 = p.conv_w[(l * 4 + 2) * 256 + ch], cw3 = p.conv_w[(l * 4 + 3) * 256 + ch];
    const float cb = p.conv_b[l * 256 + ch];
    const bfu* px = p.proj + (size_t)tok0 * PS + COL_CX + ch;
#pragma unroll
    for (int i = 0; i < 16; ++i) {
      const int t = w * 16 + i;
      const int sp = c * 64 + t;
      float x0 = (sp >= 3) ? bf2f(px[(ptrdiff_t)(t - 3) * PS]) : 0.f;
      float x1 = (sp >= 2) ? bf2f(px[(ptrdiff_t)(t - 2) * PS]) : 0.f;
      float x2 = (sp >= 1) ? bf2f(px[(ptrdiff_t)(t - 1) * PS]) : 0.f;
      float x3 = bf2f(px[(ptrdiff_t)t * PS]);
      const float xc = cb + cw0 * x0 + cw1 * x1 + cw2 * x2 + cw3 * x3;
      xcf[t * 68 + lane] = xc;
      xcb[t * 72 + lane] = f2bf(xc);
    }
  }
  __syncthreads();
  f32x4 aa[4], ax[4];
#pragma unroll
  for (int i = 0; i < 4; ++i) { aa[i] = (f32x4){0.f, 0.f, 0.f, 0.f}; ax[i] = (f32x4){0.f, 0.f, 0.f, 0.f}; }
#pragma unroll
  for (int ks = 0; ks < 2; ++ks) {
    const bf16x8 afr = *(const bf16x8*)(xcb + (w * 16 + r) * 72 + ks * 32 + q * 8);
#pragma unroll
    for (int nt = 0; nt < 4; ++nt) {
      aa[nt] = __builtin_amdgcn_mfma_f32_16x16x32_bf16(afr, wfa[ks][nt], aa[nt], 0, 0, 0);
      ax[nt] = __builtin_amdgcn_mfma_f32_16x16x32_bf16(afr, wfx[ks][nt], ax[nt], 0, 0, 0);
    }
  }
#pragma unroll
  for (int nt = 0; nt < 4; ++nt) {
    const int e = nt * 16 + r;
    const float ba = e_ba[nt], bx = e_bx[nt];
    const float lsl = 8.f * logsig_acc(e_lam[nt]);
#pragma unroll
    for (int j = 0; j < 4; ++j) {
      const int t = w * 16 + q * 4 + j;
      const float rg = sigmoid_(aa[nt][j] + ba), ig = sigmoid_(ax[nt][j] + bx);
      const float la = lsl * rg;
      const float a = fexp(la);
      const float y2 = 2.f * la;
      const float em = (y2 > -0.05f) ? -y2 * (1.f + y2 * (0.5f + y2 * (0.16666667f + y2 * 0.041666668f))) : 1.f - a * a;
      const float bv = __builtin_amdgcn_sqrtf(fmaxf(em, 0.f)) * ig * xcf[t * 68 + e];
      af[t * 68 + e] = a; xcf[t * 68 + e] = bv;
    }
  }
  __syncthreads();
  float hl[16], al[16];
  float h = 0.f, ap = 1.f;
#pragma unroll
  for (int i = 0; i < 16; ++i) {
    const int t = w * 16 + i;
    const float a = af[t * 68 + lane], bv = xcf[t * 68 + lane];
    h = a * h + bv; ap *= a; hl[i] = h; al[i] = ap;
  }
  segH[w * 64 + lane] = h; segA[w * 64 + lane] = ap;
  __syncthreads();
  if (!FINAL) {
    if (w == 0) {
      float H = 0.f, Ap = 1.f;
#pragma unroll
      for (int s = 0; s < 4; ++s) { H = segA[s * 64 + lane] * H + segH[s * 64 + lane]; Ap *= segA[s * 64 + lane]; }
      p.lru_h[sidx] = H; p.lru_a[sidx] = Ap;
    }
  } else {
    float H = Hprev;
#pragma unroll
    for (int s = 0; s < 4; ++s) if (s < w) H = segA[s * 64 + lane] * H + segH[s * 64 + lane];
    bfu* pm = p.mixed + (size_t)tok0 * 1024 + 512 + ch;
#pragma unroll
    for (int i = 0; i < 16; ++i) {
      const int t = w * 16 + i;
      const float hv = hl[i] + al[i] * H;
      pm[(size_t)t * 1024] = f2bf(hv * silu_(bf2f(gq[i])));
    }
  }
}

template <bool FINAL>
DI void s5_item(const Params& p, int l, int b, int c, int g4, unsigned char* smem) {
  const int tid = threadIdx.x, lane = tid & 63, w = tid >> 6;
  const int g = g4 * 4 + w;
  float* buw = (float*)(smem + w * 13312);
  bfu* stw = (bfu*)(smem + w * 13312 + 8448);
  const int tok0 = b * SEQ + c * 64;
  const int r = lane & 15, q = lane >> 4;
  const int lg = l * 16 + g;
  bf16x8 bfr[8], yfr[4];
#pragma unroll
  for (int nt = 0; nt < 8; ++nt) bfr[nt] = *(const bf16x8*)(p.bt_bu + ((size_t)lg * 128 + nt * 16 + r) * 32 + q * 8);
  if (FINAL) {
#pragma unroll
    for (int ks = 0; ks < 4; ++ks) yfr[ks] = *(const bf16x8*)(p.bt_y + ((size_t)lg * 16 + r) * 128 + ks * 32 + q * 8);
  }
  const float ar = p.abar[(lg * 64 + lane) * 2], ai = p.abar[(lg * 64 + lane) * 2 + 1];
  const size_t sbase = ((size_t)(b * NCH + c) * 16 + g) * 128;
  float xr = 0.f, xi = 0.f;
  if (FINAL) { xr = p.s5_state[sbase + lane]; xi = p.s5_state[sbase + 64 + lane]; }
  const float dsk = FINAL ? p.s5_d[l * 256 + g * 16 + r] : 0.f;
  bf16x8 afr[4];
  bfu uq[4][4];
#pragma unroll
  for (int mt = 0; mt < 4; ++mt) {
    afr[mt] = (bf16x8){0, 0, 0, 0, 0, 0, 0, 0};
    if (q < 2) afr[mt] = *(const bf16x8*)(p.proj + (size_t)(tok0 + mt * 16 + r) * PS + COL_DU + g * 16 + q * 8);
    if (FINAL) {
#pragma unroll
      for (int j = 0; j < 4; ++j) uq[mt][j] = p.proj[(size_t)(tok0 + mt * 16 + q * 4 + j) * PS + COL_DU + g * 16 + r];
    }
  }
  __syncthreads();
#pragma unroll
  for (int mt = 0; mt < 4; ++mt) {
    const bf16x8 a = afr[mt];
#pragma unroll
    for (int nt = 0; nt < 8; ++nt) {
      f32x4 acc = (f32x4){0.f, 0.f, 0.f, 0.f};
      acc = __builtin_amdgcn_mfma_f32_16x16x32_bf16(a, bfr[nt], acc, 0, 0, 0);
#pragma unroll
      for (int j = 0; j < 4; ++j) buw[(q * 4 + j) * 132 + nt * 16 + r] = acc[j];
    }
    __syncthreads();
#pragma unroll
    for (int tt = 0; tt < 16; ++tt) {
      const float br = buw[tt * 132 + lane], bi = buw[tt * 132 + 64 + lane];
      const float nr = ar * xr - ai * xi + br;
      const float ni = ar * xi + ai * xr + bi;
      xr = nr; xi = ni;
      if (FINAL) { stw[tt * 136 + lane] = f2bf(xr); stw[tt * 136 + 64 + lane] = f2bf(xi); }
    }
    __syncthreads();
    if (FINAL) {
      f32x4 y = (f32x4){0.f, 0.f, 0.f, 0.f};
#pragma unroll
      for (int ks = 0; ks < 4; ++ks) {
        bf16x8 a2 = *(const bf16x8*)(stw + r * 136 + ks * 32 + q * 8);
        y = __builtin_amdgcn_mfma_f32_16x16x32_bf16(a2, yfr[ks], y, 0, 0, 0);
      }
#pragma unroll
      for (int j = 0; j < 4; ++j) {
        const int t = mt * 16 + q * 4 + j;
        const float z = gelu_tanh_(y[j] + dsk * bf2f(uq[mt][j]));
        p.zbuf[(size_t)(tok0 + t) * 256 + g * 16 + r] = f2bf(z);
      }
      __syncthreads();
    }
  }
  if (!FINAL) { p.s5_state[sbase + lane] = xr; p.s5_state[sbase + 64 + lane] = xi; }
}

DI void s5_glu(const Params& p, int l, int b, int c, unsigned char* smem) {
  const int tid = threadIdx.x, lane = tid & 63, w = tid >> 6;
  bfu* zs = (bfu*)smem;
  const int tok0 = b * SEQ + c * 64;
  const int r = lane & 15, q = lane >> 4;
  __syncthreads();
#pragma unroll
  for (int i = 0; i < 8; ++i) {
    const int id = tid + i * 256;
    *(uint4*)(zs + (id >> 5) * 264 + (id & 31) * 8) = *(const uint4*)(p.zbuf + (size_t)(tok0 + (id >> 5)) * 256 + (id & 31) * 8);
  }
  __syncthreads();
  const bfu* wg = p.wt_glu + l * 65536;
#pragma unroll 1
  for (int nc = 0; nc < 4; ++nc) {
    bfu gq[4][4]; float bgv[4];
#pragma unroll
    for (int nt = 0; nt < 4; ++nt) {
      bgv[nt] = p.b_glu[l * 256 + nc * 64 + nt * 16 + r];
#pragma unroll
      for (int j = 0; j < 4; ++j) gq[nt][j] = p.proj[(size_t)(tok0 + w * 16 + q * 4 + j) * PS + COL_DG + nc * 64 + nt * 16 + r];
    }
    f32x4 acc[4];
#pragma unroll
    for (int i = 0; i < 4; ++i) acc[i] = (f32x4){0.f, 0.f, 0.f, 0.f};
#pragma unroll
    for (int kh = 0; kh < 2; ++kh) {
      bf16x8 bq[4][4];
#pragma unroll
      for (int ks = 0; ks < 4; ++ks)
#pragma unroll
        for (int nt = 0; nt < 4; ++nt) bq[ks][nt] = *(const bf16x8*)(wg + (nc * 64 + nt * 16 + r) * 256 + kh * 128 + ks * 32 + q * 8);
#pragma unroll
      for (int ks = 0; ks < 4; ++ks) {
        const bf16x8 a = *(const bf16x8*)(zs + (w * 16 + r) * 264 + kh * 128 + ks * 32 + q * 8);
#pragma unroll
        for (int nt = 0; nt < 4; ++nt) acc[nt] = __builtin_amdgcn_mfma_f32_16x16x32_bf16(a, bq[ks][nt], acc[nt], 0, 0, 0);
      }
    }
#pragma unroll
    for (int nt = 0; nt < 4; ++nt) {
      const int n = nc * 64 + nt * 16 + r;
#pragma unroll
      for (int j = 0; j < 4; ++j) {
        const int t = w * 16 + q * 4 + j;
        const float zv = bf2f(zs[t * 264 + n]);
        const float gate = silu_(bf2f(gq[nt][j]));
        p.mixed[(size_t)(tok0 + t) * 1024 + 768 + n] = f2bf(zv * sigmoid_(acc[nt][j] + bgv[nt]) * gate);
      }
    }
  }
}

#define QLOOP(QI, N, BODY)                                                                            \
  {                                                                                                   \
    unsigned* q_ctr = p.cnt + CNT_Q + (l * 8 + (QI)) * 32;                                            \
    unsigned q_nxt = blockIdx.x;                                                                      \
    for (;;) {                                                                                        \
      __syncthreads();                                                                                \
      if (threadIdx.x == 0) *s_q = q_nxt;                                                             \
      __syncthreads();                                                                                \
      const int item = (int)*s_q;                                                                     \
      if (item >= (N)) break;                                                                         \
      if (threadIdx.x == 0) q_nxt = gridDim.x + __hip_atomic_fetch_add(q_ctr, 1u, __ATOMIC_RELAXED, __HIP_MEMORY_SCOPE_AGENT); \
      BODY;                                                                                           \
    }                                                                                                 \
  }

DI void phase2(const Params& p, int l, unsigned char* smem) {
  unsigned* s_q = (unsigned*)(smem + SMEM_BYTES - 32);
  QLOOP(0, 1024, s5_item<false>(p, l, item >> 7, (item >> 2) & 31, item & 3, smem))
  QLOOP(1, 1024, hg_local(p, l, item >> 7, (item >> 2) & 31, item & 3, smem))
  QLOOP(2, 1024, ml_local(p, l, item >> 7, (item >> 2) & 31, item & 3, smem))
  QLOOP(3, 1024, lru_item<false>(p, l, item >> 7, (item >> 2) & 31, item & 3, smem))
}

DI void phase3(const Params& p, int l) {
  const int gtid = blockIdx.x * 256 + threadIdx.x, gsz = gridDim.x * 256;
  constexpr int N1 = 131072, N2 = 131072, N3 = 2048, N4 = 2048, N5 = 8192;
  for (int i = gtid; i < N1 + N2 + N3 + N4 + N5; i += gsz) {
    if (i < N1 + N2) {
      const bool ml = i >= N1;
      const int j = ml ? i - N1 : i;
      const int b = j >> 14, rem = j & 16383, hd = rem >> 12, ed = rem & 4095, d = ed & 63;
      float* stp = (ml ? p.ml_state : p.hg_state) + (size_t)(b * NCH * 4 + hd) * 4096 + ed;
      const float* dcp = ml ? (p.ml_decay + b * NCH * 4 + hd) : (p.hg_decay + (b * NCH * 4 + hd) * 64 + d);
      const int dstride = ml ? 4 : 256;
      float S = 0.f;
#pragma unroll
      for (int c0 = 0; c0 < NCH; c0 += 16) {
        float loc[16], dec[16];
#pragma unroll
        for (int c = 0; c < 16; ++c) { loc[c] = stp[(size_t)(c0 + c) * 16384]; dec[c] = dcp[(c0 + c) * dstride]; }
#pragma unroll
        for (int c = 0; c < 16; ++c) { stp[(size_t)(c0 + c) * 16384] = S; S = dec[c] * S + loc[c]; }
      }
    } else if (i < N1 + N2 + N3) {
      const int j = i - N1 - N2, b = j >> 8, rem = j & 255, hd = rem >> 6, d = rem & 63;
      float S = 0.f;
      for (int c = 0; c < NCH; ++c) {
        const int base = (b * NCH + c) * 4 + hd;
        const float dec = p.ml_decay[base];
        const float loc = p.ml_n[base * 64 + d];
        p.ml_n[base * 64 + d] = S; S = dec * S + loc;
      }
    } else if (i < N1 + N2 + N3 + N4) {
      const int j = i - N1 - N2 - N3, b = j >> 8, ch = j & 255;
      float H = 0.f;
      for (int c = 0; c < NCH; ++c) {
        const int idx = (b * NCH + c) * 256 + ch;
        const float a = p.lru_a[idx], hl = p.lru_h[idx];
        p.lru_h[idx] = H; H = a * H + hl;
      }
    } else {
      const int j = i - N1 - N2 - N3 - N4, b = j >> 10, g = (j >> 6) & 15, pp = j & 63;
      const float ar = p.abar64[((l * 16 + g) * 64 + pp) * 2], ai = p.abar64[((l * 16 + g) * 64 + pp) * 2 + 1];
      float xr = 0.f, xi = 0.f;
      for (int c = 0; c < NCH; ++c) {
        const size_t sb = ((size_t)(b * NCH + c) * 16 + g) * 128;
        const float lr = p.s5_state[sb + pp], li = p.s5_state[sb + 64 + pp];
        p.s5_state[sb + pp] = xr; p.s5_state[sb + 64 + pp] = xi;
        const float nr = ar * xr - ai * xi + lr, ni = ar * xi + ai * xr + li;
        xr = nr; xi = ni;
      }
    }
  }
}

DI void phase4(const Params& p, int l, unsigned char* smem, unsigned long long& tp_acc) {
  unsigned* s_flag = (unsigned*)(smem + SMEM_BYTES - 16);
  unsigned* s_q = (unsigned*)(smem + SMEM_BYTES - 32);
  TPS(41)
  QLOOP(4, 1024, {
    const int bc = item >> 2;
    s5_item<true>(p, l, bc >> 5, bc & 31, item & 3, smem);
    if (last_arriver(p.cnt + CNT_GLU + l * 256 + bc, 4u, s_flag)) s5_glu(p, l, bc >> 5, bc & 31, smem);
  })
  TPE(41)
  TPS(42)
  QLOOP(5, 1024, hg_out(p, l, item >> 7, (item >> 2) & 31, item & 3, smem))
  TPE(42)
  TPS(43)
  QLOOP(6, 1024, ml_out(p, l, item >> 7, (item >> 2) & 31, item & 3, smem))
  TPE(43)
  TPS(44)
  QLOOP(7, 1024, lru_item<true>(p, l, item >> 7, (item >> 2) & 31, item & 3, smem))
  TPE(44)
}

#ifdef TPROBE
#define TP_CLASS(PH) ((PH) == 0 ? 0 : (((PH) - 1) % 5) + 1)
#define TP_BEGIN(PH) unsigned long long tp_t0 = 0; if (TP_CLASS(PH) == TPROBE) tp_t0 = __builtin_amdgcn_s_memrealtime();
#define TP_END(PH) if (TP_CLASS(PH) == TPROBE) tp_acc += __builtin_amdgcn_s_memrealtime() - tp_t0;
#else
#define TP_BEGIN(PH)
#define TP_END(PH)
#endif
#define RUN_PHASE(PH, CALL)                                       \
  if (ph0 <= (PH) && (PH) < ph1) {                                \
    TP_BEGIN(PH)                                                  \
    CALL;                                                         \
    if (COOP) { if ((PH) + 1 < ph1) xcd_barrier(xb); }            \
    TP_END(PH)                                                    \
  }

template <bool COOP, int L>
DI void run_layer(const Params& p, int ph0, int ph1, unsigned char* smem, const XcdBarrier& xb, unsigned long long& tp_acc) {
#ifdef DUP1
  RUN_PHASE(1 + 5 * L, phase1(p, L, smem))
#endif
  RUN_PHASE(1 + 5 * L, phase1(p, L, smem))
#ifdef DUP2
  RUN_PHASE(2 + 5 * L, phase2(p, L, smem))
#endif
  RUN_PHASE(2 + 5 * L, phase2(p, L, smem))
  RUN_PHASE(3 + 5 * L, { phase3(p, L); if (L + 1 < DEPTH) convert_weights<(L + 1 < DEPTH ? L + 1 : 0)>(p, smem); })
#ifdef DUP4
  RUN_PHASE(4 + 5 * L, phase4(p, L, smem, tp_acc))
#endif
  RUN_PHASE(4 + 5 * L, phase4(p, L, smem, tp_acc))
  RUN_PHASE(5 + 5 * L, phase5(p, L, smem, tp_acc))
}

template <bool COOP>
__global__ void __launch_bounds__(256, 2) mk_fwd(Params p, int ph0, int ph1) {
  __shared__ __attribute__((aligned(16))) unsigned char smem[SMEM_BYTES];
  __shared__ uint4 xb_words;
  XcdBarrier xb; xb.bar = p.bar; xb.x = 0; xb.st = nullptr;
  if (COOP) {
    if (ph1 < 0) cg::this_grid().sync();
    if (threadIdx.x == 0) xb_words = make_uint4(0u, 0u, 0u, 0u);
    __syncthreads();
    xb = xcd_barrier_post(p.bar, (volatile LAS unsigned*)&xb_words);
  }
  unsigned long long tp_acc = 0;
  RUN_PHASE(0, phase0(p, smem))
  run_layer<COOP, 0>(p, ph0, ph1, smem, xb, tp_acc);
  run_layer<COOP, 1>(p, ph0, ph1, smem, xb, tp_acc);
  run_layer<COOP, 2>(p, ph0, ph1, smem, xb, tp_acc);
  run_layer<COOP, 3>(p, ph0, ph1, smem, xb, tp_acc);
#ifdef TPROBE
  if (blockIdx.x == 0 && threadIdx.x == 0) {
    const unsigned long long t0 = __builtin_amdgcn_s_memrealtime();
    while (__builtin_amdgcn_s_memrealtime() - t0 < tp_acc) __builtin_amdgcn_s_sleep(8);
  }
#endif
}

extern "C" void kernel_launch(void* const* d_in, const int* in_sizes, int n_in, void* d_out, int out_size, void* d_ws,
                              size_t ws_size, hipStream_t stream) {
  static int grid_blocks = 0;
  if (!grid_blocks) {
    int dev = 0, cus = 0, per_cu = 0;
    hipGetDevice(&dev);
    hipDeviceGetAttribute(&cus, hipDeviceAttributeMultiprocessorCount, dev);
    hipOccupancyMaxActiveBlocksPerMultiprocessor(&per_cu, mk_fwd<(MEGA != 0)>, 256, 0);
    if (per_cu < 1) per_cu = 1;
    if (per_cu > 2) per_cu = 2;
    grid_blocks = cus * per_cu;
  }
  Params p{};
  const float** pin = (const float**)&p;
  for (int i = 0; i < 28; ++i) pin[i] = (const float*)d_in[i];
  p.out = (float*)d_out;
  unsigned char* ws = (unsigned char*)d_ws;
  size_t off = 0;
  auto take = [&](size_t bytes) { unsigned char* r = ws + off; off += (bytes + 255) & ~(size_t)255; return r; };
  p.wt_in = (bfu*)take((size_t)4 * PS * 1024 * 2);
  p.wt_out = (bfu*)take((size_t)4 * 1024 * 1024 * 2);
  p.wt_a = (bfu*)take(16 * 4096 * 2);
  p.wt_x = (bfu*)take(16 * 4096 * 2);
  p.wt_glu = (bfu*)take(4 * 65536 * 2);
  p.bt_bu = (bfu*)take(64 * 128 * 32 * 2);
  p.bt_y = (bfu*)take(64 * 16 * 128 * 2);
  p.hb = (bfu*)take((size_t)NTOK * 1024 * 2);
  p.proj = (bfu*)take((size_t)NTOK * PS * 2);
  p.mixed = (bfu*)take((size_t)NTOK * 1024 * 2);
  p.zbuf = (bfu*)take((size_t)NTOK * 256 * 2);
  p.abar = (float*)take(4096 * 2 * 4);
  p.abar64 = (float*)take(4096 * 2 * 4);
  p.lbs = (float*)take(1024 * 4);
  p.hg_state = (float*)take((size_t)BATCH * NCH * 4 * 4096 * 4);
  p.hg_decay = (float*)take((size_t)BATCH * NCH * 4 * 64 * 4);
  p.ml_state = (float*)take((size_t)BATCH * NCH * 4 * 4096 * 4);
  p.ml_n = (float*)take((size_t)BATCH * NCH * 4 * 64 * 4);
  p.ml_decay = (float*)take((size_t)BATCH * NCH * 4 * 4);
  p.lru_h = (float*)take((size_t)BATCH * NCH * 256 * 4);
  p.lru_a = (float*)take((size_t)BATCH * NCH * 256 * 4);
  p.s5_state = (float*)take((size_t)BATCH * NCH * 16 * 128 * 4);
  p.cnt = (unsigned*)take(CNT_TOTAL * 4);
  p.bar = (unsigned*)take(XCD_BAR_WORDS * 4);
  if (off > ws_size) { fprintf(stderr, "workspace too small: need %zu have %zu\n", off, ws_size); return; }
  const int NPH = 1 + 5 * DEPTH;
#if MEGA
  (void)hipMemsetAsync(p.bar, 0, XCD_BAR_WORDS * 4, stream);
  int ph0 = 0, ph1 = NPH;
  void* args[] = {&p, &ph0, &ph1};
  hipError_t e = hipLaunchCooperativeKernel((void*)mk_fwd<true>, dim3(grid_blocks), dim3(256), args, 0, stream);
  if (e != hipSuccess) fprintf(stderr, "cooperative launch failed: %s (grid %d)\n", hipGetErrorString(e), grid_blocks);
#else
  for (int ph = 0; ph < NPH; ++ph) hipLaunchKernelGGL(mk_fwd<false>, dim3(grid_blocks), dim3(256), 0, stream, p, ph, ph + 1);
#endif
}
```

```cpp
#include <hip/hip_runtime.h>
#include <hip/hip_cooperative_groups.h>
#include <stdint.h>
#include <stdio.h>
namespace cg = cooperative_groups;

#ifndef MEGA
#define MEGA 1
#endif

typedef unsigned short bfu;
using bf16x8 = __attribute__((ext_vector_type(8))) short;
using f32x4  = __attribute__((ext_vector_type(4))) float;
#define DI __device__ __forceinline__

constexpr int BATCH = 8, SEQ = 2048, DM = 1024, DEPTH = 4, NTOK = BATCH * SEQ, NCH = SEQ / 64;
constexpr int DIN = 3080, PS = 3200;
constexpr int COL_AQ = 0, COL_AF = 256, COL_AI = 512, COL_AG = 768;
constexpr int COL_BQ = 1024, COL_BK = 1280, COL_BV = 1536, COL_BG = 1792, COL_BIG = 3072, COL_BFG = 3076;
constexpr int COL_CX = 2048, COL_CG = 2304, COL_DU = 2560, COL_DG = 2816;
constexpr float DN_ALPHA = 1.681792830507429f;
constexpr int SMEM_BYTES = 56 * 1024;
constexpr int CNT_LN = 0, CNT_GLU = 4 * 128, CNT_Q = 4 * 128 + 4 * 256, CNT_TOTAL = CNT_Q + 32 * 32;

struct Params {
  const float *x, *w_in, *b_in, *lb_logits, *hg_g, *ml_fb, *ml_g, *conv_w, *conv_b, *w_a, *b_a, *w_x, *b_x, *lam,
      *a_re, *a_im, *log_dt, *sb_re, *sb_im, *c_re, *c_im, *s5_d, *w_glu, *b_glu, *w_out, *b_out, *ln_g, *ln_b;
  float* out;
  bfu *wt_in, *wt_out, *wt_a, *wt_x, *wt_glu, *bt_bu, *bt_y, *hb, *proj, *mixed, *zbuf;
  float *abar, *abar64, *lbs, *hg_state, *hg_decay, *ml_state, *ml_n, *ml_decay, *lru_h, *lru_a, *s5_state;
  unsigned* cnt;
  unsigned* bar;
};

DI bfu f2bf(float x) { unsigned u = __float_as_uint(x); u += 0x7fffu + ((u >> 16) & 1u); return (bfu)(u >> 16); }
DI float bf2f(bfu h) { return __uint_as_float(((unsigned)h) << 16); }
DI unsigned pack2(float a, float b) { return (unsigned)f2bf(a) | ((unsigned)f2bf(b) << 16); }
DI float fexp(float x) { return __expf(x); }
DI float frcp(float x) { return __builtin_amdgcn_rcpf(x); }
DI float flog(float x) { return __logf(x); }
DI float sigmoid_(float x) { return frcp(1.f + fexp(-x)); }
DI float silu_(float x) { return x * frcp(1.f + fexp(-x)); }
DI float logsig_(float x) { return fminf(x, 0.f) - flog(1.f + fexp(-fabsf(x))); }
DI float logsig_acc(float x) { return fminf(x, 0.f) - log1pf(expf(-fabsf(x))); }
DI float gelu_tanh_(float x) {
  float u = 0.7978845608028654f * (x + 0.044715f * x * x * x);
  float th = 1.f - 2.f * frcp(fexp(2.f * u) + 1.f);
  return 0.5f * x * (1.f + th);
}

template <int NT, int KS>
DI void wave_mma(f32x4 (&acc)[NT], const bfu* A, int lda, const bfu* Bt, int ldb, int lane) {
  const int r = lane & 15, q = lane >> 4;
#pragma unroll
  for (int ks = 0; ks < KS; ++ks) {
    bf16x8 a = *(const bf16x8*)(A + r * lda + ks * 32 + q * 8);
#pragma unroll
    for (int nt = 0; nt < NT; ++nt) {
      bf16x8 b = *(const bf16x8*)(Bt + (nt * 16 + r) * ldb + ks * 32 + q * 8);
      acc[nt] = __builtin_amdgcn_mfma_f32_16x16x32_bf16(a, b, acc[nt], 0, 0, 0);
    }
  }
}

DI void wave_sync() { __builtin_amdgcn_fence(__ATOMIC_SEQ_CST, "wavefront"); __builtin_amdgcn_wave_barrier(); __builtin_amdgcn_fence(__ATOMIC_SEQ_CST, "wavefront"); }
DI float group16_sum(float v) {
  v += __shfl_xor(v, 1); v += __shfl_xor(v, 2); v += __shfl_xor(v, 4); v += __shfl_xor(v, 8);
  return v;
}
DI float wave_sum(float v) {
  v += __shfl_xor(v, 1); v += __shfl_xor(v, 2); v += __shfl_xor(v, 4); v += __shfl_xor(v, 8);
  v += __shfl_xor(v, 16); v += __shfl_xor(v, 32);
  return v;
}

DI bool last_arriver(unsigned* ctr, unsigned total, unsigned* s_flag) {
  asm volatile("s_waitcnt vmcnt(0)" ::: "memory");
  __syncthreads();
  if (threadIdx.x == 0) {
    __builtin_amdgcn_fence(__ATOMIC_RELEASE, "agent");
    asm volatile("s_waitcnt vmcnt(0)" ::: "memory");
    const unsigned old = __hip_atomic_fetch_add(ctr, 1u, __ATOMIC_RELAXED, __HIP_MEMORY_SCOPE_AGENT);
    const unsigned last = (old == total - 1u) ? 1u : 0u;
    if (last) { __builtin_amdgcn_fence(__ATOMIC_ACQUIRE, "agent"); asm volatile("s_waitcnt vmcnt(0)" ::: "memory"); }
    *s_flag = last;
  }
  __syncthreads();
  return (*s_flag != 0u);
}

#ifdef TPROBE
#define TPS(ID) unsigned long long tps_##ID = 0; if (TPROBE == (ID)) tps_##ID = __builtin_amdgcn_s_memrealtime();
#define TPE(ID) if (TPROBE == (ID)) tp_acc += __builtin_amdgcn_s_memrealtime() - tps_##ID;
#else
#define TPS(ID)
#define TPE(ID)
#endif

#define XB_TMO      128
#define XB_XCNT(j)  (256  + 64 * (j))
#define XB_XSUB(j)  (1280 + 64 * (j))
#define XB_XGEN(j)  (2304 + 64 * (j))
#define XB_TOP      3328
#define XB_TOPGEN   3392
#define XCD_BAR_WORDS 3456
#define XB_SPIN_CAP (1u << 22)
#define LAS __attribute__((address_space(3)))
DI unsigned xb_ld(unsigned* p) { return __hip_atomic_load(p, __ATOMIC_RELAXED, __HIP_MEMORY_SCOPE_AGENT); }
DI unsigned xb_add(unsigned* p, unsigned v) { return __hip_atomic_fetch_add(p, v, __ATOMIC_RELAXED, __HIP_MEMORY_SCOPE_AGENT); }
DI unsigned xb_xcc_id() { return (unsigned)__builtin_amdgcn_s_getreg((3 << 11) | 20) & 0xFu; }
#define XB_SPIN(cond, bar) do { unsigned _sp = 0; while (cond) { __builtin_amdgcn_s_sleep(1); \
    if ((++_sp & 255u) == 0u) { if (xb_ld(&(bar)[XB_TMO])) break; if (_sp > XB_SPIN_CAP) { atomicAdd(&(bar)[XB_TMO], 1u); break; } } } } while (0)
struct XcdBarrier { unsigned* bar; unsigned x; volatile LAS unsigned* st; };
DI XcdBarrier xcd_barrier_post(unsigned* bar, volatile LAS unsigned* st) {
  XcdBarrier b; b.bar = bar; b.x = xb_xcc_id(); b.st = st;
  if (threadIdx.x == 0) (void)xb_add(&bar[XB_XCNT(b.x)], 1u);
  return b;
}
DI void xcd_barrier_complete(unsigned* bar, unsigned x, unsigned& nloc, unsigned& nx) {
  const unsigned G = gridDim.x * gridDim.y * gridDim.z;
  unsigned sum, cnt, mine, sp = 0u;
  for (;;) {
    sum = 0u; cnt = 0u; mine = 0u;
#pragma unroll
    for (unsigned j = 0; j < 16; ++j) { const unsigned c = xb_ld(&bar[XB_XCNT(j)]); sum += c; cnt += (c > 0u) ? 1u : 0u; mine = (j == x) ? c : mine; }
    if (sum == G) break;
    __builtin_amdgcn_s_sleep(1);
    if ((++sp & 255u) == 0u) { if (xb_ld(&bar[XB_TMO])) break; if (sp > XB_SPIN_CAP) { atomicAdd(&bar[XB_TMO], 1u); break; } }
  }
  nloc = mine > 0u ? mine : 1u; nx = cnt > 0u ? cnt : 1u;
}
DI void xcd_barrier(const XcdBarrier& b) {
  asm volatile("s_waitcnt vmcnt(0)" ::: "memory");
  __syncthreads();
  if (threadIdx.x == 0) {
    unsigned* bar = b.bar;
    __builtin_amdgcn_s_waitcnt(0);
    unsigned nloc = b.st[0], nx = b.st[1];
    if (nloc == 0u) { xcd_barrier_complete(bar, b.x, nloc, nx); b.st[0] = nloc; b.st[1] = nx; }
    const unsigned old = xb_add(&bar[XB_XSUB(b.x)], 1u);
    const unsigned gen = old / nloc;
    if (old + 1u == (gen + 1u) * nloc) {
      __builtin_amdgcn_fence(__ATOMIC_RELEASE, "agent");
      asm volatile("s_waitcnt vmcnt(0)" ::: "memory");
      const unsigned og = xb_add(&bar[XB_TOP], 1u);
      const unsigned tg = og / nx;
      if (og + 1u == (tg + 1u) * nx) xb_add(&bar[XB_TOPGEN], 1u);
      else XB_SPIN(xb_ld(&bar[XB_TOPGEN]) == tg, bar);
      __builtin_amdgcn_fence(__ATOMIC_ACQUIRE, "agent");
      xb_add(&bar[XB_XGEN(b.x)], 1u);
      asm volatile("s_waitcnt vmcnt(0)" ::: "memory");
    } else {
      XB_SPIN(xb_ld(&bar[XB_XGEN(b.x)]) == gen, bar);
      __builtin_amdgcn_fence(__ATOMIC_ACQUIRE, "agent");
      asm volatile("s_waitcnt vmcnt(0)" ::: "memory");
    }
  }
  __syncthreads();
}

DI void transpose_tile(const float* src, int sld, int cv, bfu* dst, int dld, float* tile) {
  const int tid = threadIdx.x;
  __syncthreads();
  for (int i = tid; i < 4096; i += 256) {
    int r = i >> 6, c = i & 63;
    tile[r * 65 + c] = (c < cv) ? src[(size_t)r * sld + c] : 0.f;
  }
  __syncthreads();
  for (int i = tid; i < 4096; i += 256) {
    int n = i >> 6, k = i & 63;
    dst[(size_t)n * dld + k] = f2bf(tile[k * 65 + n]);
  }
}

template <int LSEL>
DI void convert_weights(const Params& p, unsigned char* smem) {
  const int tid = threadIdx.x;
  float* tile = (float*)smem;
  const int NJ = 3200 + 1024 + 16 + 16 + 64;
  for (int job = blockIdx.x; job < NJ; job += gridDim.x) {
    const float* src; int sld, cv = 64, dld; bfu* dst;
    if (job < 3200) {
      int l = job / 800, rem = job % 800, kt = rem / 50, nt = rem % 50;
      if (l != LSEL) continue;
      const int c0 = nt < 28 ? nt * 64 : (nt < 48 ? nt * 64 + 8 : 1792);
      src = p.w_in + (size_t)l * 1024 * DIN + (size_t)kt * 64 * DIN + c0; sld = DIN;
      cv = nt < 48 ? 64 : (nt == 48 ? 8 : 0);
      dst = p.wt_in + (size_t)l * PS * 1024 + (size_t)nt * 64 * 1024 + kt * 64; dld = 1024;
    } else if (job < 4224) {
      int j = job - 3200, l = j / 256, rem = j % 256, kt = rem / 16, nt = rem % 16;
      if (l != LSEL) continue;
      src = p.w_out + (size_t)l * 1048576 + (size_t)kt * 64 * 1024 + nt * 64; sld = 1024;
      dst = p.wt_out + (size_t)l * 1048576 + (size_t)nt * 64 * 1024 + kt * 64; dld = 1024;
    } else if (LSEL != 0) {
      continue;
    } else if (job < 4240) {
      int j = job - 4224; src = p.w_a + j * 4096; sld = 64; dst = p.wt_a + j * 4096; dld = 64;
    } else if (job < 4256) {
      int j = job - 4240; src = p.w_x + j * 4096; sld = 64; dst = p.wt_x + j * 4096; dld = 64;
    } else {
      int j = job - 4256, l = j / 16, rem = j % 16, kt = rem / 4, nt = rem % 4;
      src = p.w_glu + l * 65536 + kt * 64 * 256 + nt * 64; sld = 256;
      dst = p.wt_glu + l * 65536 + nt * 64 * 256 + kt * 64; dld = 256;
    }
    transpose_tile(src, sld, cv, dst, dld, tile);
  }
}

DI void phase0(const Params& p, unsigned char* smem) {
  const int tid = threadIdx.x;
  const int gtid = blockIdx.x * 256 + tid, gsz = gridDim.x * 256;
  for (int i = gtid; i < NTOK * DM / 8; i += gsz) {
    float4 a = ((const float4*)p.x)[2 * i], b = ((const float4*)p.x)[2 * i + 1];
    uint4 o; o.x = pack2(a.x, a.y); o.y = pack2(a.z, a.w); o.z = pack2(b.x, b.y); o.w = pack2(b.z, b.w);
    ((uint4*)p.hb)[i] = o;
  }
  convert_weights<0>(p, smem);
  for (int i = gtid; i < 4096; i += gsz) {
    int lg = i >> 6, pp = i & 63;
    double dt = exp((double)p.log_dt[lg]);
    double are = p.a_re[lg * 64 + pp], aim = p.a_im[lg * 64 + pp];
    double mag = exp(dt * are), ang = dt * aim;
    double abr = mag * cos(ang), abi = mag * sin(ang);
    double den = are * are + aim * aim;
    double xr = abr - 1.0, xi = abi;
    double zr = (xr * are + xi * aim) / den, zi = (xi * are - xr * aim) / den;
    bfu* o_re = p.bt_bu + ((size_t)lg * 128 + pp) * 32;
    bfu* o_im = p.bt_bu + ((size_t)lg * 128 + 64 + pp) * 32;
    for (int h = 0; h < 16; ++h) {
      double br = p.sb_re[(lg * 64 + pp) * 16 + h], bi = p.sb_im[(lg * 64 + pp) * 16 + h];
      o_re[h] = f2bf((float)(zr * br - zi * bi));
      o_im[h] = f2bf((float)(zr * bi + zi * br));
      o_re[16 + h] = 0; o_im[16 + h] = 0;
    }
    p.abar[(lg * 64 + pp) * 2 + 0] = (float)abr; p.abar[(lg * 64 + pp) * 2 + 1] = (float)abi;
    double mag64 = exp(64.0 * dt * are), ang64 = 64.0 * ang;
    p.abar64[(lg * 64 + pp) * 2 + 0] = (float)(mag64 * cos(ang64));
    p.abar64[(lg * 64 + pp) * 2 + 1] = (float)(mag64 * sin(ang64));
  }
  for (int i = gtid; i < 4 * 16 * 16 * 128; i += gsz) {
    int k = i & 127, lgn = i >> 7;
    p.bt_y[i] = (k < 64) ? f2bf(p.c_re[lgn * 64 + k]) : f2bf(-p.c_im[lgn * 64 + (k - 64)]);
  }
  for (int i = gtid; i < 256; i += gsz) {
    float v0 = p.lb_logits[i], v1 = p.lb_logits[256 + i], v2 = p.lb_logits[512 + i], v3 = p.lb_logits[768 + i];
    float m = fmaxf(fmaxf(v0, v1), fmaxf(v2, v3));
    float e0 = expf(v0 - m), e1 = expf(v1 - m), e2 = expf(v2 - m), e3 = expf(v3 - m);
    float s = e0 + e1 + e2 + e3;
    p.lbs[i] = 0.f; p.lbs[256 + i] = e1 / s; p.lbs[512 + i] = (e1 + e2) / s; p.lbs[768 + i] = (e1 + e2 + e3) / s;
  }
  for (int i = gtid; i < CNT_TOTAL; i += gsz) p.cnt[i] = 0u;
}

DI void gemm1_tile(const Params& p, int l, const bfu* A, const bfu* Bt, int m0, int n0, unsigned char* smem) {
  bfu* sA = (bfu*)smem; bfu* sB = sA + 128 * 72;
  bfu* sC = (bfu*)smem;
  const int tid = threadIdx.x, lane = tid & 63, w = tid >> 6, wm = w >> 1, wn = w & 1;
  const int r = lane & 15, q = lane >> 4;
  f32x4 acc[4][6];
#pragma unroll
  for (int i = 0; i < 4; ++i)
#pragma unroll
    for (int j = 0; j < 6; ++j) acc[i][j] = (f32x4){0.f, 0.f, 0.f, 0.f};
  const int lrow = tid >> 3, lkc = tid & 7;
  const bfu* ga = A + (size_t)(m0 + lrow) * 1024 + lkc * 8;
  const bfu* gb = Bt + (size_t)(n0 + lrow) * 1024 + lkc * 8;
  uint4 ra0 = *(const uint4*)(ga), ra1 = *(const uint4*)(ga + 32 * 1024), ra2 = *(const uint4*)(ga + 64 * 1024), ra3 = *(const uint4*)(ga + 96 * 1024);
  uint4 rb0 = *(const uint4*)(gb), rb1 = *(const uint4*)(gb + 32 * 1024), rb2 = *(const uint4*)(gb + 64 * 1024), rb3 = *(const uint4*)(gb + 96 * 1024);
  uint4 rb4 = *(const uint4*)(gb + 128 * 1024), rb5 = *(const uint4*)(gb + 160 * 1024);
  bfu* wa = sA + lrow * 72 + lkc * 8;
  bfu* wb = sB + lrow * 72 + lkc * 8;
  for (int kt = 0; kt < 16; ++kt) {
    __syncthreads();
    *(uint4*)(wa) = ra0; *(uint4*)(wa + 32 * 72) = ra1; *(uint4*)(wa + 64 * 72) = ra2; *(uint4*)(wa + 96 * 72) = ra3;
    *(uint4*)(wb) = rb0; *(uint4*)(wb + 32 * 72) = rb1; *(uint4*)(wb + 64 * 72) = rb2; *(uint4*)(wb + 96 * 72) = rb3;
    *(uint4*)(wb + 128 * 72) = rb4; *(uint4*)(wb + 160 * 72) = rb5;
    __syncthreads();
    if (kt + 1 < 16) {
      const bfu* ga2 = ga + (kt + 1) * 64; const bfu* gb2 = gb + (kt + 1) * 64;
      ra0 = *(const uint4*)(ga2); ra1 = *(const uint4*)(ga2 + 32 * 1024); ra2 = *(const uint4*)(ga2 + 64 * 1024); ra3 = *(const uint4*)(ga2 + 96 * 1024);
      rb0 = *(const uint4*)(gb2); rb1 = *(const uint4*)(gb2 + 32 * 1024); rb2 = *(const uint4*)(gb2 + 64 * 1024); rb3 = *(const uint4*)(gb2 + 96 * 1024);
      rb4 = *(const uint4*)(gb2 + 128 * 1024); rb5 = *(const uint4*)(gb2 + 160 * 1024);
    }
#pragma unroll
    for (int ks = 0; ks < 2; ++ks) {
      bf16x8 af[4], bfr[6];
#pragma unroll
      for (int mt = 0; mt < 4; ++mt) af[mt] = *(const bf16x8*)(sA + (wm * 64 + mt * 16 + r) * 72 + ks * 32 + q * 8);
#pragma unroll
      for (int nt = 0; nt < 6; ++nt) bfr[nt] = *(const bf16x8*)(sB + (wn * 96 + nt * 16 + r) * 72 + ks * 32 + q * 8);
#pragma unroll
      for (int mt = 0; mt < 4; ++mt)
#pragma unroll
        for (int nt = 0; nt < 6; ++nt) acc[mt][nt] = __builtin_amdgcn_mfma_f32_16x16x32_bf16(af[mt], bfr[nt], acc[mt][nt], 0, 0, 0);
    }
  }
  float bias[6];
#pragma unroll
  for (int nt = 0; nt < 6; ++nt) {
    const int col = n0 + wn * 96 + nt * 16 + r;
    bias[nt] = p.b_in[l * DIN + (col < 1792 ? col : col + 8)];
  }
  __syncthreads();
#pragma unroll
  for (int mt = 0; mt < 4; ++mt)
#pragma unroll
    for (int nt = 0; nt < 6; ++nt)
#pragma unroll
      for (int j = 0; j < 4; ++j)
        sC[(wm * 64 + mt * 16 + q * 4 + j) * 200 + wn * 96 + nt * 16 + r] = f2bf(acc[mt][nt][j] + bias[nt]);
  __syncthreads();
#pragma unroll
  for (int i = 0; i < 12; ++i) {
    const int id = tid + i * 256, row = id / 24, ch = id % 24;
    *(uint4*)(p.proj + (size_t)(m0 + row) * PS + n0 + ch * 8) = *(const uint4*)(sC + row * 200 + ch * 8);
  }
}

DI void gemm1_gates(const Params& p, int l, const bfu* A, const bfu* Bt, int m0) {
  const int tid = threadIdx.x, lane = tid & 63, w = tid >> 6, r = lane & 15, q = lane >> 4;
  const bfu* a0 = A + (size_t)(m0 + w * 32 + r) * 1024 + q * 8;
  const bfu* a1 = a0 + 16 * 1024;
  const bfu* bp = Bt + (size_t)(3072 + r) * 1024 + q * 8;
  f32x4 c0 = (f32x4){0.f, 0.f, 0.f, 0.f}, c1 = (f32x4){0.f, 0.f, 0.f, 0.f};
#pragma unroll 4
  for (int ks = 0; ks < 32; ++ks) {
    const bf16x8 b = *(const bf16x8*)(bp + ks * 32);
    const bf16x8 x0 = *(const bf16x8*)(a0 + ks * 32);
    const bf16x8 x1 = *(const bf16x8*)(a1 + ks * 32);
    c0 = __builtin_amdgcn_mfma_f32_16x16x32_bf16(x0, b, c0, 0, 0, 0);
    c1 = __builtin_amdgcn_mfma_f32_16x16x32_bf16(x1, b, c1, 0, 0, 0);
  }
  if (r < 8) {
    const float bias = p.b_in[l * DIN + 1792 + r];
#pragma unroll
    for (int j = 0; j < 4; ++j) {
      p.proj[(size_t)(m0 + w * 32 + q * 4 + j) * PS + 3072 + r] = f2bf(c0[j] + bias);
      p.proj[(size_t)(m0 + w * 32 + 16 + q * 4 + j) * PS + 3072 + r] = f2bf(c1[j] + bias);
    }
  }
}

DI void phase1(const Params& p, int l, unsigned char* smem) {
  const bfu* Bt = p.wt_in + (size_t)l * PS * 1024;
  for (int tile = blockIdx.x; tile < 128 * 16; tile += gridDim.x) { const int mt = tile >> 4, nt = tile & 15; gemm1_tile(p, l, p.hb, Bt, mt * 128, nt * 192, smem); }
  for (int job = blockIdx.x; job < 128; job += gridDim.x) gemm1_gates(p, l, p.hb, Bt, job * 128);
}

template <int EPI>
DI void gemm2_tile(const Params& p, int l, const bfu* A, const bfu* Bt, int m0, int n0, const float* hin, unsigned char* smem) {
  bfu* sA = (bfu*)smem; bfu* sB = sA + 128 * 72;
  const int tid = threadIdx.x, lane = tid & 63, w = tid >> 6, wm = w >> 1, wn = w & 1;
  const int r = lane & 15, q = lane >> 4;
  f32x4 acc[4][4];
#pragma unroll
  for (int i = 0; i < 4; ++i)
#pragma unroll
    for (int j = 0; j < 4; ++j) acc[i][j] = (f32x4){0.f, 0.f, 0.f, 0.f};
  const int lrow = tid >> 3, lkc = tid & 7;
  const bfu* ga = A + (size_t)(m0 + lrow) * 1024 + lkc * 8;
  const bfu* gb = Bt + (size_t)(n0 + lrow) * 1024 + lkc * 8;
  uint4 ra0 = *(const uint4*)(ga), ra1 = *(const uint4*)(ga + 32 * 1024), ra2 = *(const uint4*)(ga + 64 * 1024), ra3 = *(const uint4*)(ga + 96 * 1024);
  uint4 rb0 = *(const uint4*)(gb), rb1 = *(const uint4*)(gb + 32 * 1024), rb2 = *(const uint4*)(gb + 64 * 1024), rb3 = *(const uint4*)(gb + 96 * 1024);
  bfu* wa = sA + lrow * 72 + lkc * 8;
  bfu* wb = sB + lrow * 72 + lkc * 8;
  for (int kt = 0; kt < 16; ++kt) {
    __syncthreads();
    *(uint4*)(wa) = ra0; *(uint4*)(wa + 32 * 72) = ra1; *(uint4*)(wa + 64 * 72) = ra2; *(uint4*)(wa + 96 * 72) = ra3;
    *(uint4*)(wb) = rb0; *(uint4*)(wb + 32 * 72) = rb1; *(uint4*)(wb + 64 * 72) = rb2; *(uint4*)(wb + 96 * 72) = rb3;
    __syncthreads();
    if (kt + 1 < 16) {
      const bfu* ga2 = ga + (kt + 1) * 64; const bfu* gb2 = gb + (kt + 1) * 64;
      ra0 = *(const uint4*)(ga2); ra1 = *(const uint4*)(ga2 + 32 * 1024); ra2 = *(const uint4*)(ga2 + 64 * 1024); ra3 = *(const uint4*)(ga2 + 96 * 1024);
      rb0 = *(const uint4*)(gb2); rb1 = *(const uint4*)(gb2 + 32 * 1024); rb2 = *(const uint4*)(gb2 + 64 * 1024); rb3 = *(const uint4*)(gb2 + 96 * 1024);
    }
#pragma unroll
    for (int ks = 0; ks < 2; ++ks) {
      bf16x8 af[4], bfr[4];
#pragma unroll
      for (int mt = 0; mt < 4; ++mt) af[mt] = *(const bf16x8*)(sA + (wm * 64 + mt * 16 + r) * 72 + ks * 32 + q * 8);
#pragma unroll
      for (int nt = 0; nt < 4; ++nt) bfr[nt] = *(const bf16x8*)(sB + (wn * 64 + nt * 16 + r) * 72 + ks * 32 + q * 8);
#pragma unroll
      for (int mt = 0; mt < 4; ++mt)
#pragma unroll
        for (int nt = 0; nt < 4; ++nt) acc[mt][nt] = __builtin_amdgcn_mfma_f32_16x16x32_bf16(af[mt], bfr[nt], acc[mt][nt], 0, 0, 0);
    }
  }
#pragma unroll
  for (int nt = 0; nt < 4; ++nt) {
    const int col = n0 + wn * 64 + nt * 16 + r;
    if (EPI == 1) {
      const float bias = (col < DIN) ? p.b_in[l * DIN + col] : 0.f;
#pragma unroll
      for (int mt = 0; mt < 4; ++mt)
#pragma unroll
        for (int j = 0; j < 4; ++j) {
          const int row = m0 + wm * 64 + mt * 16 + q * 4 + j;
          p.proj[(size_t)row * PS + col] = f2bf(acc[mt][nt][j] + bias);
        }
    } else {
      const float bias = p.b_out[l * 1024 + col];
      float hv[4][4];
#pragma unroll
      for (int mt = 0; mt < 4; ++mt)
#pragma unroll
        for (int j = 0; j < 4; ++j) hv[mt][j] = hin[(size_t)(m0 + wm * 64 + mt * 16 + q * 4 + j) * 1024 + col];
#pragma unroll
      for (int mt = 0; mt < 4; ++mt)
#pragma unroll
        for (int j = 0; j < 4; ++j) {
          const int row = m0 + wm * 64 + mt * 16 + q * 4 + j;
          p.out[(size_t)row * 1024 + col] = DN_ALPHA * hv[mt][j] + acc[mt][nt][j] + bias;
        }
    }
  }
}


DI void phase5(const Params& p, int l, unsigned char* smem, unsigned long long& tp_acc) {
  const bfu* Bt = p.wt_out + (size_t)l * 1048576;
  const float* hin = (l == 0) ? p.x : p.out;
  for (int tile = blockIdx.x; tile < 128 * 8; tile += gridDim.x) gemm2_tile<2>(p, l, p.mixed, Bt, (tile >> 3) * 128, (tile & 7) * 128, hin, smem);
}

DI void phase6(const Params& p, int l) {
  const int tid = threadIdx.x, lane = tid & 63, w = tid >> 6;
  float4 g[4], bb[4];
#pragma unroll
  for (int i = 0; i < 4; ++i) { g[i] = *(const float4*)(p.ln_g + l * 1024 + i * 256 + lane * 4); bb[i] = *(const float4*)(p.ln_b + l * 1024 + i * 256 + lane * 4); }
  for (int rb = blockIdx.x; rb < NTOK / 16; rb += gridDim.x) {
    const int row0 = rb * 16 + w * 4;
    float4 v[4][4];
#pragma unroll
    for (int rr = 0; rr < 4; ++rr)
#pragma unroll
      for (int i = 0; i < 4; ++i) v[rr][i] = *(const float4*)(p.out + (size_t)(row0 + rr) * 1024 + i * 256 + lane * 4);
#pragma unroll
    for (int rr = 0; rr < 4; ++rr) {
      float sm = 0.f;
#pragma unroll
      for (int i = 0; i < 4; ++i) sm += v[rr][i].x + v[rr][i].y + v[rr][i].z + v[rr][i].w;
      const float mu = wave_sum(sm) * (1.f / 1024.f);
      float ss = 0.f;
#pragma unroll
      for (int i = 0; i < 4; ++i) {
        v[rr][i].x -= mu; v[rr][i].y -= mu; v[rr][i].z -= mu; v[rr][i].w -= mu;
        ss += v[rr][i].x * v[rr][i].x + v[rr][i].y * v[rr][i].y + v[rr][i].z * v[rr][i].z + v[rr][i].w * v[rr][i].w;
      }
      const float rs = rsqrtf(wave_sum(ss) * (1.f / 1024.f) + 1e-5f);
#pragma unroll
      for (int i = 0; i < 4; ++i) {
        const int c = i * 256 + lane * 4;
        float4 o;
        o.x = v[rr][i].x * rs * g[i].x + bb[i].x; o.y = v[rr][i].y * rs * g[i].y + bb[i].y;
        o.z = v[rr][i].z * rs * g[i].z + bb[i].z; o.w = v[rr][i].w * rs * g[i].w + bb[i].w;
        *(float4*)(p.out + (size_t)(row0 + rr) * 1024 + c) = o;
        uint2 ob; ob.x = pack2(o.x, o.y); ob.y = pack2(o.z, o.w);
        *(uint2*)(p.hb + (size_t)(row0 + rr) * 1024 + c) = ob;
      }
    }
  }
}

DI void hg_gate(float x, float lb, float& lf, float& k) {
  x = fmaxf(x, -80.f);
  const float E = fexp(-x);
  const float sg = frcp(1.f + E);
  k = (1.f - lb) * (E * sg);
  lf = flog(lb + (1.f - lb) * sg);
}

DI void hg_local(const Params& p, int l, int b, int c, int hd, unsigned char* smem) {
  const int tid = threadIdx.x, lane = tid & 63, w = tid >> 6;
  bfu* At = (bfu*)smem;
  bfu* Bt = At + 64 * 72;
  float* segtot = (float*)(smem + 2 * 64 * 72 * 2);
  const int tok0 = b * SEQ + c * 64;
  const int d = lane;
  const float lb = p.lbs[l * 256 + hd * 64 + d];
  const bfu* pf = p.proj + (size_t)tok0 * PS + COL_AF + hd * 64 + d;
  const bfu* pv = p.proj + (size_t)tok0 * PS + COL_AI + hd * 64 + d;
  float bl[16], kk[16];
  float run = 0.f;
  __syncthreads();
#pragma unroll
  for (int i = 0; i < 16; ++i) {
    const int t = w * 16 + i;
    float lf, k; hg_gate(bf2f(pf[(size_t)t * PS]), lb, lf, k);
    run += lf; bl[i] = run; kk[i] = k;
    At[d * 72 + t] = pv[(size_t)t * PS];
  }
  segtot[w * 64 + d] = run;
  __syncthreads();
  float off = 0.f, tot = 0.f;
#pragma unroll
  for (int s = 0; s < 4; ++s) { float v = segtot[s * 64 + d]; tot += v; if (s < w) off += v; }
#pragma unroll
  for (int i = 0; i < 16; ++i) { const int t = w * 16 + i; Bt[d * 72 + t] = f2bf(kk[i] * fexp(tot - (bl[i] + off))); }
  const int base = (b * NCH + c) * 4 + hd;
  if (w == 0) p.hg_decay[base * 64 + d] = fexp(tot);
  __syncthreads();
  f32x4 acc[4];
#pragma unroll
  for (int i = 0; i < 4; ++i) acc[i] = (f32x4){0.f, 0.f, 0.f, 0.f};
  wave_mma<4, 2>(acc, At + w * 16 * 72, 72, Bt, 72, lane);
  float* st = p.hg_state + (size_t)base * 4096;
  const int r = lane & 15, q = lane >> 4;
#pragma unroll
  for (int nt = 0; nt < 4; ++nt)
#pragma unroll
    for (int j = 0; j < 4; ++j) st[(w * 16 + q * 4 + j) * 64 + nt * 16 + r] = acc[nt][j];
}

constexpr int O_A = 0, O_BT = 17408, O_QP = 34816, O_KP = 44032, O_MISC = 53248;

DI void hg_out(const Params& p, int l, int b, int c, int hd, unsigned char* smem) {
  const int tid = threadIdx.x, lane = tid & 63, w = tid >> 6;
  bfu* A = (bfu*)(smem + O_A); bfu* Bt = (bfu*)(smem + O_BT); bfu* Qp = (bfu*)(smem + O_QP); bfu* Kp = (bfu*)(smem + O_KP);
  float* segtot = (float*)(smem + O_MISC);
  const int tok0 = b * SEQ + c * 64;
  const int d = lane;
  const float lb = p.lbs[l * 256 + hd * 64 + d];
  const bfu* pq = p.proj + (size_t)tok0 * PS + COL_AQ + hd * 64 + d;
  const bfu* pf = p.proj + (size_t)tok0 * PS + COL_AF + hd * 64 + d;
  const bfu* pv = p.proj + (size_t)tok0 * PS + COL_AI + hd * 64 + d;
  const int base = (b * NCH + c) * 4 + hd;
  const float* st = p.hg_state + (size_t)base * 4096;
  float bl[16], kk[16];
  float run = 0.f;
  const int r = lane & 15, q = lane >> 4;
  bfu fraw[16], vraw[16], qraw[16]; float sraw[16];
#pragma unroll
  for (int i = 0; i < 16; ++i) {
    const int t = w * 16 + i;
    fraw[i] = pf[(size_t)t * PS]; vraw[i] = pv[(size_t)t * PS]; qraw[i] = pq[(size_t)t * PS]; sraw[i] = st[(w + 4 * i) * 64 + d];
  }
  bfu gt[4][4]; float gw[4];
#pragma unroll
  for (int nt = 0; nt < 4; ++nt) {
    gw[nt] = p.hg_g[l * 256 + hd * 64 + nt * 16 + r];
#pragma unroll
    for (int j = 0; j < 4; ++j) gt[j][nt] = p.proj[(size_t)(tok0 + w * 16 + q * 4 + j) * PS + COL_AG + hd * 64 + nt * 16 + r];
  }
  __syncthreads();
#pragma unroll
  for (int i = 0; i < 16; ++i) {
    const int t = w * 16 + i;
    float lf, k; hg_gate(bf2f(fraw[i]), lb, lf, k);
    run += lf; bl[i] = run; kk[i] = k;
    Bt[d * 136 + t] = vraw[i];
    const int e = w + 4 * i;
    Bt[e * 136 + 64 + d] = f2bf(sraw[i]);
  }
  segtot[w * 64 + d] = run;
  __syncthreads();
  float off = 0.f;
#pragma unroll
  for (int s = 0; s < 4; ++s) { float v = segtot[s * 64 + d]; if (s < w) off += v; }
  const float bm = segtot[d] + segtot[64 + d];
#pragma unroll
  for (int i = 0; i < 16; ++i) {
    const int t = w * 16 + i;
    const float bt = bl[i] + off;
    const float qv = silu_(bf2f(qraw[i]));
    Qp[t * 72 + d] = f2bf(qv * fexp(fmaxf(bt - bm, -80.f)));
    Kp[t * 72 + d] = f2bf(kk[i] * fexp(fminf(bm - bt, 80.f)));
    A[t * 136 + 64 + d] = f2bf(qv * fexp(bt));
  }
  __syncthreads();
  f32x4 acc[4];
#pragma unroll
  for (int i = 0; i < 4; ++i) acc[i] = (f32x4){0.f, 0.f, 0.f, 0.f};
  wave_mma<4, 2>(acc, Qp + w * 16 * 72, 72, Kp, 72, lane);
#pragma unroll
  for (int nt = 0; nt < 4; ++nt)
#pragma unroll
    for (int j = 0; j < 4; ++j) {
      const int t = w * 16 + q * 4 + j, s = nt * 16 + r;
      A[t * 136 + s] = f2bf(s <= t ? acc[nt][j] : 0.f);
    }
  __syncthreads();
  f32x4 o[4];
#pragma unroll
  for (int i = 0; i < 4; ++i) o[i] = (f32x4){0.f, 0.f, 0.f, 0.f};
  wave_mma<4, 4>(o, A + w * 16 * 136, 136, Bt, 136, lane);
#pragma unroll
  for (int j = 0; j < 4; ++j) {
    float ss = 0.f;
#pragma unroll
    for (int nt = 0; nt < 4; ++nt) ss += o[nt][j] * o[nt][j];
    ss = group16_sum(ss);
    const float sc = rsqrtf(ss * (1.f / 64.f) + 1e-6f);
    const int t = w * 16 + q * 4 + j;
    bfu* mrow = p.mixed + (size_t)(tok0 + t) * 1024 + hd * 64;
#pragma unroll
    for (int nt = 0; nt < 4; ++nt) {
      const int e = nt * 16 + r;
      mrow[e] = f2bf(o[nt][j] * sc * gw[nt] * silu_(bf2f(gt[j][nt])));
    }
  }
}

DI void ml_gates(const Params& p, int l, int tok0, int hd, float* bs, float* igs, int tid) {
  if (tid < 64) {
    const bfu* row = p.proj + (size_t)(tok0 + tid) * PS;
    const float ig = bf2f(row[COL_BIG + hd]);
    const float fg = bf2f(row[COL_BFG + hd]) + p.ml_fb[l * 4 + hd];
    float lf = logsig_(fg);
#pragma unroll
    for (int o = 1; o < 64; o <<= 1) { float v = __shfl_up(lf, o); if (tid >= o) lf += v; }
    bs[tid] = lf; igs[tid] = ig;
  }
}

DI void ml_local(const Params& p, int l, int b, int c, int hd, unsigned char* smem) {
  const int tid = threadIdx.x, lane = tid & 63, w = tid >> 6;
  bfu* At = (bfu*)smem;
  bfu* Bt = At + 64 * 72;
  float* bs = (float*)(smem + 2 * 64 * 72 * 2);
  float* igs = bs + 64; float* nseg = igs + 64;
  const int tok0 = b * SEQ + c * 64;
  const int d = lane;
  const bfu* pk = p.proj + (size_t)tok0 * PS + COL_BK + hd * 64 + d;
  const bfu* pv = p.proj + (size_t)tok0 * PS + COL_BV + hd * 64 + d;
  bfu kraw[16], vraw[16];
#pragma unroll
  for (int i = 0; i < 16; ++i) { kraw[i] = pk[(size_t)(w * 16 + i) * PS]; vraw[i] = pv[(size_t)(w * 16 + i) * PS]; }
  __syncthreads();
  ml_gates(p, l, tok0, hd, bs, igs, tid);
  __syncthreads();
  const float blast = bs[63];
  float nacc = 0.f;
#pragma unroll
  for (int i = 0; i < 16; ++i) {
    const int s = w * 16 + i;
    const float ws = fexp(blast - bs[s] + igs[s]);
    const float kw = bf2f(kraw[i]) * 0.125f * ws;
    Bt[d * 72 + s] = f2bf(kw); nacc += kw;
    At[d * 72 + s] = vraw[i];
  }
  nseg[w * 64 + d] = nacc;
  __syncthreads();
  const int base = (b * NCH + c) * 4 + hd;
  if (w == 0) p.ml_n[base * 64 + d] = nseg[d] + nseg[64 + d] + nseg[128 + d] + nseg[192 + d];
  if (tid == 0) p.ml_decay[base] = fexp(blast);
  f32x4 acc[4];
#pragma unroll
  for (int i = 0; i < 4; ++i) acc[i] = (f32x4){0.f, 0.f, 0.f, 0.f};
  wave_mma<4, 2>(acc, At + w * 16 * 72, 72, Bt, 72, lane);
  float* st = p.ml_state + (size_t)base * 4096;
  const int r = lane & 15, q = lane >> 4;
#pragma unroll
  for (int nt = 0; nt < 4; ++nt)
#pragma unroll
    for (int j = 0; j < 4; ++j) st[(w * 16 + q * 4 + j) * 64 + nt * 16 + r] = acc[nt][j];
}

DI void ml_out(const Params& p, int l, int b, int c, int hd, unsigned char* smem) {
  const int tid = threadIdx.x, lane = tid & 63, w = tid >> 6;
  bfu* A = (bfu*)(smem + O_A); bfu* Bt = (bfu*)(smem + O_BT); bfu* Qp = (bfu*)(smem + O_QP); bfu* Kp = (bfu*)(smem + O_KP);
  float* bs = (float*)(smem + O_MISC); float* igs = bs + 64; float* npv = igs + 64; float* den2 = npv + 64;
  const int tok0 = b * SEQ + c * 64;
  const int d = lane;
  const int base = (b * NCH + c) * 4 + hd;
  const float* st = p.ml_state + (size_t)base * 4096;
  const int r = lane & 15, q = lane >> 4;
  const bfu* pq = p.proj + (size_t)tok0 * PS + COL_BQ + hd * 64 + d;
  const bfu* pk = p.proj + (size_t)tok0 * PS + COL_BK + hd * 64 + d;
  const bfu* pv = p.proj + (size_t)tok0 * PS + COL_BV + hd * 64 + d;
  bfu qraw[16], kraw[16], vraw[16]; float sraw[16];
#pragma unroll
  for (int i = 0; i < 16; ++i) {
    const int t = w * 16 + i;
    qraw[i] = pq[(size_t)t * PS]; kraw[i] = pk[(size_t)t * PS]; vraw[i] = pv[(size_t)t * PS]; sraw[i] = st[(w + 4 * i) * 64 + d];
  }
  bfu gt[4][4]; float gw[4];
#pragma unroll
  for (int nt = 0; nt < 4; ++nt) {
    gw[nt] = p.ml_g[l * 256 + hd * 64 + nt * 16 + r];
#pragma unroll
    for (int j = 0; j < 4; ++j) gt[j][nt] = p.proj[(size_t)(tok0 + w * 16 + q * 4 + j) * PS + COL_BG + hd * 64 + nt * 16 + r];
  }
  __syncthreads();
  ml_gates(p, l, tok0, hd, bs, igs, tid);
  if (tid >= 64 && tid < 128) npv[tid - 64] = p.ml_n[base * 64 + tid - 64];
  __syncthreads();
#pragma unroll
  for (int i = 0; i < 16; ++i) {
    const int t = w * 16 + i;
    Qp[t * 72 + d] = qraw[i];
    Kp[t * 72 + d] = kraw[i];
    A[t * 136 + 64 + d] = f2bf(bf2f(qraw[i]) * fexp(bs[t]));
    Bt[d * 136 + t] = vraw[i];
    const int e = w + 4 * i;
    Bt[e * 136 + 64 + d] = f2bf(sraw[i]);
  }
  __syncthreads();
  if (tid < 64) {
    float s = 0.f;
    for (int dd = 0; dd < 64; ++dd) s += bf2f(A[tid * 136 + 64 + dd]) * npv[dd];
    den2[tid] = s;
  }
  f32x4 acc[4];
#pragma unroll
  for (int i = 0; i < 4; ++i) acc[i] = (f32x4){0.f, 0.f, 0.f, 0.f};
  wave_mma<4, 2>(acc, Qp + w * 16 * 72, 72, Kp, 72, lane);
  float den1[4];
#pragma unroll
  for (int j = 0; j < 4; ++j) {
    const int t = w * 16 + q * 4 + j;
    const float bt = bs[t];
    float rs = 0.f;
#pragma unroll
    for (int nt = 0; nt < 4; ++nt) {
      const int s = nt * 16 + r;
      float wv = 0.f;
      if (s <= t) wv = fexp(bt - bs[s] + igs[s]) * acc[nt][j] * 0.125f;
      rs += wv;
      A[t * 136 + s] = f2bf(wv);
    }
    den1[j] = group16_sum(rs);
  }
  __syncthreads();
  f32x4 o[4];
#pragma unroll
  for (int i = 0; i < 4; ++i) o[i] = (f32x4){0.f, 0.f, 0.f, 0.f};
  wave_mma<4, 4>(o, A + w * 16 * 136, 136, Bt, 136, lane);
#pragma unroll
  for (int j = 0; j < 4; ++j) {
    const int t = w * 16 + q * 4 + j;
    const float den = den1[j] + den2[t];
    const float inv = frcp(fmaxf(fabsf(den), 1.f));
    float hv[4];
    float ss = 0.f;
#pragma unroll
    for (int nt = 0; nt < 4; ++nt) { hv[nt] = o[nt][j] * inv; ss += hv[nt] * hv[nt]; }
    ss = group16_sum(ss);
    const float sc = rsqrtf(ss * (1.f / 64.f) + 1e-6f);
    bfu* mrow = p.mixed + (size_t)(tok0 + t) * 1024 + 256 + hd * 64;
#pragma unroll
    for (int nt = 0; nt < 4; ++nt) {
      const int e = nt * 16 + r;
      mrow[e] = f2bf(hv[nt] * sc * gw[nt] * silu_(bf2f(gt[j][nt])));
    }
  }
}

template <bool FINAL>
DI void lru_item(const Params& p, int l, int b, int c, int n, unsigned char* smem) {
  const int tid = threadIdx.x, lane = tid & 63, w = tid >> 6;
  bfu* xcb = (bfu*)smem;
  float* xcf = (float*)(smem + 9216);
  float* af = (float*)(smem + 9216 + 17408);
  float* segH = (float*)(smem + 9216 + 2 * 17408);
  float* segA = segH + 256;
  const int tok0 = b * SEQ + c * 64;
  const int ch = n * 64 + lane;
  const int r = lane & 15, q = lane >> 4;
  bf16x8 wfa[2][4], wfx[2][4];
#pragma unroll
  for (int ks = 0; ks < 2; ++ks)
#pragma unroll
    for (int nt = 0; nt < 4; ++nt) {
      wfa[ks][nt] = *(const bf16x8*)(p.wt_a + (l * 4 + n) * 4096 + (nt * 16 + r) * 64 + ks * 32 + q * 8);
      wfx[ks][nt] = *(const bf16x8*)(p.wt_x + (l * 4 + n) * 4096 + (nt * 16 + r) * 64 + ks * 32 + q * 8);
    }
  float e_ba[4], e_bx[4], e_lam[4];
#pragma unroll
  for (int nt = 0; nt < 4; ++nt) {
    const int che = n * 64 + nt * 16 + r;
    e_ba[nt] = p.b_a[l * 256 + che]; e_bx[nt] = p.b_x[l * 256 + che]; e_lam[nt] = p.lam[l * 256 + che];
  }
  const int sidx = (b * NCH + c) * 256 + ch;
  float Hprev = 0.f;
  bfu gq[16];
  if (FINAL) {
    Hprev = p.lru_h[sidx];
    const bfu* pg0 = p.proj + (size_t)tok0 * PS + COL_CG + ch;
#pragma unroll
    for (int i = 0; i < 16; ++i) gq[i] = pg0[(size_t)(w * 16 + i) * PS];
  }
  __syncthreads();
  {
    const float cw0 = p.conv_w[(l * 4 + 0) * 256 + ch], cw1 = p.conv_w[(l * 4 + 1) * 256 + ch];
    const float cw2 = p.conv_w[(l * 4 + 2) * 256 + ch], cw3 = p.conv_w[(l * 4 + 3) * 256 + ch];
    const float cb = p.conv_b[l * 256 + ch];
    const bfu* px = p.proj + (size_t)tok0 * PS + COL_CX + ch;
#pragma unroll
    for (int i = 0; i < 16; ++i) {
      const int t = w * 16 + i;
      const int sp = c * 64 + t;
      float x0 = (sp >= 3) ? bf2f(px[(ptrdiff_t)(t - 3) * PS]) : 0.f;
      float x1 = (sp >= 2) ? bf2f(px[(ptrdiff_t)(t - 2) * PS]) : 0.f;
      float x2 = (sp >= 1) ? bf2f(px[(ptrdiff_t)(t - 1) * PS]) : 0.f;
      float x3 = bf2f(px[(ptrdiff_t)t * PS]);
      const float xc = cb + cw0 * x0 + cw1 * x1 + cw2 * x2 + cw3 * x3;
      xcf[t * 68 + lane] = xc;
      xcb[t * 72 + lane] = f2bf(xc);
    }
  }
  __syncthreads();
  f32x4 aa[4], ax[4];
#pragma unroll
  for (int i = 0; i < 4; ++i) { aa[i] = (f32x4){0.f, 0.f, 0.f, 0.f}; ax[i] = (f32x4){0.f, 0.f, 0.f, 0.f}; }
#pragma unroll
  for (int ks = 0; ks < 2; ++ks) {
    const bf16x8 afr = *(const bf16x8*)(xcb + (w * 16 + r) * 72 + ks * 32 + q * 8);
#pragma unroll
    for (int nt = 0; nt < 4; ++nt) {
      aa[nt] = __builtin_amdgcn_mfma_f32_16x16x32_bf16(afr, wfa[ks][nt], aa[nt], 0, 0, 0);
      ax[nt] = __builtin_amdgcn_mfma_f32_16x16x32_bf16(afr, wfx[ks][nt], ax[nt], 0, 0, 0);
    }
  }
#pragma unroll
  for (int nt = 0; nt < 4; ++nt) {
    const int e = nt * 16 + r;
    const float ba = e_ba[nt], bx = e_bx[nt];
    const float lsl = 8.f * logsig_acc(e_lam[nt]);
#pragma unroll
    for (int j = 0; j < 4; ++j) {
      const int t = w * 16 + q * 4 + j;
      const float rg = sigmoid_(aa[nt][j] + ba), ig = sigmoid_(ax[nt][j] + bx);
      const float la = lsl * rg;
      const float a = fexp(la);
      const float y2 = 2.f * la;
      const float em = (y2 > -0.05f) ? -y2 * (1.f + y2 * (0.5f + y2 * (0.16666667f + y2 * 0.041666668f))) : 1.f - a * a;
      const float bv = __builtin_amdgcn_sqrtf(fmaxf(em, 0.f)) * ig * xcf[t * 68 + e];
      af[t * 68 + e] = a; xcf[t * 68 + e] = bv;
    }
  }
  __syncthreads();
  float hl[16], al[16];
  float h = 0.f, ap = 1.f;
#pragma unroll
  for (int i = 0; i < 16; ++i) {
    const int t = w * 16 + i;
    const float a = af[t * 68 + lane], bv = xcf[t * 68 + lane];
    h = a * h + bv; ap *= a; hl[i] = h; al[i] = ap;
  }
  segH[w * 64 + lane] = h; segA[w * 64 + lane] = ap;
  __syncthreads();
  if (!FINAL) {
    if (w == 0) {
      float H = 0.f, Ap = 1.f;
#pragma unroll
      for (int s = 0; s < 4; ++s) { H = segA[s * 64 + lane] * H + segH[s * 64 + lane]; Ap *= segA[s * 64 + lane]; }
      p.lru_h[sidx] = H; p.lru_a[sidx] = Ap;
    }
  } else {
    float H = Hprev;
#pragma unroll
    for (int s = 0; s < 4; ++s) if (s < w) H = segA[s * 64 + lane] * H + segH[s * 64 + lane];
    bfu* pm = p.mixed + (size_t)tok0 * 1024 + 512 + ch;
#pragma unroll
    for (int i = 0; i < 16; ++i) {
      const int t = w * 16 + i;
      const float hv = hl[i] + al[i] * H;
      pm[(size_t)t * 1024] = f2bf(hv * silu_(bf2f(gq[i])));
    }
  }
}

template <bool FINAL>
DI void s5_item(const Params& p, int l, int b, int c, int g4, unsigned char* smem) {
  const int tid = threadIdx.x, lane = tid & 63, w = tid >> 6;
  const int g = g4 * 4 + w;
  float* buw = (float*)(smem + w * 13312);
  bfu* stw = (bfu*)(smem + w * 13312 + 8448);
  const int tok0 = b * SEQ + c * 64;
  const int r = lane & 15, q = lane >> 4;
  const int lg = l * 16 + g;
  bf16x8 bfr[8], yfr[4];
#pragma unroll
  for (int nt = 0; nt < 8; ++nt) bfr[nt] = *(const bf16x8*)(p.bt_bu + ((size_t)lg * 128 + nt * 16 + r) * 32 + q * 8);
  if (FINAL) {
#pragma unroll
    for (int ks = 0; ks < 4; ++ks) yfr[ks] = *(const bf16x8*)(p.bt_y + ((size_t)lg * 16 + r) * 128 + ks * 32 + q * 8);
  }
  const float ar = p.abar[(lg * 64 + lane) * 2], ai = p.abar[(lg * 64 + lane) * 2 + 1];
  const size_t sbase = ((size_t)(b * NCH + c) * 16 + g) * 128;
  float xr = 0.f, xi = 0.f;
  if (FINAL) { xr = p.s5_state[sbase + lane]; xi = p.s5_state[sbase + 64 + lane]; }
  const float dsk = FINAL ? p.s5_d[l * 256 + g * 16 + r] : 0.f;
  bf16x8 afr[4];
  bfu uq[4][4];
#pragma unroll
  for (int mt = 0; mt < 4; ++mt) {
    afr[mt] = (bf16x8){0, 0, 0, 0, 0, 0, 0, 0};
    if (q < 2) afr[mt] = *(const bf16x8*)(p.proj + (size_t)(tok0 + mt * 16 + r) * PS + COL_DU + g * 16 + q * 8);
    if (FINAL) {
#pragma unroll
      for (int j = 0; j < 4; ++j) uq[mt][j] = p.proj[(size_t)(tok0 + mt * 16 + q * 4 + j) * PS + COL_DU + g * 16 + r];
    }
  }
  __syncthreads();
#pragma unroll
  for (int mt = 0; mt < 4; ++mt) {
    const bf16x8 a = afr[mt];
#pragma unroll
    for (int nt = 0; nt < 8; ++nt) {
      f32x4 acc = (f32x4){0.f, 0.f, 0.f, 0.f};
      acc = __builtin_amdgcn_mfma_f32_16x16x32_bf16(a, bfr[nt], acc, 0, 0, 0);
#pragma unroll
      for (int j = 0; j < 4; ++j) buw[(q * 4 + j) * 132 + nt * 16 + r] = acc[j];
    }
    wave_sync();
    {
      float br[16], bi[16];
#pragma unroll
      for (int tt = 0; tt < 16; ++tt) { br[tt] = buw[tt * 132 + lane]; bi[tt] = buw[tt * 132 + 64 + lane]; }
#pragma unroll
      for (int tt = 0; tt < 16; ++tt) {
        const float nr = ar * xr - ai * xi + br[tt];
        const float ni = ar * xi + ai * xr + bi[tt];
        xr = nr; xi = ni;
        br[tt] = xr; bi[tt] = xi;
      }
      if (FINAL) {
#pragma unroll
        for (int tt = 0; tt < 16; ++tt) { stw[tt * 136 + lane] = f2bf(br[tt]); stw[tt * 136 + 64 + lane] = f2bf(bi[tt]); }
      }
    }
    wave_sync();
    if (FINAL) {
      f32x4 y = (f32x4){0.f, 0.f, 0.f, 0.f};
#pragma unroll
      for (int ks = 0; ks < 4; ++ks) {
        bf16x8 a2 = *(const bf16x8*)(stw + r * 136 + ks * 32 + q * 8);
        y = __builtin_amdgcn_mfma_f32_16x16x32_bf16(a2, yfr[ks], y, 0, 0, 0);
      }
#pragma unroll
      for (int j = 0; j < 4; ++j) {
        const int t = mt * 16 + q * 4 + j;
        const float z = gelu_tanh_(y[j] + dsk * bf2f(uq[mt][j]));
        p.zbuf[(size_t)(tok0 + t) * 256 + g * 16 + r] = f2bf(z);
      }
      wave_sync();
    }
  }
  if (!FINAL) { p.s5_state[sbase + lane] = xr; p.s5_state[sbase + 64 + lane] = xi; }
}

DI void s5_glu(const Params& p, int l, int b, int c, unsigned char* smem) {
  const int tid = threadIdx.x, lane = tid & 63, w = tid >> 6;
  bfu* zs = (bfu*)smem;
  const int tok0 = b * SEQ + c * 64;
  const int r = lane & 15, q = lane >> 4;
  __syncthreads();
#pragma unroll
  for (int i = 0; i < 8; ++i) {
    const int id = tid + i * 256;
    *(uint4*)(zs + (id >> 5) * 264 + (id & 31) * 8) = *(const uint4*)(p.zbuf + (size_t)(tok0 + (id >> 5)) * 256 + (id & 31) * 8);
  }
  __syncthreads();
  const bfu* wg = p.wt_glu + l * 65536;
#pragma unroll 1
  for (int nc = 0; nc < 4; ++nc) {
    bfu gq[4][4]; float bgv[4];
#pragma unroll
    for (int nt = 0; nt < 4; ++nt) {
      bgv[nt] = p.b_glu[l * 256 + nc * 64 + nt * 16 + r];
#pragma unroll
      for (int j = 0; j < 4; ++j) gq[nt][j] = p.proj[(size_t)(tok0 + w * 16 + q * 4 + j) * PS + COL_DG + nc * 64 + nt * 16 + r];
    }
    f32x4 acc[4];
#pragma unroll
    for (int i = 0; i < 4; ++i) acc[i] = (f32x4){0.f, 0.f, 0.f, 0.f};
#pragma unroll
    for (int kh = 0; kh < 2; ++kh) {
      bf16x8 bq[4][4];
#pragma unroll
      for (int ks = 0; ks < 4; ++ks)
#pragma unroll
        for (int nt = 0; nt < 4; ++nt) bq[ks][nt] = *(const bf16x8*)(wg + (nc * 64 + nt * 16 + r) * 256 + kh * 128 + ks * 32 + q * 8);
#pragma unroll
      for (int ks = 0; ks < 4; ++ks) {
        const bf16x8 a = *(const bf16x8*)(zs + (w * 16 + r) * 264 + kh * 128 + ks * 32 + q * 8);
#pragma unroll
        for (int nt = 0; nt < 4; ++nt) acc[nt] = __builtin_amdgcn_mfma_f32_16x16x32_bf16(a, bq[ks][nt], acc[nt], 0, 0, 0);
      }
    }
#pragma unroll
    for (int nt = 0; nt < 4; ++nt) {
      const int n = nc * 64 + nt * 16 + r;
#pragma unroll
      for (int j = 0; j < 4; ++j) {
        const int t = w * 16 + q * 4 + j;
        const float zv = bf2f(zs[t * 264 + n]);
        const float gate = silu_(bf2f(gq[nt][j]));
        p.mixed[(size_t)(tok0 + t) * 1024 + 768 + n] = f2bf(zv * sigmoid_(acc[nt][j] + bgv[nt]) * gate);
      }
    }
  }
}

#define QLOOP(QI, N, BODY)                                                                            \
  {                                                                                                   \
    unsigned* q_ctr = p.cnt + CNT_Q + (l * 8 + (QI)) * 32;                                            \
    unsigned q_nxt = blockIdx.x;                                                                      \
    for (;;) {                                                                                        \
      __syncthreads();                                                                                \
      if (threadIdx.x == 0) *s_q = q_nxt;                                                             \
      __syncthreads();                                                                                \
      const int item = (int)*s_q;                                                                     \
      if (item >= (N)) break;                                                                         \
      if (threadIdx.x == 0) q_nxt = gridDim.x + __hip_atomic_fetch_add(q_ctr, 1u, __ATOMIC_RELAXED, __HIP_MEMORY_SCOPE_AGENT); \
      BODY;                                                                                           \
    }                                                                                                 \
  }

DI void phase2(const Params& p, int l, unsigned char* smem) {
  unsigned* s_q = (unsigned*)(smem + SMEM_BYTES - 32);
  QLOOP(0, 1024, s5_item<false>(p, l, item >> 7, (item >> 2) & 31, item & 3, smem))
  QLOOP(1, 1024, hg_local(p, l, item >> 7, (item >> 2) & 31, item & 3, smem))
  QLOOP(2, 1024, ml_local(p, l, item >> 7, (item >> 2) & 31, item & 3, smem))
  QLOOP(3, 1024, lru_item<false>(p, l, item >> 7, (item >> 2) & 31, item & 3, smem))
}

DI void phase3(const Params& p, int l) {
  const int gtid = blockIdx.x * 256 + threadIdx.x, gsz = gridDim.x * 256;
  constexpr int N1 = 131072, N2 = 131072, N3 = 2048, N4 = 2048, N5 = 8192;
  for (int i = gtid; i < N1 + N2 + N3 + N4 + N5; i += gsz) {
    if (i < N1 + N2) {
      const bool ml = i >= N1;
      const int j = ml ? i - N1 : i;
      const int b = j >> 14, rem = j & 16383, hd = rem >> 12, ed = rem & 4095, d = ed & 63;
      float* stp = (ml ? p.ml_state : p.hg_state) + (size_t)(b * NCH * 4 + hd) * 4096 + ed;
      const float* dcp = ml ? (p.ml_decay + b * NCH * 4 + hd) : (p.hg_decay + (b * NCH * 4 + hd) * 64 + d);
      const int dstride = ml ? 4 : 256;
      float S = 0.f;
#pragma unroll
      for (int c0 = 0; c0 < NCH; c0 += 16) {
        float loc[16], dec[16];
#pragma unroll
        for (int c = 0; c < 16; ++c) { loc[c] = stp[(size_t)(c0 + c) * 16384]; dec[c] = dcp[(c0 + c) * dstride]; }
#pragma unroll
        for (int c = 0; c < 16; ++c) { stp[(size_t)(c0 + c) * 16384] = S; S = dec[c] * S + loc[c]; }
      }
    } else if (i < N1 + N2 + N3) {
      const int j = i - N1 - N2, b = j >> 8, rem = j & 255, hd = rem >> 6, d = rem & 63;
      float S = 0.f;
      for (int c = 0; c < NCH; ++c) {
        const int base = (b * NCH + c) * 4 + hd;
        const float dec = p.ml_decay[base];
        const float loc = p.ml_n[base * 64 + d];
        p.ml_n[base * 64 + d] = S; S = dec * S + loc;
      }
    } else if (i < N1 + N2 + N3 + N4) {
      const int j = i - N1 - N2 - N3, b = j >> 8, ch = j & 255;
      float H = 0.f;
      for (int c = 0; c < NCH; ++c) {
        const int idx = (b * NCH + c) * 256 + ch;
        const float a = p.lru_a[idx], hl = p.lru_h[idx];
        p.lru_h[idx] = H; H = a * H + hl;
      }
    } else {
      const int j = i - N1 - N2 - N3 - N4, b = j >> 10, g = (j >> 6) & 15, pp = j & 63;
      const float ar = p.abar64[((l * 16 + g) * 64 + pp) * 2], ai = p.abar64[((l * 16 + g) * 64 + pp) * 2 + 1];
      float xr = 0.f, xi = 0.f;
      for (int c = 0; c < NCH; ++c) {
        const size_t sb = ((size_t)(b * NCH + c) * 16 + g) * 128;
        const float lr = p.s5_state[sb + pp], li = p.s5_state[sb + 64 + pp];
        p.s5_state[sb + pp] = xr; p.s5_state[sb + 64 + pp] = xi;
        const float nr = ar * xr - ai * xi + lr, ni = ar * xi + ai * xr + li;
        xr = nr; xi = ni;
      }
    }
  }
}

DI void phase4(const Params& p, int l, unsigned char* smem, unsigned long long& tp_acc) {
  unsigned* s_flag = (unsigned*)(smem + SMEM_BYTES - 16);
  unsigned* s_q = (unsigned*)(smem + SMEM_BYTES - 32);
  TPS(41)
  QLOOP(4, 256, {
    _Pragma("unroll 1") for (int g4 = 0; g4 < 4; ++g4) s5_item<true>(p, l, item >> 5, item & 31, g4, smem);
    asm volatile("s_waitcnt vmcnt(0)" ::: "memory");
    s5_glu(p, l, item >> 5, item & 31, smem);
  })
  TPE(41)
  TPS(42)
  QLOOP(5, 1024, hg_out(p, l, item >> 7, (item >> 2) & 31, item & 3, smem))
  TPE(42)
  TPS(43)
  QLOOP(6, 1024, ml_out(p, l, item >> 7, (item >> 2) & 31, item & 3, smem))
  TPE(43)
  TPS(44)
  QLOOP(7, 1024, lru_item<true>(p, l, item >> 7, (item >> 2) & 31, item & 3, smem))
  TPE(44)
}

#ifdef TPROBE
#define TP_CLASS(PH) ((PH) == 0 ? 0 : (((PH) - 1) % 6) + 1)
#define TP_BEGIN(PH) unsigned long long tp_t0 = 0; if (TP_CLASS(PH) == TPROBE) tp_t0 = __builtin_amdgcn_s_memrealtime();
#define TP_END(PH) if (TP_CLASS(PH) == TPROBE) tp_acc += __builtin_amdgcn_s_memrealtime() - tp_t0;
#else
#define TP_BEGIN(PH)
#define TP_END(PH)
#endif
#define RUN_PHASE(PH, CALL)                                       \
  if (ph0 <= (PH) && (PH) < ph1) {                                \
    TP_BEGIN(PH)                                                  \
    CALL;                                                         \
    if (COOP) { if ((PH) + 1 < ph1) xcd_barrier(xb); }            \
    TP_END(PH)                                                    \
  }

template <bool COOP, int L>
DI void run_layer(const Params& p, int ph0, int ph1, unsigned char* smem, const XcdBarrier& xb, unsigned long long& tp_acc) {
#ifdef DUP1
  RUN_PHASE(1 + 6 * L, phase1(p, L, smem))
#endif
  RUN_PHASE(1 + 6 * L, phase1(p, L, smem))
#ifdef DUP2
  RUN_PHASE(2 + 6 * L, phase2(p, L, smem))
#endif
  RUN_PHASE(2 + 6 * L, phase2(p, L, smem))
  RUN_PHASE(3 + 6 * L, { phase3(p, L); if (L + 1 < DEPTH) convert_weights<(L + 1 < DEPTH ? L + 1 : 0)>(p, smem); })
#ifdef DUP4
  RUN_PHASE(4 + 6 * L, phase4(p, L, smem, tp_acc))
#endif
  RUN_PHASE(4 + 6 * L, phase4(p, L, smem, tp_acc))
  RUN_PHASE(5 + 6 * L, phase5(p, L, smem, tp_acc))
  RUN_PHASE(6 + 6 * L, phase6(p, L))
}

template <bool COOP>
__global__ void __launch_bounds__(256, 2) mk_fwd(Params p, int ph0, int ph1) {
  __shared__ __attribute__((aligned(16))) unsigned char smem[SMEM_BYTES];
  __shared__ uint4 xb_words;
  XcdBarrier xb; xb.bar = p.bar; xb.x = 0; xb.st = nullptr;
  if (COOP) {
    if (ph1 < 0) cg::this_grid().sync();
    if (threadIdx.x == 0) xb_words = make_uint4(0u, 0u, 0u, 0u);
    __syncthreads();
    xb = xcd_barrier_post(p.bar, (volatile LAS unsigned*)&xb_words);
  }
  unsigned long long tp_acc = 0;
  RUN_PHASE(0, phase0(p, smem))
  run_layer<COOP, 0>(p, ph0, ph1, smem, xb, tp_acc);
  run_layer<COOP, 1>(p, ph0, ph1, smem, xb, tp_acc);
  run_layer<COOP, 2>(p, ph0, ph1, smem, xb, tp_acc);
  run_layer<COOP, 3>(p, ph0, ph1, smem, xb, tp_acc);
#ifdef TPROBE
  if (blockIdx.x == 0 && threadIdx.x == 0) {
    const unsigned long long t0 = __builtin_amdgcn_s_memrealtime();
    while (__builtin_amdgcn_s_memrealtime() - t0 < tp_acc) __builtin_amdgcn_s_sleep(8);
  }
#endif
}

extern "C" void kernel_launch(void* const* d_in, const int* in_sizes, int n_in, void* d_out, int out_size, void* d_ws,
                              size_t ws_size, hipStream_t stream) {
  static int grid_blocks = 0;
  if (!grid_blocks) {
    int dev = 0, cus = 0, per_cu = 0;
    hipGetDevice(&dev);
    hipDeviceGetAttribute(&cus, hipDeviceAttributeMultiprocessorCount, dev);
    hipOccupancyMaxActiveBlocksPerMultiprocessor(&per_cu, mk_fwd<(MEGA != 0)>, 256, 0);
    if (per_cu < 1) per_cu = 1;
    if (per_cu > 2) per_cu = 2;
    grid_blocks = cus * per_cu;
  }
  Params p{};
  const float** pin = (const float**)&p;
  for (int i = 0; i < 28; ++i) pin[i] = (const float*)d_in[i];
  p.out = (float*)d_out;
  unsigned char* ws = (unsigned char*)d_ws;
  size_t off = 0;
  auto take = [&](size_t bytes) { unsigned char* r = ws + off; off += (bytes + 255) & ~(size_t)255; return r; };
  p.wt_in = (bfu*)take((size_t)4 * PS * 1024 * 2);
  p.wt_out = (bfu*)take((size_t)4 * 1024 * 1024 * 2);
  p.wt_a = (bfu*)take(16 * 4096 * 2);
  p.wt_x = (bfu*)take(16 * 4096 * 2);
  p.wt_glu = (bfu*)take(4 * 65536 * 2);
  p.bt_bu = (bfu*)take(64 * 128 * 32 * 2);
  p.bt_y = (bfu*)take(64 * 16 * 128 * 2);
  p.hb = (bfu*)take((size_t)NTOK * 1024 * 2);
  p.proj = (bfu*)take((size_t)NTOK * PS * 2);
  p.mixed = (bfu*)take((size_t)NTOK * 1024 * 2);
  p.zbuf = (bfu*)take((size_t)NTOK * 256 * 2);
  p.abar = (float*)take(4096 * 2 * 4);
  p.abar64 = (float*)take(4096 * 2 * 4);
  p.lbs = (float*)take(1024 * 4);
  p.hg_state = (float*)take((size_t)BATCH * NCH * 4 * 4096 * 4);
  p.hg_decay = (float*)take((size_t)BATCH * NCH * 4 * 64 * 4);
  p.ml_state = (float*)take((size_t)BATCH * NCH * 4 * 4096 * 4);
  p.ml_n = (float*)take((size_t)BATCH * NCH * 4 * 64 * 4);
  p.ml_decay = (float*)take((size_t)BATCH * NCH * 4 * 4);
  p.lru_h = (float*)take((size_t)BATCH * NCH * 256 * 4);
  p.lru_a = (float*)take((size_t)BATCH * NCH * 256 * 4);
  p.s5_state = (float*)take((size_t)BATCH * NCH * 16 * 128 * 4);
  p.cnt = (unsigned*)take(CNT_TOTAL * 4);
  p.bar = (unsigned*)take(XCD_BAR_WORDS * 4);
  if (off > ws_size) { fprintf(stderr, "workspace too small: need %zu have %zu\n", off, ws_size); return; }
  const int NPH = 1 + 6 * DEPTH;
#if MEGA
  (void)hipMemsetAsync(p.bar, 0, XCD_BAR_WORDS * 4, stream);
  int ph0 = 0, ph1 = NPH;
  void* args[] = {&p, &ph0, &ph1};
  hipError_t e = hipLaunchCooperativeKernel((void*)mk_fwd<true>, dim3(grid_blocks), dim3(256), args, 0, stream);
  if (e != hipSuccess) fprintf(stderr, "cooperative launch failed: %s (grid %d)\n", hipGetErrorString(e), grid_blocks);
#else
  for (int ph = 0; ph < NPH; ++ph) hipLaunchKernelGGL(mk_fwd<false>, dim3(grid_blocks), dim3(256), 0, stream, p, ph, ph + 1);
#endif
}
```

```cpp
#include <hip/hip_runtime.h>
#include <hip/hip_cooperative_groups.h>
#include <stdint.h>
#include <stdio.h>
namespace cg = cooperative_groups;

#ifndef MEGA
#define MEGA 1
#endif

typedef unsigned short bfu;
using bf16x8 = __attribute__((ext_vector_type(8))) short;
using f32x4  = __attribute__((ext_vector_type(4))) float;
#define DI __device__ __forceinline__

constexpr int BATCH = 8, SEQ = 2048, DM = 1024, DEPTH = 4, NTOK = BATCH * SEQ, NCH = SEQ / 64;
constexpr int DIN = 3080, PS = 3200;
constexpr int COL_AQ = 0, COL_AF = 256, COL_AI = 512, COL_AG = 768;
constexpr int COL_BQ = 1024, COL_BK = 1280, COL_BV = 1536, COL_BG = 1792, COL_BIG = 3072, COL_BFG = 3076;
constexpr int COL_CX = 2048, COL_CG = 2304, COL_DU = 2560, COL_DG = 2816;
constexpr float DN_ALPHA = 1.681792830507429f;
constexpr int SMEM_BYTES = 56 * 1024;
constexpr int CNT_LN = 0, CNT_GLU = 4 * 128, CNT_Q = 4 * 128 + 4 * 256, CNT_TOTAL = CNT_Q + 32 * 32;

struct Params {
  const float *x, *w_in, *b_in, *lb_logits, *hg_g, *ml_fb, *ml_g, *conv_w, *conv_b, *w_a, *b_a, *w_x, *b_x, *lam,
      *a_re, *a_im, *log_dt, *sb_re, *sb_im, *c_re, *c_im, *s5_d, *w_glu, *b_glu, *w_out, *b_out, *ln_g, *ln_b;
  float* out;
  bfu *wt_in, *wt_out, *wt_a, *wt_x, *wt_glu, *bt_bu, *bt_y, *hb, *proj, *mixed, *zbuf;
  float *abar, *abar64, *lbs, *hg_state, *hg_decay, *ml_state, *ml_n, *ml_decay, *lru_h, *lru_a, *s5_state;
  unsigned* cnt;
  unsigned* bar;
};

DI bfu f2bf(float x) { return __builtin_bit_cast(unsigned short, (__bf16)x); }
DI float bf2f(bfu h) { return __uint_as_float(((unsigned)h) << 16); }
typedef __bf16 bf16v2 __attribute__((ext_vector_type(2)));
typedef float f32v2 __attribute__((ext_vector_type(2)));
DI unsigned pack2(float a, float b) { f32v2 v = {a, b}; return __builtin_bit_cast(unsigned, __builtin_convertvector(v, bf16v2)); }
DI float fexp(float x) { return __expf(x); }
DI float frcp(float x) { return __builtin_amdgcn_rcpf(x); }
DI float flog(float x) { return __logf(x); }
DI float sigmoid_(float x) { return frcp(1.f + fexp(-x)); }
DI float silu_(float x) { return x * frcp(1.f + fexp(-x)); }
DI float logsig_(float x) { return fminf(x, 0.f) - flog(1.f + fexp(-fabsf(x))); }
DI float logsig_acc(float x) { return fminf(x, 0.f) - log1pf(expf(-fabsf(x))); }
DI float gelu_tanh_(float x) {
  float u = 0.7978845608028654f * (x + 0.044715f * x * x * x);
  float th = 1.f - 2.f * frcp(fexp(2.f * u) + 1.f);
  return 0.5f * x * (1.f + th);
}

template <int NT, int KS>
DI void wave_mma(f32x4 (&acc)[NT], const bfu* A, int lda, const bfu* Bt, int ldb, int lane) {
  const int r = lane & 15, q = lane >> 4;
#pragma unroll
  for (int ks = 0; ks < KS; ++ks) {
    bf16x8 a = *(const bf16x8*)(A + r * lda + ks * 32 + q * 8);
#pragma unroll
    for (int nt = 0; nt < NT; ++nt) {
      bf16x8 b = *(const bf16x8*)(Bt + (nt * 16 + r) * ldb + ks * 32 + q * 8);
      acc[nt] = __builtin_amdgcn_mfma_f32_16x16x32_bf16(a, b, acc[nt], 0, 0, 0);
    }
  }
}

DI void wave_sync() { __builtin_amdgcn_fence(__ATOMIC_SEQ_CST, "wavefront"); __builtin_amdgcn_wave_barrier(); __builtin_amdgcn_fence(__ATOMIC_SEQ_CST, "wavefront"); }
DI float group16_sum(float v) {
  v += __shfl_xor(v, 1); v += __shfl_xor(v, 2); v += __shfl_xor(v, 4); v += __shfl_xor(v, 8);
  return v;
}
DI float wave_sum(float v) {
  v += __shfl_xor(v, 1); v += __shfl_xor(v, 2); v += __shfl_xor(v, 4); v += __shfl_xor(v, 8);
  v += __shfl_xor(v, 16); v += __shfl_xor(v, 32);
  return v;
}

DI bool last_arriver(unsigned* ctr, unsigned total, unsigned* s_flag) {
  asm volatile("s_waitcnt vmcnt(0)" ::: "memory");
  __syncthreads();
  if (threadIdx.x == 0) {
    __builtin_amdgcn_fence(__ATOMIC_RELEASE, "agent");
    asm volatile("s_waitcnt vmcnt(0)" ::: "memory");
    const unsigned old = __hip_atomic_fetch_add(ctr, 1u, __ATOMIC_RELAXED, __HIP_MEMORY_SCOPE_AGENT);
    const unsigned last = (old == total - 1u) ? 1u : 0u;
    if (last) { __builtin_amdgcn_fence(__ATOMIC_ACQUIRE, "agent"); asm volatile("s_waitcnt vmcnt(0)" ::: "memory"); }
    *s_flag = last;
  }
  __syncthreads();
  return (*s_flag != 0u);
}

#ifdef TPROBE
#define TPS(ID) unsigned long long tps_##ID = 0; if (TPROBE == (ID)) tps_##ID = __builtin_amdgcn_s_memrealtime();
#define TPE(ID) if (TPROBE == (ID)) tp_acc += __builtin_amdgcn_s_memrealtime() - tps_##ID;
#else
#define TPS(ID)
#define TPE(ID)
#endif

#define XB_TMO      128
#define XB_XCNT(j)  (256  + 64 * (j))
#define XB_XSUB(j)  (1280 + 64 * (j))
#define XB_XGEN(j)  (2304 + 64 * (j))
#define XB_TOP      3328
#define XB_TOPGEN   3392
#define XCD_BAR_WORDS 3456
#define XB_SPIN_CAP (1u << 22)
#define LAS __attribute__((address_space(3)))
DI unsigned xb_ld(unsigned* p) { return __hip_atomic_load(p, __ATOMIC_RELAXED, __HIP_MEMORY_SCOPE_AGENT); }
DI unsigned xb_add(unsigned* p, unsigned v) { return __hip_atomic_fetch_add(p, v, __ATOMIC_RELAXED, __HIP_MEMORY_SCOPE_AGENT); }
DI unsigned xb_xcc_id() { return (unsigned)__builtin_amdgcn_s_getreg((3 << 11) | 20) & 0xFu; }
#define XB_SPIN(cond, bar) do { unsigned _sp = 0; while (cond) { __builtin_amdgcn_s_sleep(1); \
    if ((++_sp & 255u) == 0u) { if (xb_ld(&(bar)[XB_TMO])) break; if (_sp > XB_SPIN_CAP) { atomicAdd(&(bar)[XB_TMO], 1u); break; } } } } while (0)
struct XcdBarrier { unsigned* bar; unsigned x; volatile LAS unsigned* st; };
DI XcdBarrier xcd_barrier_post(unsigned* bar, volatile LAS unsigned* st) {
  XcdBarrier b; b.bar = bar; b.x = xb_xcc_id(); b.st = st;
  if (threadIdx.x == 0) (void)xb_add(&bar[XB_XCNT(b.x)], 1u);
  return b;
}
DI void xcd_barrier_complete(unsigned* bar, unsigned x, unsigned& nloc, unsigned& nx) {
  const unsigned G = gridDim.x * gridDim.y * gridDim.z;
  unsigned sum, cnt, mine, sp = 0u;
  for (;;) {
    sum = 0u; cnt = 0u; mine = 0u;
#pragma unroll
    for (unsigned j = 0; j < 16; ++j) { const unsigned c = xb_ld(&bar[XB_XCNT(j)]); sum += c; cnt += (c > 0u) ? 1u : 0u; mine = (j == x) ? c : mine; }
    if (sum == G) break;
    __builtin_amdgcn_s_sleep(1);
    if ((++sp & 255u) == 0u) { if (xb_ld(&bar[XB_TMO])) break; if (sp > XB_SPIN_CAP) { atomicAdd(&bar[XB_TMO], 1u); break; } }
  }
  nloc = mine > 0u ? mine : 1u; nx = cnt > 0u ? cnt : 1u;
}
DI void xcd_barrier(const XcdBarrier& b) {
  asm volatile("s_waitcnt vmcnt(0)" ::: "memory");
  __syncthreads();
  if (threadIdx.x == 0) {
    unsigned* bar = b.bar;
    __builtin_amdgcn_s_waitcnt(0);
    unsigned nloc = b.st[0], nx = b.st[1];
    if (nloc == 0u) { xcd_barrier_complete(bar, b.x, nloc, nx); b.st[0] = nloc; b.st[1] = nx; }
    const unsigned old = xb_add(&bar[XB_XSUB(b.x)], 1u);
    const unsigned gen = old / nloc;
    if (old + 1u == (gen + 1u) * nloc) {
      __builtin_amdgcn_fence(__ATOMIC_RELEASE, "agent");
      asm volatile("s_waitcnt vmcnt(0)" ::: "memory");
      const unsigned og = xb_add(&bar[XB_TOP], 1u);
      const unsigned tg = og / nx;
      if (og + 1u == (tg + 1u) * nx) xb_add(&bar[XB_TOPGEN], 1u);
      else XB_SPIN(xb_ld(&bar[XB_TOPGEN]) == tg, bar);
      __builtin_amdgcn_fence(__ATOMIC_ACQUIRE, "agent");
      xb_add(&bar[XB_XGEN(b.x)], 1u);
      asm volatile("s_waitcnt vmcnt(0)" ::: "memory");
    } else {
      XB_SPIN(xb_ld(&bar[XB_XGEN(b.x)]) == gen, bar);
      __builtin_amdgcn_fence(__ATOMIC_ACQUIRE, "agent");
      asm volatile("s_waitcnt vmcnt(0)" ::: "memory");
    }
  }
  __syncthreads();
}

DI void transpose_tile(const float* src, int sld, int cv, bfu* dst, int dld, float* tile) {
  const int tid = threadIdx.x;
  __syncthreads();
  for (int i = tid; i < 4096; i += 256) {
    int r = i >> 6, c = i & 63;
    tile[r * 65 + c] = (c < cv) ? src[(size_t)r * sld + c] : 0.f;
  }
  __syncthreads();
  for (int i = tid; i < 4096; i += 256) {
    int n = i >> 6, k = i & 63;
    dst[(size_t)n * dld + k] = f2bf(tile[k * 65 + n]);
  }
}

template <int LSEL>
DI void convert_weights(const Params& p, unsigned char* smem) {
  const int tid = threadIdx.x;
  float* tile = (float*)smem;
  const int NJ = 3200 + 1024 + 16 + 16 + 64;
  for (int job = blockIdx.x; job < NJ; job += gridDim.x) {
    const float* src; int sld, cv = 64, dld; bfu* dst;
    if (job < 3200) {
      int l = job / 800, rem = job % 800, kt = rem / 50, nt = rem % 50;
      if (l != LSEL) continue;
      const int c0 = nt < 28 ? nt * 64 : (nt < 48 ? nt * 64 + 8 : 1792);
      src = p.w_in + (size_t)l * 1024 * DIN + (size_t)kt * 64 * DIN + c0; sld = DIN;
      cv = nt < 48 ? 64 : (nt == 48 ? 8 : 0);
      dst = p.wt_in + (size_t)l * PS * 1024 + (size_t)nt * 64 * 1024 + kt * 64; dld = 1024;
    } else if (job < 4224) {
      int j = job - 3200, l = j / 256, rem = j % 256, kt = rem / 16, nt = rem % 16;
      if (l != LSEL) continue;
      src = p.w_out + (size_t)l * 1048576 + (size_t)kt * 64 * 1024 + nt * 64; sld = 1024;
      dst = p.wt_out + (size_t)l * 1048576 + (size_t)nt * 64 * 1024 + kt * 64; dld = 1024;
    } else if (LSEL != 0) {
      continue;
    } else if (job < 4240) {
      int j = job - 4224; src = p.w_a + j * 4096; sld = 64; dst = p.wt_a + j * 4096; dld = 64;
    } else if (job < 4256) {
      int j = job - 4240; src = p.w_x + j * 4096; sld = 64; dst = p.wt_x + j * 4096; dld = 64;
    } else {
      int j = job - 4256, l = j / 16, rem = j % 16, kt = rem / 4, nt = rem % 4;
      src = p.w_glu + l * 65536 + kt * 64 * 256 + nt * 64; sld = 256;
      dst = p.wt_glu + l * 65536 + nt * 64 * 256 + kt * 64; dld = 256;
    }
    transpose_tile(src, sld, cv, dst, dld, tile);
  }
}

DI void phase0(const Params& p, unsigned char* smem) {
  const int tid = threadIdx.x;
  const int gtid = blockIdx.x * 256 + tid, gsz = gridDim.x * 256;
  for (int i = gtid; i < NTOK * DM / 8; i += gsz) {
    float4 a = ((const float4*)p.x)[2 * i], b = ((const float4*)p.x)[2 * i + 1];
    uint4 o; o.x = pack2(a.x, a.y); o.y = pack2(a.z, a.w); o.z = pack2(b.x, b.y); o.w = pack2(b.z, b.w);
    ((uint4*)p.hb)[i] = o;
  }
  convert_weights<0>(p, smem);
  for (int i = gtid; i < 4096; i += gsz) {
    int lg = i >> 6, pp = i & 63;
    double dt = exp((double)p.log_dt[lg]);
    double are = p.a_re[lg * 64 + pp], aim = p.a_im[lg * 64 + pp];
    double mag = exp(dt * are), ang = dt * aim;
    double abr = mag * cos(ang), abi = mag * sin(ang);
    double den = are * are + aim * aim;
    double xr = abr - 1.0, xi = abi;
    double zr = (xr * are + xi * aim) / den, zi = (xi * are - xr * aim) / den;
    bfu* o_re = p.bt_bu + ((size_t)lg * 128 + pp) * 32;
    bfu* o_im = p.bt_bu + ((size_t)lg * 128 + 64 + pp) * 32;
    for (int h = 0; h < 16; ++h) {
      double br = p.sb_re[(lg * 64 + pp) * 16 + h], bi = p.sb_im[(lg * 64 + pp) * 16 + h];
      o_re[h] = f2bf((float)(zr * br - zi * bi));
      o_im[h] = f2bf((float)(zr * bi + zi * br));
      o_re[16 + h] = 0; o_im[16 + h] = 0;
    }
    p.abar[(lg * 64 + pp) * 2 + 0] = (float)abr; p.abar[(lg * 64 + pp) * 2 + 1] = (float)abi;
    double mag64 = exp(64.0 * dt * are), ang64 = 64.0 * ang;
    p.abar64[(lg * 64 + pp) * 2 + 0] = (float)(mag64 * cos(ang64));
    p.abar64[(lg * 64 + pp) * 2 + 1] = (float)(mag64 * sin(ang64));
  }
  for (int i = gtid; i < 4 * 16 * 16 * 128; i += gsz) {
    int k = i & 127, lgn = i >> 7;
    p.bt_y[i] = (k < 64) ? f2bf(p.c_re[lgn * 64 + k]) : f2bf(-p.c_im[lgn * 64 + (k - 64)]);
  }
  for (int i = gtid; i < 256; i += gsz) {
    float v0 = p.lb_logits[i], v1 = p.lb_logits[256 + i], v2 = p.lb_logits[512 + i], v3 = p.lb_logits[768 + i];
    float m = fmaxf(fmaxf(v0, v1), fmaxf(v2, v3));
    float e0 = expf(v0 - m), e1 = expf(v1 - m), e2 = expf(v2 - m), e3 = expf(v3 - m);
    float s = e0 + e1 + e2 + e3;
    p.lbs[i] = 0.f; p.lbs[256 + i] = e1 / s; p.lbs[512 + i] = (e1 + e2) / s; p.lbs[768 + i] = (e1 + e2 + e3) / s;
  }
  for (int i = gtid; i < CNT_TOTAL; i += gsz) p.cnt[i] = 0u;
}

DI void gemm1_tile(const Params& p, int l, const bfu* A, const bfu* Bt, int m0, int n0, unsigned char* smem) {
  bfu* sA = (bfu*)smem; bfu* sB = sA + 128 * 72;
  bfu* sC = (bfu*)smem;
  const int tid = threadIdx.x, lane = tid & 63, w = tid >> 6, wm = w >> 1, wn = w & 1;
  const int r = lane & 15, q = lane >> 4;
  f32x4 acc[4][6];
#pragma unroll
  for (int i = 0; i < 4; ++i)
#pragma unroll
    for (int j = 0; j < 6; ++j) acc[i][j] = (f32x4){0.f, 0.f, 0.f, 0.f};
  const int lrow = tid >> 3, lkc = tid & 7;
  const bfu* ga = A + (size_t)(m0 + lrow) * 1024 + lkc * 8;
  const bfu* gb = Bt + (size_t)(n0 + lrow) * 1024 + lkc * 8;
  uint4 ra0 = *(const uint4*)(ga), ra1 = *(const uint4*)(ga + 32 * 1024), ra2 = *(const uint4*)(ga + 64 * 1024), ra3 = *(const uint4*)(ga + 96 * 1024);
  uint4 rb0 = *(const uint4*)(gb), rb1 = *(const uint4*)(gb + 32 * 1024), rb2 = *(const uint4*)(gb + 64 * 1024), rb3 = *(const uint4*)(gb + 96 * 1024);
  uint4 rb4 = *(const uint4*)(gb + 128 * 1024), rb5 = *(const uint4*)(gb + 160 * 1024);
  bfu* wa = sA + lrow * 72 + lkc * 8;
  bfu* wb = sB + lrow * 72 + lkc * 8;
  for (int kt = 0; kt < 16; ++kt) {
    __syncthreads();
    *(uint4*)(wa) = ra0; *(uint4*)(wa + 32 * 72) = ra1; *(uint4*)(wa + 64 * 72) = ra2; *(uint4*)(wa + 96 * 72) = ra3;
    *(uint4*)(wb) = rb0; *(uint4*)(wb + 32 * 72) = rb1; *(uint4*)(wb + 64 * 72) = rb2; *(uint4*)(wb + 96 * 72) = rb3;
    *(uint4*)(wb + 128 * 72) = rb4; *(uint4*)(wb + 160 * 72) = rb5;
    __syncthreads();
    if (kt + 1 < 16) {
      const bfu* ga2 = ga + (kt + 1) * 64; const bfu* gb2 = gb + (kt + 1) * 64;
      ra0 = *(const uint4*)(ga2); ra1 = *(const uint4*)(ga2 + 32 * 1024); ra2 = *(const uint4*)(ga2 + 64 * 1024); ra3 = *(const uint4*)(ga2 + 96 * 1024);
      rb0 = *(const uint4*)(gb2); rb1 = *(const uint4*)(gb2 + 32 * 1024); rb2 = *(const uint4*)(gb2 + 64 * 1024); rb3 = *(const uint4*)(gb2 + 96 * 1024);
      rb4 = *(const uint4*)(gb2 + 128 * 1024); rb5 = *(const uint4*)(gb2 + 160 * 1024);
    }
#pragma unroll
    for (int ks = 0; ks < 2; ++ks) {
      bf16x8 af[4], bfr[6];
#pragma unroll
      for (int mt = 0; mt < 4; ++mt) af[mt] = *(const bf16x8*)(sA + (wm * 64 + mt * 16 + r) * 72 + ks * 32 + q * 8);
#pragma unroll
      for (int nt = 0; nt < 6; ++nt) bfr[nt] = *(const bf16x8*)(sB + (wn * 96 + nt * 16 + r) * 72 + ks * 32 + q * 8);
#pragma unroll
      for (int mt = 0; mt < 4; ++mt)
#pragma unroll
        for (int nt = 0; nt < 6; ++nt) acc[mt][nt] = __builtin_amdgcn_mfma_f32_16x16x32_bf16(af[mt], bfr[nt], acc[mt][nt], 0, 0, 0);
    }
  }
  float bias[6];
#pragma unroll
  for (int nt = 0; nt < 6; ++nt) {
    const int col = n0 + wn * 96 + nt * 16 + r;
    bias[nt] = p.b_in[l * DIN + (col < 1792 ? col : col + 8)];
  }
  __syncthreads();
#pragma unroll
  for (int mt = 0; mt < 4; ++mt)
#pragma unroll
    for (int nt = 0; nt < 6; ++nt)
#pragma unroll
      for (int j = 0; j < 4; ++j)
        sC[(wm * 64 + mt * 16 + q * 4 + j) * 200 + wn * 96 + nt * 16 + r] = f2bf(acc[mt][nt][j] + bias[nt]);
  __syncthreads();
#pragma unroll
  for (int i = 0; i < 12; ++i) {
    const int id = tid + i * 256, row = id / 24, ch = id % 24;
    *(uint4*)(p.proj + (size_t)(m0 + row) * PS + n0 + ch * 8) = *(const uint4*)(sC + row * 200 + ch * 8);
  }
}

DI void gemm1_gates(const Params& p, int l, const bfu* A, const bfu* Bt, int m0) {
  const int tid = threadIdx.x, lane = tid & 63, w = tid >> 6, r = lane & 15, q = lane >> 4;
  const bfu* a0 = A + (size_t)(m0 + w * 32 + r) * 1024 + q * 8;
  const bfu* a1 = a0 + 16 * 1024;
  const bfu* bp = Bt + (size_t)(3072 + r) * 1024 + q * 8;
  f32x4 c0 = (f32x4){0.f, 0.f, 0.f, 0.f}, c1 = (f32x4){0.f, 0.f, 0.f, 0.f};
#pragma unroll 4
  for (int ks = 0; ks < 32; ++ks) {
    const bf16x8 b = *(const bf16x8*)(bp + ks * 32);
    const bf16x8 x0 = *(const bf16x8*)(a0 + ks * 32);
    const bf16x8 x1 = *(const bf16x8*)(a1 + ks * 32);
    c0 = __builtin_amdgcn_mfma_f32_16x16x32_bf16(x0, b, c0, 0, 0, 0);
    c1 = __builtin_amdgcn_mfma_f32_16x16x32_bf16(x1, b, c1, 0, 0, 0);
  }
  if (r < 8) {
    const float bias = p.b_in[l * DIN + 1792 + r];
#pragma unroll
    for (int j = 0; j < 4; ++j) {
      p.proj[(size_t)(m0 + w * 32 + q * 4 + j) * PS + 3072 + r] = f2bf(c0[j] + bias);
      p.proj[(size_t)(m0 + w * 32 + 16 + q * 4 + j) * PS + 3072 + r] = f2bf(c1[j] + bias);
    }
  }
}

DI void phase1(const Params& p, int l, unsigned char* smem) {
  const bfu* Bt = p.wt_in + (size_t)l * PS * 1024;
  for (int tile = blockIdx.x; tile < 128 * 16; tile += gridDim.x) { const int mt = tile >> 4, nt = tile & 15; gemm1_tile(p, l, p.hb, Bt, mt * 128, nt * 192, smem); }
  for (int job = blockIdx.x; job < 128; job += gridDim.x) gemm1_gates(p, l, p.hb, Bt, job * 128);
}

template <int EPI>
DI void gemm2_tile(const Params& p, int l, const bfu* A, const bfu* Bt, int m0, int n0, const float* hin, unsigned char* smem) {
  bfu* sA = (bfu*)smem; bfu* sB = sA + 128 * 72;
  const int tid = threadIdx.x, lane = tid & 63, w = tid >> 6, wm = w >> 1, wn = w & 1;
  const int r = lane & 15, q = lane >> 4;
  f32x4 acc[4][4];
#pragma unroll
  for (int i = 0; i < 4; ++i)
#pragma unroll
    for (int j = 0; j < 4; ++j) acc[i][j] = (f32x4){0.f, 0.f, 0.f, 0.f};
  const int lrow = tid >> 3, lkc = tid & 7;
  const bfu* ga = A + (size_t)(m0 + lrow) * 1024 + lkc * 8;
  const bfu* gb = Bt + (size_t)(n0 + lrow) * 1024 + lkc * 8;
  uint4 ra0 = *(const uint4*)(ga), ra1 = *(const uint4*)(ga + 32 * 1024), ra2 = *(const uint4*)(ga + 64 * 1024), ra3 = *(const uint4*)(ga + 96 * 1024);
  uint4 rb0 = *(const uint4*)(gb), rb1 = *(const uint4*)(gb + 32 * 1024), rb2 = *(const uint4*)(gb + 64 * 1024), rb3 = *(const uint4*)(gb + 96 * 1024);
  bfu* wa = sA + lrow * 72 + lkc * 8;
  bfu* wb = sB + lrow * 72 + lkc * 8;
  for (int kt = 0; kt < 16; ++kt) {
    __syncthreads();
    *(uint4*)(wa) = ra0; *(uint4*)(wa + 32 * 72) = ra1; *(uint4*)(wa + 64 * 72) = ra2; *(uint4*)(wa + 96 * 72) = ra3;
    *(uint4*)(wb) = rb0; *(uint4*)(wb + 32 * 72) = rb1; *(uint4*)(wb + 64 * 72) = rb2; *(uint4*)(wb + 96 * 72) = rb3;
    __syncthreads();
    if (kt + 1 < 16) {
      const bfu* ga2 = ga + (kt + 1) * 64; const bfu* gb2 = gb + (kt + 1) * 64;
      ra0 = *(const uint4*)(ga2); ra1 = *(const uint4*)(ga2 + 32 * 1024); ra2 = *(const uint4*)(ga2 + 64 * 1024); ra3 = *(const uint4*)(ga2 + 96 * 1024);
      rb0 = *(const uint4*)(gb2); rb1 = *(const uint4*)(gb2 + 32 * 1024); rb2 = *(const uint4*)(gb2 + 64 * 1024); rb3 = *(const uint4*)(gb2 + 96 * 1024);
    }
#pragma unroll
    for (int ks = 0; ks < 2; ++ks) {
      bf16x8 af[4], bfr[4];
#pragma unroll
      for (int mt = 0; mt < 4; ++mt) af[mt] = *(const bf16x8*)(sA + (wm * 64 + mt * 16 + r) * 72 + ks * 32 + q * 8);
#pragma unroll
      for (int nt = 0; nt < 4; ++nt) bfr[nt] = *(const bf16x8*)(sB + (wn * 64 + nt * 16 + r) * 72 + ks * 32 + q * 8);
#pragma unroll
      for (int mt = 0; mt < 4; ++mt)
#pragma unroll
        for (int nt = 0; nt < 4; ++nt) acc[mt][nt] = __builtin_amdgcn_mfma_f32_16x16x32_bf16(af[mt], bfr[nt], acc[mt][nt], 0, 0, 0);
    }
  }
#pragma unroll
  for (int nt = 0; nt < 4; ++nt) {
    const int col = n0 + wn * 64 + nt * 16 + r;
    if (EPI == 1) {
      const float bias = (col < DIN) ? p.b_in[l * DIN + col] : 0.f;
#pragma unroll
      for (int mt = 0; mt < 4; ++mt)
#pragma unroll
        for (int j = 0; j < 4; ++j) {
          const int row = m0 + wm * 64 + mt * 16 + q * 4 + j;
          p.proj[(size_t)row * PS + col] = f2bf(acc[mt][nt][j] + bias);
        }
    } else {
      const float bias = p.b_out[l * 1024 + col];
      float hv[4][4];
#pragma unroll
      for (int mt = 0; mt < 4; ++mt)
#pragma unroll
        for (int j = 0; j < 4; ++j) hv[mt][j] = hin[(size_t)(m0 + wm * 64 + mt * 16 + q * 4 + j) * 1024 + col];
#pragma unroll
      for (int mt = 0; mt < 4; ++mt)
#pragma unroll
        for (int j = 0; j < 4; ++j) {
          const int row = m0 + wm * 64 + mt * 16 + q * 4 + j;
          p.out[(size_t)row * 1024 + col] = DN_ALPHA * hv[mt][j] + acc[mt][nt][j] + bias;
        }
    }
  }
}


DI void phase5(const Params& p, int l, unsigned char* smem, unsigned long long& tp_acc) {
  const bfu* Bt = p.wt_out + (size_t)l * 1048576;
  const float* hin = (l == 0) ? p.x : p.out;
  for (int tile = blockIdx.x; tile < 128 * 8; tile += gridDim.x) gemm2_tile<2>(p, l, p.mixed, Bt, (tile >> 3) * 128, (tile & 7) * 128, hin, smem);
}

DI void phase6(const Params& p, int l) {
  const int tid = threadIdx.x, lane = tid & 63, w = tid >> 6;
  float4 g[4], bb[4];
#pragma unroll
  for (int i = 0; i < 4; ++i) { g[i] = *(const float4*)(p.ln_g + l * 1024 + i * 256 + lane * 4); bb[i] = *(const float4*)(p.ln_b + l * 1024 + i * 256 + lane * 4); }
  for (int rb = blockIdx.x; rb < NTOK / 16; rb += gridDim.x) {
    const int row0 = rb * 16 + w * 4;
    float4 v[4][4];
#pragma unroll
    for (int rr = 0; rr < 4; ++rr)
#pragma unroll
      for (int i = 0; i < 4; ++i) v[rr][i] = *(const float4*)(p.out + (size_t)(row0 + rr) * 1024 + i * 256 + lane * 4);
#pragma unroll
    for (int rr = 0; rr < 4; ++rr) {
      float sm = 0.f;
#pragma unroll
      for (int i = 0; i < 4; ++i) sm += v[rr][i].x + v[rr][i].y + v[rr][i].z + v[rr][i].w;
      const float mu = wave_sum(sm) * (1.f / 1024.f);
      float ss = 0.f;
#pragma unroll
      for (int i = 0; i < 4; ++i) {
        v[rr][i].x -= mu; v[rr][i].y -= mu; v[rr][i].z -= mu; v[rr][i].w -= mu;
        ss += v[rr][i].x * v[rr][i].x + v[rr][i].y * v[rr][i].y + v[rr][i].z * v[rr][i].z + v[rr][i].w * v[rr][i].w;
      }
      const float rs = rsqrtf(wave_sum(ss) * (1.f / 1024.f) + 1e-5f);
#pragma unroll
      for (int i = 0; i < 4; ++i) {
        const int c = i * 256 + lane * 4;
        float4 o;
        o.x = v[rr][i].x * rs * g[i].x + bb[i].x; o.y = v[rr][i].y * rs * g[i].y + bb[i].y;
        o.z = v[rr][i].z * rs * g[i].z + bb[i].z; o.w = v[rr][i].w * rs * g[i].w + bb[i].w;
        *(float4*)(p.out + (size_t)(row0 + rr) * 1024 + c) = o;
        uint2 ob; ob.x = pack2(o.x, o.y); ob.y = pack2(o.z, o.w);
        *(uint2*)(p.hb + (size_t)(row0 + rr) * 1024 + c) = ob;
      }
    }
  }
}

DI void hg_gate(float x, float lb, float& lf, float& k) {
  x = fmaxf(x, -80.f);
  const float E = fexp(-x);
  const float sg = frcp(1.f + E);
  k = (1.f - lb) * (E * sg);
  lf = flog(lb + (1.f - lb) * sg);
}

DI void hg_local(const Params& p, int l, int b, int c, int hd, unsigned char* smem) {
  const int tid = threadIdx.x, lane = tid & 63, w = tid >> 6;
  bfu* At = (bfu*)smem;
  bfu* Bt = At + 64 * 72;
  float* segtot = (float*)(smem + 2 * 64 * 72 * 2);
  const int tok0 = b * SEQ + c * 64;
  const int d = lane;
  const float lb = p.lbs[l * 256 + hd * 64 + d];
  const bfu* pf = p.proj + (size_t)tok0 * PS + COL_AF + hd * 64 + d;
  const bfu* pv = p.proj + (size_t)tok0 * PS + COL_AI + hd * 64 + d;
  float bl[16], kk[16];
  float run = 0.f;
  __syncthreads();
#pragma unroll
  for (int i = 0; i < 16; ++i) {
    const int t = w * 16 + i;
    float lf, k; hg_gate(bf2f(pf[(size_t)t * PS]), lb, lf, k);
    run += lf; bl[i] = run; kk[i] = k;
    At[d * 72 + t] = pv[(size_t)t * PS];
  }
  segtot[w * 64 + d] = run;
  __syncthreads();
  float off = 0.f, tot = 0.f;
#pragma unroll
  for (int s = 0; s < 4; ++s) { float v = segtot[s * 64 + d]; tot += v; if (s < w) off += v; }
#pragma unroll
  for (int i = 0; i < 16; ++i) { const int t = w * 16 + i; Bt[d * 72 + t] = f2bf(kk[i] * fexp(tot - (bl[i] + off))); }
  const int base = (b * NCH + c) * 4 + hd;
  if (w == 0) p.hg_decay[base * 64 + d] = fexp(tot);
  __syncthreads();
  f32x4 acc[4];
#pragma unroll
  for (int i = 0; i < 4; ++i) acc[i] = (f32x4){0.f, 0.f, 0.f, 0.f};
  wave_mma<4, 2>(acc, At + w * 16 * 72, 72, Bt, 72, lane);
  float* st = p.hg_state + (size_t)base * 4096;
  const int r = lane & 15, q = lane >> 4;
#pragma unroll
  for (int nt = 0; nt < 4; ++nt)
#pragma unroll
    for (int j = 0; j < 4; ++j) st[(w * 16 + q * 4 + j) * 64 + nt * 16 + r] = acc[nt][j];
}

constexpr int O_A = 0, O_BT = 17408, O_QP = 34816, O_KP = 44032, O_MISC = 53248;

DI void hg_out(const Params& p, int l, int b, int c, int hd, unsigned char* smem) {
  const int tid = threadIdx.x, lane = tid & 63, w = tid >> 6;
  bfu* A = (bfu*)(smem + O_A); bfu* Bt = (bfu*)(smem + O_BT); bfu* Qp = (bfu*)(smem + O_QP); bfu* Kp = (bfu*)(smem + O_KP);
  float* segtot = (float*)(smem + O_MISC);
  const int tok0 = b * SEQ + c * 64;
  const int d = lane;
  const float lb = p.lbs[l * 256 + hd * 64 + d];
  const bfu* pq = p.proj + (size_t)tok0 * PS + COL_AQ + hd * 64 + d;
  const bfu* pf = p.proj + (size_t)tok0 * PS + COL_AF + hd * 64 + d;
  const bfu* pv = p.proj + (size_t)tok0 * PS + COL_AI + hd * 64 + d;
  const int base = (b * NCH + c) * 4 + hd;
  const float* st = p.hg_state + (size_t)base * 4096;
  float bl[16], kk[16];
  float run = 0.f;
  const int r = lane & 15, q = lane >> 4;
  bfu fraw[16], vraw[16], qraw[16]; float sraw[16];
#pragma unroll
  for (int i = 0; i < 16; ++i) {
    const int t = w * 16 + i;
    fraw[i] = pf[(size_t)t * PS]; vraw[i] = pv[(size_t)t * PS]; qraw[i] = pq[(size_t)t * PS]; sraw[i] = st[(w + 4 * i) * 64 + d];
  }
  bfu gt[4][4]; float gw[4];
#pragma unroll
  for (int nt = 0; nt < 4; ++nt) {
    gw[nt] = p.hg_g[l * 256 + hd * 64 + nt * 16 + r];
#pragma unroll
    for (int j = 0; j < 4; ++j) gt[j][nt] = p.proj[(size_t)(tok0 + w * 16 + q * 4 + j) * PS + COL_AG + hd * 64 + nt * 16 + r];
  }
  __syncthreads();
#pragma unroll
  for (int i = 0; i < 16; ++i) {
    const int t = w * 16 + i;
    float lf, k; hg_gate(bf2f(fraw[i]), lb, lf, k);
    run += lf; bl[i] = run; kk[i] = k;
    Bt[d * 136 + t] = vraw[i];
    const int e = w + 4 * i;
    Bt[e * 136 + 64 + d] = f2bf(sraw[i]);
  }
  segtot[w * 64 + d] = run;
  __syncthreads();
  float off = 0.f;
#pragma unroll
  for (int s = 0; s < 4; ++s) { float v = segtot[s * 64 + d]; if (s < w) off += v; }
  const float bm = segtot[d] + segtot[64 + d];
#pragma unroll
  for (int i = 0; i < 16; ++i) {
    const int t = w * 16 + i;
    const float bt = bl[i] + off;
    const float qv = silu_(bf2f(qraw[i]));
    Qp[t * 72 + d] = f2bf(qv * fexp(fmaxf(bt - bm, -80.f)));
    Kp[t * 72 + d] = f2bf(kk[i] * fexp(fminf(bm - bt, 80.f)));
    A[t * 136 + 64 + d] = f2bf(qv * fexp(bt));
  }
  __syncthreads();
  f32x4 acc[4];
#pragma unroll
  for (int i = 0; i < 4; ++i) acc[i] = (f32x4){0.f, 0.f, 0.f, 0.f};
  wave_mma<4, 2>(acc, Qp + w * 16 * 72, 72, Kp, 72, lane);
#pragma unroll
  for (int nt = 0; nt < 4; ++nt)
#pragma unroll
    for (int j = 0; j < 4; ++j) {
      const int t = w * 16 + q * 4 + j, s = nt * 16 + r;
      A[t * 136 + s] = f2bf(s <= t ? acc[nt][j] : 0.f);
    }
  __syncthreads();
  f32x4 o[4];
#pragma unroll
  for (int i = 0; i < 4; ++i) o[i] = (f32x4){0.f, 0.f, 0.f, 0.f};
  wave_mma<4, 4>(o, A + w * 16 * 136, 136, Bt, 136, lane);
#pragma unroll
  for (int j = 0; j < 4; ++j) {
    float ss = 0.f;
#pragma unroll
    for (int nt = 0; nt < 4; ++nt) ss += o[nt][j] * o[nt][j];
    ss = group16_sum(ss);
    const float sc = rsqrtf(ss * (1.f / 64.f) + 1e-6f);
    const int t = w * 16 + q * 4 + j;
    bfu* mrow = p.mixed + (size_t)(tok0 + t) * 1024 + hd * 64;
#pragma unroll
    for (int nt = 0; nt < 4; ++nt) {
      const int e = nt * 16 + r;
      mrow[e] = f2bf(o[nt][j] * sc * gw[nt] * silu_(bf2f(gt[j][nt])));
    }
  }
}

DI void ml_gates(const Params& p, int l, int tok0, int hd, float* bs, float* igs, int tid) {
  if (tid < 64) {
    const bfu* row = p.proj + (size_t)(tok0 + tid) * PS;
    const float ig = bf2f(row[COL_BIG + hd]);
    const float fg = bf2f(row[COL_BFG + hd]) + p.ml_fb[l * 4 + hd];
    float lf = logsig_(fg);
#pragma unroll
    for (int o = 1; o < 64; o <<= 1) { float v = __shfl_up(lf, o); if (tid >= o) lf += v; }
    bs[tid] = lf; igs[tid] = ig;
  }
}

DI void ml_local(const Params& p, int l, int b, int c, int hd, unsigned char* smem) {
  const int tid = threadIdx.x, lane = tid & 63, w = tid >> 6;
  bfu* At = (bfu*)smem;
  bfu* Bt = At + 64 * 72;
  float* bs = (float*)(smem + 2 * 64 * 72 * 2);
  float* igs = bs + 64; float* nseg = igs + 64;
  const int tok0 = b * SEQ + c * 64;
  const int d = lane;
  const bfu* pk = p.proj + (size_t)tok0 * PS + COL_BK + hd * 64 + d;
  const bfu* pv = p.proj + (size_t)tok0 * PS + COL_BV + hd * 64 + d;
  bfu kraw[16], vraw[16];
#pragma unroll
  for (int i = 0; i < 16; ++i) { kraw[i] = pk[(size_t)(w * 16 + i) * PS]; vraw[i] = pv[(size_t)(w * 16 + i) * PS]; }
  __syncthreads();
  ml_gates(p, l, tok0, hd, bs, igs, tid);
  __syncthreads();
  const float blast = bs[63];
  float nacc = 0.f;
#pragma unroll
  for (int i = 0; i < 16; ++i) {
    const int s = w * 16 + i;
    const float ws = fexp(blast - bs[s] + igs[s]);
    const float kw = bf2f(kraw[i]) * 0.125f * ws;
    Bt[d * 72 + s] = f2bf(kw); nacc += kw;
    At[d * 72 + s] = vraw[i];
  }
  nseg[w * 64 + d] = nacc;
  __syncthreads();
  const int base = (b * NCH + c) * 4 + hd;
  if (w == 0) p.ml_n[base * 64 + d] = nseg[d] + nseg[64 + d] + nseg[128 + d] + nseg[192 + d];
  if (tid == 0) p.ml_decay[base] = fexp(blast);
  f32x4 acc[4];
#pragma unroll
  for (int i = 0; i < 4; ++i) acc[i] = (f32x4){0.f, 0.f, 0.f, 0.f};
  wave_mma<4, 2>(acc, At + w * 16 * 72, 72, Bt, 72, lane);
  float* st = p.ml_state + (size_t)base * 4096;
  const int r = lane & 15, q = lane >> 4;
#pragma unroll
  for (int nt = 0; nt < 4; ++nt)
#pragma unroll
    for (int j = 0; j < 4; ++j) st[(w * 16 + q * 4 + j) * 64 + nt * 16 + r] = acc[nt][j];
}

DI void ml_out(const Params& p, int l, int b, int c, int hd, unsigned char* smem) {
  const int tid = threadIdx.x, lane = tid & 63, w = tid >> 6;
  bfu* A = (bfu*)(smem + O_A); bfu* Bt = (bfu*)(smem + O_BT); bfu* Qp = (bfu*)(smem + O_QP); bfu* Kp = (bfu*)(smem + O_KP);
  float* bs = (float*)(smem + O_MISC); float* igs = bs + 64; float* npv = igs + 64; float* den2 = npv + 64;
  const int tok0 = b * SEQ + c * 64;
  const int d = lane;
  const int base = (b * NCH + c) * 4 + hd;
  const float* st = p.ml_state + (size_t)base * 4096;
  const int r = lane & 15, q = lane >> 4;
  const bfu* pq = p.proj + (size_t)tok0 * PS + COL_BQ + hd * 64 + d;
  const bfu* pk = p.proj + (size_t)tok0 * PS + COL_BK + hd * 64 + d;
  const bfu* pv = p.proj + (size_t)tok0 * PS + COL_BV + hd * 64 + d;
  bfu qraw[16], kraw[16], vraw[16]; float sraw[16];
#pragma unroll
  for (int i = 0; i < 16; ++i) {
    const int t = w * 16 + i;
    qraw[i] = pq[(size_t)t * PS]; kraw[i] = pk[(size_t)t * PS]; vraw[i] = pv[(size_t)t * PS]; sraw[i] = st[(w + 4 * i) * 64 + d];
  }
  bfu gt[4][4]; float gw[4];
#pragma unroll
  for (int nt = 0; nt < 4; ++nt) {
    gw[nt] = p.ml_g[l * 256 + hd * 64 + nt * 16 + r];
#pragma unroll
    for (int j = 0; j < 4; ++j) gt[j][nt] = p.proj[(size_t)(tok0 + w * 16 + q * 4 + j) * PS + COL_BG + hd * 64 + nt * 16 + r];
  }
  __syncthreads();
  ml_gates(p, l, tok0, hd, bs, igs, tid);
  if (tid >= 64 && tid < 128) npv[tid - 64] = p.ml_n[base * 64 + tid - 64];
  __syncthreads();
#pragma unroll
  for (int i = 0; i < 16; ++i) {
    const int t = w * 16 + i;
    Qp[t * 72 + d] = qraw[i];
    Kp[t * 72 + d] = kraw[i];
    A[t * 136 + 64 + d] = f2bf(bf2f(qraw[i]) * fexp(bs[t]));
    Bt[d * 136 + t] = vraw[i];
    const int e = w + 4 * i;
    Bt[e * 136 + 64 + d] = f2bf(sraw[i]);
  }
  __syncthreads();
  if (tid < 64) {
    float s = 0.f;
    for (int dd = 0; dd < 64; ++dd) s += bf2f(A[tid * 136 + 64 + dd]) * npv[dd];
    den2[tid] = s;
  }
  f32x4 acc[4];
#pragma unroll
  for (int i = 0; i < 4; ++i) acc[i] = (f32x4){0.f, 0.f, 0.f, 0.f};
  wave_mma<4, 2>(acc, Qp + w * 16 * 72, 72, Kp, 72, lane);
  float den1[4];
#pragma unroll
  for (int j = 0; j < 4; ++j) {
    const int t = w * 16 + q * 4 + j;
    const float bt = bs[t];
    float rs = 0.f;
#pragma unroll
    for (int nt = 0; nt < 4; ++nt) {
      const int s = nt * 16 + r;
      float wv = 0.f;
      if (s <= t) wv = fexp(bt - bs[s] + igs[s]) * acc[nt][j] * 0.125f;
      rs += wv;
      A[t * 136 + s] = f2bf(wv);
    }
    den1[j] = group16_sum(rs);
  }
  __syncthreads();
  f32x4 o[4];
#pragma unroll
  for (int i = 0; i < 4; ++i) o[i] = (f32x4){0.f, 0.f, 0.f, 0.f};
  wave_mma<4, 4>(o, A + w * 16 * 136, 136, Bt, 136, lane);
#pragma unroll
  for (int j = 0; j < 4; ++j) {
    const int t = w * 16 + q * 4 + j;
    const float den = den1[j] + den2[t];
    const float inv = frcp(fmaxf(fabsf(den), 1.f));
    float hv[4];
    float ss = 0.f;
#pragma unroll
    for (int nt = 0; nt < 4; ++nt) { hv[nt] = o[nt][j] * inv; ss += hv[nt] * hv[nt]; }
    ss = group16_sum(ss);
    const float sc = rsqrtf(ss * (1.f / 64.f) + 1e-6f);
    bfu* mrow = p.mixed + (size_t)(tok0 + t) * 1024 + 256 + hd * 64;
#pragma unroll
    for (int nt = 0; nt < 4; ++nt) {
      const int e = nt * 16 + r;
      mrow[e] = f2bf(hv[nt] * sc * gw[nt] * silu_(bf2f(gt[j][nt])));
    }
  }
}

template <bool FINAL>
DI void lru_item(const Params& p, int l, int b, int c, int n, unsigned char* smem) {
  const int tid = threadIdx.x, lane = tid & 63, w = tid >> 6;
  bfu* xcb = (bfu*)smem;
  float* xcf = (float*)(smem + 9216);
  float* af = (float*)(smem + 9216 + 17408);
  float* segH = (float*)(smem + 9216 + 2 * 17408);
  float* segA = segH + 256;
  const int tok0 = b * SEQ + c * 64;
  const int ch = n * 64 + lane;
  const int r = lane & 15, q = lane >> 4;
  bf16x8 wfa[2][4], wfx[2][4];
#pragma unroll
  for (int ks = 0; ks < 2; ++ks)
#pragma unroll
    for (int nt = 0; nt < 4; ++nt) {
      wfa[ks][nt] = *(const bf16x8*)(p.wt_a + (l * 4 + n) * 4096 + (nt * 16 + r) * 64 + ks * 32 + q * 8);
      wfx[ks][nt] = *(const bf16x8*)(p.wt_x + (l * 4 + n) * 4096 + (nt * 16 + r) * 64 + ks * 32 + q * 8);
    }
  float e_ba[4], e_bx[4], e_lam[4];
#pragma unroll
  for (int nt = 0; nt < 4; ++nt) {
    const int che = n * 64 + nt * 16 + r;
    e_ba[nt] = p.b_a[l * 256 + che]; e_bx[nt] = p.b_x[l * 256 + che]; e_lam[nt] = p.lam[l * 256 + che];
  }
  const int sidx = (b * NCH + c) * 256 + ch;
  float Hprev = 0.f;
  bfu gq[16];
  if (FINAL) {
    Hprev = p.lru_h[sidx];
    const bfu* pg0 = p.proj + (size_t)tok0 * PS + COL_CG + ch;
#pragma unroll
    for (int i = 0; i < 16; ++i) gq[i] = pg0[(size_t)(w * 16 + i) * PS];
  }
  __syncthreads();
  {
    const float cw0 = p.conv_w[(l * 4 + 0) * 256 + ch], cw1 = p.conv_w[(l * 4 + 1) * 256 + ch];
    const float cw2 = p.conv_w[(l * 4 + 2) * 256 + ch], cw3 = p.conv_w[(l * 4 + 3) * 256 + ch];
    const float cb = p.conv_b[l * 256 + ch];
    const bfu* px = p.proj + (size_t)tok0 * PS + COL_CX + ch;
#pragma unroll
    for (int i = 0; i < 16; ++i) {
      const int t = w * 16 + i;
      const int sp = c * 64 + t;
      float x0 = (sp >= 3) ? bf2f(px[(ptrdiff_t)(t - 3) * PS]) : 0.f;
      float x1 = (sp >= 2) ? bf2f(px[(ptrdiff_t)(t - 2) * PS]) : 0.f;
      float x2 = (sp >= 1) ? bf2f(px[(ptrdiff_t)(t - 1) * PS]) : 0.f;
      float x3 = bf2f(px[(ptrdiff_t)t * PS]);
      const float xc = cb + cw0 * x0 + cw1 * x1 + cw2 * x2 + cw3 * x3;
      xcf[t * 68 + lane] = xc;
      xcb[t * 72 + lane] = f2bf(xc);
    }
  }
  __syncthreads();
  f32x4 aa[4], ax[4];
#pragma unroll
  for (int i = 0; i < 4; ++i) { aa[i] = (f32x4){0.f, 0.f, 0.f, 0.f}; ax[i] = (f32x4){0.f, 0.f, 0.f, 0.f}; }
#pragma unroll
  for (int ks = 0; ks < 2; ++ks) {
    const bf16x8 afr = *(const bf16x8*)(xcb + (w * 16 + r) * 72 + ks * 32 + q * 8);
#pragma unroll
    for (int nt = 0; nt < 4; ++nt) {
      aa[nt] = __builtin_amdgcn_mfma_f32_16x16x32_bf16(afr, wfa[ks][nt], aa[nt], 0, 0, 0);
      ax[nt] = __builtin_amdgcn_mfma_f32_16x16x32_bf16(afr, wfx[ks][nt], ax[nt], 0, 0, 0);
    }
  }
#pragma unroll
  for (int nt = 0; nt < 4; ++nt) {
    const int e = nt * 16 + r;
    const float ba = e_ba[nt], bx = e_bx[nt];
    const float lsl = 8.f * logsig_acc(e_lam[nt]);
#pragma unroll
    for (int j = 0; j < 4; ++j) {
      const int t = w * 16 + q * 4 + j;
      const float rg = sigmoid_(aa[nt][j] + ba), ig = sigmoid_(ax[nt][j] + bx);
      const float la = lsl * rg;
      const float a = fexp(la);
      const float y2 = 2.f * la;
      const float em = (y2 > -0.05f) ? -y2 * (1.f + y2 * (0.5f + y2 * (0.16666667f + y2 * 0.041666668f))) : 1.f - a * a;
      const float bv = __builtin_amdgcn_sqrtf(fmaxf(em, 0.f)) * ig * xcf[t * 68 + e];
      af[t * 68 + e] = a; xcf[t * 68 + e] = bv;
    }
  }
  __syncthreads();
  float hl[16], al[16];
  float h = 0.f, ap = 1.f;
#pragma unroll
  for (int i = 0; i < 16; ++i) {
    const int t = w * 16 + i;
    const float a = af[t * 68 + lane], bv = xcf[t * 68 + lane];
    h = a * h + bv; ap *= a; hl[i] = h; al[i] = ap;
  }
  segH[w * 64 + lane] = h; segA[w * 64 + lane] = ap;
  __syncthreads();
  if (!FINAL) {
    if (w == 0) {
      float H = 0.f, Ap = 1.f;
#pragma unroll
      for (int s = 0; s < 4; ++s) { H = segA[s * 64 + lane] * H + segH[s * 64 + lane]; Ap *= segA[s * 64 + lane]; }
      p.lru_h[sidx] = H; p.lru_a[sidx] = Ap;
    }
  } else {
    float H = Hprev;
#pragma unroll
    for (int s = 0; s < 4; ++s) if (s < w) H = segA[s * 64 + lane] * H + segH[s * 64 + lane];
    bfu* pm = p.mixed + (size_t)tok0 * 1024 + 512 + ch;
#pragma unroll
    for (int i = 0; i < 16; ++i) {
      const int t = w * 16 + i;
      const float hv = hl[i] + al[i] * H;
      pm[(size_t)t * 1024] = f2bf(hv * silu_(bf2f(gq[i])));
    }
  }
}

template <bool FINAL>
DI void s5_item(const Params& p, int l, int b, int c, int g4, unsigned char* smem) {
  const int tid = threadIdx.x, lane = tid & 63, w = tid >> 6;
  const int g = g4 * 4 + w;
  float* buw = (float*)(smem + w * 13312);
  bfu* stw = (bfu*)(smem + w * 13312 + 8448);
  const int tok0 = b * SEQ + c * 64;
  const int r = lane & 15, q = lane >> 4;
  const int lg = l * 16 + g;
  bf16x8 bfr[8], yfr[4];
#pragma unroll
  for (int nt = 0; nt < 8; ++nt) bfr[nt] = *(const bf16x8*)(p.bt_bu + ((size_t)lg * 128 + nt * 16 + r) * 32 + q * 8);
  if (FINAL) {
#pragma unroll
    for (int ks = 0; ks < 4; ++ks) yfr[ks] = *(const bf16x8*)(p.bt_y + ((size_t)lg * 16 + r) * 128 + ks * 32 + q * 8);
  }
  const float ar = p.abar[(lg * 64 + lane) * 2], ai = p.abar[(lg * 64 + lane) * 2 + 1];
  const size_t sbase = ((size_t)(b * NCH + c) * 16 + g) * 128;
  float xr = 0.f, xi = 0.f;
  if (FINAL) { xr = p.s5_state[sbase + lane]; xi = p.s5_state[sbase + 64 + lane]; }
  const float dsk = FINAL ? p.s5_d[l * 256 + g * 16 + r] : 0.f;
  bf16x8 afr[4];
  bfu uq[4][4];
#pragma unroll
  for (int mt = 0; mt < 4; ++mt) {
    afr[mt] = (bf16x8){0, 0, 0, 0, 0, 0, 0, 0};
    if (q < 2) afr[mt] = *(const bf16x8*)(p.proj + (size_t)(tok0 + mt * 16 + r) * PS + COL_DU + g * 16 + q * 8);
    if (FINAL) {
#pragma unroll
      for (int j = 0; j < 4; ++j) uq[mt][j] = p.proj[(size_t)(tok0 + mt * 16 + q * 4 + j) * PS + COL_DU + g * 16 + r];
    }
  }
  __syncthreads();
#pragma unroll
  for (int mt = 0; mt < 4; ++mt) {
    const bf16x8 a = afr[mt];
#pragma unroll
    for (int nt = 0; nt < 8; ++nt) {
      f32x4 acc = (f32x4){0.f, 0.f, 0.f, 0.f};
      acc = __builtin_amdgcn_mfma_f32_16x16x32_bf16(a, bfr[nt], acc, 0, 0, 0);
#pragma unroll
      for (int j = 0; j < 4; ++j) buw[(q * 4 + j) * 132 + nt * 16 + r] = acc[j];
    }
    wave_sync();
    {
      float br[16], bi[16];
#pragma unroll
      for (int tt = 0; tt < 16; ++tt) { br[tt] = buw[tt * 132 + lane]; bi[tt] = buw[tt * 132 + 64 + lane]; }
#pragma unroll
      for (int tt = 0; tt < 16; ++tt) {
        const float nr = ar * xr - ai * xi + br[tt];
        const float ni = ar * xi + ai * xr + bi[tt];
        xr = nr; xi = ni;
        br[tt] = xr; bi[tt] = xi;
      }
      if (FINAL) {
#pragma unroll
        for (int tt = 0; tt < 16; ++tt) { stw[tt * 136 + lane] = f2bf(br[tt]); stw[tt * 136 + 64 + lane] = f2bf(bi[tt]); }
      }
    }
    wave_sync();
    if (FINAL) {
      f32x4 y = (f32x4){0.f, 0.f, 0.f, 0.f};
#pragma unroll
      for (int ks = 0; ks < 4; ++ks) {
        bf16x8 a2 = *(const bf16x8*)(stw + r * 136 + ks * 32 + q * 8);
        y = __builtin_amdgcn_mfma_f32_16x16x32_bf16(a2, yfr[ks], y, 0, 0, 0);
      }
#pragma unroll
      for (int j = 0; j < 4; ++j) {
        const int t = mt * 16 + q * 4 + j;
        const float z = gelu_tanh_(y[j] + dsk * bf2f(uq[mt][j]));
        p.zbuf[(size_t)(tok0 + t) * 256 + g * 16 + r] = f2bf(z);
      }
      wave_sync();
    }
  }
  if (!FINAL) { p.s5_state[sbase + lane] = xr; p.s5_state[sbase + 64 + lane] = xi; }
}

DI void s5_glu(const Params& p, int l, int b, int c, unsigned char* smem) {
  const int tid = threadIdx.x, lane = tid & 63, w = tid >> 6;
  bfu* zs = (bfu*)smem;
  const int tok0 = b * SEQ + c * 64;
  const int r = lane & 15, q = lane >> 4;
  __syncthreads();
#pragma unroll
  for (int i = 0; i < 8; ++i) {
    const int id = tid + i * 256;
    *(uint4*)(zs + (id >> 5) * 264 + (id & 31) * 8) = *(const uint4*)(p.zbuf + (size_t)(tok0 + (id >> 5)) * 256 + (id & 31) * 8);
  }
  __syncthreads();
  const bfu* wg = p.wt_glu + l * 65536;
#pragma unroll 1
  for (int nc = 0; nc < 4; ++nc) {
    bfu gq[4][4]; float bgv[4];
#pragma unroll
    for (int nt = 0; nt < 4; ++nt) {
      bgv[nt] = p.b_glu[l * 256 + nc * 64 + nt * 16 + r];
#pragma unroll
      for (int j = 0; j < 4; ++j) gq[nt][j] = p.proj[(size_t)(tok0 + w * 16 + q * 4 + j) * PS + COL_DG + nc * 64 + nt * 16 + r];
    }
    f32x4 acc[4];
#pragma unroll
    for (int i = 0; i < 4; ++i) acc[i] = (f32x4){0.f, 0.f, 0.f, 0.f};
#pragma unroll
    for (int kh = 0; kh < 2; ++kh) {
      bf16x8 bq[4][4];
#pragma unroll
      for (int ks = 0; ks < 4; ++ks)
#pragma unroll
        for (int nt = 0; nt < 4; ++nt) bq[ks][nt] = *(const bf16x8*)(wg + (nc * 64 + nt * 16 + r) * 256 + kh * 128 + ks * 32 + q * 8);
#pragma unroll
      for (int ks = 0; ks < 4; ++ks) {
        const bf16x8 a = *(const bf16x8*)(zs + (w * 16 + r) * 264 + kh * 128 + ks * 32 + q * 8);
#pragma unroll
        for (int nt = 0; nt < 4; ++nt) acc[nt] = __builtin_amdgcn_mfma_f32_16x16x32_bf16(a, bq[ks][nt], acc[nt], 0, 0, 0);
      }
    }
#pragma unroll
    for (int nt = 0; nt < 4; ++nt) {
      const int n = nc * 64 + nt * 16 + r;
#pragma unroll
      for (int j = 0; j < 4; ++j) {
        const int t = w * 16 + q * 4 + j;
        const float zv = bf2f(zs[t * 264 + n]);
        const float gate = silu_(bf2f(gq[nt][j]));
        p.mixed[(size_t)(tok0 + t) * 1024 + 768 + n] = f2bf(zv * sigmoid_(acc[nt][j] + bgv[nt]) * gate);
      }
    }
  }
}

#define QLOOP(QI, N, BODY)                                                                            \
  {                                                                                                   \
    unsigned* q_ctr = p.cnt + CNT_Q + (l * 8 + (QI)) * 32;                                            \
    unsigned q_nxt = blockIdx.x;                                                                      \
    for (;;) {                                                                                        \
      __syncthreads();                                                                                \
      if (threadIdx.x == 0) *s_q = q_nxt;                                                             \
      __syncthreads();                                                                                \
      const int item = (int)*s_q;                                                                     \
      if (item >= (N)) break;                                                                         \
      if (threadIdx.x == 0) q_nxt = gridDim.x + __hip_atomic_fetch_add(q_ctr, 1u, __ATOMIC_RELAXED, __HIP_MEMORY_SCOPE_AGENT); \
      BODY;                                                                                           \
    }                                                                                                 \
  }

DI void phase2(const Params& p, int l, unsigned char* smem) {
  unsigned* s_q = (unsigned*)(smem + SMEM_BYTES - 32);
  QLOOP(0, 1024, s5_item<false>(p, l, item >> 7, (item >> 2) & 31, item & 3, smem))
  QLOOP(1, 1024, hg_local(p, l, item >> 7, (item >> 2) & 31, item & 3, smem))
  QLOOP(2, 1024, ml_local(p, l, item >> 7, (item >> 2) & 31, item & 3, smem))
  QLOOP(3, 1024, lru_item<false>(p, l, item >> 7, (item >> 2) & 31, item & 3, smem))
}

DI void phase3(const Params& p, int l) {
  const int gtid = blockIdx.x * 256 + threadIdx.x, gsz = gridDim.x * 256;
  constexpr int N1 = 131072, N2 = 131072, N3 = 2048, N4 = 2048, N5 = 8192;
  for (int i = gtid; i < N1 + N2 + N3 + N4 + N5; i += gsz) {
    if (i < N1 + N2) {
      const bool ml = i >= N1;
      const int j = ml ? i - N1 : i;
      const int b = j >> 14, rem = j & 16383, hd = rem >> 12, ed = rem & 4095, d = ed & 63;
      float* stp = (ml ? p.ml_state : p.hg_state) + (size_t)(b * NCH * 4 + hd) * 4096 + ed;
      const float* dcp = ml ? (p.ml_decay + b * NCH * 4 + hd) : (p.hg_decay + (b * NCH * 4 + hd) * 64 + d);
      const int dstride = ml ? 4 : 256;
      float S = 0.f;
#pragma unroll
      for (int c0 = 0; c0 < NCH; c0 += 16) {
        float loc[16], dec[16];
#pragma unroll
        for (int c = 0; c < 16; ++c) { loc[c] = stp[(size_t)(c0 + c) * 16384]; dec[c] = dcp[(c0 + c) * dstride]; }
#pragma unroll
        for (int c = 0; c < 16; ++c) { stp[(size_t)(c0 + c) * 16384] = S; S = dec[c] * S + loc[c]; }
      }
    } else if (i < N1 + N2 + N3) {
      const int j = i - N1 - N2, b = j >> 8, rem = j & 255, hd = rem >> 6, d = rem & 63;
      float S = 0.f;
      for (int c = 0; c < NCH; ++c) {
        const int base = (b * NCH + c) * 4 + hd;
        const float dec = p.ml_decay[base];
        const float loc = p.ml_n[base * 64 + d];
        p.ml_n[base * 64 + d] = S; S = dec * S + loc;
      }
    } else if (i < N1 + N2 + N3 + N4) {
      const int j = i - N1 - N2 - N3, b = j >> 8, ch = j & 255;
      float H = 0.f;
      for (int c = 0; c < NCH; ++c) {
        const int idx = (b * NCH + c) * 256 + ch;
        const float a = p.lru_a[idx], hl = p.lru_h[idx];
        p.lru_h[idx] = H; H = a * H + hl;
      }
    } else {
      const int j = i - N1 - N2 - N3 - N4, b = j >> 10, g = (j >> 6) & 15, pp = j & 63;
      const float ar = p.abar64[((l * 16 + g) * 64 + pp) * 2], ai = p.abar64[((l * 16 + g) * 64 + pp) * 2 + 1];
      float xr = 0.f, xi = 0.f;
      for (int c = 0; c < NCH; ++c) {
        const size_t sb = ((size_t)(b * NCH + c) * 16 + g) * 128;
        const float lr = p.s5_state[sb + pp], li = p.s5_state[sb + 64 + pp];
        p.s5_state[sb + pp] = xr; p.s5_state[sb + 64 + pp] = xi;
        const float nr = ar * xr - ai * xi + lr, ni = ar * xi + ai * xr + li;
        xr = nr; xi = ni;
      }
    }
  }
}

DI void phase4(const Params& p, int l, unsigned char* smem, unsigned long long& tp_acc) {
  unsigned* s_flag = (unsigned*)(smem + SMEM_BYTES - 16);
  unsigned* s_q = (unsigned*)(smem + SMEM_BYTES - 32);
  TPS(41)
  QLOOP(4, 256, {
    _Pragma("unroll 1") for (int g4 = 0; g4 < 4; ++g4) s5_item<true>(p, l, item >> 5, item & 31, g4, smem);
    asm volatile("s_waitcnt vmcnt(0)" ::: "memory");
    s5_glu(p, l, item >> 5, item & 31, smem);
  })
  TPE(41)
  TPS(42)
  QLOOP(5, 1024, hg_out(p, l, item >> 7, (item >> 2) & 31, item & 3, smem))
  TPE(42)
  TPS(43)
  QLOOP(6, 1024, ml_out(p, l, item >> 7, (item >> 2) & 31, item & 3, smem))
  TPE(43)
  TPS(44)
  QLOOP(7, 1024, lru_item<true>(p, l, item >> 7, (item >> 2) & 31, item & 3, smem))
  TPE(44)
}

#ifdef TPROBE
#define TP_CLASS(PH) ((PH) == 0 ? 0 : (((PH) - 1) % 6) + 1)
#define TP_BEGIN(PH) unsigned long long tp_t0 = 0; if (TP_CLASS(PH) == TPROBE) tp_t0 = __builtin_amdgcn_s_memrealtime();
#define TP_END(PH) if (TP_CLASS(PH) == TPROBE) tp_acc += __builtin_amdgcn_s_memrealtime() - tp_t0;
#else
#define TP_BEGIN(PH)
#define TP_END(PH)
#endif
#define RUN_PHASE(PH, CALL)                                       \
  if (ph0 <= (PH) && (PH) < ph1) {                                \
    TP_BEGIN(PH)                                                  \
    CALL;                                                         \
    if (COOP) { if ((PH) + 1 < ph1) xcd_barrier(xb); }            \
    TP_END(PH)                                                    \
  }

template <bool COOP, int L>
DI void run_layer(const Params& p, int ph0, int ph1, unsigned char* smem, const XcdBarrier& xb, unsigned long long& tp_acc) {
#ifdef DUP1
  RUN_PHASE(1 + 6 * L, phase1(p, L, smem))
#endif
  RUN_PHASE(1 + 6 * L, phase1(p, L, smem))
#ifdef DUP2
  RUN_PHASE(2 + 6 * L, phase2(p, L, smem))
#endif
  RUN_PHASE(2 + 6 * L, phase2(p, L, smem))
  RUN_PHASE(3 + 6 * L, { phase3(p, L); if (L + 1 < DEPTH) convert_weights<(L + 1 < DEPTH ? L + 1 : 0)>(p, smem); })
#ifdef DUP4
  RUN_PHASE(4 + 6 * L, phase4(p, L, smem, tp_acc))
#endif
  RUN_PHASE(4 + 6 * L, phase4(p, L, smem, tp_acc))
  RUN_PHASE(5 + 6 * L, phase5(p, L, smem, tp_acc))
  RUN_PHASE(6 + 6 * L, phase6(p, L))
}

template <bool COOP>
__global__ void __launch_bounds__(256, 2) mk_fwd(Params p, int ph0, int ph1) {
  __shared__ __attribute__((aligned(16))) unsigned char smem[SMEM_BYTES];
  __shared__ uint4 xb_words;
  XcdBarrier xb; xb.bar = p.bar; xb.x = 0; xb.st = nullptr;
  if (COOP) {
    if (ph1 < 0) cg::this_grid().sync();
    if (threadIdx.x == 0) xb_words = make_uint4(0u, 0u, 0u, 0u);
    __syncthreads();
    xb = xcd_barrier_post(p.bar, (volatile LAS unsigned*)&xb_words);
  }
  unsigned long long tp_acc = 0;
  RUN_PHASE(0, phase0(p, smem))
  run_layer<COOP, 0>(p, ph0, ph1, smem, xb, tp_acc);
  run_layer<COOP, 1>(p, ph0, ph1, smem, xb, tp_acc);
  run_layer<COOP, 2>(p, ph0, ph1, smem, xb, tp_acc);
  run_layer<COOP, 3>(p, ph0, ph1, smem, xb, tp_acc);
#ifdef TPROBE
  if (blockIdx.x == 0 && threadIdx.x == 0) {
    const unsigned long long t0 = __builtin_amdgcn_s_memrealtime();
    while (__builtin_amdgcn_s_memrealtime() - t0 < tp_acc) __builtin_amdgcn_s_sleep(8);
  }
#endif
}

extern "C" void kernel_launch(void* const* d_in, const int* in_sizes, int n_in, void* d_out, int out_size, void* d_ws,
                              size_t ws_size, hipStream_t stream) {
  static int grid_blocks = 0;
  if (!grid_blocks) {
    int dev = 0, cus = 0, per_cu = 0;
    hipGetDevice(&dev);
    hipDeviceGetAttribute(&cus, hipDeviceAttributeMultiprocessorCount, dev);
    hipOccupancyMaxActiveBlocksPerMultiprocessor(&per_cu, mk_fwd<(MEGA != 0)>, 256, 0);
    if (per_cu < 1) per_cu = 1;
    if (per_cu > 2) per_cu = 2;
    grid_blocks = cus * per_cu;
  }
  Params p{};
  const float** pin = (const float**)&p;
  for (int i = 0; i < 28; ++i) pin[i] = (const float*)d_in[i];
  p.out = (float*)d_out;
  unsigned char* ws = (unsigned char*)d_ws;
  size_t off = 0;
  auto take = [&](size_t bytes) { unsigned char* r = ws + off; off += (bytes + 255) & ~(size_t)255; return r; };
  p.wt_in = (bfu*)take((size_t)4 * PS * 1024 * 2);
  p.wt_out = (bfu*)take((size_t)4 * 1024 * 1024 * 2);
  p.wt_a = (bfu*)take(16 * 4096 * 2);
  p.wt_x = (bfu*)take(16 * 4096 * 2);
  p.wt_glu = (bfu*)take(4 * 65536 * 2);
  p.bt_bu = (bfu*)take(64 * 128 * 32 * 2);
  p.bt_y = (bfu*)take(64 * 16 * 128 * 2);
  p.hb = (bfu*)take((size_t)NTOK * 1024 * 2);
  p.proj = (bfu*)take((size_t)NTOK * PS * 2);
  p.mixed = (bfu*)take((size_t)NTOK * 1024 * 2);
  p.zbuf = (bfu*)take((size_t)NTOK * 256 * 2);
  p.abar = (float*)take(4096 * 2 * 4);
  p.abar64 = (float*)take(4096 * 2 * 4);
  p.lbs = (float*)take(1024 * 4);
  p.hg_state = (float*)take((size_t)BATCH * NCH * 4 * 4096 * 4);
  p.hg_decay = (float*)take((size_t)BATCH * NCH * 4 * 64 * 4);
  p.ml_state = (float*)take((size_t)BATCH * NCH * 4 * 4096 * 4);
  p.ml_n = (float*)take((size_t)BATCH * NCH * 4 * 64 * 4);
  p.ml_decay = (float*)take((size_t)BATCH * NCH * 4 * 4);
  p.lru_h = (float*)take((size_t)BATCH * NCH * 256 * 4);
  p.lru_a = (float*)take((size_t)BATCH * NCH * 256 * 4);
  p.s5_state = (float*)take((size_t)BATCH * NCH * 16 * 128 * 4);
  p.cnt = (unsigned*)take(CNT_TOTAL * 4);
  p.bar = (unsigned*)take(XCD_BAR_WORDS * 4);
  if (off > ws_size) { fprintf(stderr, "workspace too small: need %zu have %zu\n", off, ws_size); return; }
  const int NPH = 1 + 6 * DEPTH;
#if MEGA
  (void)hipMemsetAsync(p.bar, 0, XCD_BAR_WORDS * 4, stream);
  int ph0 = 0, ph1 = NPH;
  void* args[] = {&p, &ph0, &ph1};
  hipError_t e = hipLaunchCooperativeKernel((void*)mk_fwd<true>, dim3(grid_blocks), dim3(256), args, 0, stream);
  if (e != hipSuccess) fprintf(stderr, "cooperative launch failed: %s (grid %d)\n", hipGetErrorString(e), grid_blocks);
#else
  for (int ph = 0; ph < NPH; ++ph) hipLaunchKernelGGL(mk_fwd<false>, dim3(grid_blocks), dim3(256), 0, stream, p, ph, ph + 1);
#endif
}
```

```cpp
#include <hip/hip_runtime.h>
#include <hip/hip_cooperative_groups.h>
#include <stdint.h>
#include <stdio.h>
namespace cg = cooperative_groups;

#ifndef MEGA
#define MEGA 1
#endif

typedef unsigned short bfu;
using bf16x8 = __attribute__((ext_vector_type(8))) short;
using f32x4  = __attribute__((ext_vector_type(4))) float;
#define DI __device__ __forceinline__

constexpr int BATCH = 8, SEQ = 2048, DM = 1024, DEPTH = 4, NTOK = BATCH * SEQ, NCH = SEQ / 64;
constexpr int DIN = 3080, PS = 3200;
constexpr int COL_AQ = 0, COL_AF = 256, COL_AI = 512, COL_AG = 768;
constexpr int COL_BQ = 1024, COL_BK = 1280, COL_BV = 1536, COL_BG = 1792, COL_BIG = 3072, COL_BFG = 3076;
constexpr int COL_CX = 2048, COL_CG = 2304, COL_DU = 2560, COL_DG = 2816;
constexpr float DN_ALPHA = 1.681792830507429f;
constexpr int SMEM_BYTES = 56 * 1024;
constexpr int CNT_LN = 0, CNT_GLU = 4 * 128, CNT_Q = 4 * 128 + 4 * 256, CNT_TOTAL = CNT_Q + 32 * 32;

struct Params {
  const float *x, *w_in, *b_in, *lb_logits, *hg_g, *ml_fb, *ml_g, *conv_w, *conv_b, *w_a, *b_a, *w_x, *b_x, *lam,
      *a_re, *a_im, *log_dt, *sb_re, *sb_im, *c_re, *c_im, *s5_d, *w_glu, *b_glu, *w_out, *b_out, *ln_g, *ln_b;
  float* out;
  bfu *wt_in, *wt_out, *wt_a, *wt_x, *wt_glu, *bt_bu, *bt_y, *hb, *proj, *mixed, *zbuf;
  float *abar, *abar64, *lbs, *hg_state, *hg_decay, *ml_state, *ml_n, *ml_decay, *lru_h, *lru_a, *s5_state;
  unsigned* cnt;
  unsigned* bar;
};

DI bfu f2bf(float x) { return __builtin_bit_cast(unsigned short, (__bf16)x); }
DI float bf2f(bfu h) { return __uint_as_float(((unsigned)h) << 16); }
typedef __bf16 bf16v2 __attribute__((ext_vector_type(2)));
typedef float f32v2 __attribute__((ext_vector_type(2)));
DI unsigned pack2(float a, float b) { f32v2 v = {a, b}; return __builtin_bit_cast(unsigned, __builtin_convertvector(v, bf16v2)); }
DI float fexp(float x) { return __expf(x); }
DI float frcp(float x) { return __builtin_amdgcn_rcpf(x); }
DI float flog(float x) { return __logf(x); }
DI float sigmoid_(float x) { return frcp(1.f + fexp(-x)); }
DI float silu_(float x) { return x * frcp(1.f + fexp(-x)); }
DI float logsig_(float x) { return fminf(x, 0.f) - flog(1.f + fexp(-fabsf(x))); }
DI float logsig_acc(float x) { return fminf(x, 0.f) - log1pf(expf(-fabsf(x))); }
DI float gelu_tanh_(float x) {
  float u = 0.7978845608028654f * (x + 0.044715f * x * x * x);
  float th = 1.f - 2.f * frcp(fexp(2.f * u) + 1.f);
  return 0.5f * x * (1.f + th);
}

template <int NT, int KS>
DI void wave_mma(f32x4 (&acc)[NT], const bfu* A, int lda, const bfu* Bt, int ldb, int lane) {
  const int r = lane & 15, q = lane >> 4;
#pragma unroll
  for (int ks = 0; ks < KS; ++ks) {
    bf16x8 a = *(const bf16x8*)(A + r * lda + ks * 32 + q * 8);
#pragma unroll
    for (int nt = 0; nt < NT; ++nt) {
      bf16x8 b = *(const bf16x8*)(Bt + (nt * 16 + r) * ldb + ks * 32 + q * 8);
      acc[nt] = __builtin_amdgcn_mfma_f32_16x16x32_bf16(a, b, acc[nt], 0, 0, 0);
    }
  }
}

DI void wave_sync() { __builtin_amdgcn_fence(__ATOMIC_SEQ_CST, "wavefront"); __builtin_amdgcn_wave_barrier(); __builtin_amdgcn_fence(__ATOMIC_SEQ_CST, "wavefront"); }
DI float group16_sum(float v) {
  v += __shfl_xor(v, 1); v += __shfl_xor(v, 2); v += __shfl_xor(v, 4); v += __shfl_xor(v, 8);
  return v;
}
DI float wave_sum(float v) {
  v += __shfl_xor(v, 1); v += __shfl_xor(v, 2); v += __shfl_xor(v, 4); v += __shfl_xor(v, 8);
  v += __shfl_xor(v, 16); v += __shfl_xor(v, 32);
  return v;
}

DI bool last_arriver(unsigned* ctr, unsigned total, unsigned* s_flag) {
  asm volatile("s_waitcnt vmcnt(0)" ::: "memory");
  __syncthreads();
  if (threadIdx.x == 0) {
    __builtin_amdgcn_fence(__ATOMIC_RELEASE, "agent");
    asm volatile("s_waitcnt vmcnt(0)" ::: "memory");
    const unsigned old = __hip_atomic_fetch_add(ctr, 1u, __ATOMIC_RELAXED, __HIP_MEMORY_SCOPE_AGENT);
    const unsigned last = (old == total - 1u) ? 1u : 0u;
    if (last) { __builtin_amdgcn_fence(__ATOMIC_ACQUIRE, "agent"); asm volatile("s_waitcnt vmcnt(0)" ::: "memory"); }
    *s_flag = last;
  }
  __syncthreads();
  return (*s_flag != 0u);
}

#ifdef TPROBE
#define TPS(ID) unsigned long long tps_##ID = 0; if (TPROBE == (ID)) tps_##ID = __builtin_amdgcn_s_memrealtime();
#define TPE(ID) if (TPROBE == (ID)) tp_acc += __builtin_amdgcn_s_memrealtime() - tps_##ID;
#else
#define TPS(ID)
#define TPE(ID)
#endif

#define XB_TMO      128
#define XB_XCNT(j)  (256  + 64 * (j))
#define XB_XSUB(j)  (1280 + 64 * (j))
#define XB_XGEN(j)  (2304 + 64 * (j))
#define XB_TOP      3328
#define XB_TOPGEN   3392
#define XCD_BAR_WORDS 3456
#define XB_SPIN_CAP (1u << 22)
#define LAS __attribute__((address_space(3)))
DI unsigned xb_ld(unsigned* p) { return __hip_atomic_load(p, __ATOMIC_RELAXED, __HIP_MEMORY_SCOPE_AGENT); }
DI unsigned xb_add(unsigned* p, unsigned v) { return __hip_atomic_fetch_add(p, v, __ATOMIC_RELAXED, __HIP_MEMORY_SCOPE_AGENT); }
DI unsigned xb_xcc_id() { return (unsigned)__builtin_amdgcn_s_getreg((3 << 11) | 20) & 0xFu; }
#define XB_SPIN(cond, bar) do { unsigned _sp = 0; while (cond) { __builtin_amdgcn_s_sleep(1); \
    if ((++_sp & 255u) == 0u) { if (xb_ld(&(bar)[XB_TMO])) break; if (_sp > XB_SPIN_CAP) { atomicAdd(&(bar)[XB_TMO], 1u); break; } } } } while (0)
struct XcdBarrier { unsigned* bar; unsigned x; volatile LAS unsigned* st; };
DI XcdBarrier xcd_barrier_post(unsigned* bar, volatile LAS unsigned* st) {
  XcdBarrier b; b.bar = bar; b.x = xb_xcc_id(); b.st = st;
  if (threadIdx.x == 0) (void)xb_add(&bar[XB_XCNT(b.x)], 1u);
  return b;
}
DI void xcd_barrier_complete(unsigned* bar, unsigned x, unsigned& nloc, unsigned& nx) {
  const unsigned G = gridDim.x * gridDim.y * gridDim.z;
  unsigned sum, cnt, mine, sp = 0u;
  for (;;) {
    sum = 0u; cnt = 0u; mine = 0u;
#pragma unroll
    for (unsigned j = 0; j < 16; ++j) { const unsigned c = xb_ld(&bar[XB_XCNT(j)]); sum += c; cnt += (c > 0u) ? 1u : 0u; mine = (j == x) ? c : mine; }
    if (sum == G) break;
    __builtin_amdgcn_s_sleep(1);
    if ((++sp & 255u) == 0u) { if (xb_ld(&bar[XB_TMO])) break; if (sp > XB_SPIN_CAP) { atomicAdd(&bar[XB_TMO], 1u); break; } }
  }
  nloc = mine > 0u ? mine : 1u; nx = cnt > 0u ? cnt : 1u;
}
DI void xcd_barrier(const XcdBarrier& b) {
  asm volatile("s_waitcnt vmcnt(0)" ::: "memory");
  __syncthreads();
  if (threadIdx.x == 0) {
    unsigned* bar = b.bar;
    __builtin_amdgcn_s_waitcnt(0);
    unsigned nloc = b.st[0], nx = b.st[1];
    if (nloc == 0u) { xcd_barrier_complete(bar, b.x, nloc, nx); b.st[0] = nloc; b.st[1] = nx; }
    const unsigned old = xb_add(&bar[XB_XSUB(b.x)], 1u);
    const unsigned gen = old / nloc;
    if (old + 1u == (gen + 1u) * nloc) {
      __builtin_amdgcn_fence(__ATOMIC_RELEASE, "agent");
      asm volatile("s_waitcnt vmcnt(0)" ::: "memory");
      const unsigned og = xb_add(&bar[XB_TOP], 1u);
      const unsigned tg = og / nx;
      if (og + 1u == (tg + 1u) * nx) xb_add(&bar[XB_TOPGEN], 1u);
      else XB_SPIN(xb_ld(&bar[XB_TOPGEN]) == tg, bar);
      __builtin_amdgcn_fence(__ATOMIC_ACQUIRE, "agent");
      xb_add(&bar[XB_XGEN(b.x)], 1u);
      asm volatile("s_waitcnt vmcnt(0)" ::: "memory");
    } else {
      XB_SPIN(xb_ld(&bar[XB_XGEN(b.x)]) == gen, bar);
      __builtin_amdgcn_fence(__ATOMIC_ACQUIRE, "agent");
      asm volatile("s_waitcnt vmcnt(0)" ::: "memory");
    }
  }
  __syncthreads();
}

DI void transpose_tile(const float* src, int sld, int cv, bfu* dst, int dld, float* tile) {
  const int tid = threadIdx.x;
  __syncthreads();
  for (int i = tid; i < 4096; i += 256) {
    int r = i >> 6, c = i & 63;
    tile[r * 65 + c] = (c < cv) ? src[(size_t)r * sld + c] : 0.f;
  }
  __syncthreads();
  for (int i = tid; i < 4096; i += 256) {
    int n = i >> 6, k = i & 63;
    dst[(size_t)n * dld + k] = f2bf(tile[k * 65 + n]);
  }
}

template <int LSEL>
DI void convert_weights(const Params& p, unsigned char* smem) {
  const int tid = threadIdx.x;
  float* tile = (float*)smem;
  const int NJ = 3200 + 1024 + 16 + 16 + 64;
  for (int job = blockIdx.x; job < NJ; job += gridDim.x) {
    const float* src; int sld, cv = 64, dld; bfu* dst;
    if (job < 3200) {
      int l = job / 800, rem = job % 800, kt = rem / 50, nt = rem % 50;
      if (l != LSEL) continue;
      const int c0 = nt < 28 ? nt * 64 : (nt < 48 ? nt * 64 + 8 : 1792);
      src = p.w_in + (size_t)l * 1024 * DIN + (size_t)kt * 64 * DIN + c0; sld = DIN;
      cv = nt < 48 ? 64 : (nt == 48 ? 8 : 0);
      dst = p.wt_in + (size_t)l * PS * 1024 + (size_t)nt * 64 * 1024 + kt * 64; dld = 1024;
    } else if (job < 4224) {
      int j = job - 3200, l = j / 256, rem = j % 256, kt = rem / 16, nt = rem % 16;
      if (l != LSEL) continue;
      src = p.w_out + (size_t)l * 1048576 + (size_t)kt * 64 * 1024 + nt * 64; sld = 1024;
      dst = p.wt_out + (size_t)l * 1048576 + (size_t)nt * 64 * 1024 + kt * 64; dld = 1024;
    } else if (LSEL != 0) {
      continue;
    } else if (job < 4240) {
      int j = job - 4224; src = p.w_a + j * 4096; sld = 64; dst = p.wt_a + j * 4096; dld = 64;
    } else if (job < 4256) {
      int j = job - 4240; src = p.w_x + j * 4096; sld = 64; dst = p.wt_x + j * 4096; dld = 64;
    } else {
      int j = job - 4256, l = j / 16, rem = j % 16, kt = rem / 4, nt = rem % 4;
      src = p.w_glu + l * 65536 + kt * 64 * 256 + nt * 64; sld = 256;
      dst = p.wt_glu + l * 65536 + nt * 64 * 256 + kt * 64; dld = 256;
    }
    transpose_tile(src, sld, cv, dst, dld, tile);
  }
}

DI void phase0(const Params& p, unsigned char* smem) {
  const int tid = threadIdx.x;
  const int gtid = blockIdx.x * 256 + tid, gsz = gridDim.x * 256;
  for (int i = gtid; i < NTOK * DM / 8; i += gsz) {
    float4 a = ((const float4*)p.x)[2 * i], b = ((const float4*)p.x)[2 * i + 1];
    uint4 o; o.x = pack2(a.x, a.y); o.y = pack2(a.z, a.w); o.z = pack2(b.x, b.y); o.w = pack2(b.z, b.w);
    ((uint4*)p.hb)[i] = o;
  }
  convert_weights<0>(p, smem);
  for (int i = (gridDim.x - 1 - blockIdx.x) * 256 + tid; i < 4096; i += gsz) {
    int lg = i >> 6, pp = i & 63;
    double dt = exp((double)p.log_dt[lg]);
    double are = p.a_re[lg * 64 + pp], aim = p.a_im[lg * 64 + pp];
    double mag = exp(dt * are), ang = dt * aim;
    double abr = mag * cos(ang), abi = mag * sin(ang);
    double den = are * are + aim * aim;
    double xr = abr - 1.0, xi = abi;
    double zr = (xr * are + xi * aim) / den, zi = (xi * are - xr * aim) / den;
    bfu* o_re = p.bt_bu + ((size_t)lg * 128 + pp) * 32;
    bfu* o_im = p.bt_bu + ((size_t)lg * 128 + 64 + pp) * 32;
    for (int h = 0; h < 16; ++h) {
      double br = p.sb_re[(lg * 64 + pp) * 16 + h], bi = p.sb_im[(lg * 64 + pp) * 16 + h];
      o_re[h] = f2bf((float)(zr * br - zi * bi));
      o_im[h] = f2bf((float)(zr * bi + zi * br));
      o_re[16 + h] = 0; o_im[16 + h] = 0;
    }
    p.abar[(lg * 64 + pp) * 2 + 0] = (float)abr; p.abar[(lg * 64 + pp) * 2 + 1] = (float)abi;
    double mag64 = exp(64.0 * dt * are), ang64 = 64.0 * ang;
    p.abar64[(lg * 64 + pp) * 2 + 0] = (float)(mag64 * cos(ang64));
    p.abar64[(lg * 64 + pp) * 2 + 1] = (float)(mag64 * sin(ang64));
  }
  for (int i = gtid; i < 4 * 16 * 16 * 128; i += gsz) {
    int k = i & 127, lgn = i >> 7;
    p.bt_y[i] = (k < 64) ? f2bf(p.c_re[lgn * 64 + k]) : f2bf(-p.c_im[lgn * 64 + (k - 64)]);
  }
  for (int i = gtid; i < 256; i += gsz) {
    float v0 = p.lb_logits[i], v1 = p.lb_logits[256 + i], v2 = p.lb_logits[512 + i], v3 = p.lb_logits[768 + i];
    float m = fmaxf(fmaxf(v0, v1), fmaxf(v2, v3));
    float e0 = expf(v0 - m), e1 = expf(v1 - m), e2 = expf(v2 - m), e3 = expf(v3 - m);
    float s = e0 + e1 + e2 + e3;
    p.lbs[i] = 0.f; p.lbs[256 + i] = e1 / s; p.lbs[512 + i] = (e1 + e2) / s; p.lbs[768 + i] = (e1 + e2 + e3) / s;
  }
  for (int i = gtid; i < CNT_TOTAL; i += gsz) p.cnt[i] = 0u;
}

DI void gemm1_tile(const Params& p, int l, const bfu* A, const bfu* Bt, int m0, int n0, unsigned char* smem) {
  bfu* sA = (bfu*)smem; bfu* sB = sA + 128 * 72;
  bfu* sC = (bfu*)smem;
  const int tid = threadIdx.x, lane = tid & 63, w = tid >> 6, wm = w >> 1, wn = w & 1;
  const int r = lane & 15, q = lane >> 4;
  f32x4 acc[4][6];
#pragma unroll
  for (int i = 0; i < 4; ++i)
#pragma unroll
    for (int j = 0; j < 6; ++j) acc[i][j] = (f32x4){0.f, 0.f, 0.f, 0.f};
  const int lrow = tid >> 3, lkc = tid & 7;
  const bfu* ga = A + (size_t)(m0 + lrow) * 1024 + lkc * 8;
  const bfu* gb = Bt + (size_t)(n0 + lrow) * 1024 + lkc * 8;
  uint4 ra0 = *(const uint4*)(ga), ra1 = *(const uint4*)(ga + 32 * 1024), ra2 = *(const uint4*)(ga + 64 * 1024), ra3 = *(const uint4*)(ga + 96 * 1024);
  uint4 rb0 = *(const uint4*)(gb), rb1 = *(const uint4*)(gb + 32 * 1024), rb2 = *(const uint4*)(gb + 64 * 1024), rb3 = *(const uint4*)(gb + 96 * 1024);
  uint4 rb4 = *(const uint4*)(gb + 128 * 1024), rb5 = *(const uint4*)(gb + 160 * 1024);
  bfu* wa = sA + lrow * 72 + lkc * 8;
  bfu* wb = sB + lrow * 72 + lkc * 8;
  for (int kt = 0; kt < 16; ++kt) {
    __syncthreads();
    *(uint4*)(wa) = ra0; *(uint4*)(wa + 32 * 72) = ra1; *(uint4*)(wa + 64 * 72) = ra2; *(uint4*)(wa + 96 * 72) = ra3;
    *(uint4*)(wb) = rb0; *(uint4*)(wb + 32 * 72) = rb1; *(uint4*)(wb + 64 * 72) = rb2; *(uint4*)(wb + 96 * 72) = rb3;
    *(uint4*)(wb + 128 * 72) = rb4; *(uint4*)(wb + 160 * 72) = rb5;
    __syncthreads();
    if (kt + 1 < 16) {
      const bfu* ga2 = ga + (kt + 1) * 64; const bfu* gb2 = gb + (kt + 1) * 64;
      ra0 = *(const uint4*)(ga2); ra1 = *(const uint4*)(ga2 + 32 * 1024); ra2 = *(const uint4*)(ga2 + 64 * 1024); ra3 = *(const uint4*)(ga2 + 96 * 1024);
      rb0 = *(const uint4*)(gb2); rb1 = *(const uint4*)(gb2 + 32 * 1024); rb2 = *(const uint4*)(gb2 + 64 * 1024); rb3 = *(const uint4*)(gb2 + 96 * 1024);
      rb4 = *(const uint4*)(gb2 + 128 * 1024); rb5 = *(const uint4*)(gb2 + 160 * 1024);
    }
#pragma unroll
    for (int ks = 0; ks < 2; ++ks) {
      bf16x8 af[4], bfr[6];
#pragma unroll
      for (int mt = 0; mt < 4; ++mt) af[mt] = *(const bf16x8*)(sA + (wm * 64 + mt * 16 + r) * 72 + ks * 32 + q * 8);
#pragma unroll
      for (int nt = 0; nt < 6; ++nt) bfr[nt] = *(const bf16x8*)(sB + (wn * 96 + nt * 16 + r) * 72 + ks * 32 + q * 8);
#pragma unroll
      for (int mt = 0; mt < 4; ++mt)
#pragma unroll
        for (int nt = 0; nt < 6; ++nt) acc[mt][nt] = __builtin_amdgcn_mfma_f32_16x16x32_bf16(af[mt], bfr[nt], acc[mt][nt], 0, 0, 0);
    }
  }
  float bias[6];
#pragma unroll
  for (int nt = 0; nt < 6; ++nt) {
    const int col = n0 + wn * 96 + nt * 16 + r;
    bias[nt] = p.b_in[l * DIN + (col < 1792 ? col : col + 8)];
  }
  __syncthreads();
#pragma unroll
  for (int mt = 0; mt < 4; ++mt)
#pragma unroll
    for (int nt = 0; nt < 6; ++nt)
#pragma unroll
      for (int j = 0; j < 4; ++j)
        sC[(wm * 64 + mt * 16 + q * 4 + j) * 200 + wn * 96 + nt * 16 + r] = f2bf(acc[mt][nt][j] + bias[nt]);
  __syncthreads();
#pragma unroll
  for (int i = 0; i < 12; ++i) {
    const int id = tid + i * 256, row = id / 24, ch = id % 24;
    *(uint4*)(p.proj + (size_t)(m0 + row) * PS + n0 + ch * 8) = *(const uint4*)(sC + row * 200 + ch * 8);
  }
}

DI void gemm1_gates(const Params& p, int l, const bfu* A, const bfu* Bt, int m0) {
  const int tid = threadIdx.x, lane = tid & 63, w = tid >> 6, r = lane & 15, q = lane >> 4;
  const bfu* a0 = A + (size_t)(m0 + w * 32 + r) * 1024 + q * 8;
  const bfu* a1 = a0 + 16 * 1024;
  const bfu* bp = Bt + (size_t)(3072 + r) * 1024 + q * 8;
  f32x4 c0 = (f32x4){0.f, 0.f, 0.f, 0.f}, c1 = (f32x4){0.f, 0.f, 0.f, 0.f};
#pragma unroll 4
  for (int ks = 0; ks < 32; ++ks) {
    const bf16x8 b = *(const bf16x8*)(bp + ks * 32);
    const bf16x8 x0 = *(const bf16x8*)(a0 + ks * 32);
    const bf16x8 x1 = *(const bf16x8*)(a1 + ks * 32);
    c0 = __builtin_amdgcn_mfma_f32_16x16x32_bf16(x0, b, c0, 0, 0, 0);
    c1 = __builtin_amdgcn_mfma_f32_16x16x32_bf16(x1, b, c1, 0, 0, 0);
  }
  if (r < 8) {
    const float bias = p.b_in[l * DIN + 1792 + r];
#pragma unroll
    for (int j = 0; j < 4; ++j) {
      p.proj[(size_t)(m0 + w * 32 + q * 4 + j) * PS + 3072 + r] = f2bf(c0[j] + bias);
      p.proj[(size_t)(m0 + w * 32 + 16 + q * 4 + j) * PS + 3072 + r] = f2bf(c1[j] + bias);
    }
  }
}

DI void phase1(const Params& p, int l, unsigned char* smem) {
  const bfu* Bt = p.wt_in + (size_t)l * PS * 1024;
  for (int tile = blockIdx.x; tile < 128 * 16; tile += gridDim.x) { const int mt = tile >> 4, nt = tile & 15; gemm1_tile(p, l, p.hb, Bt, mt * 128, nt * 192, smem); }
  for (int job = blockIdx.x; job < 128; job += gridDim.x) gemm1_gates(p, l, p.hb, Bt, job * 128);
}

template <int EPI>
DI void gemm2_tile(const Params& p, int l, const bfu* A, const bfu* Bt, int m0, int n0, const float* hin, unsigned char* smem) {
  bfu* sA = (bfu*)smem; bfu* sB = sA + 128 * 72;
  const int tid = threadIdx.x, lane = tid & 63, w = tid >> 6, wm = w >> 1, wn = w & 1;
  const int r = lane & 15, q = lane >> 4;
  f32x4 acc[4][4];
#pragma unroll
  for (int i = 0; i < 4; ++i)
#pragma unroll
    for (int j = 0; j < 4; ++j) acc[i][j] = (f32x4){0.f, 0.f, 0.f, 0.f};
  const int lrow = tid >> 3, lkc = tid & 7;
  const bfu* ga = A + (size_t)(m0 + lrow) * 1024 + lkc * 8;
  const bfu* gb = Bt + (size_t)(n0 + lrow) * 1024 + lkc * 8;
  uint4 ra0 = *(const uint4*)(ga), ra1 = *(const uint4*)(ga + 32 * 1024), ra2 = *(const uint4*)(ga + 64 * 1024), ra3 = *(const uint4*)(ga + 96 * 1024);
  uint4 rb0 = *(const uint4*)(gb), rb1 = *(const uint4*)(gb + 32 * 1024), rb2 = *(const uint4*)(gb + 64 * 1024), rb3 = *(const uint4*)(gb + 96 * 1024);
  bfu* wa = sA + lrow * 72 + lkc * 8;
  bfu* wb = sB + lrow * 72 + lkc * 8;
  for (int kt = 0; kt < 16; ++kt) {
    __syncthreads();
    *(uint4*)(wa) = ra0; *(uint4*)(wa + 32 * 72) = ra1; *(uint4*)(wa + 64 * 72) = ra2; *(uint4*)(wa + 96 * 72) = ra3;
    *(uint4*)(wb) = rb0; *(uint4*)(wb + 32 * 72) = rb1; *(uint4*)(wb + 64 * 72) = rb2; *(uint4*)(wb + 96 * 72) = rb3;
    __syncthreads();
    if (kt + 1 < 16) {
      const bfu* ga2 = ga + (kt + 1) * 64; const bfu* gb2 = gb + (kt + 1) * 64;
      ra0 = *(const uint4*)(ga2); ra1 = *(const uint4*)(ga2 + 32 * 1024); ra2 = *(const uint4*)(ga2 + 64 * 1024); ra3 = *(const uint4*)(ga2 + 96 * 1024);
      rb0 = *(const uint4*)(gb2); rb1 = *(const uint4*)(gb2 + 32 * 1024); rb2 = *(const uint4*)(gb2 + 64 * 1024); rb3 = *(const uint4*)(gb2 + 96 * 1024);
    }
#pragma unroll
    for (int ks = 0; ks < 2; ++ks) {
      bf16x8 af[4], bfr[4];
#pragma unroll
      for (int mt = 0; mt < 4; ++mt) af[mt] = *(const bf16x8*)(sA + (wm * 64 + mt * 16 + r) * 72 + ks * 32 + q * 8);
#pragma unroll
      for (int nt = 0; nt < 4; ++nt) bfr[nt] = *(const bf16x8*)(sB + (wn * 64 + nt * 16 + r) * 72 + ks * 32 + q * 8);
#pragma unroll
      for (int mt = 0; mt < 4; ++mt)
#pragma unroll
        for (int nt = 0; nt < 4; ++nt) acc[mt][nt] = __builtin_amdgcn_mfma_f32_16x16x32_bf16(af[mt], bfr[nt], acc[mt][nt], 0, 0, 0);
    }
  }
#pragma unroll
  for (int nt = 0; nt < 4; ++nt) {
    const int col = n0 + wn * 64 + nt * 16 + r;
    if (EPI == 1) {
      const float bias = (col < DIN) ? p.b_in[l * DIN + col] : 0.f;
#pragma unroll
      for (int mt = 0; mt < 4; ++mt)
#pragma unroll
        for (int j = 0; j < 4; ++j) {
          const int row = m0 + wm * 64 + mt * 16 + q * 4 + j;
          p.proj[(size_t)row * PS + col] = f2bf(acc[mt][nt][j] + bias);
        }
    } else {
      const float bias = p.b_out[l * 1024 + col];
      float hv[4][4];
#pragma unroll
      for (int mt = 0; mt < 4; ++mt)
#pragma unroll
        for (int j = 0; j < 4; ++j) hv[mt][j] = hin[(size_t)(m0 + wm * 64 + mt * 16 + q * 4 + j) * 1024 + col];
#pragma unroll
      for (int mt = 0; mt < 4; ++mt)
#pragma unroll
        for (int j = 0; j < 4; ++j) {
          const int row = m0 + wm * 64 + mt * 16 + q * 4 + j;
          p.out[(size_t)row * 1024 + col] = DN_ALPHA * hv[mt][j] + acc[mt][nt][j] + bias;
        }
    }
  }
}


DI void phase5(const Params& p, int l, unsigned char* smem, unsigned long long& tp_acc) {
  const bfu* Bt = p.wt_out + (size_t)l * 1048576;
  const float* hin = (l == 0) ? p.x : p.out;
  for (int tile = blockIdx.x; tile < 128 * 8; tile += gridDim.x) gemm2_tile<2>(p, l, p.mixed, Bt, (tile >> 3) * 128, (tile & 7) * 128, hin, smem);
}

DI void phase6(const Params& p, int l) {
  const int tid = threadIdx.x, lane = tid & 63, w = tid >> 6;
  float4 g[4], bb[4];
#pragma unroll
  for (int i = 0; i < 4; ++i) { g[i] = *(const float4*)(p.ln_g + l * 1024 + i * 256 + lane * 4); bb[i] = *(const float4*)(p.ln_b + l * 1024 + i * 256 + lane * 4); }
  for (int rb = blockIdx.x; rb < NTOK / 16; rb += gridDim.x) {
    const int row0 = rb * 16 + w * 4;
    float4 v[4][4];
#pragma unroll
    for (int rr = 0; rr < 4; ++rr)
#pragma unroll
      for (int i = 0; i < 4; ++i) v[rr][i] = *(const float4*)(p.out + (size_t)(row0 + rr) * 1024 + i * 256 + lane * 4);
#pragma unroll
    for (int rr = 0; rr < 4; ++rr) {
      float sm = 0.f;
#pragma unroll
      for (int i = 0; i < 4; ++i) sm += v[rr][i].x + v[rr][i].y + v[rr][i].z + v[rr][i].w;
      const float mu = wave_sum(sm) * (1.f / 1024.f);
      float ss = 0.f;
#pragma unroll
      for (int i = 0; i < 4; ++i) {
        v[rr][i].x -= mu; v[rr][i].y -= mu; v[rr][i].z -= mu; v[rr][i].w -= mu;
        ss += v[rr][i].x * v[rr][i].x + v[rr][i].y * v[rr][i].y + v[rr][i].z * v[rr][i].z + v[rr][i].w * v[rr][i].w;
      }
      const float rs = rsqrtf(wave_sum(ss) * (1.f / 1024.f) + 1e-5f);
#pragma unroll
      for (int i = 0; i < 4; ++i) {
        const int c = i * 256 + lane * 4;
        float4 o;
        o.x = v[rr][i].x * rs * g[i].x + bb[i].x; o.y = v[rr][i].y * rs * g[i].y + bb[i].y;
        o.z = v[rr][i].z * rs * g[i].z + bb[i].z; o.w = v[rr][i].w * rs * g[i].w + bb[i].w;
        *(float4*)(p.out + (size_t)(row0 + rr) * 1024 + c) = o;
        uint2 ob; ob.x = pack2(o.x, o.y); ob.y = pack2(o.z, o.w);
        *(uint2*)(p.hb + (size_t)(row0 + rr) * 1024 + c) = ob;
      }
    }
  }
}

DI void hg_gate(float x, float lb, float& lf, float& k) {
  x = fmaxf(x, -80.f);
  const float E = fexp(-x);
  const float sg = frcp(1.f + E);
  k = (1.f - lb) * (E * sg);
  lf = flog(lb + (1.f - lb) * sg);
}

DI void hg_local(const Params& p, int l, int b, int c, int hd, unsigned char* smem) {
  const int tid = threadIdx.x, lane = tid & 63, w = tid >> 6;
  bfu* At = (bfu*)smem;
  bfu* Bt = At + 64 * 72;
  float* segtot = (float*)(smem + 2 * 64 * 72 * 2);
  const int tok0 = b * SEQ + c * 64;
  const int d = lane;
  const float lb = p.lbs[l * 256 + hd * 64 + d];
  const bfu* pf = p.proj + (size_t)tok0 * PS + COL_AF + hd * 64 + d;
  const bfu* pv = p.proj + (size_t)tok0 * PS + COL_AI + hd * 64 + d;
  float bl[16], kk[16];
  float run = 0.f;
  __syncthreads();
#pragma unroll
  for (int i = 0; i < 16; ++i) {
    const int t = w * 16 + i;
    float lf, k; hg_gate(bf2f(pf[(size_t)t * PS]), lb, lf, k);
    run += lf; bl[i] = run; kk[i] = k;
    At[d * 72 + t] = pv[(size_t)t * PS];
  }
  segtot[w * 64 + d] = run;
  __syncthreads();
  float off = 0.f, tot = 0.f;
#pragma unroll
  for (int s = 0; s < 4; ++s) { float v = segtot[s * 64 + d]; tot += v; if (s < w) off += v; }
#pragma unroll
  for (int i = 0; i < 16; ++i) { const int t = w * 16 + i; Bt[d * 72 + t] = f2bf(kk[i] * fexp(tot - (bl[i] + off))); }
  const int base = (b * NCH + c) * 4 + hd;
  if (w == 0) p.hg_decay[base * 64 + d] = fexp(tot);
  __syncthreads();
  f32x4 acc[4];
#pragma unroll
  for (int i = 0; i < 4; ++i) acc[i] = (f32x4){0.f, 0.f, 0.f, 0.f};
  wave_mma<4, 2>(acc, At + w * 16 * 72, 72, Bt, 72, lane);
  float* st = p.hg_state + (size_t)base * 4096;
  const int r = lane & 15, q = lane >> 4;
#pragma unroll
  for (int nt = 0; nt < 4; ++nt)
#pragma unroll
    for (int j = 0; j < 4; ++j) st[(w * 16 + q * 4 + j) * 64 + nt * 16 + r] = acc[nt][j];
}

constexpr int O_A = 0, O_BT = 17408, O_QP = 34816, O_KP = 44032, O_MISC = 53248;

DI void hg_out(const Params& p, int l, int b, int c, int hd, unsigned char* smem) {
  const int tid = threadIdx.x, lane = tid & 63, w = tid >> 6;
  bfu* A = (bfu*)(smem + O_A); bfu* Bt = (bfu*)(smem + O_BT); bfu* Qp = (bfu*)(smem + O_QP); bfu* Kp = (bfu*)(smem + O_KP);
  float* segtot = (float*)(smem + O_MISC);
  const int tok0 = b * SEQ + c * 64;
  const int d = lane;
  const float lb = p.lbs[l * 256 + hd * 64 + d];
  const bfu* pq = p.proj + (size_t)tok0 * PS + COL_AQ + hd * 64 + d;
  const bfu* pf = p.proj + (size_t)tok0 * PS + COL_AF + hd * 64 + d;
  const bfu* pv = p.proj + (size_t)tok0 * PS + COL_AI + hd * 64 + d;
  const int base = (b * NCH + c) * 4 + hd;
  const float* st = p.hg_state + (size_t)base * 4096;
  float bl[16], kk[16];
  float run = 0.f;
  const int r = lane & 15, q = lane >> 4;
  bfu fraw[16], vraw[16], qraw[16]; float sraw[16];
#pragma unroll
  for (int i = 0; i < 16; ++i) {
    const int t = w * 16 + i;
    fraw[i] = pf[(size_t)t * PS]; vraw[i] = pv[(size_t)t * PS]; qraw[i] = pq[(size_t)t * PS]; sraw[i] = st[(w + 4 * i) * 64 + d];
  }
  bfu gt[4][4]; float gw[4];
#pragma unroll
  for (int nt = 0; nt < 4; ++nt) {
    gw[nt] = p.hg_g[l * 256 + hd * 64 + nt * 16 + r];
#pragma unroll
    for (int j = 0; j < 4; ++j) gt[j][nt] = p.proj[(size_t)(tok0 + w * 16 + q * 4 + j) * PS + COL_AG + hd * 64 + nt * 16 + r];
  }
  __syncthreads();
#pragma unroll
  for (int i = 0; i < 16; ++i) {
    const int t = w * 16 + i;
    float lf, k; hg_gate(bf2f(fraw[i]), lb, lf, k);
    run += lf; bl[i] = run; kk[i] = k;
    Bt[d * 136 + t] = vraw[i];
    const int e = w + 4 * i;
    Bt[e * 136 + 64 + d] = f2bf(sraw[i]);
  }
  segtot[w * 64 + d] = run;
  __syncthreads();
  float off = 0.f;
#pragma unroll
  for (int s = 0; s < 4; ++s) { float v = segtot[s * 64 + d]; if (s < w) off += v; }
  const float bm = segtot[d] + segtot[64 + d];
#pragma unroll
  for (int i = 0; i < 16; ++i) {
    const int t = w * 16 + i;
    const float bt = bl[i] + off;
    const float qv = silu_(bf2f(qraw[i]));
    Qp[t * 72 + d] = f2bf(qv * fexp(fmaxf(bt - bm, -80.f)));
    Kp[t * 72 + d] = f2bf(kk[i] * fexp(fminf(bm - bt, 80.f)));
    A[t * 136 + 64 + d] = f2bf(qv * fexp(bt));
  }
  __syncthreads();
  f32x4 acc[4];
#pragma unroll
  for (int i = 0; i < 4; ++i) acc[i] = (f32x4){0.f, 0.f, 0.f, 0.f};
  wave_mma<4, 2>(acc, Qp + w * 16 * 72, 72, Kp, 72, lane);
#pragma unroll
  for (int nt = 0; nt < 4; ++nt)
#pragma unroll
    for (int j = 0; j < 4; ++j) {
      const int t = w * 16 + q * 4 + j, s = nt * 16 + r;
      A[t * 136 + s] = f2bf(s <= t ? acc[nt][j] : 0.f);
    }
  __syncthreads();
  f32x4 o[4];
#pragma unroll
  for (int i = 0; i < 4; ++i) o[i] = (f32x4){0.f, 0.f, 0.f, 0.f};
  wave_mma<4, 4>(o, A + w * 16 * 136, 136, Bt, 136, lane);
#pragma unroll
  for (int j = 0; j < 4; ++j) {
    float ss = 0.f;
#pragma unroll
    for (int nt = 0; nt < 4; ++nt) ss += o[nt][j] * o[nt][j];
    ss = group16_sum(ss);
    const float sc = rsqrtf(ss * (1.f / 64.f) + 1e-6f);
    const int t = w * 16 + q * 4 + j;
    bfu* mrow = p.mixed + (size_t)(tok0 + t) * 1024 + hd * 64;
#pragma unroll
    for (int nt = 0; nt < 4; ++nt) {
      const int e = nt * 16 + r;
      mrow[e] = f2bf(o[nt][j] * sc * gw[nt] * silu_(bf2f(gt[j][nt])));
    }
  }
}

DI void ml_gates(const Params& p, int l, int tok0, int hd, float* bs, float* igs, int tid) {
  if (tid < 64) {
    const bfu* row = p.proj + (size_t)(tok0 + tid) * PS;
    const float ig = bf2f(row[COL_BIG + hd]);
    const float fg = bf2f(row[COL_BFG + hd]) + p.ml_fb[l * 4 + hd];
    float lf = logsig_(fg);
#pragma unroll
    for (int o = 1; o < 64; o <<= 1) { float v = __shfl_up(lf, o); if (tid >= o) lf += v; }
    bs[tid] = lf; igs[tid] = ig;
  }
}

DI void ml_local(const Params& p, int l, int b, int c, int hd, unsigned char* smem) {
  const int tid = threadIdx.x, lane = tid & 63, w = tid >> 6;
  bfu* At = (bfu*)smem;
  bfu* Bt = At + 64 * 72;
  float* bs = (float*)(smem + 2 * 64 * 72 * 2);
  float* igs = bs + 64; float* nseg = igs + 64;
  const int tok0 = b * SEQ + c * 64;
  const int d = lane;
  const bfu* pk = p.proj + (size_t)tok0 * PS + COL_BK + hd * 64 + d;
  const bfu* pv = p.proj + (size_t)tok0 * PS + COL_BV + hd * 64 + d;
  bfu kraw[16], vraw[16];
#pragma unroll
  for (int i = 0; i < 16; ++i) { kraw[i] = pk[(size_t)(w * 16 + i) * PS]; vraw[i] = pv[(size_t)(w * 16 + i) * PS]; }
  __syncthreads();
  ml_gates(p, l, tok0, hd, bs, igs, tid);
  __syncthreads();
  const float blast = bs[63];
  float nacc = 0.f;
#pragma unroll
  for (int i = 0; i < 16; ++i) {
    const int s = w * 16 + i;
    const float ws = fexp(blast - bs[s] + igs[s]);
    const float kw = bf2f(kraw[i]) * 0.125f * ws;
    Bt[d * 72 + s] = f2bf(kw); nacc += kw;
    At[d * 72 + s] = vraw[i];
  }
  nseg[w * 64 + d] = nacc;
  __syncthreads();
  const int base = (b * NCH + c) * 4 + hd;
  if (w == 0) p.ml_n[base * 64 + d] = nseg[d] + nseg[64 + d] + nseg[128 + d] + nseg[192 + d];
  if (tid == 0) p.ml_decay[base] = fexp(blast);
  f32x4 acc[4];
#pragma unroll
  for (int i = 0; i < 4; ++i) acc[i] = (f32x4){0.f, 0.f, 0.f, 0.f};
  wave_mma<4, 2>(acc, At + w * 16 * 72, 72, Bt, 72, lane);
  float* st = p.ml_state + (size_t)base * 4096;
  const int r = lane & 15, q = lane >> 4;
#pragma unroll
  for (int nt = 0; nt < 4; ++nt)
#pragma unroll
    for (int j = 0; j < 4; ++j) st[(w * 16 + q * 4 + j) * 64 + nt * 16 + r] = acc[nt][j];
}

DI void ml_out(const Params& p, int l, int b, int c, int hd, unsigned char* smem) {
  const int tid = threadIdx.x, lane = tid & 63, w = tid >> 6;
  bfu* A = (bfu*)(smem + O_A); bfu* Bt = (bfu*)(smem + O_BT); bfu* Qp = (bfu*)(smem + O_QP); bfu* Kp = (bfu*)(smem + O_KP);
  float* bs = (float*)(smem + O_MISC); float* igs = bs + 64; float* npv = igs + 64; float* den2 = npv + 64;
  const int tok0 = b * SEQ + c * 64;
  const int d = lane;
  const int base = (b * NCH + c) * 4 + hd;
  const float* st = p.ml_state + (size_t)base * 4096;
  const int r = lane & 15, q = lane >> 4;
  const bfu* pq = p.proj + (size_t)tok0 * PS + COL_BQ + hd * 64 + d;
  const bfu* pk = p.proj + (size_t)tok0 * PS + COL_BK + hd * 64 + d;
  const bfu* pv = p.proj + (size_t)tok0 * PS + COL_BV + hd * 64 + d;
  bfu qraw[16], kraw[16], vraw[16]; float sraw[16];
#pragma unroll
  for (int i = 0; i < 16; ++i) {
    const int t = w * 16 + i;
    qraw[i] = pq[(size_t)t * PS]; kraw[i] = pk[(size_t)t * PS]; vraw[i] = pv[(size_t)t * PS]; sraw[i] = st[(w + 4 * i) * 64 + d];
  }
  bfu gt[4][4]; float gw[4];
#pragma unroll
  for (int nt = 0; nt < 4; ++nt) {
    gw[nt] = p.ml_g[l * 256 + hd * 64 + nt * 16 + r];
#pragma unroll
    for (int j = 0; j < 4; ++j) gt[j][nt] = p.proj[(size_t)(tok0 + w * 16 + q * 4 + j) * PS + COL_BG + hd * 64 + nt * 16 + r];
  }
  __syncthreads();
  ml_gates(p, l, tok0, hd, bs, igs, tid);
  if (tid >= 64 && tid < 128) npv[tid - 64] = p.ml_n[base * 64 + tid - 64];
  __syncthreads();
#pragma unroll
  for (int i = 0; i < 16; ++i) {
    const int t = w * 16 + i;
    Qp[t * 72 + d] = qraw[i];
    Kp[t * 72 + d] = kraw[i];
    A[t * 136 + 64 + d] = f2bf(bf2f(qraw[i]) * fexp(bs[t]));
    Bt[d * 136 + t] = vraw[i];
    const int e = w + 4 * i;
    Bt[e * 136 + 64 + d] = f2bf(sraw[i]);
  }
  __syncthreads();
  if (tid < 64) {
    float s = 0.f;
    for (int dd = 0; dd < 64; ++dd) s += bf2f(A[tid * 136 + 64 + dd]) * npv[dd];
    den2[tid] = s;
  }
  f32x4 acc[4];
#pragma unroll
  for (int i = 0; i < 4; ++i) acc[i] = (f32x4){0.f, 0.f, 0.f, 0.f};
  wave_mma<4, 2>(acc, Qp + w * 16 * 72, 72, Kp, 72, lane);
  float den1[4];
#pragma unroll
  for (int j = 0; j < 4; ++j) {
    const int t = w * 16 + q * 4 + j;
    const float bt = bs[t];
    float rs = 0.f;
#pragma unroll
    for (int nt = 0; nt < 4; ++nt) {
      const int s = nt * 16 + r;
      float wv = 0.f;
      if (s <= t) wv = fexp(bt - bs[s] + igs[s]) * acc[nt][j] * 0.125f;
      rs += wv;
      A[t * 136 + s] = f2bf(wv);
    }
    den1[j] = group16_sum(rs);
  }
  __syncthreads();
  f32x4 o[4];
#pragma unroll
  for (int i = 0; i < 4; ++i) o[i] = (f32x4){0.f, 0.f, 0.f, 0.f};
  wave_mma<4, 4>(o, A + w * 16 * 136, 136, Bt, 136, lane);
#pragma unroll
  for (int j = 0; j < 4; ++j) {
    const int t = w * 16 + q * 4 + j;
    const float den = den1[j] + den2[t];
    const float inv = frcp(fmaxf(fabsf(den), 1.f));
    float hv[4];
    float ss = 0.f;
#pragma unroll
    for (int nt = 0; nt < 4; ++nt) { hv[nt] = o[nt][j] * inv; ss += hv[nt] * hv[nt]; }
    ss = group16_sum(ss);
    const float sc = rsqrtf(ss * (1.f / 64.f) + 1e-6f);
    bfu* mrow = p.mixed + (size_t)(tok0 + t) * 1024 + 256 + hd * 64;
#pragma unroll
    for (int nt = 0; nt < 4; ++nt) {
      const int e = nt * 16 + r;
      mrow[e] = f2bf(hv[nt] * sc * gw[nt] * silu_(bf2f(gt[j][nt])));
    }
  }
}

template <bool FINAL>
DI void lru_item(const Params& p, int l, int b, int c, int n, unsigned char* smem) {
  const int tid = threadIdx.x, lane = tid & 63, w = tid >> 6;
  bfu* xcb = (bfu*)smem;
  float* xcf = (float*)(smem + 9216);
  float* af = (float*)(smem + 9216 + 17408);
  float* segH = (float*)(smem + 9216 + 2 * 17408);
  float* segA = segH + 256;
  const int tok0 = b * SEQ + c * 64;
  const int ch = n * 64 + lane;
  const int r = lane & 15, q = lane >> 4;
  bf16x8 wfa[2][4], wfx[2][4];
#pragma unroll
  for (int ks = 0; ks < 2; ++ks)
#pragma unroll
    for (int nt = 0; nt < 4; ++nt) {
      wfa[ks][nt] = *(const bf16x8*)(p.wt_a + (l * 4 + n) * 4096 + (nt * 16 + r) * 64 + ks * 32 + q * 8);
      wfx[ks][nt] = *(const bf16x8*)(p.wt_x + (l * 4 + n) * 4096 + (nt * 16 + r) * 64 + ks * 32 + q * 8);
    }
  float e_ba[4], e_bx[4], e_lam[4];
#pragma unroll
  for (int nt = 0; nt < 4; ++nt) {
    const int che = n * 64 + nt * 16 + r;
    e_ba[nt] = p.b_a[l * 256 + che]; e_bx[nt] = p.b_x[l * 256 + che]; e_lam[nt] = p.lam[l * 256 + che];
  }
  const int sidx = (b * NCH + c) * 256 + ch;
  float Hprev = 0.f;
  bfu gq[16];
  if (FINAL) {
    Hprev = p.lru_h[sidx];
    const bfu* pg0 = p.proj + (size_t)tok0 * PS + COL_CG + ch;
#pragma unroll
    for (int i = 0; i < 16; ++i) gq[i] = pg0[(size_t)(w * 16 + i) * PS];
  }
  __syncthreads();
  {
    const float cw0 = p.conv_w[(l * 4 + 0) * 256 + ch], cw1 = p.conv_w[(l * 4 + 1) * 256 + ch];
    const float cw2 = p.conv_w[(l * 4 + 2) * 256 + ch], cw3 = p.conv_w[(l * 4 + 3) * 256 + ch];
    const float cb = p.conv_b[l * 256 + ch];
    const bfu* px = p.proj + (size_t)tok0 * PS + COL_CX + ch;
#pragma unroll
    for (int i = 0; i < 16; ++i) {
      const int t = w * 16 + i;
      const int sp = c * 64 + t;
      float x0 = (sp >= 3) ? bf2f(px[(ptrdiff_t)(t - 3) * PS]) : 0.f;
      float x1 = (sp >= 2) ? bf2f(px[(ptrdiff_t)(t - 2) * PS]) : 0.f;
      float x2 = (sp >= 1) ? bf2f(px[(ptrdiff_t)(t - 1) * PS]) : 0.f;
      float x3 = bf2f(px[(ptrdiff_t)t * PS]);
      const float xc = cb + cw0 * x0 + cw1 * x1 + cw2 * x2 + cw3 * x3;
      xcf[t * 68 + lane] = xc;
      xcb[t * 72 + lane] = f2bf(xc);
    }
  }
  __syncthreads();
  f32x4 aa[4], ax[4];
#pragma unroll
  for (int i = 0; i < 4; ++i) { aa[i] = (f32x4){0.f, 0.f, 0.f, 0.f}; ax[i] = (f32x4){0.f, 0.f, 0.f, 0.f}; }
#pragma unroll
  for (int ks = 0; ks < 2; ++ks) {
    const bf16x8 afr = *(const bf16x8*)(xcb + (w * 16 + r) * 72 + ks * 32 + q * 8);
#pragma unroll
    for (int nt = 0; nt < 4; ++nt) {
      aa[nt] = __builtin_amdgcn_mfma_f32_16x16x32_bf16(afr, wfa[ks][nt], aa[nt], 0, 0, 0);
      ax[nt] = __builtin_amdgcn_mfma_f32_16x16x32_bf16(afr, wfx[ks][nt], ax[nt], 0, 0, 0);
    }
  }
#pragma unroll
  for (int nt = 0; nt < 4; ++nt) {
    const int e = nt * 16 + r;
    const float ba = e_ba[nt], bx = e_bx[nt];
    const float lsl = 8.f * logsig_acc(e_lam[nt]);
#pragma unroll
    for (int j = 0; j < 4; ++j) {
      const int t = w * 16 + q * 4 + j;
      const float rg = sigmoid_(aa[nt][j] + ba), ig = sigmoid_(ax[nt][j] + bx);
      const float la = lsl * rg;
      const float a = fexp(la);
      const float y2 = 2.f * la;
      const float em = (y2 > -0.05f) ? -y2 * (1.f + y2 * (0.5f + y2 * (0.16666667f + y2 * 0.041666668f))) : 1.f - a * a;
      const float bv = __builtin_amdgcn_sqrtf(fmaxf(em, 0.f)) * ig * xcf[t * 68 + e];
      af[t * 68 + e] = a; xcf[t * 68 + e] = bv;
    }
  }
  __syncthreads();
  float hl[16], al[16];
  float h = 0.f, ap = 1.f;
#pragma unroll
  for (int i = 0; i < 16; ++i) {
    const int t = w * 16 + i;
    const float a = af[t * 68 + lane], bv = xcf[t * 68 + lane];
    h = a * h + bv; ap *= a; hl[i] = h; al[i] = ap;
  }
  segH[w * 64 + lane] = h; segA[w * 64 + lane] = ap;
  __syncthreads();
  if (!FINAL) {
    if (w == 0) {
      float H = 0.f, Ap = 1.f;
#pragma unroll
      for (int s = 0; s < 4; ++s) { H = segA[s * 64 + lane] * H + segH[s * 64 + lane]; Ap *= segA[s * 64 + lane]; }
      p.lru_h[sidx] = H; p.lru_a[sidx] = Ap;
    }
  } else {
    float H = Hprev;
#pragma unroll
    for (int s = 0; s < 4; ++s) if (s < w) H = segA[s * 64 + lane] * H + segH[s * 64 + lane];
    bfu* pm = p.mixed + (size_t)tok0 * 1024 + 512 + ch;
#pragma unroll
    for (int i = 0; i < 16; ++i) {
      const int t = w * 16 + i;
      const float hv = hl[i] + al[i] * H;
      pm[(size_t)t * 1024] = f2bf(hv * silu_(bf2f(gq[i])));
    }
  }
}

template <bool FINAL>
DI void s5_item(const Params& p, int l, int b, int c, int g4, unsigned char* smem) {
  const int tid = threadIdx.x, lane = tid & 63, w = tid >> 6;
  const int g = g4 * 4 + w;
  float* buw = (float*)(smem + w * 13312);
  bfu* stw = (bfu*)(smem + w * 13312 + 8448);
  const int tok0 = b * SEQ + c * 64;
  const int r = lane & 15, q = lane >> 4;
  const int lg = l * 16 + g;
  bf16x8 bfr[8], yfr[4];
#pragma unroll
  for (int nt = 0; nt < 8; ++nt) bfr[nt] = *(const bf16x8*)(p.bt_bu + ((size_t)lg * 128 + nt * 16 + r) * 32 + q * 8);
  if (FINAL) {
#pragma unroll
    for (int ks = 0; ks < 4; ++ks) yfr[ks] = *(const bf16x8*)(p.bt_y + ((size_t)lg * 16 + r) * 128 + ks * 32 + q * 8);
  }
  const float ar = p.abar[(lg * 64 + lane) * 2], ai = p.abar[(lg * 64 + lane) * 2 + 1];
  const size_t sbase = ((size_t)(b * NCH + c) * 16 + g) * 128;
  float xr = 0.f, xi = 0.f;
  if (FINAL) { xr = p.s5_state[sbase + lane]; xi = p.s5_state[sbase + 64 + lane]; }
  const float dsk = FINAL ? p.s5_d[l * 256 + g * 16 + r] : 0.f;
  bf16x8 afr[4];
  bfu uq[4][4];
#pragma unroll
  for (int mt = 0; mt < 4; ++mt) {
    afr[mt] = (bf16x8){0, 0, 0, 0, 0, 0, 0, 0};
    if (q < 2) afr[mt] = *(const bf16x8*)(p.proj + (size_t)(tok0 + mt * 16 + r) * PS + COL_DU + g * 16 + q * 8);
    if (FINAL) {
#pragma unroll
      for (int j = 0; j < 4; ++j) uq[mt][j] = p.proj[(size_t)(tok0 + mt * 16 + q * 4 + j) * PS + COL_DU + g * 16 + r];
    }
  }
  __syncthreads();
#pragma unroll
  for (int mt = 0; mt < 4; ++mt) {
    const bf16x8 a = afr[mt];
#pragma unroll
    for (int nt = 0; nt < 8; ++nt) {
      f32x4 acc = (f32x4){0.f, 0.f, 0.f, 0.f};
      acc = __builtin_amdgcn_mfma_f32_16x16x32_bf16(a, bfr[nt], acc, 0, 0, 0);
#pragma unroll
      for (int j = 0; j < 4; ++j) buw[(q * 4 + j) * 132 + nt * 16 + r] = acc[j];
    }
    wave_sync();
    {
      float br[16], bi[16];
#pragma unroll
      for (int tt = 0; tt < 16; ++tt) { br[tt] = buw[tt * 132 + lane]; bi[tt] = buw[tt * 132 + 64 + lane]; }
#pragma unroll
      for (int tt = 0; tt < 16; ++tt) {
        const float nr = ar * xr - ai * xi + br[tt];
        const float ni = ar * xi + ai * xr + bi[tt];
        xr = nr; xi = ni;
        br[tt] = xr; bi[tt] = xi;
      }
      if (FINAL) {
#pragma unroll
        for (int tt = 0; tt < 16; ++tt) { stw[tt * 136 + lane] = f2bf(br[tt]); stw[tt * 136 + 64 + lane] = f2bf(bi[tt]); }
      }
    }
    wave_sync();
    if (FINAL) {
      f32x4 y = (f32x4){0.f, 0.f, 0.f, 0.f};
#pragma unroll
      for (int ks = 0; ks < 4; ++ks) {
        bf16x8 a2 = *(const bf16x8*)(stw + r * 136 + ks * 32 + q * 8);
        y = __builtin_amdgcn_mfma_f32_16x16x32_bf16(a2, yfr[ks], y, 0, 0, 0);
      }
#pragma unroll
      for (int j = 0; j < 4; ++j) {
        const int t = mt * 16 + q * 4 + j;
        const float z = gelu_tanh_(y[j] + dsk * bf2f(uq[mt][j]));
        p.zbuf[(size_t)(tok0 + t) * 256 + g * 16 + r] = f2bf(z);
      }
      wave_sync();
    }
  }
  if (!FINAL) { p.s5_state[sbase + lane] = xr; p.s5_state[sbase + 64 + lane] = xi; }
}

DI void s5_glu(const Params& p, int l, int b, int c, unsigned char* smem) {
  const int tid = threadIdx.x, lane = tid & 63, w = tid >> 6;
  bfu* zs = (bfu*)smem;
  const int tok0 = b * SEQ + c * 64;
  const int r = lane & 15, q = lane >> 4;
  __syncthreads();
#pragma unroll
  for (int i = 0; i < 8; ++i) {
    const int id = tid + i * 256;
    *(uint4*)(zs + (id >> 5) * 264 + (id & 31) * 8) = *(const uint4*)(p.zbuf + (size_t)(tok0 + (id >> 5)) * 256 + (id & 31) * 8);
  }
  __syncthreads();
  const bfu* wg = p.wt_glu + l * 65536;
#pragma unroll 1
  for (int nc = 0; nc < 4; ++nc) {
    bfu gq[4][4]; float bgv[4];
#pragma unroll
    for (int nt = 0; nt < 4; ++nt) {
      bgv[nt] = p.b_glu[l * 256 + nc * 64 + nt * 16 + r];
#pragma unroll
      for (int j = 0; j < 4; ++j) gq[nt][j] = p.proj[(size_t)(tok0 + w * 16 + q * 4 + j) * PS + COL_DG + nc * 64 + nt * 16 + r];
    }
    f32x4 acc[4];
#pragma unroll
    for (int i = 0; i < 4; ++i) acc[i] = (f32x4){0.f, 0.f, 0.f, 0.f};
#pragma unroll
    for (int kh = 0; kh < 2; ++kh) {
      bf16x8 bq[4][4];
#pragma unroll
      for (int ks = 0; ks < 4; ++ks)
#pragma unroll
        for (int nt = 0; nt < 4; ++nt) bq[ks][nt] = *(const bf16x8*)(wg + (nc * 64 + nt * 16 + r) * 256 + kh * 128 + ks * 32 + q * 8);
#pragma unroll
      for (int ks = 0; ks < 4; ++ks) {
        const bf16x8 a = *(const bf16x8*)(zs + (w * 16 + r) * 264 + kh * 128 + ks * 32 + q * 8);
#pragma unroll
        for (int nt = 0; nt < 4; ++nt) acc[nt] = __builtin_amdgcn_mfma_f32_16x16x32_bf16(a, bq[ks][nt], acc[nt], 0, 0, 0);
      }
    }
#pragma unroll
    for (int nt = 0; nt < 4; ++nt) {
      const int n = nc * 64 + nt * 16 + r;
#pragma unroll
      for (int j = 0; j < 4; ++j) {
        const int t = w * 16 + q * 4 + j;
        const float zv = bf2f(zs[t * 264 + n]);
        const float gate = silu_(bf2f(gq[nt][j]));
        p.mixed[(size_t)(tok0 + t) * 1024 + 768 + n] = f2bf(zv * sigmoid_(acc[nt][j] + bgv[nt]) * gate);
      }
    }
  }
}

#define QLOOP(QI, N, BODY)                                                                            \
  {                                                                                                   \
    unsigned* q_ctr = p.cnt + CNT_Q + (l * 8 + (QI)) * 32;                                            \
    unsigned q_nxt = blockIdx.x;                                                                      \
    for (;;) {                                                                                        \
      __syncthreads();                                                                                \
      if (threadIdx.x == 0) *s_q = q_nxt;                                                             \
      __syncthreads();                                                                                \
      const int item = (int)*s_q;                                                                     \
      if (item >= (N)) break;                                                                         \
      if (threadIdx.x == 0) q_nxt = gridDim.x + __hip_atomic_fetch_add(q_ctr, 1u, __ATOMIC_RELAXED, __HIP_MEMORY_SCOPE_AGENT); \
      BODY;                                                                                           \
    }                                                                                                 \
  }

DI void phase2(const Params& p, int l, unsigned char* smem) {
  unsigned* s_q = (unsigned*)(smem + SMEM_BYTES - 32);
  QLOOP(0, 1024, s5_item<false>(p, l, item >> 7, (item >> 2) & 31, item & 3, smem))
  QLOOP(1, 1024, hg_local(p, l, item >> 7, (item >> 2) & 31, item & 3, smem))
  QLOOP(2, 1024, ml_local(p, l, item >> 7, (item >> 2) & 31, item & 3, smem))
  QLOOP(3, 1024, lru_item<false>(p, l, item >> 7, (item >> 2) & 31, item & 3, smem))
}

DI void phase3(const Params& p, int l) {
  const int gtid = blockIdx.x * 256 + threadIdx.x, gsz = gridDim.x * 256;
  constexpr int N1 = 131072, N2 = 131072, N3 = 2048, N4 = 2048, N5 = 8192;
  for (int i = gtid; i < N1 + N2 + N3 + N4 + N5; i += gsz) {
    if (i < N1 + N2) {
      const bool ml = i >= N1;
      const int j = ml ? i - N1 : i;
      const int b = j >> 14, rem = j & 16383, hd = rem >> 12, ed = rem & 4095, d = ed & 63;
      float* stp = (ml ? p.ml_state : p.hg_state) + (size_t)(b * NCH * 4 + hd) * 4096 + ed;
      const float* dcp = ml ? (p.ml_decay + b * NCH * 4 + hd) : (p.hg_decay + (b * NCH * 4 + hd) * 64 + d);
      const int dstride = ml ? 4 : 256;
      float S = 0.f;
#pragma unroll
      for (int c0 = 0; c0 < NCH; c0 += 16) {
        float loc[16], dec[16];
#pragma unroll
        for (int c = 0; c < 16; ++c) { loc[c] = stp[(size_t)(c0 + c) * 16384]; dec[c] = dcp[(c0 + c) * dstride]; }
#pragma unroll
        for (int c = 0; c < 16; ++c) { stp[(size_t)(c0 + c) * 16384] = S; S = dec[c] * S + loc[c]; }
      }
    } else if (i < N1 + N2 + N3) {
      const int j = i - N1 - N2, b = j >> 8, rem = j & 255, hd = rem >> 6, d = rem & 63;
      float S = 0.f;
      for (int c = 0; c < NCH; ++c) {
        const int base = (b * NCH + c) * 4 + hd;
        const float dec = p.ml_decay[base];
        const float loc = p.ml_n[base * 64 + d];
        p.ml_n[base * 64 + d] = S; S = dec * S + loc;
      }
    } else if (i < N1 + N2 + N3 + N4) {
      const int j = i - N1 - N2 - N3, b = j >> 8, ch = j & 255;
      float H = 0.f;
      for (int c = 0; c < NCH; ++c) {
        const int idx = (b * NCH + c) * 256 + ch;
        const float a = p.lru_a[idx], hl = p.lru_h[idx];
        p.lru_h[idx] = H; H = a * H + hl;
      }
    } else {
      const int j = i - N1 - N2 - N3 - N4, b = j >> 10, g = (j >> 6) & 15, pp = j & 63;
      const float ar = p.abar64[((l * 16 + g) * 64 + pp) * 2], ai = p.abar64[((l * 16 + g) * 64 + pp) * 2 + 1];
      float xr = 0.f, xi = 0.f;
      for (int c = 0; c < NCH; ++c) {
        const size_t sb = ((size_t)(b * NCH + c) * 16 + g) * 128;
        const float lr = p.s5_state[sb + pp], li = p.s5_state[sb + 64 + pp];
        p.s5_state[sb + pp] = xr; p.s5_state[sb + 64 + pp] = xi;
        const float nr = ar * xr - ai * xi + lr, ni = ar * xi + ai * xr + li;
        xr = nr; xi = ni;
      }
    }
  }
}

DI void phase4(const Params& p, int l, unsigned char* smem, unsigned long long& tp_acc) {
  unsigned* s_flag = (unsigned*)(smem + SMEM_BYTES - 16);
  unsigned* s_q = (unsigned*)(smem + SMEM_BYTES - 32);
  TPS(41)
  QLOOP(4, 256, {
    _Pragma("unroll 1") for (int g4 = 0; g4 < 4; ++g4) s5_item<true>(p, l, item >> 5, item & 31, g4, smem);
    asm volatile("s_waitcnt vmcnt(0)" ::: "memory");
    s5_glu(p, l, item >> 5, item & 31, smem);
  })
  TPE(41)
  TPS(42)
  QLOOP(5, 1024, hg_out(p, l, item >> 7, (item >> 2) & 31, item & 3, smem))
  TPE(42)
  TPS(43)
  QLOOP(6, 1024, ml_out(p, l, item >> 7, (item >> 2) & 31, item & 3, smem))
  TPE(43)
  TPS(44)
  QLOOP(7, 1024, lru_item<true>(p, l, item >> 7, (item >> 2) & 31, item & 3, smem))
  TPE(44)
}

#ifdef TPROBE
#define TP_CLASS(PH) ((PH) == 0 ? 0 : (((PH) - 1) % 6) + 1)
#define TP_BEGIN(PH) unsigned long long tp_t0 = 0; if (TP_CLASS(PH) == TPROBE) tp_t0 = __builtin_amdgcn_s_memrealtime();
#define TP_END(PH) if (TP_CLASS(PH) == TPROBE) tp_acc += __builtin_amdgcn_s_memrealtime() - tp_t0;
#else
#define TP_BEGIN(PH)
#define TP_END(PH)
#endif
#define RUN_PHASE(PH, CALL)                                       \
  if (ph0 <= (PH) && (PH) < ph1) {                                \
    TP_BEGIN(PH)                                                  \
    CALL;                                                         \
    if (COOP) { if ((PH) + 1 < ph1) xcd_barrier(xb); }            \
    TP_END(PH)                                                    \
  }

template <bool COOP, int L>
DI void run_layer(const Params& p, int ph0, int ph1, unsigned char* smem, const XcdBarrier& xb, unsigned long long& tp_acc) {
#ifdef DUP1
  RUN_PHASE(1 + 6 * L, phase1(p, L, smem))
#endif
  RUN_PHASE(1 + 6 * L, phase1(p, L, smem))
#ifdef DUP2
  RUN_PHASE(2 + 6 * L, phase2(p, L, smem))
#endif
  RUN_PHASE(2 + 6 * L, phase2(p, L, smem))
  RUN_PHASE(3 + 6 * L, { phase3(p, L); if (L + 1 < DEPTH) convert_weights<(L + 1 < DEPTH ? L + 1 : 0)>(p, smem); })
#ifdef DUP4
  RUN_PHASE(4 + 6 * L, phase4(p, L, smem, tp_acc))
#endif
  RUN_PHASE(4 + 6 * L, phase4(p, L, smem, tp_acc))
  RUN_PHASE(5 + 6 * L, phase5(p, L, smem, tp_acc))
  RUN_PHASE(6 + 6 * L, phase6(p, L))
}

template <bool COOP>
__global__ void __launch_bounds__(256, 2) mk_fwd(Params p, int ph0, int ph1) {
  __shared__ __attribute__((aligned(16))) unsigned char smem[SMEM_BYTES];
  __shared__ uint4 xb_words;
  XcdBarrier xb; xb.bar = p.bar; xb.x = 0; xb.st = nullptr;
  if (COOP) {
    if (ph1 < 0) cg::this_grid().sync();
    if (threadIdx.x == 0) xb_words = make_uint4(0u, 0u, 0u, 0u);
    __syncthreads();
    xb = xcd_barrier_post(p.bar, (volatile LAS unsigned*)&xb_words);
  }
  unsigned long long tp_acc = 0;
  RUN_PHASE(0, phase0(p, smem))
  run_layer<COOP, 0>(p, ph0, ph1, smem, xb, tp_acc);
  run_layer<COOP, 1>(p, ph0, ph1, smem, xb, tp_acc);
  run_layer<COOP, 2>(p, ph0, ph1, smem, xb, tp_acc);
  run_layer<COOP, 3>(p, ph0, ph1, smem, xb, tp_acc);
#ifdef TPROBE
  if (blockIdx.x == 0 && threadIdx.x == 0) {
    const unsigned long long t0 = __builtin_amdgcn_s_memrealtime();
    while (__builtin_amdgcn_s_memrealtime() - t0 < tp_acc) __builtin_amdgcn_s_sleep(8);
  }
#endif
}

extern "C" void kernel_launch(void* const* d_in, const int* in_sizes, int n_in, void* d_out, int out_size, void* d_ws,
                              size_t ws_size, hipStream_t stream) {
  static int grid_blocks = 0;
  if (!grid_blocks) {
    int dev = 0, cus = 0, per_cu = 0;
    hipGetDevice(&dev);
    hipDeviceGetAttribute(&cus, hipDeviceAttributeMultiprocessorCount, dev);
    hipOccupancyMaxActiveBlocksPerMultiprocessor(&per_cu, mk_fwd<(MEGA != 0)>, 256, 0);
    if (per_cu < 1) per_cu = 1;
    if (per_cu > 2) per_cu = 2;
    grid_blocks = cus * per_cu;
  }
  Params p{};
  const float** pin = (const float**)&p;
  for (int i = 0; i < 28; ++i) pin[i] = (const float*)d_in[i];
  p.out = (float*)d_out;
  unsigned char* ws = (unsigned char*)d_ws;
  size_t off = 0;
  auto take = [&](size_t bytes) { unsigned char* r = ws + off; off += (bytes + 255) & ~(size_t)255; return r; };
  p.wt_in = (bfu*)take((size_t)4 * PS * 1024 * 2);
  p.wt_out = (bfu*)take((size_t)4 * 1024 * 1024 * 2);
  p.wt_a = (bfu*)take(16 * 4096 * 2);
  p.wt_x = (bfu*)take(16 * 4096 * 2);
  p.wt_glu = (bfu*)take(4 * 65536 * 2);
  p.bt_bu = (bfu*)take(64 * 128 * 32 * 2);
  p.bt_y = (bfu*)take(64 * 16 * 128 * 2);
  p.hb = (bfu*)take((size_t)NTOK * 1024 * 2);
  p.proj = (bfu*)take((size_t)NTOK * PS * 2);
  p.mixed = (bfu*)take((size_t)NTOK * 1024 * 2);
  p.zbuf = (bfu*)take((size_t)NTOK * 256 * 2);
  p.abar = (float*)take(4096 * 2 * 4);
  p.abar64 = (float*)take(4096 * 2 * 4);
  p.lbs = (float*)take(1024 * 4);
  p.hg_state = (float*)take((size_t)BATCH * NCH * 4 * 4096 * 4);
  p.hg_decay = (float*)take((size_t)BATCH * NCH * 4 * 64 * 4);
  p.ml_state = (float*)take((size_t)BATCH * NCH * 4 * 4096 * 4);
  p.ml_n = (float*)take((size_t)BATCH * NCH * 4 * 64 * 4);
  p.ml_decay = (float*)take((size_t)BATCH * NCH * 4 * 4);
  p.lru_h = (float*)take((size_t)BATCH * NCH * 256 * 4);
  p.lru_a = (float*)take((size_t)BATCH * NCH * 256 * 4);
  p.s5_state = (float*)take((size_t)BATCH * NCH * 16 * 128 * 4);
  p.cnt = (unsigned*)take(CNT_TOTAL * 4);
  p.bar = (unsigned*)take(XCD_BAR_WORDS * 4);
  if (off > ws_size) { fprintf(stderr, "workspace too small: need %zu have %zu\n", off, ws_size); return; }
  const int NPH = 1 + 6 * DEPTH;
#if MEGA
  (void)hipMemsetAsync(p.bar, 0, XCD_BAR_WORDS * 4, stream);
  int ph0 = 0, ph1 = NPH;
  void* args[] = {&p, &ph0, &ph1};
  hipError_t e = hipLaunchCooperativeKernel((void*)mk_fwd<true>, dim3(grid_blocks), dim3(256), args, 0, stream);
  if (e != hipSuccess) fprintf(stderr, "cooperative launch failed: %s (grid %d)\n", hipGetErrorString(e), grid_blocks);
#else
  for (int ph = 0; ph < NPH; ++ph) hipLaunchKernelGGL(mk_fwd<false>, dim3(grid_blocks), dim3(256), 0, stream, p, ph, ph + 1);
#endif
}
```

```cpp
#include <hip/hip_runtime.h>
#include <hip/hip_cooperative_groups.h>
#include <stdint.h>
#include <stdio.h>
namespace cg = cooperative_groups;

#ifndef MEGA
#define MEGA 1
#endif

typedef unsigned short bfu;
using bf16x8 = __attribute__((ext_vector_type(8))) short;
using f32x4  = __attribute__((ext_vector_type(4))) float;
#define DI __device__ __forceinline__

constexpr int BATCH = 8, SEQ = 2048, DM = 1024, DEPTH = 4, NTOK = BATCH * SEQ, NCH = SEQ / 64;
constexpr int DIN = 3080, PS = 3200;
constexpr int COL_AQ = 0, COL_AF = 256, COL_AI = 512, COL_AG = 768;
constexpr int COL_BQ = 1024, COL_BK = 1280, COL_BV = 1536, COL_BG = 1792, COL_BIG = 3072, COL_BFG = 3076;
constexpr int COL_CX = 2048, COL_CG = 2304, COL_DU = 2560, COL_DG = 2816;
constexpr float DN_ALPHA = 1.681792830507429f;
constexpr int SMEM_BYTES = 56 * 1024;
constexpr int CNT_LN = 0, CNT_GLU = 4 * 128, CNT_Q = 4 * 128 + 4 * 256, CNT_TOTAL = CNT_Q + 32 * 32;

struct Params {
  const float *x, *w_in, *b_in, *lb_logits, *hg_g, *ml_fb, *ml_g, *conv_w, *conv_b, *w_a, *b_a, *w_x, *b_x, *lam,
      *a_re, *a_im, *log_dt, *sb_re, *sb_im, *c_re, *c_im, *s5_d, *w_glu, *b_glu, *w_out, *b_out, *ln_g, *ln_b;
  float* out;
  bfu *wt_in, *wt_out, *wt_a, *wt_x, *wt_glu, *bt_bu, *bt_y, *hb, *proj, *mixed, *zbuf;
  float *abar, *abar64, *lbs, *hg_state, *hg_decay, *ml_state, *ml_n, *ml_decay, *lru_h, *lru_a, *s5_state;
  unsigned* cnt;
  unsigned* bar;
};

DI bfu f2bf(float x) { return __builtin_bit_cast(unsigned short, (__bf16)x); }
DI float bf2f(bfu h) { return __uint_as_float(((unsigned)h) << 16); }
typedef __bf16 bf16v2 __attribute__((ext_vector_type(2)));
typedef float f32v2 __attribute__((ext_vector_type(2)));
DI unsigned pack2(float a, float b) { f32v2 v = {a, b}; return __builtin_bit_cast(unsigned, __builtin_convertvector(v, bf16v2)); }
DI float fexp(float x) { return __expf(x); }
DI float frcp(float x) { return __builtin_amdgcn_rcpf(x); }
DI float flog(float x) { return __logf(x); }
DI float sigmoid_(float x) { return frcp(1.f + fexp(-x)); }
DI float silu_(float x) { return x * frcp(1.f + fexp(-x)); }
DI float logsig_(float x) { return fminf(x, 0.f) - flog(1.f + fexp(-fabsf(x))); }
DI float logsig_acc(float x) { return fminf(x, 0.f) - log1pf(expf(-fabsf(x))); }
DI float gelu_tanh_(float x) {
  float u = 0.7978845608028654f * (x + 0.044715f * x * x * x);
  float th = 1.f - 2.f * frcp(fexp(2.f * u) + 1.f);
  return 0.5f * x * (1.f + th);
}

template <int NT, int KS>
DI void wave_mma(f32x4 (&acc)[NT], const bfu* A, int lda, const bfu* Bt, int ldb, int lane) {
  const int r = lane & 15, q = lane >> 4;
#pragma unroll
  for (int ks = 0; ks < KS; ++ks) {
    bf16x8 a = *(const bf16x8*)(A + r * lda + ks * 32 + q * 8);
#pragma unroll
    for (int nt = 0; nt < NT; ++nt) {
      bf16x8 b = *(const bf16x8*)(Bt + (nt * 16 + r) * ldb + ks * 32 + q * 8);
      acc[nt] = __builtin_amdgcn_mfma_f32_16x16x32_bf16(a, b, acc[nt], 0, 0, 0);
    }
  }
}

DI void wave_sync() { __builtin_amdgcn_fence(__ATOMIC_SEQ_CST, "wavefront"); __builtin_amdgcn_wave_barrier(); __builtin_amdgcn_fence(__ATOMIC_SEQ_CST, "wavefront"); }
DI float group16_sum(float v) {
  v += __shfl_xor(v, 1); v += __shfl_xor(v, 2); v += __shfl_xor(v, 4); v += __shfl_xor(v, 8);
  return v;
}
DI float wave_sum(float v) {
  v += __shfl_xor(v, 1); v += __shfl_xor(v, 2); v += __shfl_xor(v, 4); v += __shfl_xor(v, 8);
  v += __shfl_xor(v, 16); v += __shfl_xor(v, 32);
  return v;
}

DI bool last_arriver(unsigned* ctr, unsigned total, unsigned* s_flag) {
  asm volatile("s_waitcnt vmcnt(0)" ::: "memory");
  __syncthreads();
  if (threadIdx.x == 0) {
    __builtin_amdgcn_fence(__ATOMIC_RELEASE, "agent");
    asm volatile("s_waitcnt vmcnt(0)" ::: "memory");
    const unsigned old = __hip_atomic_fetch_add(ctr, 1u, __ATOMIC_RELAXED, __HIP_MEMORY_SCOPE_AGENT);
    const unsigned last = (old == total - 1u) ? 1u : 0u;
    if (last) { __builtin_amdgcn_fence(__ATOMIC_ACQUIRE, "agent"); asm volatile("s_waitcnt vmcnt(0)" ::: "memory"); }
    *s_flag = last;
  }
  __syncthreads();
  return (*s_flag != 0u);
}

#ifdef TPROBE
#define TPS(ID) unsigned long long tps_##ID = 0; if (TPROBE == (ID)) tps_##ID = __builtin_amdgcn_s_memrealtime();
#define TPE(ID) if (TPROBE == (ID)) tp_acc += __builtin_amdgcn_s_memrealtime() - tps_##ID;
#else
#define TPS(ID)
#define TPE(ID)
#endif

#define XB_TMO      128
#define XB_XCNT(j)  (256  + 64 * (j))
#define XB_XSUB(j)  (1280 + 64 * (j))
#define XB_XGEN(j)  (2304 + 64 * (j))
#define XB_TOP      3328
#define XB_TOPGEN   3392
#define XCD_BAR_WORDS 3456
#define XB_SPIN_CAP (1u << 22)
#define LAS __attribute__((address_space(3)))
DI unsigned xb_ld(unsigned* p) { return __hip_atomic_load(p, __ATOMIC_RELAXED, __HIP_MEMORY_SCOPE_AGENT); }
DI unsigned xb_add(unsigned* p, unsigned v) { return __hip_atomic_fetch_add(p, v, __ATOMIC_RELAXED, __HIP_MEMORY_SCOPE_AGENT); }
DI unsigned xb_xcc_id() { return (unsigned)__builtin_amdgcn_s_getreg((3 << 11) | 20) & 0xFu; }
#define XB_SPIN(cond, bar) do { unsigned _sp = 0; while (cond) { __builtin_amdgcn_s_sleep(1); \
    if ((++_sp & 255u) == 0u) { if (xb_ld(&(bar)[XB_TMO])) break; if (_sp > XB_SPIN_CAP) { atomicAdd(&(bar)[XB_TMO], 1u); break; } } } } while (0)
struct XcdBarrier { unsigned* bar; unsigned x; volatile LAS unsigned* st; };
DI XcdBarrier xcd_barrier_post(unsigned* bar, volatile LAS unsigned* st) {
  XcdBarrier b; b.bar = bar; b.x = xb_xcc_id(); b.st = st;
  if (threadIdx.x == 0) (void)xb_add(&bar[XB_XCNT(b.x)], 1u);
  return b;
}
DI void xcd_barrier_complete(unsigned* bar, unsigned x, unsigned& nloc, unsigned& nx) {
  const unsigned G = gridDim.x * gridDim.y * gridDim.z;
  unsigned sum, cnt, mine, sp = 0u;
  for (;;) {
    sum = 0u; cnt = 0u; mine = 0u;
#pragma unroll
    for (unsigned j = 0; j < 16; ++j) { const unsigned c = xb_ld(&bar[XB_XCNT(j)]); sum += c; cnt += (c > 0u) ? 1u : 0u; mine = (j == x) ? c : mine; }
    if (sum == G) break;
    __builtin_amdgcn_s_sleep(1);
    if ((++sp & 255u) == 0u) { if (xb_ld(&bar[XB_TMO])) break; if (sp > XB_SPIN_CAP) { atomicAdd(&bar[XB_TMO], 1u); break; } }
  }
  nloc = mine > 0u ? mine : 1u; nx = cnt > 0u ? cnt : 1u;
}
DI void xcd_barrier(const XcdBarrier& b) {
  asm volatile("s_waitcnt vmcnt(0)" ::: "memory");
  __syncthreads();
  if (threadIdx.x == 0) {
    unsigned* bar = b.bar;
    __builtin_amdgcn_s_waitcnt(0);
    unsigned nloc = b.st[0], nx = b.st[1];
    if (nloc == 0u) { xcd_barrier_complete(bar, b.x, nloc, nx); b.st[0] = nloc; b.st[1] = nx; }
    const unsigned old = xb_add(&bar[XB_XSUB(b.x)], 1u);
    const unsigned gen = old / nloc;
    if (old + 1u == (gen + 1u) * nloc) {
      __builtin_amdgcn_fence(__ATOMIC_RELEASE, "agent");
      asm volatile("s_waitcnt vmcnt(0)" ::: "memory");
      const unsigned og = xb_add(&bar[XB_TOP], 1u);
      const unsigned tg = og / nx;
      if (og + 1u == (tg + 1u) * nx) xb_add(&bar[XB_TOPGEN], 1u);
      else XB_SPIN(xb_ld(&bar[XB_TOPGEN]) == tg, bar);
      __builtin_amdgcn_fence(__ATOMIC_ACQUIRE, "agent");
      xb_add(&bar[XB_XGEN(b.x)], 1u);
      asm volatile("s_waitcnt vmcnt(0)" ::: "memory");
    } else {
      XB_SPIN(xb_ld(&bar[XB_XGEN(b.x)]) == gen, bar);
      __builtin_amdgcn_fence(__ATOMIC_ACQUIRE, "agent");
      asm volatile("s_waitcnt vmcnt(0)" ::: "memory");
    }
  }
  __syncthreads();
}

DI void transpose_tile(const float* src, int sld, int cv, bfu* dst, int dld, float* tile) {
  const int tid = threadIdx.x;
  __syncthreads();
  for (int i = tid; i < 4096; i += 256) {
    int r = i >> 6, c = i & 63;
    tile[r * 65 + c] = (c < cv) ? src[(size_t)r * sld + c] : 0.f;
  }
  __syncthreads();
  for (int i = tid; i < 4096; i += 256) {
    int n = i >> 6, k = i & 63;
    dst[(size_t)n * dld + k] = f2bf(tile[k * 65 + n]);
  }
}

template <int LSEL>
DI void convert_weights(const Params& p, unsigned char* smem) {
  const int tid = threadIdx.x;
  float* tile = (float*)smem;
  const int NJ = 3200 + 1024 + 16 + 16 + 64;
  for (int job = blockIdx.x; job < NJ; job += gridDim.x) {
    const float* src; int sld, cv = 64, dld; bfu* dst;
    if (job < 3200) {
      int l = job / 800, rem = job % 800, kt = rem / 50, nt = rem % 50;
      if (l != LSEL) continue;
      const int c0 = nt < 28 ? nt * 64 : (nt < 48 ? nt * 64 + 8 : 1792);
      src = p.w_in + (size_t)l * 1024 * DIN + (size_t)kt * 64 * DIN + c0; sld = DIN;
      cv = nt < 48 ? 64 : (nt == 48 ? 8 : 0);
      dst = p.wt_in + (size_t)l * PS * 1024 + (size_t)nt * 64 * 1024 + kt * 64; dld = 1024;
    } else if (job < 4224) {
      int j = job - 3200, l = j / 256, rem = j % 256, kt = rem / 16, nt = rem % 16;
      if (l != LSEL) continue;
      src = p.w_out + (size_t)l * 1048576 + (size_t)kt * 64 * 1024 + nt * 64; sld = 1024;
      dst = p.wt_out + (size_t)l * 1048576 + (size_t)nt * 64 * 1024 + kt * 64; dld = 1024;
    } else if (LSEL != 0) {
      continue;
    } else if (job < 4240) {
      int j = job - 4224; src = p.w_a + j * 4096; sld = 64; dst = p.wt_a + j * 4096; dld = 64;
    } else if (job < 4256) {
      int j = job - 4240; src = p.w_x + j * 4096; sld = 64; dst = p.wt_x + j * 4096; dld = 64;
    } else {
      int j = job - 4256, l = j / 16, rem = j % 16, kt = rem / 4, nt = rem % 4;
      src = p.w_glu + l * 65536 + kt * 64 * 256 + nt * 64; sld = 256;
      dst = p.wt_glu + l * 65536 + nt * 64 * 256 + kt * 64; dld = 256;
    }
    transpose_tile(src, sld, cv, dst, dld, tile);
  }
}

DI void phase0(const Params& p, unsigned char* smem) {
  const int tid = threadIdx.x;
  const int gtid = blockIdx.x * 256 + tid, gsz = gridDim.x * 256;
  for (int i0 = gtid; i0 < NTOK * DM / 8; i0 += 4 * gsz) {
    float4 a[4], b[4];
#pragma unroll
    for (int u = 0; u < 4; ++u) {
      const int i = i0 + u * gsz;
      if (i < NTOK * DM / 8) { a[u] = ((const float4*)p.x)[2 * i]; b[u] = ((const float4*)p.x)[2 * i + 1]; }
    }
#pragma unroll
    for (int u = 0; u < 4; ++u) {
      const int i = i0 + u * gsz;
      if (i < NTOK * DM / 8) {
        uint4 o; o.x = pack2(a[u].x, a[u].y); o.y = pack2(a[u].z, a[u].w); o.z = pack2(b[u].x, b[u].y); o.w = pack2(b[u].z, b[u].w);
        ((uint4*)p.hb)[i] = o;
      }
    }
  }
  convert_weights<0>(p, smem);
  for (int i = (gridDim.x - 1 - blockIdx.x) * 256 + tid; i < 4096; i += gsz) {
    int lg = i >> 6, pp = i & 63;
    double dt = exp((double)p.log_dt[lg]);
    double are = p.a_re[lg * 64 + pp], aim = p.a_im[lg * 64 + pp];
    double mag = exp(dt * are), ang = dt * aim;
    double abr = mag * cos(ang), abi = mag * sin(ang);
    double den = are * are + aim * aim;
    double xr = abr - 1.0, xi = abi;
    double zr = (xr * are + xi * aim) / den, zi = (xi * are - xr * aim) / den;
    bfu* o_re = p.bt_bu + ((size_t)lg * 128 + pp) * 32;
    bfu* o_im = p.bt_bu + ((size_t)lg * 128 + 64 + pp) * 32;
    for (int h = 0; h < 16; ++h) {
      double br = p.sb_re[(lg * 64 + pp) * 16 + h], bi = p.sb_im[(lg * 64 + pp) * 16 + h];
      o_re[h] = f2bf((float)(zr * br - zi * bi));
      o_im[h] = f2bf((float)(zr * bi + zi * br));
      o_re[16 + h] = 0; o_im[16 + h] = 0;
    }
    p.abar[(lg * 64 + pp) * 2 + 0] = (float)abr; p.abar[(lg * 64 + pp) * 2 + 1] = (float)abi;
    double mag64 = exp(64.0 * dt * are), ang64 = 64.0 * ang;
    p.abar64[(lg * 64 + pp) * 2 + 0] = (float)(mag64 * cos(ang64));
    p.abar64[(lg * 64 + pp) * 2 + 1] = (float)(mag64 * sin(ang64));
  }
  for (int i = gtid; i < 4 * 16 * 16 * 128; i += gsz) {
    int k = i & 127, lgn = i >> 7;
    p.bt_y[i] = (k < 64) ? f2bf(p.c_re[lgn * 64 + k]) : f2bf(-p.c_im[lgn * 64 + (k - 64)]);
  }
  for (int i = gtid; i < 256; i += gsz) {
    float v0 = p.lb_logits[i], v1 = p.lb_logits[256 + i], v2 = p.lb_logits[512 + i], v3 = p.lb_logits[768 + i];
    float m = fmaxf(fmaxf(v0, v1), fmaxf(v2, v3));
    float e0 = expf(v0 - m), e1 = expf(v1 - m), e2 = expf(v2 - m), e3 = expf(v3 - m);
    float s = e0 + e1 + e2 + e3;
    p.lbs[i] = 0.f; p.lbs[256 + i] = e1 / s; p.lbs[512 + i] = (e1 + e2) / s; p.lbs[768 + i] = (e1 + e2 + e3) / s;
  }
  for (int i = gtid; i < CNT_TOTAL; i += gsz) p.cnt[i] = 0u;
}

DI void gemm1_tile(const Params& p, int l, const bfu* A, const bfu* Bt, int m0, int n0, unsigned char* smem) {
  bfu* sA = (bfu*)smem; bfu* sB = sA + 128 * 72;
  bfu* sC = (bfu*)smem;
  const int tid = threadIdx.x, lane = tid & 63, w = tid >> 6, wm = w >> 1, wn = w & 1;
  const int r = lane & 15, q = lane >> 4;
  f32x4 acc[4][6];
#pragma unroll
  for (int i = 0; i < 4; ++i)
#pragma unroll
    for (int j = 0; j < 6; ++j) acc[i][j] = (f32x4){0.f, 0.f, 0.f, 0.f};
  const int lrow = tid >> 3, lkc = tid & 7;
  const bfu* ga = A + (size_t)(m0 + lrow) * 1024 + lkc * 8;
  const bfu* gb = Bt + (size_t)(n0 + lrow) * 1024 + lkc * 8;
  uint4 ra0 = *(const uint4*)(ga), ra1 = *(const uint4*)(ga + 32 * 1024), ra2 = *(const uint4*)(ga + 64 * 1024), ra3 = *(const uint4*)(ga + 96 * 1024);
  uint4 rb0 = *(const uint4*)(gb), rb1 = *(const uint4*)(gb + 32 * 1024), rb2 = *(const uint4*)(gb + 64 * 1024), rb3 = *(const uint4*)(gb + 96 * 1024);
  uint4 rb4 = *(const uint4*)(gb + 128 * 1024), rb5 = *(const uint4*)(gb + 160 * 1024);
  bfu* wa = sA + lrow * 72 + lkc * 8;
  bfu* wb = sB + lrow * 72 + lkc * 8;
  for (int kt = 0; kt < 16; ++kt) {
    __syncthreads();
    *(uint4*)(wa) = ra0; *(uint4*)(wa + 32 * 72) = ra1; *(uint4*)(wa + 64 * 72) = ra2; *(uint4*)(wa + 96 * 72) = ra3;
    *(uint4*)(wb) = rb0; *(uint4*)(wb + 32 * 72) = rb1; *(uint4*)(wb + 64 * 72) = rb2; *(uint4*)(wb + 96 * 72) = rb3;
    *(uint4*)(wb + 128 * 72) = rb4; *(uint4*)(wb + 160 * 72) = rb5;
    __syncthreads();
    if (kt + 1 < 16) {
      const bfu* ga2 = ga + (kt + 1) * 64; const bfu* gb2 = gb + (kt + 1) * 64;
      ra0 = *(const uint4*)(ga2); ra1 = *(const uint4*)(ga2 + 32 * 1024); ra2 = *(const uint4*)(ga2 + 64 * 1024); ra3 = *(const uint4*)(ga2 + 96 * 1024);
      rb0 = *(const uint4*)(gb2); rb1 = *(const uint4*)(gb2 + 32 * 1024); rb2 = *(const uint4*)(gb2 + 64 * 1024); rb3 = *(const uint4*)(gb2 + 96 * 1024);
      rb4 = *(const uint4*)(gb2 + 128 * 1024); rb5 = *(const uint4*)(gb2 + 160 * 1024);
    }
#pragma unroll
    for (int ks = 0; ks < 2; ++ks) {
      bf16x8 af[4], bfr[6];
#pragma unroll
      for (int mt = 0; mt < 4; ++mt) af[mt] = *(const bf16x8*)(sA + (wm * 64 + mt * 16 + r) * 72 + ks * 32 + q * 8);
#pragma unroll
      for (int nt = 0; nt < 6; ++nt) bfr[nt] = *(const bf16x8*)(sB + (wn * 96 + nt * 16 + r) * 72 + ks * 32 + q * 8);
#pragma unroll
      for (int mt = 0; mt < 4; ++mt)
#pragma unroll
        for (int nt = 0; nt < 6; ++nt) acc[mt][nt] = __builtin_amdgcn_mfma_f32_16x16x32_bf16(af[mt], bfr[nt], acc[mt][nt], 0, 0, 0);
    }
  }
  float bias[6];
#pragma unroll
  for (int nt = 0; nt < 6; ++nt) {
    const int col = n0 + wn * 96 + nt * 16 + r;
    bias[nt] = p.b_in[l * DIN + (col < 1792 ? col : col + 8)];
  }
  __syncthreads();
#pragma unroll
  for (int mt = 0; mt < 4; ++mt)
#pragma unroll
    for (int nt = 0; nt < 6; ++nt)
#pragma unroll
      for (int j = 0; j < 4; ++j)
        sC[(wm * 64 + mt * 16 + q * 4 + j) * 200 + wn * 96 + nt * 16 + r] = f2bf(acc[mt][nt][j] + bias[nt]);
  __syncthreads();
#pragma unroll
  for (int i = 0; i < 12; ++i) {
    const int id = tid + i * 256, row = id / 24, ch = id % 24;
    *(uint4*)(p.proj + (size_t)(m0 + row) * PS + n0 + ch * 8) = *(const uint4*)(sC + row * 200 + ch * 8);
  }
}

DI void gemm1_gates(const Params& p, int l, const bfu* A, const bfu* Bt, int m0) {
  const int tid = threadIdx.x, lane = tid & 63, w = tid >> 6, r = lane & 15, q = lane >> 4;
  const bfu* a0 = A + (size_t)(m0 + w * 32 + r) * 1024 + q * 8;
  const bfu* a1 = a0 + 16 * 1024;
  const bfu* bp = Bt + (size_t)(3072 + r) * 1024 + q * 8;
  f32x4 c0 = (f32x4){0.f, 0.f, 0.f, 0.f}, c1 = (f32x4){0.f, 0.f, 0.f, 0.f};
#pragma unroll 4
  for (int ks = 0; ks < 32; ++ks) {
    const bf16x8 b = *(const bf16x8*)(bp + ks * 32);
    const bf16x8 x0 = *(const bf16x8*)(a0 + ks * 32);
    const bf16x8 x1 = *(const bf16x8*)(a1 + ks * 32);
    c0 = __builtin_amdgcn_mfma_f32_16x16x32_bf16(x0, b, c0, 0, 0, 0);
    c1 = __builtin_amdgcn_mfma_f32_16x16x32_bf16(x1, b, c1, 0, 0, 0);
  }
  if (r < 8) {
    const float bias = p.b_in[l * DIN + 1792 + r];
#pragma unroll
    for (int j = 0; j < 4; ++j) {
      p.proj[(size_t)(m0 + w * 32 + q * 4 + j) * PS + 3072 + r] = f2bf(c0[j] + bias);
      p.proj[(size_t)(m0 + w * 32 + 16 + q * 4 + j) * PS + 3072 + r] = f2bf(c1[j] + bias);
    }
  }
}

DI void phase1(const Params& p, int l, unsigned char* smem) {
  const bfu* Bt = p.wt_in + (size_t)l * PS * 1024;
  for (int tile = blockIdx.x; tile < 128 * 16; tile += gridDim.x) { const int mt = tile >> 4, nt = tile & 15; gemm1_tile(p, l, p.hb, Bt, mt * 128, nt * 192, smem); }
  for (int job = blockIdx.x; job < 128; job += gridDim.x) gemm1_gates(p, l, p.hb, Bt, job * 128);
}

template <int EPI>
DI void gemm2_tile(const Params& p, int l, const bfu* A, const bfu* Bt, int m0, int n0, const float* hin, unsigned char* smem) {
  bfu* sA = (bfu*)smem; bfu* sB = sA + 128 * 72;
  const int tid = threadIdx.x, lane = tid & 63, w = tid >> 6, wm = w >> 1, wn = w & 1;
  const int r = lane & 15, q = lane >> 4;
  f32x4 acc[4][4];
#pragma unroll
  for (int i = 0; i < 4; ++i)
#pragma unroll
    for (int j = 0; j < 4; ++j) acc[i][j] = (f32x4){0.f, 0.f, 0.f, 0.f};
  const int lrow = tid >> 3, lkc = tid & 7;
  const bfu* ga = A + (size_t)(m0 + lrow) * 1024 + lkc * 8;
  const bfu* gb = Bt + (size_t)(n0 + lrow) * 1024 + lkc * 8;
  uint4 ra0 = *(const uint4*)(ga), ra1 = *(const uint4*)(ga + 32 * 1024), ra2 = *(const uint4*)(ga + 64 * 1024), ra3 = *(const uint4*)(ga + 96 * 1024);
  uint4 rb0 = *(const uint4*)(gb), rb1 = *(const uint4*)(gb + 32 * 1024), rb2 = *(const uint4*)(gb + 64 * 1024), rb3 = *(const uint4*)(gb + 96 * 1024);
  bfu* wa = sA + lrow * 72 + lkc * 8;
  bfu* wb = sB + lrow * 72 + lkc * 8;
  for (int kt = 0; kt < 16; ++kt) {
    __syncthreads();
    *(uint4*)(wa) = ra0; *(uint4*)(wa + 32 * 72) = ra1; *(uint4*)(wa + 64 * 72) = ra2; *(uint4*)(wa + 96 * 72) = ra3;
    *(uint4*)(wb) = rb0; *(uint4*)(wb + 32 * 72) = rb1; *(uint4*)(wb + 64 * 72) = rb2; *(uint4*)(wb + 96 * 72) = rb3;
    __syncthreads();
    if (kt + 1 < 16) {
      const bfu* ga2 = ga + (kt + 1) * 64; const bfu* gb2 = gb + (kt + 1) * 64;
      ra0 = *(const uint4*)(ga2); ra1 = *(const uint4*)(ga2 + 32 * 1024); ra2 = *(const uint4*)(ga2 + 64 * 1024); ra3 = *(const uint4*)(ga2 + 96 * 1024);
      rb0 = *(const uint4*)(gb2); rb1 = *(const uint4*)(gb2 + 32 * 1024); rb2 = *(const uint4*)(gb2 + 64 * 1024); rb3 = *(const uint4*)(gb2 + 96 * 1024);
    }
#pragma unroll
    for (int ks = 0; ks < 2; ++ks) {
      bf16x8 af[4], bfr[4];
#pragma unroll
      for (int mt = 0; mt < 4; ++mt) af[mt] = *(const bf16x8*)(sA + (wm * 64 + mt * 16 + r) * 72 + ks * 32 + q * 8);
#pragma unroll
      for (int nt = 0; nt < 4; ++nt) bfr[nt] = *(const bf16x8*)(sB + (wn * 64 + nt * 16 + r) * 72 + ks * 32 + q * 8);
#pragma unroll
      for (int mt = 0; mt < 4; ++mt)
#pragma unroll
        for (int nt = 0; nt < 4; ++nt) acc[mt][nt] = __builtin_amdgcn_mfma_f32_16x16x32_bf16(af[mt], bfr[nt], acc[mt][nt], 0, 0, 0);
    }
  }
#pragma unroll
  for (int nt = 0; nt < 4; ++nt) {
    const int col = n0 + wn * 64 + nt * 16 + r;
    if (EPI == 1) {
      const float bias = (col < DIN) ? p.b_in[l * DIN + col] : 0.f;
#pragma unroll
      for (int mt = 0; mt < 4; ++mt)
#pragma unroll
        for (int j = 0; j < 4; ++j) {
          const int row = m0 + wm * 64 + mt * 16 + q * 4 + j;
          p.proj[(size_t)row * PS + col] = f2bf(acc[mt][nt][j] + bias);
        }
    } else {
      const float bias = p.b_out[l * 1024 + col];
      float hv[4][4];
#pragma unroll
      for (int mt = 0; mt < 4; ++mt)
#pragma unroll
        for (int j = 0; j < 4; ++j) hv[mt][j] = hin[(size_t)(m0 + wm * 64 + mt * 16 + q * 4 + j) * 1024 + col];
#pragma unroll
      for (int mt = 0; mt < 4; ++mt)
#pragma unroll
        for (int j = 0; j < 4; ++j) {
          const int row = m0 + wm * 64 + mt * 16 + q * 4 + j;
          p.out[(size_t)row * 1024 + col] = DN_ALPHA * hv[mt][j] + acc[mt][nt][j] + bias;
        }
    }
  }
}


DI void phase5(const Params& p, int l, unsigned char* smem, unsigned long long& tp_acc) {
  const bfu* Bt = p.wt_out + (size_t)l * 1048576;
  const float* hin = (l == 0) ? p.x : p.out;
  for (int tile = blockIdx.x; tile < 128 * 8; tile += gridDim.x) gemm2_tile<2>(p, l, p.mixed, Bt, (tile >> 3) * 128, (tile & 7) * 128, hin, smem);
}

DI void phase6(const Params& p, int l) {
  const int tid = threadIdx.x, lane = tid & 63, w = tid >> 6;
  float4 g[4], bb[4];
#pragma unroll
  for (int i = 0; i < 4; ++i) { g[i] = *(const float4*)(p.ln_g + l * 1024 + i * 256 + lane * 4); bb[i] = *(const float4*)(p.ln_b + l * 1024 + i * 256 + lane * 4); }
  for (int rb = blockIdx.x; rb < NTOK / 16; rb += gridDim.x) {
    const int row0 = rb * 16 + w * 4;
    float4 v[4][4];
#pragma unroll
    for (int rr = 0; rr < 4; ++rr)
#pragma unroll
      for (int i = 0; i < 4; ++i) v[rr][i] = *(const float4*)(p.out + (size_t)(row0 + rr) * 1024 + i * 256 + lane * 4);
#pragma unroll
    for (int rr = 0; rr < 4; ++rr) {
      float sm = 0.f;
#pragma unroll
      for (int i = 0; i < 4; ++i) sm += v[rr][i].x + v[rr][i].y + v[rr][i].z + v[rr][i].w;
      const float mu = wave_sum(sm) * (1.f / 1024.f);
      float ss = 0.f;
#pragma unroll
      for (int i = 0; i < 4; ++i) {
        v[rr][i].x -= mu; v[rr][i].y -= mu; v[rr][i].z -= mu; v[rr][i].w -= mu;
        ss += v[rr][i].x * v[rr][i].x + v[rr][i].y * v[rr][i].y + v[rr][i].z * v[rr][i].z + v[rr][i].w * v[rr][i].w;
      }
      const float rs = rsqrtf(wave_sum(ss) * (1.f / 1024.f) + 1e-5f);
#pragma unroll
      for (int i = 0; i < 4; ++i) {
        const int c = i * 256 + lane * 4;
        float4 o;
        o.x = v[rr][i].x * rs * g[i].x + bb[i].x; o.y = v[rr][i].y * rs * g[i].y + bb[i].y;
        o.z = v[rr][i].z * rs * g[i].z + bb[i].z; o.w = v[rr][i].w * rs * g[i].w + bb[i].w;
        *(float4*)(p.out + (size_t)(row0 + rr) * 1024 + c) = o;
        uint2 ob; ob.x = pack2(o.x, o.y); ob.y = pack2(o.z, o.w);
        *(uint2*)(p.hb + (size_t)(row0 + rr) * 1024 + c) = ob;
      }
    }
  }
}

DI void hg_gate(float x, float lb, float& lf, float& k) {
  x = fmaxf(x, -80.f);
  const float E = fexp(-x);
  const float sg = frcp(1.f + E);
  k = (1.f - lb) * (E * sg);
  lf = flog(lb + (1.f - lb) * sg);
}

DI void hg_local(const Params& p, int l, int b, int c, int hd, unsigned char* smem) {
  const int tid = threadIdx.x, lane = tid & 63, w = tid >> 6;
  bfu* At = (bfu*)smem;
  bfu* Bt = At + 64 * 72;
  float* segtot = (float*)(smem + 2 * 64 * 72 * 2);
  const int tok0 = b * SEQ + c * 64;
  const int d = lane;
  const float lb = p.lbs[l * 256 + hd * 64 + d];
  const bfu* pf = p.proj + (size_t)tok0 * PS + COL_AF + hd * 64 + d;
  const bfu* pv = p.proj + (size_t)tok0 * PS + COL_AI + hd * 64 + d;
  float bl[16], kk[16];
  float run = 0.f;
  __syncthreads();
#pragma unroll
  for (int i = 0; i < 16; ++i) {
    const int t = w * 16 + i;
    float lf, k; hg_gate(bf2f(pf[(size_t)t * PS]), lb, lf, k);
    run += lf; bl[i] = run; kk[i] = k;
    At[d * 72 + t] = pv[(size_t)t * PS];
  }
  segtot[w * 64 + d] = run;
  __syncthreads();
  float off = 0.f, tot = 0.f;
#pragma unroll
  for (int s = 0; s < 4; ++s) { float v = segtot[s * 64 + d]; tot += v; if (s < w) off += v; }
#pragma unroll
  for (int i = 0; i < 16; ++i) { const int t = w * 16 + i; Bt[d * 72 + t] = f2bf(kk[i] * fexp(tot - (bl[i] + off))); }
  const int base = (b * NCH + c) * 4 + hd;
  if (w == 0) p.hg_decay[base * 64 + d] = fexp(tot);
  __syncthreads();
  f32x4 acc[4];
#pragma unroll
  for (int i = 0; i < 4; ++i) acc[i] = (f32x4){0.f, 0.f, 0.f, 0.f};
  wave_mma<4, 2>(acc, At + w * 16 * 72, 72, Bt, 72, lane);
  float* st = p.hg_state + (size_t)base * 4096;
  const int r = lane & 15, q = lane >> 4;
#pragma unroll
  for (int nt = 0; nt < 4; ++nt)
#pragma unroll
    for (int j = 0; j < 4; ++j) st[(w * 16 + q * 4 + j) * 64 + nt * 16 + r] = acc[nt][j];
}

constexpr int O_A = 0, O_BT = 17408, O_QP = 34816, O_KP = 44032, O_MISC = 53248;

DI void hg_out(const Params& p, int l, int b, int c, int hd, unsigned char* smem) {
  const int tid = threadIdx.x, lane = tid & 63, w = tid >> 6;
  bfu* A = (bfu*)(smem + O_A); bfu* Bt = (bfu*)(smem + O_BT); bfu* Qp = (bfu*)(smem + O_QP); bfu* Kp = (bfu*)(smem + O_KP);
  float* segtot = (float*)(smem + O_MISC);
  const int tok0 = b * SEQ + c * 64;
  const int d = lane;
  const float lb = p.lbs[l * 256 + hd * 64 + d];
  const bfu* pq = p.proj + (size_t)tok0 * PS + COL_AQ + hd * 64 + d;
  const bfu* pf = p.proj + (size_t)tok0 * PS + COL_AF + hd * 64 + d;
  const bfu* pv = p.proj + (size_t)tok0 * PS + COL_AI + hd * 64 + d;
  const int base = (b * NCH + c) * 4 + hd;
  const float* st = p.hg_state + (size_t)base * 4096;
  float bl[16], kk[16];
  float run = 0.f;
  const int r = lane & 15, q = lane >> 4;
  bfu fraw[16], vraw[16], qraw[16]; float sraw[16];
#pragma unroll
  for (int i = 0; i < 16; ++i) {
    const int t = w * 16 + i;
    fraw[i] = pf[(size_t)t * PS]; vraw[i] = pv[(size_t)t * PS]; qraw[i] = pq[(size_t)t * PS]; sraw[i] = st[(w + 4 * i) * 64 + d];
  }
  bfu gt[4][4]; float gw[4];
#pragma unroll
  for (int nt = 0; nt < 4; ++nt) {
    gw[nt] = p.hg_g[l * 256 + hd * 64 + nt * 16 + r];
#pragma unroll
    for (int j = 0; j < 4; ++j) gt[j][nt] = p.proj[(size_t)(tok0 + w * 16 + q * 4 + j) * PS + COL_AG + hd * 64 + nt * 16 + r];
  }
  __syncthreads();
#pragma unroll
  for (int i = 0; i < 16; ++i) {
    const int t = w * 16 + i;
    float lf, k; hg_gate(bf2f(fraw[i]), lb, lf, k);
    run += lf; bl[i] = run; kk[i] = k;
    Bt[d * 136 + t] = vraw[i];
    const int e = w + 4 * i;
    Bt[e * 136 + 64 + d] = f2bf(sraw[i]);
  }
  segtot[w * 64 + d] = run;
  __syncthreads();
  float off = 0.f;
#pragma unroll
  for (int s = 0; s < 4; ++s) { float v = segtot[s * 64 + d]; if (s < w) off += v; }
  const float bm = segtot[d] + segtot[64 + d];
#pragma unroll
  for (int i = 0; i < 16; ++i) {
    const int t = w * 16 + i;
    const float bt = bl[i] + off;
    const float qv = silu_(bf2f(qraw[i]));
    Qp[t * 72 + d] = f2bf(qv * fexp(fmaxf(bt - bm, -80.f)));
    Kp[t * 72 + d] = f2bf(kk[i] * fexp(fminf(bm - bt, 80.f)));
    A[t * 136 + 64 + d] = f2bf(qv * fexp(bt));
  }
  __syncthreads();
  f32x4 acc[4];
#pragma unroll
  for (int i = 0; i < 4; ++i) acc[i] = (f32x4){0.f, 0.f, 0.f, 0.f};
  wave_mma<4, 2>(acc, Qp + w * 16 * 72, 72, Kp, 72, lane);
#pragma unroll
  for (int nt = 0; nt < 4; ++nt)
#pragma unroll
    for (int j = 0; j < 4; ++j) {
      const int t = w * 16 + q * 4 + j, s = nt * 16 + r;
      A[t * 136 + s] = f2bf(s <= t ? acc[nt][j] : 0.f);
    }
  __syncthreads();
  f32x4 o[4];
#pragma unroll
  for (int i = 0; i < 4; ++i) o[i] = (f32x4){0.f, 0.f, 0.f, 0.f};
  wave_mma<4, 4>(o, A + w * 16 * 136, 136, Bt, 136, lane);
#pragma unroll
  for (int j = 0; j < 4; ++j) {
    float ss = 0.f;
#pragma unroll
    for (int nt = 0; nt < 4; ++nt) ss += o[nt][j] * o[nt][j];
    ss = group16_sum(ss);
    const float sc = rsqrtf(ss * (1.f / 64.f) + 1e-6f);
    const int t = w * 16 + q * 4 + j;
    bfu* mrow = p.mixed + (size_t)(tok0 + t) * 1024 + hd * 64;
#pragma unroll
    for (int nt = 0; nt < 4; ++nt) {
      const int e = nt * 16 + r;
      mrow[e] = f2bf(o[nt][j] * sc * gw[nt] * silu_(bf2f(gt[j][nt])));
    }
  }
}

DI void ml_gates(const Params& p, int l, int tok0, int hd, float* bs, float* igs, int tid) {
  if (tid < 64) {
    const bfu* row = p.proj + (size_t)(tok0 + tid) * PS;
    const float ig = bf2f(row[COL_BIG + hd]);
    const float fg = bf2f(row[COL_BFG + hd]) + p.ml_fb[l * 4 + hd];
    float lf = logsig_(fg);
#pragma unroll
    for (int o = 1; o < 64; o <<= 1) { float v = __shfl_up(lf, o); if (tid >= o) lf += v; }
    bs[tid] = lf; igs[tid] = ig;
  }
}

DI void ml_local(const Params& p, int l, int b, int c, int hd, unsigned char* smem) {
  const int tid = threadIdx.x, lane = tid & 63, w = tid >> 6;
  bfu* At = (bfu*)smem;
  bfu* Bt = At + 64 * 72;
  float* bs = (float*)(smem + 2 * 64 * 72 * 2);
  float* igs = bs + 64; float* nseg = igs + 64;
  const int tok0 = b * SEQ + c * 64;
  const int d = lane;
  const bfu* pk = p.proj + (size_t)tok0 * PS + COL_BK + hd * 64 + d;
  const bfu* pv = p.proj + (size_t)tok0 * PS + COL_BV + hd * 64 + d;
  bfu kraw[16], vraw[16];
#pragma unroll
  for (int i = 0; i < 16; ++i) { kraw[i] = pk[(size_t)(w * 16 + i) * PS]; vraw[i] = pv[(size_t)(w * 16 + i) * PS]; }
  __syncthreads();
  ml_gates(p, l, tok0, hd, bs, igs, tid);
  __syncthreads();
  const float blast = bs[63];
  float nacc = 0.f;
#pragma unroll
  for (int i = 0; i < 16; ++i) {
    const int s = w * 16 + i;
    const float ws = fexp(blast - bs[s] + igs[s]);
    const float kw = bf2f(kraw[i]) * 0.125f * ws;
    Bt[d * 72 + s] = f2bf(kw); nacc += kw;
    At[d * 72 + s] = vraw[i];
  }
  nseg[w * 64 + d] = nacc;
  __syncthreads();
  const int base = (b * NCH + c) * 4 + hd;
  if (w == 0) p.ml_n[base * 64 + d] = nseg[d] + nseg[64 + d] + nseg[128 + d] + nseg[192 + d];
  if (tid == 0) p.ml_decay[base] = fexp(blast);
  f32x4 acc[4];
#pragma unroll
  for (int i = 0; i < 4; ++i) acc[i] = (f32x4){0.f, 0.f, 0.f, 0.f};
  wave_mma<4, 2>(acc, At + w * 16 * 72, 72, Bt, 72, lane);
  float* st = p.ml_state + (size_t)base * 4096;
  const int r = lane & 15, q = lane >> 4;
#pragma unroll
  for (int nt = 0; nt < 4; ++nt)
#pragma unroll
    for (int j = 0; j < 4; ++j) st[(w * 16 + q * 4 + j) * 64 + nt * 16 + r] = acc[nt][j];
}

DI void ml_out(const Params& p, int l, int b, int c, int hd, unsigned char* smem) {
  const int tid = threadIdx.x, lane = tid & 63, w = tid >> 6;
  bfu* A = (bfu*)(smem + O_A); bfu* Bt = (bfu*)(smem + O_BT); bfu* Qp = (bfu*)(smem + O_QP); bfu* Kp = (bfu*)(smem + O_KP);
  float* bs = (float*)(smem + O_MISC); float* igs = bs + 64; float* npv = igs + 64; float* den2 = npv + 64;
  const int tok0 = b * SEQ + c * 64;
  const int d = lane;
  const int base = (b * NCH + c) * 4 + hd;
  const float* st = p.ml_state + (size_t)base * 4096;
  const int r = lane & 15, q = lane >> 4;
  const bfu* pq = p.proj + (size_t)tok0 * PS + COL_BQ + hd * 64 + d;
  const bfu* pk = p.proj + (size_t)tok0 * PS + COL_BK + hd * 64 + d;
  const bfu* pv = p.proj + (size_t)tok0 * PS + COL_BV + hd * 64 + d;
  bfu qraw[16], kraw[16], vraw[16]; float sraw[16];
#pragma unroll
  for (int i = 0; i < 16; ++i) {
    const int t = w * 16 + i;
    qraw[i] = pq[(size_t)t * PS]; kraw[i] = pk[(size_t)t * PS]; vraw[i] = pv[(size_t)t * PS]; sraw[i] = st[(w + 4 * i) * 64 + d];
  }
  bfu gt[4][4]; float gw[4];
#pragma unroll
  for (int nt = 0; nt < 4; ++nt) {
    gw[nt] = p.ml_g[l * 256 + hd * 64 + nt * 16 + r];
#pragma unroll
    for (int j = 0; j < 4; ++j) gt[j][nt] = p.proj[(size_t)(tok0 + w * 16 + q * 4 + j) * PS + COL_BG + hd * 64 + nt * 16 + r];
  }
  __syncthreads();
  ml_gates(p, l, tok0, hd, bs, igs, tid);
  if (tid >= 64 && tid < 128) npv[tid - 64] = p.ml_n[base * 64 + tid - 64];
  __syncthreads();
#pragma unroll
  for (int i = 0; i < 16; ++i) {
    const int t = w * 16 + i;
    Qp[t * 72 + d] = qraw[i];
    Kp[t * 72 + d] = kraw[i];
    A[t * 136 + 64 + d] = f2bf(bf2f(qraw[i]) * fexp(bs[t]));
    Bt[d * 136 + t] = vraw[i];
    const int e = w + 4 * i;
    Bt[e * 136 + 64 + d] = f2bf(sraw[i]);
  }
  __syncthreads();
  if (tid < 64) {
    float s = 0.f;
    for (int dd = 0; dd < 64; ++dd) s += bf2f(A[tid * 136 + 64 + dd]) * npv[dd];
    den2[tid] = s;
  }
  f32x4 acc[4];
#pragma unroll
  for (int i = 0; i < 4; ++i) acc[i] = (f32x4){0.f, 0.f, 0.f, 0.f};
  wave_mma<4, 2>(acc, Qp + w * 16 * 72, 72, Kp, 72, lane);
  float den1[4];
#pragma unroll
  for (int j = 0; j < 4; ++j) {
    const int t = w * 16 + q * 4 + j;
    const float bt = bs[t];
    float rs = 0.f;
#pragma unroll
    for (int nt = 0; nt < 4; ++nt) {
      const int s = nt * 16 + r;
      float wv = 0.f;
      if (s <= t) wv = fexp(bt - bs[s] + igs[s]) * acc[nt][j] * 0.125f;
      rs += wv;
      A[t * 136 + s] = f2bf(wv);
    }
    den1[j] = group16_sum(rs);
  }
  __syncthreads();
  f32x4 o[4];
#pragma unroll
  for (int i = 0; i < 4; ++i) o[i] = (f32x4){0.f, 0.f, 0.f, 0.f};
  wave_mma<4, 4>(o, A + w * 16 * 136, 136, Bt, 136, lane);
#pragma unroll
  for (int j = 0; j < 4; ++j) {
    const int t = w * 16 + q * 4 + j;
    const float den = den1[j] + den2[t];
    const float inv = frcp(fmaxf(fabsf(den), 1.f));
    float hv[4];
    float ss = 0.f;
#pragma unroll
    for (int nt = 0; nt < 4; ++nt) { hv[nt] = o[nt][j] * inv; ss += hv[nt] * hv[nt]; }
    ss = group16_sum(ss);
    const float sc = rsqrtf(ss * (1.f / 64.f) + 1e-6f);
    bfu* mrow = p.mixed + (size_t)(tok0 + t) * 1024 + 256 + hd * 64;
#pragma unroll
    for (int nt = 0; nt < 4; ++nt) {
      const int e = nt * 16 + r;
      mrow[e] = f2bf(hv[nt] * sc * gw[nt] * silu_(bf2f(gt[j][nt])));
    }
  }
}

template <bool FINAL>
DI void lru_item(const Params& p, int l, int b, int c, int n, unsigned char* smem) {
  const int tid = threadIdx.x, lane = tid & 63, w = tid >> 6;
  bfu* xcb = (bfu*)smem;
  float* xcf = (float*)(smem + 9216);
  float* af = (float*)(smem + 9216 + 17408);
  float* segH = (float*)(smem + 9216 + 2 * 17408);
  float* segA = segH + 256;
  const int tok0 = b * SEQ + c * 64;
  const int ch = n * 64 + lane;
  const int r = lane & 15, q = lane >> 4;
  bf16x8 wfa[2][4], wfx[2][4];
#pragma unroll
  for (int ks = 0; ks < 2; ++ks)
#pragma unroll
    for (int nt = 0; nt < 4; ++nt) {
      wfa[ks][nt] = *(const bf16x8*)(p.wt_a + (l * 4 + n) * 4096 + (nt * 16 + r) * 64 + ks * 32 + q * 8);
      wfx[ks][nt] = *(const bf16x8*)(p.wt_x + (l * 4 + n) * 4096 + (nt * 16 + r) * 64 + ks * 32 + q * 8);
    }
  float e_ba[4], e_bx[4], e_lam[4];
#pragma unroll
  for (int nt = 0; nt < 4; ++nt) {
    const int che = n * 64 + nt * 16 + r;
    e_ba[nt] = p.b_a[l * 256 + che]; e_bx[nt] = p.b_x[l * 256 + che]; e_lam[nt] = p.lam[l * 256 + che];
  }
  const int sidx = (b * NCH + c) * 256 + ch;
  float Hprev = 0.f;
  bfu gq[16];
  if (FINAL) {
    Hprev = p.lru_h[sidx];
    const bfu* pg0 = p.proj + (size_t)tok0 * PS + COL_CG + ch;
#pragma unroll
    for (int i = 0; i < 16; ++i) gq[i] = pg0[(size_t)(w * 16 + i) * PS];
  }
  __syncthreads();
  {
    const float cw0 = p.conv_w[(l * 4 + 0) * 256 + ch], cw1 = p.conv_w[(l * 4 + 1) * 256 + ch];
    const float cw2 = p.conv_w[(l * 4 + 2) * 256 + ch], cw3 = p.conv_w[(l * 4 + 3) * 256 + ch];
    const float cb = p.conv_b[l * 256 + ch];
    const bfu* px = p.proj + (size_t)tok0 * PS + COL_CX + ch;
#pragma unroll
    for (int i = 0; i < 16; ++i) {
      const int t = w * 16 + i;
      const int sp = c * 64 + t;
      float x0 = (sp >= 3) ? bf2f(px[(ptrdiff_t)(t - 3) * PS]) : 0.f;
      float x1 = (sp >= 2) ? bf2f(px[(ptrdiff_t)(t - 2) * PS]) : 0.f;
      float x2 = (sp >= 1) ? bf2f(px[(ptrdiff_t)(t - 1) * PS]) : 0.f;
      float x3 = bf2f(px[(ptrdiff_t)t * PS]);
      const float xc = cb + cw0 * x0 + cw1 * x1 + cw2 * x2 + cw3 * x3;
      xcf[t * 68 + lane] = xc;
      xcb[t * 72 + lane] = f2bf(xc);
    }
  }
  __syncthreads();
  f32x4 aa[4], ax[4];
#pragma unroll
  for (int i = 0; i < 4; ++i) { aa[i] = (f32x4){0.f, 0.f, 0.f, 0.f}; ax[i] = (f32x4){0.f, 0.f, 0.f, 0.f}; }
#pragma unroll
  for (int ks = 0; ks < 2; ++ks) {
    const bf16x8 afr = *(const bf16x8*)(xcb + (w * 16 + r) * 72 + ks * 32 + q * 8);
#pragma unroll
    for (int nt = 0; nt < 4; ++nt) {
      aa[nt] = __builtin_amdgcn_mfma_f32_16x16x32_bf16(afr, wfa[ks][nt], aa[nt], 0, 0, 0);
      ax[nt] = __builtin_amdgcn_mfma_f32_16x16x32_bf16(afr, wfx[ks][nt], ax[nt], 0, 0, 0);
    }
  }
#pragma unroll
  for (int nt = 0; nt < 4; ++nt) {
    const int e = nt * 16 + r;
    const float ba = e_ba[nt], bx = e_bx[nt];
    const float lsl = 8.f * logsig_acc(e_lam[nt]);
#pragma unroll
    for (int j = 0; j < 4; ++j) {
      const int t = w * 16 + q * 4 + j;
      const float rg = sigmoid_(aa[nt][j] + ba), ig = sigmoid_(ax[nt][j] + bx);
      const float la = lsl * rg;
      const float a = fexp(la);
      const float y2 = 2.f * la;
      const float em = (y2 > -0.05f) ? -y2 * (1.f + y2 * (0.5f + y2 * (0.16666667f + y2 * 0.041666668f))) : 1.f - a * a;
      const float bv = __builtin_amdgcn_sqrtf(fmaxf(em, 0.f)) * ig * xcf[t * 68 + e];
      af[t * 68 + e] = a; xcf[t * 68 + e] = bv;
    }
  }
  __syncthreads();
  float hl[16], al[16];
  float h = 0.f, ap = 1.f;
#pragma unroll
  for (int i = 0; i < 16; ++i) {
    const int t = w * 16 + i;
    const float a = af[t * 68 + lane], bv = xcf[t * 68 + lane];
    h = a * h + bv; ap *= a; hl[i] = h; al[i] = ap;
  }
  segH[w * 64 + lane] = h; segA[w * 64 + lane] = ap;
  __syncthreads();
  if (!FINAL) {
    if (w == 0) {
      float H = 0.f, Ap = 1.f;
#pragma unroll
      for (int s = 0; s < 4; ++s) { H = segA[s * 64 + lane] * H + segH[s * 64 + lane]; Ap *= segA[s * 64 + lane]; }
      p.lru_h[sidx] = H; p.lru_a[sidx] = Ap;
    }
  } else {
    float H = Hprev;
#pragma unroll
    for (int s = 0; s < 4; ++s) if (s < w) H = segA[s * 64 + lane] * H + segH[s * 64 + lane];
    bfu* pm = p.mixed + (size_t)tok0 * 1024 + 512 + ch;
#pragma unroll
    for (int i = 0; i < 16; ++i) {
      const int t = w * 16 + i;
      const float hv = hl[i] + al[i] * H;
      pm[(size_t)t * 1024] = f2bf(hv * silu_(bf2f(gq[i])));
    }
  }
}

template <bool FINAL>
DI void s5_item(const Params& p, int l, int b, int c, int g4, unsigned char* smem) {
  const int tid = threadIdx.x, lane = tid & 63, w = tid >> 6;
  const int g = g4 * 4 + w;
  float* buw = (float*)(smem + w * 13312);
  bfu* stw = (bfu*)(smem + w * 13312 + 8448);
  const int tok0 = b * SEQ + c * 64;
  const int r = lane & 15, q = lane >> 4;
  const int lg = l * 16 + g;
  bf16x8 bfr[8], yfr[4];
#pragma unroll
  for (int nt = 0; nt < 8; ++nt) bfr[nt] = *(const bf16x8*)(p.bt_bu + ((size_t)lg * 128 + nt * 16 + r) * 32 + q * 8);
  if (FINAL) {
#pragma unroll
    for (int ks = 0; ks < 4; ++ks) yfr[ks] = *(const bf16x8*)(p.bt_y + ((size_t)lg * 16 + r) * 128 + ks * 32 + q * 8);
  }
  const float ar = p.abar[(lg * 64 + lane) * 2], ai = p.abar[(lg * 64 + lane) * 2 + 1];
  const size_t sbase = ((size_t)(b * NCH + c) * 16 + g) * 128;
  float xr = 0.f, xi = 0.f;
  if (FINAL) { xr = p.s5_state[sbase + lane]; xi = p.s5_state[sbase + 64 + lane]; }
  const float dsk = FINAL ? p.s5_d[l * 256 + g * 16 + r] : 0.f;
  bf16x8 afr[4];
  bfu uq[4][4];
#pragma unroll
  for (int mt = 0; mt < 4; ++mt) {
    afr[mt] = (bf16x8){0, 0, 0, 0, 0, 0, 0, 0};
    if (q < 2) afr[mt] = *(const bf16x8*)(p.proj + (size_t)(tok0 + mt * 16 + r) * PS + COL_DU + g * 16 + q * 8);
    if (FINAL) {
#pragma unroll
      for (int j = 0; j < 4; ++j) uq[mt][j] = p.proj[(size_t)(tok0 + mt * 16 + q * 4 + j) * PS + COL_DU + g * 16 + r];
    }
  }
  __syncthreads();
#pragma unroll
  for (int mt = 0; mt < 4; ++mt) {
    const bf16x8 a = afr[mt];
#pragma unroll
    for (int nt = 0; nt < 8; ++nt) {
      f32x4 acc = (f32x4){0.f, 0.f, 0.f, 0.f};
      acc = __builtin_amdgcn_mfma_f32_16x16x32_bf16(a, bfr[nt], acc, 0, 0, 0);
#pragma unroll
      for (int j = 0; j < 4; ++j) buw[(q * 4 + j) * 132 + nt * 16 + r] = acc[j];
    }
    wave_sync();
    {
      float br[16], bi[16];
#pragma unroll
      for (int tt = 0; tt < 16; ++tt) { br[tt] = buw[tt * 132 + lane]; bi[tt] = buw[tt * 132 + 64 + lane]; }
#pragma unroll
      for (int tt = 0; tt < 16; ++tt) {
        const float nr = ar * xr - ai * xi + br[tt];
        const float ni = ar * xi + ai * xr + bi[tt];
        xr = nr; xi = ni;
        br[tt] = xr; bi[tt] = xi;
      }
      if (FINAL) {
#pragma unroll
        for (int tt = 0; tt < 16; ++tt) { stw[tt * 136 + lane] = f2bf(br[tt]); stw[tt * 136 + 64 + lane] = f2bf(bi[tt]); }
      }
    }
    wave_sync();
    if (FINAL) {
      f32x4 y = (f32x4){0.f, 0.f, 0.f, 0.f};
#pragma unroll
      for (int ks = 0; ks < 4; ++ks) {
        bf16x8 a2 = *(const bf16x8*)(stw + r * 136 + ks * 32 + q * 8);
        y = __builtin_amdgcn_mfma_f32_16x16x32_bf16(a2, yfr[ks], y, 0, 0, 0);
      }
#pragma unroll
      for (int j = 0; j < 4; ++j) {
        const int t = mt * 16 + q * 4 + j;
        const float z = gelu_tanh_(y[j] + dsk * bf2f(uq[mt][j]));
        p.zbuf[(size_t)(tok0 + t) * 256 + g * 16 + r] = f2bf(z);
      }
      wave_sync();
    }
  }
  if (!FINAL) { p.s5_state[sbase + lane] = xr; p.s5_state[sbase + 64 + lane] = xi; }
}

DI void s5_glu(const Params& p, int l, int b, int c, unsigned char* smem) {
  const int tid = threadIdx.x, lane = tid & 63, w = tid >> 6;
  bfu* zs = (bfu*)smem;
  const int tok0 = b * SEQ + c * 64;
  const int r = lane & 15, q = lane >> 4;
  __syncthreads();
#pragma unroll
  for (int i = 0; i < 8; ++i) {
    const int id = tid + i * 256;
    *(uint4*)(zs + (id >> 5) * 264 + (id & 31) * 8) = *(const uint4*)(p.zbuf + (size_t)(tok0 + (id >> 5)) * 256 + (id & 31) * 8);
  }
  __syncthreads();
  const bfu* wg = p.wt_glu + l * 65536;
#pragma unroll 1
  for (int nc = 0; nc < 4; ++nc) {
    bfu gq[4][4]; float bgv[4];
#pragma unroll
    for (int nt = 0; nt < 4; ++nt) {
      bgv[nt] = p.b_glu[l * 256 + nc * 64 + nt * 16 + r];
#pragma unroll
      for (int j = 0; j < 4; ++j) gq[nt][j] = p.proj[(size_t)(tok0 + w * 16 + q * 4 + j) * PS + COL_DG + nc * 64 + nt * 16 + r];
    }
    f32x4 acc[4];
#pragma unroll
    for (int i = 0; i < 4; ++i) acc[i] = (f32x4){0.f, 0.f, 0.f, 0.f};
#pragma unroll
    for (int kh = 0; kh < 2; ++kh) {
      bf16x8 bq[4][4];
#pragma unroll
      for (int ks = 0; ks < 4; ++ks)
#pragma unroll
        for (int nt = 0; nt < 4; ++nt) bq[ks][nt] = *(const bf16x8*)(wg + (nc * 64 + nt * 16 + r) * 256 + kh * 128 + ks * 32 + q * 8);
#pragma unroll
      for (int ks = 0; ks < 4; ++ks) {
        const bf16x8 a = *(const bf16x8*)(zs + (w * 16 + r) * 264 + kh * 128 + ks * 32 + q * 8);
#pragma unroll
        for (int nt = 0; nt < 4; ++nt) acc[nt] = __builtin_amdgcn_mfma_f32_16x16x32_bf16(a, bq[ks][nt], acc[nt], 0, 0, 0);
      }
    }
#pragma unroll
    for (int nt = 0; nt < 4; ++nt) {
      const int n = nc * 64 + nt * 16 + r;
#pragma unroll
      for (int j = 0; j < 4; ++j) {
        const int t = w * 16 + q * 4 + j;
        const float zv = bf2f(zs[t * 264 + n]);
        const float gate = silu_(bf2f(gq[nt][j]));
        p.mixed[(size_t)(tok0 + t) * 1024 + 768 + n] = f2bf(zv * sigmoid_(acc[nt][j] + bgv[nt]) * gate);
      }
    }
  }
}

#define QLOOP(QI, N, BODY)                                                                            \
  {                                                                                                   \
    unsigned* q_ctr = p.cnt + CNT_Q + (l * 8 + (QI)) * 32;                                            \
    unsigned q_nxt = blockIdx.x;                                                                      \
    for (;;) {                                                                                        \
      __syncthreads();                                                                                \
      if (threadIdx.x == 0) *s_q = q_nxt;                                                             \
      __syncthreads();                                                                                \
      const int item = (int)*s_q;                                                                     \
      if (item >= (N)) break;                                                                         \
      if (threadIdx.x == 0) q_nxt = gridDim.x + __hip_atomic_fetch_add(q_ctr, 1u, __ATOMIC_RELAXED, __HIP_MEMORY_SCOPE_AGENT); \
      BODY;                                                                                           \
    }                                                                                                 \
  }

DI void phase2(const Params& p, int l, unsigned char* smem) {
  unsigned* s_q = (unsigned*)(smem + SMEM_BYTES - 32);
  QLOOP(0, 1024, s5_item<false>(p, l, item >> 7, (item >> 2) & 31, item & 3, smem))
  QLOOP(1, 1024, hg_local(p, l, item >> 7, (item >> 2) & 31, item & 3, smem))
  QLOOP(2, 1024, ml_local(p, l, item >> 7, (item >> 2) & 31, item & 3, smem))
  QLOOP(3, 1024, lru_item<false>(p, l, item >> 7, (item >> 2) & 31, item & 3, smem))
}

DI void phase3(const Params& p, int l) {
  const int gtid = blockIdx.x * 256 + threadIdx.x, gsz = gridDim.x * 256;
  constexpr int N1 = 131072, N2 = 131072, N3 = 2048, N4 = 2048, N5 = 8192;
  for (int i = gtid; i < N1 + N2 + N3 + N4 + N5; i += gsz) {
    if (i < N1 + N2) {
      const bool ml = i >= N1;
      const int j = ml ? i - N1 : i;
      const int b = j >> 14, rem = j & 16383, hd = rem >> 12, ed = rem & 4095, d = ed & 63;
      float* stp = (ml ? p.ml_state : p.hg_state) + (size_t)(b * NCH * 4 + hd) * 4096 + ed;
      const float* dcp = ml ? (p.ml_decay + b * NCH * 4 + hd) : (p.hg_decay + (b * NCH * 4 + hd) * 64 + d);
      const int dstride = ml ? 4 : 256;
      float S = 0.f;
#pragma unroll
      for (int c0 = 0; c0 < NCH; c0 += 16) {
        float loc[16], dec[16];
#pragma unroll
        for (int c = 0; c < 16; ++c) { loc[c] = stp[(size_t)(c0 + c) * 16384]; dec[c] = dcp[(c0 + c) * dstride]; }
#pragma unroll
        for (int c = 0; c < 16; ++c) { stp[(size_t)(c0 + c) * 16384] = S; S = dec[c] * S + loc[c]; }
      }
    } else if (i < N1 + N2 + N3) {
      const int j = i - N1 - N2, b = j >> 8, rem = j & 255, hd = rem >> 6, d = rem & 63;
      float S = 0.f;
#pragma unroll
      for (int c0 = 0; c0 < NCH; c0 += 16) {
        float loc[16], dec[16];
#pragma unroll
        for (int c = 0; c < 16; ++c) { const int base = (b * NCH + c0 + c) * 4 + hd; dec[c] = p.ml_decay[base]; loc[c] = p.ml_n[base * 64 + d]; }
#pragma unroll
        for (int c = 0; c < 16; ++c) { const int base = (b * NCH + c0 + c) * 4 + hd; p.ml_n[base * 64 + d] = S; S = dec[c] * S + loc[c]; }
      }
    } else if (i < N1 + N2 + N3 + N4) {
      const int j = i - N1 - N2 - N3, b = j >> 8, ch = j & 255;
      float H = 0.f;
#pragma unroll
      for (int c0 = 0; c0 < NCH; c0 += 16) {
        float av[16], hv[16];
#pragma unroll
        for (int c = 0; c < 16; ++c) { const int idx = (b * NCH + c0 + c) * 256 + ch; av[c] = p.lru_a[idx]; hv[c] = p.lru_h[idx]; }
#pragma unroll
        for (int c = 0; c < 16; ++c) { const int idx = (b * NCH + c0 + c) * 256 + ch; p.lru_h[idx] = H; H = av[c] * H + hv[c]; }
      }
    } else {
      const int j = i - N1 - N2 - N3 - N4, b = j >> 10, g = (j >> 6) & 15, pp = j & 63;
      const float ar = p.abar64[((l * 16 + g) * 64 + pp) * 2], ai = p.abar64[((l * 16 + g) * 64 + pp) * 2 + 1];
      float xr = 0.f, xi = 0.f;
#pragma unroll
      for (int c0 = 0; c0 < NCH; c0 += 16) {
        float lr[16], li[16];
#pragma unroll
        for (int c = 0; c < 16; ++c) { const size_t sb = ((size_t)(b * NCH + c0 + c) * 16 + g) * 128; lr[c] = p.s5_state[sb + pp]; li[c] = p.s5_state[sb + 64 + pp]; }
#pragma unroll
        for (int c = 0; c < 16; ++c) {
          const size_t sb = ((size_t)(b * NCH + c0 + c) * 16 + g) * 128;
          p.s5_state[sb + pp] = xr; p.s5_state[sb + 64 + pp] = xi;
          const float nr = ar * xr - ai * xi + lr[c], ni = ar * xi + ai * xr + li[c];
          xr = nr; xi = ni;
        }
      }
    }
  }
}

DI void phase4(const Params& p, int l, unsigned char* smem, unsigned long long& tp_acc) {
  unsigned* s_flag = (unsigned*)(smem + SMEM_BYTES - 16);
  unsigned* s_q = (unsigned*)(smem + SMEM_BYTES - 32);
  TPS(41)
  QLOOP(4, 256, {
    _Pragma("unroll 1") for (int g4 = 0; g4 < 4; ++g4) s5_item<true>(p, l, item >> 5, item & 31, g4, smem);
    asm volatile("s_waitcnt vmcnt(0)" ::: "memory");
    s5_glu(p, l, item >> 5, item & 31, smem);
  })
  TPE(41)
  TPS(42)
  QLOOP(5, 1024, hg_out(p, l, item >> 7, (item >> 2) & 31, item & 3, smem))
  TPE(42)
  TPS(43)
  QLOOP(6, 1024, ml_out(p, l, item >> 7, (item >> 2) & 31, item & 3, smem))
  TPE(43)
  TPS(44)
  QLOOP(7, 1024, lru_item<true>(p, l, item >> 7, (item >> 2) & 31, item & 3, smem))
  TPE(44)
}

#ifdef TPROBE
#define TP_CLASS(PH) ((PH) == 0 ? 0 : (((PH) - 1) % 6) + 1)
#define TP_BEGIN(PH) unsigned long long tp_t0 = 0; if (TP_CLASS(PH) == TPROBE) tp_t0 = __builtin_amdgcn_s_memrealtime();
#define TP_END(PH) if (TP_CLASS(PH) == TPROBE) tp_acc += __builtin_amdgcn_s_memrealtime() - tp_t0;
#else
#define TP_BEGIN(PH)
#define TP_END(PH)
#endif
#define RUN_PHASE(PH, CALL)                                       \
  if (ph0 <= (PH) && (PH) < ph1) {                                \
    TP_BEGIN(PH)                                                  \
    CALL;                                                         \
    if (COOP) { if ((PH) + 1 < ph1) xcd_barrier(xb); }            \
    TP_END(PH)                                                    \
  }

template <bool COOP, int L>
DI void run_layer(const Params& p, int ph0, int ph1, unsigned char* smem, const XcdBarrier& xb, unsigned long long& tp_acc) {
#ifdef DUP1
  RUN_PHASE(1 + 6 * L, phase1(p, L, smem))
#endif
  RUN_PHASE(1 + 6 * L, phase1(p, L, smem))
#ifdef DUP2
  RUN_PHASE(2 + 6 * L, phase2(p, L, smem))
#endif
  RUN_PHASE(2 + 6 * L, phase2(p, L, smem))
  RUN_PHASE(3 + 6 * L, { phase3(p, L); if (L + 1 < DEPTH) convert_weights<(L + 1 < DEPTH ? L + 1 : 0)>(p, smem); })
#ifdef DUP4
  RUN_PHASE(4 + 6 * L, phase4(p, L, smem, tp_acc))
#endif
  RUN_PHASE(4 + 6 * L, phase4(p, L, smem, tp_acc))
  RUN_PHASE(5 + 6 * L, phase5(p, L, smem, tp_acc))
  RUN_PHASE(6 + 6 * L, phase6(p, L))
}

template <bool COOP>
__global__ void __launch_bounds__(256, 2) mk_fwd(Params p, int ph0, int ph1) {
  __shared__ __attribute__((aligned(16))) unsigned char smem[SMEM_BYTES];
  __shared__ uint4 xb_words;
  XcdBarrier xb; xb.bar = p.bar; xb.x = 0; xb.st = nullptr;
  if (COOP) {
    if (ph1 < 0) cg::this_grid().sync();
    if (threadIdx.x == 0) xb_words = make_uint4(0u, 0u, 0u, 0u);
    __syncthreads();
    xb = xcd_barrier_post(p.bar, (volatile LAS unsigned*)&xb_words);
  }
  unsigned long long tp_acc = 0;
  RUN_PHASE(0, phase0(p, smem))
  run_layer<COOP, 0>(p, ph0, ph1, smem, xb, tp_acc);
  run_layer<COOP, 1>(p, ph0, ph1, smem, xb, tp_acc);
  run_layer<COOP, 2>(p, ph0, ph1, smem, xb, tp_acc);
  run_layer<COOP, 3>(p, ph0, ph1, smem, xb, tp_acc);
#ifdef TPROBE
  if (blockIdx.x == 0 && threadIdx.x == 0) {
    const unsigned long long t0 = __builtin_amdgcn_s_memrealtime();
    while (__builtin_amdgcn_s_memrealtime() - t0 < tp_acc) __builtin_amdgcn_s_sleep(8);
  }
#endif
}

extern "C" void kernel_launch(void* const* d_in, const int* in_sizes, int n_in, void* d_out, int out_size, void* d_ws,
                              size_t ws_size, hipStream_t stream) {
  static int grid_blocks = 0;
  if (!grid_blocks) {
    int dev = 0, cus = 0, per_cu = 0;
    hipGetDevice(&dev);
    hipDeviceGetAttribute(&cus, hipDeviceAttributeMultiprocessorCount, dev);
    hipOccupancyMaxActiveBlocksPerMultiprocessor(&per_cu, mk_fwd<(MEGA != 0)>, 256, 0);
    if (per_cu < 1) per_cu = 1;
    if (per_cu > 2) per_cu = 2;
    grid_blocks = cus * per_cu;
  }
  Params p{};
  const float** pin = (const float**)&p;
  for (int i = 0; i < 28; ++i) pin[i] = (const float*)d_in[i];
  p.out = (float*)d_out;
  unsigned char* ws = (unsigned char*)d_ws;
  size_t off = 0;
  auto take = [&](size_t bytes) { unsigned char* r = ws + off; off += (bytes + 255) & ~(size_t)255; return r; };
  p.wt_in = (bfu*)take((size_t)4 * PS * 1024 * 2);
  p.wt_out = (bfu*)take((size_t)4 * 1024 * 1024 * 2);
  p.wt_a = (bfu*)take(16 * 4096 * 2);
  p.wt_x = (bfu*)take(16 * 4096 * 2);
  p.wt_glu = (bfu*)take(4 * 65536 * 2);
  p.bt_bu = (bfu*)take(64 * 128 * 32 * 2);
  p.bt_y = (bfu*)take(64 * 16 * 128 * 2);
  p.hb = (bfu*)take((size_t)NTOK * 1024 * 2);
  p.proj = (bfu*)take((size_t)NTOK * PS * 2);
  p.mixed = (bfu*)take((size_t)NTOK * 1024 * 2);
  p.zbuf = (bfu*)take((size_t)NTOK * 256 * 2);
  p.abar = (float*)take(4096 * 2 * 4);
  p.abar64 = (float*)take(4096 * 2 * 4);
  p.lbs = (float*)take(1024 * 4);
  p.hg_state = (float*)take((size_t)BATCH * NCH * 4 * 4096 * 4);
  p.hg_decay = (float*)take((size_t)BATCH * NCH * 4 * 64 * 4);
  p.ml_state = (float*)take((size_t)BATCH * NCH * 4 * 4096 * 4);
  p.ml_n = (float*)take((size_t)BATCH * NCH * 4 * 64 * 4);
  p.ml_decay = (float*)take((size_t)BATCH * NCH * 4 * 4);
  p.lru_h = (float*)take((size_t)BATCH * NCH * 256 * 4);
  p.lru_a = (float*)take((size_t)BATCH * NCH * 256 * 4);
  p.s5_state = (float*)take((size_t)BATCH * NCH * 16 * 128 * 4);
  p.cnt = (unsigned*)take(CNT_TOTAL * 4);
  p.bar = (unsigned*)take(XCD_BAR_WORDS * 4);
  if (off > ws_size) { fprintf(stderr, "workspace too small: need %zu have %zu\n", off, ws_size); return; }
  const int NPH = 1 + 6 * DEPTH;
#if MEGA
  (void)hipMemsetAsync(p.bar, 0, XCD_BAR_WORDS * 4, stream);
  int ph0 = 0, ph1 = NPH;
  void* args[] = {&p, &ph0, &ph1};
  hipError_t e = hipLaunchCooperativeKernel((void*)mk_fwd<true>, dim3(grid_blocks), dim3(256), args, 0, stream);
  if (e != hipSuccess) fprintf(stderr, "cooperative launch failed: %s (grid %d)\n", hipGetErrorString(e), grid_blocks);
#else
  for (int ph = 0; ph < NPH; ++ph) hipLaunchKernelGGL(mk_fwd<false>, dim3(grid_blocks), dim3(256), 0, stream, p, ph, ph + 1);
#endif
}
```

```cpp
#include <hip/hip_runtime.h>
#include <hip/hip_cooperative_groups.h>
#include <stdint.h>
#include <stdio.h>
namespace cg = cooperative_groups;

#ifndef MEGA
#define MEGA 1
#endif

typedef unsigned short bfu;
using bf16x8 = __attribute__((ext_vector_type(8))) short;
using f32x4  = __attribute__((ext_vector_type(4))) float;
#define DI __device__ __forceinline__

constexpr int BATCH = 8, SEQ = 2048, DM = 1024, DEPTH = 4, NTOK = BATCH * SEQ, NCH = SEQ / 64;
constexpr int DIN = 3080, PS = 3200;
constexpr int COL_AQ = 0, COL_AF = 256, COL_AI = 512, COL_AG = 768;
constexpr int COL_BQ = 1024, COL_BK = 1280, COL_BV = 1536, COL_BG = 1792, COL_BIG = 3072, COL_BFG = 3076;
constexpr int COL_CX = 2048, COL_CG = 2304, COL_DU = 2560, COL_DG = 2816;
constexpr float DN_ALPHA = 1.681792830507429f;
constexpr int SMEM_BYTES = 56 * 1024;
constexpr int CNT_LN = 0, CNT_GLU = 4 * 128, CNT_Q = 4 * 128 + 4 * 256, CNT_TOTAL = CNT_Q + 32 * 32;

struct Params {
  const float *x, *w_in, *b_in, *lb_logits, *hg_g, *ml_fb, *ml_g, *conv_w, *conv_b, *w_a, *b_a, *w_x, *b_x, *lam,
      *a_re, *a_im, *log_dt, *sb_re, *sb_im, *c_re, *c_im, *s5_d, *w_glu, *b_glu, *w_out, *b_out, *ln_g, *ln_b;
  float* out;
  bfu *wt_in, *wt_out, *wt_a, *wt_x, *wt_glu, *bt_bu, *bt_y, *hb, *proj, *mixed, *zbuf;
  float *abar, *abar64, *lbs, *hg_state, *hg_decay, *ml_state, *ml_n, *ml_decay, *lru_h, *lru_a, *s5_state;
  unsigned* cnt;
  unsigned* bar;
};

DI bfu f2bf(float x) { return __builtin_bit_cast(unsigned short, (__bf16)x); }
DI float bf2f(bfu h) { return __uint_as_float(((unsigned)h) << 16); }
typedef __bf16 bf16v2 __attribute__((ext_vector_type(2)));
typedef float f32v2 __attribute__((ext_vector_type(2)));
DI unsigned pack2(float a, float b) { f32v2 v = {a, b}; return __builtin_bit_cast(unsigned, __builtin_convertvector(v, bf16v2)); }
DI float fexp(float x) { return __expf(x); }
DI float frcp(float x) { return __builtin_amdgcn_rcpf(x); }
DI float flog(float x) { return __logf(x); }
DI float sigmoid_(float x) { return frcp(1.f + fexp(-x)); }
DI float silu_(float x) { return x * frcp(1.f + fexp(-x)); }
DI float logsig_(float x) { return fminf(x, 0.f) - flog(1.f + fexp(-fabsf(x))); }
DI float logsig_acc(float x) { return fminf(x, 0.f) - log1pf(expf(-fabsf(x))); }
DI float gelu_tanh_(float x) {
  float u = 0.7978845608028654f * (x + 0.044715f * x * x * x);
  float th = 1.f - 2.f * frcp(fexp(2.f * u) + 1.f);
  return 0.5f * x * (1.f + th);
}

template <int NT, int KS>
DI void wave_mma(f32x4 (&acc)[NT], const bfu* A, int lda, const bfu* Bt, int ldb, int lane) {
  const int r = lane & 15, q = lane >> 4;
#pragma unroll
  for (int ks = 0; ks < KS; ++ks) {
    bf16x8 a = *(const bf16x8*)(A + r * lda + ks * 32 + q * 8);
#pragma unroll
    for (int nt = 0; nt < NT; ++nt) {
      bf16x8 b = *(const bf16x8*)(Bt + (nt * 16 + r) * ldb + ks * 32 + q * 8);
      acc[nt] = __builtin_amdgcn_mfma_f32_16x16x32_bf16(a, b, acc[nt], 0, 0, 0);
    }
  }
}

DI void wave_sync() { __builtin_amdgcn_fence(__ATOMIC_SEQ_CST, "wavefront"); __builtin_amdgcn_wave_barrier(); __builtin_amdgcn_fence(__ATOMIC_SEQ_CST, "wavefront"); }
DI float group16_sum(float v) {
  v += __shfl_xor(v, 1); v += __shfl_xor(v, 2); v += __shfl_xor(v, 4); v += __shfl_xor(v, 8);
  return v;
}
DI float wave_sum(float v) {
  v += __shfl_xor(v, 1); v += __shfl_xor(v, 2); v += __shfl_xor(v, 4); v += __shfl_xor(v, 8);
  v += __shfl_xor(v, 16); v += __shfl_xor(v, 32);
  return v;
}

DI bool last_arriver(unsigned* ctr, unsigned total, unsigned* s_flag) {
  asm volatile("s_waitcnt vmcnt(0)" ::: "memory");
  __syncthreads();
  if (threadIdx.x == 0) {
    __builtin_amdgcn_fence(__ATOMIC_RELEASE, "agent");
    asm volatile("s_waitcnt vmcnt(0)" ::: "memory");
    const unsigned old = __hip_atomic_fetch_add(ctr, 1u, __ATOMIC_RELAXED, __HIP_MEMORY_SCOPE_AGENT);
    const unsigned last = (old == total - 1u) ? 1u : 0u;
    if (last) { __builtin_amdgcn_fence(__ATOMIC_ACQUIRE, "agent"); asm volatile("s_waitcnt vmcnt(0)" ::: "memory"); }
    *s_flag = last;
  }
  __syncthreads();
  return (*s_flag != 0u);
}

#ifdef TPROBE
#define TPS(ID) unsigned long long tps_##ID = 0; if (TPROBE == (ID)) tps_##ID = __builtin_amdgcn_s_memrealtime();
#define TPE(ID) if (TPROBE == (ID)) tp_acc += __builtin_amdgcn_s_memrealtime() - tps_##ID;
#else
#define TPS(ID)
#define TPE(ID)
#endif

#define XB_TMO      128
#define XB_XCNT(j)  (256  + 64 * (j))
#define XB_XSUB(j)  (1280 + 64 * (j))
#define XB_XGEN(j)  (2304 + 64 * (j))
#define XB_TOP      3328
#define XB_TOPGEN   3392
#define XCD_BAR_WORDS 3456
#define XB_SPIN_CAP (1u << 22)
#define LAS __attribute__((address_space(3)))
DI unsigned xb_ld(unsigned* p) { return __hip_atomic_load(p, __ATOMIC_RELAXED, __HIP_MEMORY_SCOPE_AGENT); }
DI unsigned xb_add(unsigned* p, unsigned v) { return __hip_atomic_fetch_add(p, v, __ATOMIC_RELAXED, __HIP_MEMORY_SCOPE_AGENT); }
DI unsigned xb_xcc_id() { return (unsigned)__builtin_amdgcn_s_getreg((3 << 11) | 20) & 0xFu; }
#define XB_SPIN(cond, bar) do { unsigned _sp = 0; while (cond) { __builtin_amdgcn_s_sleep(1); \
    if ((++_sp & 255u) == 0u) { if (xb_ld(&(bar)[XB_TMO])) break; if (_sp > XB_SPIN_CAP) { atomicAdd(&(bar)[XB_TMO], 1u); break; } } } } while (0)
struct XcdBarrier { unsigned* bar; unsigned x; volatile LAS unsigned* st; };
DI XcdBarrier xcd_barrier_post(unsigned* bar, volatile LAS unsigned* st) {
  XcdBarrier b; b.bar = bar; b.x = xb_xcc_id(); b.st = st;
  if (threadIdx.x == 0) (void)xb_add(&bar[XB_XCNT(b.x)], 1u);
  return b;
}
DI void xcd_barrier_complete(unsigned* bar, unsigned x, unsigned& nloc, unsigned& nx) {
  const unsigned G = gridDim.x * gridDim.y * gridDim.z;
  unsigned sum, cnt, mine, sp = 0u;
  for (;;) {
    sum = 0u; cnt = 0u; mine = 0u;
#pragma unroll
    for (unsigned j = 0; j < 16; ++j) { const unsigned c = xb_ld(&bar[XB_XCNT(j)]); sum += c; cnt += (c > 0u) ? 1u : 0u; mine = (j == x) ? c : mine; }
    if (sum == G) break;
    __builtin_amdgcn_s_sleep(1);
    if ((++sp & 255u) == 0u) { if (xb_ld(&bar[XB_TMO])) break; if (sp > XB_SPIN_CAP) { atomicAdd(&bar[XB_TMO], 1u); break; } }
  }
  nloc = mine > 0u ? mine : 1u; nx = cnt > 0u ? cnt : 1u;
}
DI void xcd_barrier(const XcdBarrier& b) {
  asm volatile("s_waitcnt vmcnt(0)" ::: "memory");
  __syncthreads();
  if (threadIdx.x == 0) {
    unsigned* bar = b.bar;
    __builtin_amdgcn_s_waitcnt(0);
    unsigned nloc = b.st[0], nx = b.st[1];
    if (nloc == 0u) { xcd_barrier_complete(bar, b.x, nloc, nx); b.st[0] = nloc; b.st[1] = nx; }
    const unsigned old = xb_add(&bar[XB_XSUB(b.x)], 1u);
    const unsigned gen = old / nloc;
    if (old + 1u == (gen + 1u) * nloc) {
      __builtin_amdgcn_fence(__ATOMIC_RELEASE, "agent");
      asm volatile("s_waitcnt vmcnt(0)" ::: "memory");
      const unsigned og = xb_add(&bar[XB_TOP], 1u);
      const unsigned tg = og / nx;
      if (og + 1u == (tg + 1u) * nx) xb_add(&bar[XB_TOPGEN], 1u);
      else XB_SPIN(xb_ld(&bar[XB_TOPGEN]) == tg, bar);
      __builtin_amdgcn_fence(__ATOMIC_ACQUIRE, "agent");
      xb_add(&bar[XB_XGEN(b.x)], 1u);
      asm volatile("s_waitcnt vmcnt(0)" ::: "memory");
    } else {
      XB_SPIN(xb_ld(&bar[XB_XGEN(b.x)]) == gen, bar);
      __builtin_amdgcn_fence(__ATOMIC_ACQUIRE, "agent");
      asm volatile("s_waitcnt vmcnt(0)" ::: "memory");
    }
  }
  __syncthreads();
}

DI void transpose_tile(const float* src, int sld, int cv, bfu* dst, int dld, float* tile) {
  const int tid = threadIdx.x;
  __syncthreads();
  for (int i = tid; i < 4096; i += 256) {
    int r = i >> 6, c = i & 63;
    tile[r * 65 + c] = (c < cv) ? src[(size_t)r * sld + c] : 0.f;
  }
  __syncthreads();
  for (int i = tid; i < 4096; i += 256) {
    int n = i >> 6, k = i & 63;
    dst[(size_t)n * dld + k] = f2bf(tile[k * 65 + n]);
  }
}

template <int LSEL>
DI void convert_weights(const Params& p, unsigned char* smem) {
  const int tid = threadIdx.x;
  float* tile = (float*)smem;
  const int NJ = 3200 + 1024 + 16 + 16 + 64;
  for (int job = blockIdx.x; job < NJ; job += gridDim.x) {
    const float* src; int sld, cv = 64, dld; bfu* dst;
    if (job < 3200) {
      int l = job / 800, rem = job % 800, kt = rem / 50, nt = rem % 50;
      if (l != LSEL) continue;
      const int c0 = nt < 28 ? nt * 64 : (nt < 48 ? nt * 64 + 8 : 1792);
      src = p.w_in + (size_t)l * 1024 * DIN + (size_t)kt * 64 * DIN + c0; sld = DIN;
      cv = nt < 48 ? 64 : (nt == 48 ? 8 : 0);
      dst = p.wt_in + (size_t)l * PS * 1024 + (size_t)nt * 64 * 1024 + kt * 64; dld = 1024;
    } else if (job < 4224) {
      int j = job - 3200, l = j / 256, rem = j % 256, kt = rem / 16, nt = rem % 16;
      if (l != LSEL) continue;
      src = p.w_out + (size_t)l * 1048576 + (size_t)kt * 64 * 1024 + nt * 64; sld = 1024;
      dst = p.wt_out + (size_t)l * 1048576 + (size_t)nt * 64 * 1024 + kt * 64; dld = 1024;
    } else if (LSEL != 0) {
      continue;
    } else if (job < 4240) {
      int j = job - 4224; src = p.w_a + j * 4096; sld = 64; dst = p.wt_a + j * 4096; dld = 64;
    } else if (job < 4256) {
      int j = job - 4240; src = p.w_x + j * 4096; sld = 64; dst = p.wt_x + j * 4096; dld = 64;
    } else {
      int j = job - 4256, l = j / 16, rem = j % 16, kt = rem / 4, nt = rem % 4;
      src = p.w_glu + l * 65536 + kt * 64 * 256 + nt * 64; sld = 256;
      dst = p.wt_glu + l * 65536 + nt * 64 * 256 + kt * 64; dld = 256;
    }
    transpose_tile(src, sld, cv, dst, dld, tile);
  }
}

DI void phase0(const Params& p, unsigned char* smem) {
  const int tid = threadIdx.x;
  const int gtid = blockIdx.x * 256 + tid, gsz = gridDim.x * 256;
  for (int i0 = gtid; i0 < NTOK * DM / 8; i0 += 4 * gsz) {
    float4 a[4], b[4];
#pragma unroll
    for (int u = 0; u < 4; ++u) {
      const int i = i0 + u * gsz;
      if (i < NTOK * DM / 8) { a[u] = ((const float4*)p.x)[2 * i]; b[u] = ((const float4*)p.x)[2 * i + 1]; }
    }
#pragma unroll
    for (int u = 0; u < 4; ++u) {
      const int i = i0 + u * gsz;
      if (i < NTOK * DM / 8) {
        uint4 o; o.x = pack2(a[u].x, a[u].y); o.y = pack2(a[u].z, a[u].w); o.z = pack2(b[u].x, b[u].y); o.w = pack2(b[u].z, b[u].w);
        ((uint4*)p.hb)[i] = o;
      }
    }
  }
  convert_weights<0>(p, smem);
  for (int i = (gridDim.x - 1 - blockIdx.x) * 256 + tid; i < 4096; i += gsz) {
    int lg = i >> 6, pp = i & 63;
    double dt = exp((double)p.log_dt[lg]);
    double are = p.a_re[lg * 64 + pp], aim = p.a_im[lg * 64 + pp];
    double mag = exp(dt * are), ang = dt * aim;
    double abr = mag * cos(ang), abi = mag * sin(ang);
    double den = are * are + aim * aim;
    double xr = abr - 1.0, xi = abi;
    double zr = (xr * are + xi * aim) / den, zi = (xi * are - xr * aim) / den;
    bfu* o_re = p.bt_bu + ((size_t)lg * 128 + pp) * 32;
    bfu* o_im = p.bt_bu + ((size_t)lg * 128 + 64 + pp) * 32;
    for (int h = 0; h < 16; ++h) {
      double br = p.sb_re[(lg * 64 + pp) * 16 + h], bi = p.sb_im[(lg * 64 + pp) * 16 + h];
      o_re[h] = f2bf((float)(zr * br - zi * bi));
      o_im[h] = f2bf((float)(zr * bi + zi * br));
      o_re[16 + h] = 0; o_im[16 + h] = 0;
    }
    p.abar[(lg * 64 + pp) * 2 + 0] = (float)abr; p.abar[(lg * 64 + pp) * 2 + 1] = (float)abi;
    double mag64 = exp(64.0 * dt * are), ang64 = 64.0 * ang;
    p.abar64[(lg * 64 + pp) * 2 + 0] = (float)(mag64 * cos(ang64));
    p.abar64[(lg * 64 + pp) * 2 + 1] = (float)(mag64 * sin(ang64));
  }
  for (int i = gtid; i < 4 * 16 * 16 * 128; i += gsz) {
    int k = i & 127, lgn = i >> 7;
    p.bt_y[i] = (k < 64) ? f2bf(p.c_re[lgn * 64 + k]) : f2bf(-p.c_im[lgn * 64 + (k - 64)]);
  }
  for (int i = gtid; i < 256; i += gsz) {
    float v0 = p.lb_logits[i], v1 = p.lb_logits[256 + i], v2 = p.lb_logits[512 + i], v3 = p.lb_logits[768 + i];
    float m = fmaxf(fmaxf(v0, v1), fmaxf(v2, v3));
    float e0 = expf(v0 - m), e1 = expf(v1 - m), e2 = expf(v2 - m), e3 = expf(v3 - m);
    float s = e0 + e1 + e2 + e3;
    p.lbs[i] = 0.f; p.lbs[256 + i] = e1 / s; p.lbs[512 + i] = (e1 + e2) / s; p.lbs[768 + i] = (e1 + e2 + e3) / s;
  }
  for (int i = gtid; i < CNT_TOTAL; i += gsz) p.cnt[i] = 0u;
}

DI void gemm1_tile(const Params& p, int l, const bfu* A, const bfu* Bt, int m0, int n0, unsigned char* smem) {
  bfu* sA = (bfu*)smem; bfu* sB = sA + 128 * 72;
  bfu* sC = (bfu*)smem;
  const int tid = threadIdx.x, lane = tid & 63, w = tid >> 6, wm = w >> 1, wn = w & 1;
  const int r = lane & 15, q = lane >> 4;
  f32x4 acc[4][6];
#pragma unroll
  for (int i = 0; i < 4; ++i)
#pragma unroll
    for (int j = 0; j < 6; ++j) acc[i][j] = (f32x4){0.f, 0.f, 0.f, 0.f};
  const int lrow = tid >> 3, lkc = tid & 7;
  const bfu* ga = A + (size_t)(m0 + lrow) * 1024 + lkc * 8;
  const bfu* gb = Bt + (size_t)(n0 + lrow) * 1024 + lkc * 8;
  uint4 ra0 = *(const uint4*)(ga), ra1 = *(const uint4*)(ga + 32 * 1024), ra2 = *(const uint4*)(ga + 64 * 1024), ra3 = *(const uint4*)(ga + 96 * 1024);
  uint4 rb0 = *(const uint4*)(gb), rb1 = *(const uint4*)(gb + 32 * 1024), rb2 = *(const uint4*)(gb + 64 * 1024), rb3 = *(const uint4*)(gb + 96 * 1024);
  uint4 rb4 = *(const uint4*)(gb + 128 * 1024), rb5 = *(const uint4*)(gb + 160 * 1024);
  bfu* wa = sA + lrow * 72 + lkc * 8;
  bfu* wb = sB + lrow * 72 + lkc * 8;
  for (int kt = 0; kt < 16; ++kt) {
    __syncthreads();
    *(uint4*)(wa) = ra0; *(uint4*)(wa + 32 * 72) = ra1; *(uint4*)(wa + 64 * 72) = ra2; *(uint4*)(wa + 96 * 72) = ra3;
    *(uint4*)(wb) = rb0; *(uint4*)(wb + 32 * 72) = rb1; *(uint4*)(wb + 64 * 72) = rb2; *(uint4*)(wb + 96 * 72) = rb3;
    *(uint4*)(wb + 128 * 72) = rb4; *(uint4*)(wb + 160 * 72) = rb5;
    __syncthreads();
    if (kt + 1 < 16) {
      const bfu* ga2 = ga + (kt + 1) * 64; const bfu* gb2 = gb + (kt + 1) * 64;
      ra0 = *(const uint4*)(ga2); ra1 = *(const uint4*)(ga2 + 32 * 1024); ra2 = *(const uint4*)(ga2 + 64 * 1024); ra3 = *(const uint4*)(ga2 + 96 * 1024);
      rb0 = *(const uint4*)(gb2); rb1 = *(const uint4*)(gb2 + 32 * 1024); rb2 = *(const uint4*)(gb2 + 64 * 1024); rb3 = *(const uint4*)(gb2 + 96 * 1024);
      rb4 = *(const uint4*)(gb2 + 128 * 1024); rb5 = *(const uint4*)(gb2 + 160 * 1024);
    }
#pragma unroll
    for (int ks = 0; ks < 2; ++ks) {
      bf16x8 af[4], bfr[6];
#pragma unroll
      for (int mt = 0; mt < 4; ++mt) af[mt] = *(const bf16x8*)(sA + (wm * 64 + mt * 16 + r) * 72 + ks * 32 + q * 8);
#pragma unroll
      for (int nt = 0; nt < 6; ++nt) bfr[nt] = *(const bf16x8*)(sB + (wn * 96 + nt * 16 + r) * 72 + ks * 32 + q * 8);
#pragma unroll
      for (int mt = 0; mt < 4; ++mt)
#pragma unroll
        for (int nt = 0; nt < 6; ++nt) acc[mt][nt] = __builtin_amdgcn_mfma_f32_16x16x32_bf16(af[mt], bfr[nt], acc[mt][nt], 0, 0, 0);
    }
  }
  float bias[6];
#pragma unroll
  for (int nt = 0; nt < 6; ++nt) {
    const int col = n0 + wn * 96 + nt * 16 + r;
    bias[nt] = p.b_in[l * DIN + (col < 1792 ? col : col + 8)];
  }
  __syncthreads();
#pragma unroll
  for (int mt = 0; mt < 4; ++mt)
#pragma unroll
    for (int nt = 0; nt < 6; ++nt)
#pragma unroll
      for (int j = 0; j < 4; ++j)
        sC[(wm * 64 + mt * 16 + q * 4 + j) * 200 + wn * 96 + nt * 16 + r] = f2bf(acc[mt][nt][j] + bias[nt]);
  __syncthreads();
#pragma unroll
  for (int i = 0; i < 12; ++i) {
    const int id = tid + i * 256, row = id / 24, ch = id % 24;
    *(uint4*)(p.proj + (size_t)(m0 + row) * PS + n0 + ch * 8) = *(const uint4*)(sC + row * 200 + ch * 8);
  }
}

DI void gemm1_gates(const Params& p, int l, const bfu* A, const bfu* Bt, int m0) {
  const int tid = threadIdx.x, lane = tid & 63, w = tid >> 6, r = lane & 15, q = lane >> 4;
  const bfu* a0 = A + (size_t)(m0 + w * 32 + r) * 1024 + q * 8;
  const bfu* a1 = a0 + 16 * 1024;
  const bfu* bp = Bt + (size_t)(3072 + r) * 1024 + q * 8;
  f32x4 c0 = (f32x4){0.f, 0.f, 0.f, 0.f}, c1 = (f32x4){0.f, 0.f, 0.f, 0.f};
#pragma unroll 4
  for (int ks = 0; ks < 32; ++ks) {
    const bf16x8 b = *(const bf16x8*)(bp + ks * 32);
    const bf16x8 x0 = *(const bf16x8*)(a0 + ks * 32);
    const bf16x8 x1 = *(const bf16x8*)(a1 + ks * 32);
    c0 = __builtin_amdgcn_mfma_f32_16x16x32_bf16(x0, b, c0, 0, 0, 0);
    c1 = __builtin_amdgcn_mfma_f32_16x16x32_bf16(x1, b, c1, 0, 0, 0);
  }
  if (r < 8) {
    const float bias = p.b_in[l * DIN + 1792 + r];
#pragma unroll
    for (int j = 0; j < 4; ++j) {
      p.proj[(size_t)(m0 + w * 32 + q * 4 + j) * PS + 3072 + r] = f2bf(c0[j] + bias);
      p.proj[(size_t)(m0 + w * 32 + 16 + q * 4 + j) * PS + 3072 + r] = f2bf(c1[j] + bias);
    }
  }
}

DI void phase1(const Params& p, int l, unsigned char* smem) {
  const bfu* Bt = p.wt_in + (size_t)l * PS * 1024;
  for (int tile = blockIdx.x; tile < 128 * 16; tile += gridDim.x) { const int mt = tile >> 4, nt = tile & 15; gemm1_tile(p, l, p.hb, Bt, mt * 128, nt * 192, smem); }
  for (int job = blockIdx.x; job < 128; job += gridDim.x) gemm1_gates(p, l, p.hb, Bt, job * 128);
}

template <int EPI>
DI void gemm2_tile(const Params& p, int l, const bfu* A, const bfu* Bt, int m0, int n0, const float* hin, unsigned char* smem) {
  bfu* sA = (bfu*)smem; bfu* sB = sA + 128 * 72;
  const int tid = threadIdx.x, lane = tid & 63, w = tid >> 6, wm = w >> 1, wn = w & 1;
  const int r = lane & 15, q = lane >> 4;
  f32x4 acc[4][4];
#pragma unroll
  for (int i = 0; i < 4; ++i)
#pragma unroll
    for (int j = 0; j < 4; ++j) acc[i][j] = (f32x4){0.f, 0.f, 0.f, 0.f};
  const int lrow = tid >> 3, lkc = tid & 7;
  const bfu* ga = A + (size_t)(m0 + lrow) * 1024 + lkc * 8;
  const bfu* gb = Bt + (size_t)(n0 + lrow) * 1024 + lkc * 8;
  uint4 ra0 = *(const uint4*)(ga), ra1 = *(const uint4*)(ga + 32 * 1024), ra2 = *(const uint4*)(ga + 64 * 1024), ra3 = *(const uint4*)(ga + 96 * 1024);
  uint4 rb0 = *(const uint4*)(gb), rb1 = *(const uint4*)(gb + 32 * 1024), rb2 = *(const uint4*)(gb + 64 * 1024), rb3 = *(const uint4*)(gb + 96 * 1024);
  bfu* wa = sA + lrow * 72 + lkc * 8;
  bfu* wb = sB + lrow * 72 + lkc * 8;
  for (int kt = 0; kt < 16; ++kt) {
    __syncthreads();
    *(uint4*)(wa) = ra0; *(uint4*)(wa + 32 * 72) = ra1; *(uint4*)(wa + 64 * 72) = ra2; *(uint4*)(wa + 96 * 72) = ra3;
    *(uint4*)(wb) = rb0; *(uint4*)(wb + 32 * 72) = rb1; *(uint4*)(wb + 64 * 72) = rb2; *(uint4*)(wb + 96 * 72) = rb3;
    __syncthreads();
    if (kt + 1 < 16) {
      const bfu* ga2 = ga + (kt + 1) * 64; const bfu* gb2 = gb + (kt + 1) * 64;
      ra0 = *(const uint4*)(ga2); ra1 = *(const uint4*)(ga2 + 32 * 1024); ra2 = *(const uint4*)(ga2 + 64 * 1024); ra3 = *(const uint4*)(ga2 + 96 * 1024);
      rb0 = *(const uint4*)(gb2); rb1 = *(const uint4*)(gb2 + 32 * 1024); rb2 = *(const uint4*)(gb2 + 64 * 1024); rb3 = *(const uint4*)(gb2 + 96 * 1024);
    }
#pragma unroll
    for (int ks = 0; ks < 2; ++ks) {
      bf16x8 af[4], bfr[4];
#pragma unroll
      for (int mt = 0; mt < 4; ++mt) af[mt] = *(const bf16x8*)(sA + (wm * 64 + mt * 16 + r) * 72 + ks * 32 + q * 8);
#pragma unroll
      for (int nt = 0; nt < 4; ++nt) bfr[nt] = *(const bf16x8*)(sB + (wn * 64 + nt * 16 + r) * 72 + ks * 32 + q * 8);
#pragma unroll
      for (int mt = 0; mt < 4; ++mt)
#pragma unroll
        for (int nt = 0; nt < 4; ++nt) acc[mt][nt] = __builtin_amdgcn_mfma_f32_16x16x32_bf16(af[mt], bfr[nt], acc[mt][nt], 0, 0, 0);
    }
  }
#pragma unroll
  for (int np = 0; np < 2; ++np) {
    float hv[2][4][4], bias[2];
#pragma unroll
    for (int u = 0; u < 2; ++u) {
      const int col = n0 + wn * 64 + (np * 2 + u) * 16 + r;
      bias[u] = p.b_out[l * 1024 + col];
#pragma unroll
      for (int mt = 0; mt < 4; ++mt)
#pragma unroll
        for (int j = 0; j < 4; ++j) hv[u][mt][j] = hin[(size_t)(m0 + wm * 64 + mt * 16 + q * 4 + j) * 1024 + col];
    }
#pragma unroll
    for (int u = 0; u < 2; ++u) {
      const int nt = np * 2 + u, col = n0 + wn * 64 + nt * 16 + r;
#pragma unroll
      for (int mt = 0; mt < 4; ++mt)
#pragma unroll
        for (int j = 0; j < 4; ++j) {
          const int row = m0 + wm * 64 + mt * 16 + q * 4 + j;
          p.out[(size_t)row * 1024 + col] = DN_ALPHA * hv[u][mt][j] + acc[mt][nt][j] + bias[u];
        }
    }
  }
}


DI void phase5(const Params& p, int l, unsigned char* smem, unsigned long long& tp_acc) {
  const bfu* Bt = p.wt_out + (size_t)l * 1048576;
  const float* hin = (l == 0) ? p.x : p.out;
  for (int tile = blockIdx.x; tile < 128 * 8; tile += gridDim.x) gemm2_tile<2>(p, l, p.mixed, Bt, (tile >> 3) * 128, (tile & 7) * 128, hin, smem);
}

DI void phase6(const Params& p, int l) {
  const int tid = threadIdx.x, lane = tid & 63, w = tid >> 6;
  float4 g[4], bb[4];
#pragma unroll
  for (int i = 0; i < 4; ++i) { g[i] = *(const float4*)(p.ln_g + l * 1024 + i * 256 + lane * 4); bb[i] = *(const float4*)(p.ln_b + l * 1024 + i * 256 + lane * 4); }
  for (int rb = blockIdx.x; rb < NTOK / 16; rb += gridDim.x) {
    const int row0 = rb * 16 + w * 4;
    float4 v[4][4];
#pragma unroll
    for (int rr = 0; rr < 4; ++rr)
#pragma unroll
      for (int i = 0; i < 4; ++i) v[rr][i] = *(const float4*)(p.out + (size_t)(row0 + rr) * 1024 + i * 256 + lane * 4);
#pragma unroll
    for (int rr = 0; rr < 4; ++rr) {
      float sm = 0.f;
#pragma unroll
      for (int i = 0; i < 4; ++i) sm += v[rr][i].x + v[rr][i].y + v[rr][i].z + v[rr][i].w;
      const float mu = wave_sum(sm) * (1.f / 1024.f);
      float ss = 0.f;
#pragma unroll
      for (int i = 0; i < 4; ++i) {
        v[rr][i].x -= mu; v[rr][i].y -= mu; v[rr][i].z -= mu; v[rr][i].w -= mu;
        ss += v[rr][i].x * v[rr][i].x + v[rr][i].y * v[rr][i].y + v[rr][i].z * v[rr][i].z + v[rr][i].w * v[rr][i].w;
      }
      const float rs = rsqrtf(wave_sum(ss) * (1.f / 1024.f) + 1e-5f);
#pragma unroll
      for (int i = 0; i < 4; ++i) {
        const int c = i * 256 + lane * 4;
        float4 o;
        o.x = v[rr][i].x * rs * g[i].x + bb[i].x; o.y = v[rr][i].y * rs * g[i].y + bb[i].y;
        o.z = v[rr][i].z * rs * g[i].z + bb[i].z; o.w = v[rr][i].w * rs * g[i].w + bb[i].w;
        *(float4*)(p.out + (size_t)(row0 + rr) * 1024 + c) = o;
        uint2 ob; ob.x = pack2(o.x, o.y); ob.y = pack2(o.z, o.w);
        *(uint2*)(p.hb + (size_t)(row0 + rr) * 1024 + c) = ob;
      }
    }
  }
}

DI void hg_gate(float x, float lb, float& lf, float& k) {
  x = fmaxf(x, -80.f);
  const float E = fexp(-x);
  const float sg = frcp(1.f + E);
  k = (1.f - lb) * (E * sg);
  lf = flog(lb + (1.f - lb) * sg);
}

DI void hg_local(const Params& p, int l, int b, int c, int hd, unsigned char* smem) {
  const int tid = threadIdx.x, lane = tid & 63, w = tid >> 6;
  bfu* At = (bfu*)smem;
  bfu* Bt = At + 64 * 72;
  float* segtot = (float*)(smem + 2 * 64 * 72 * 2);
  const int tok0 = b * SEQ + c * 64;
  const int d = lane;
  const float lb = p.lbs[l * 256 + hd * 64 + d];
  const bfu* pf = p.proj + (size_t)tok0 * PS + COL_AF + hd * 64 + d;
  const bfu* pv = p.proj + (size_t)tok0 * PS + COL_AI + hd * 64 + d;
  float bl[16], kk[16];
  float run = 0.f;
  __syncthreads();
#pragma unroll
  for (int i = 0; i < 16; ++i) {
    const int t = w * 16 + i;
    float lf, k; hg_gate(bf2f(pf[(size_t)t * PS]), lb, lf, k);
    run += lf; bl[i] = run; kk[i] = k;
    At[d * 72 + t] = pv[(size_t)t * PS];
  }
  segtot[w * 64 + d] = run;
  __syncthreads();
  float off = 0.f, tot = 0.f;
#pragma unroll
  for (int s = 0; s < 4; ++s) { float v = segtot[s * 64 + d]; tot += v; if (s < w) off += v; }
#pragma unroll
  for (int i = 0; i < 16; ++i) { const int t = w * 16 + i; Bt[d * 72 + t] = f2bf(kk[i] * fexp(tot - (bl[i] + off))); }
  const int base = (b * NCH + c) * 4 + hd;
  if (w == 0) p.hg_decay[base * 64 + d] = fexp(tot);
  __syncthreads();
  f32x4 acc[4];
#pragma unroll
  for (int i = 0; i < 4; ++i) acc[i] = (f32x4){0.f, 0.f, 0.f, 0.f};
  wave_mma<4, 2>(acc, At + w * 16 * 72, 72, Bt, 72, lane);
  float* st = p.hg_state + (size_t)base * 4096;
  const int r = lane & 15, q = lane >> 4;
#pragma unroll
  for (int nt = 0; nt < 4; ++nt)
#pragma unroll
    for (int j = 0; j < 4; ++j) st[(w * 16 + q * 4 + j) * 64 + nt * 16 + r] = acc[nt][j];
}

constexpr int O_A = 0, O_BT = 17408, O_QP = 34816, O_KP = 44032, O_MISC = 53248;

DI void hg_out(const Params& p, int l, int b, int c, int hd, unsigned char* smem) {
  const int tid = threadIdx.x, lane = tid & 63, w = tid >> 6;
  bfu* A = (bfu*)(smem + O_A); bfu* Bt = (bfu*)(smem + O_BT); bfu* Qp = (bfu*)(smem + O_QP); bfu* Kp = (bfu*)(smem + O_KP);
  float* segtot = (float*)(smem + O_MISC);
  const int tok0 = b * SEQ + c * 64;
  const int d = lane;
  const float lb = p.lbs[l * 256 + hd * 64 + d];
  const bfu* pq = p.proj + (size_t)tok0 * PS + COL_AQ + hd * 64 + d;
  const bfu* pf = p.proj + (size_t)tok0 * PS + COL_AF + hd * 64 + d;
  const bfu* pv = p.proj + (size_t)tok0 * PS + COL_AI + hd * 64 + d;
  const int base = (b * NCH + c) * 4 + hd;
  const float* st = p.hg_state + (size_t)base * 4096;
  float bl[16], kk[16];
  float run = 0.f;
  const int r = lane & 15, q = lane >> 4;
  bfu fraw[16], vraw[16], qraw[16]; float sraw[16];
#pragma unroll
  for (int i = 0; i < 16; ++i) {
    const int t = w * 16 + i;
    fraw[i] = pf[(size_t)t * PS]; vraw[i] = pv[(size_t)t * PS]; qraw[i] = pq[(size_t)t * PS]; sraw[i] = st[(w + 4 * i) * 64 + d];
  }
  bfu gt[4][4]; float gw[4];
#pragma unroll
  for (int nt = 0; nt < 4; ++nt) {
    gw[nt] = p.hg_g[l * 256 + hd * 64 + nt * 16 + r];
#pragma unroll
    for (int j = 0; j < 4; ++j) gt[j][nt] = p.proj[(size_t)(tok0 + w * 16 + q * 4 + j) * PS + COL_AG + hd * 64 + nt * 16 + r];
  }
  __syncthreads();
#pragma unroll
  for (int i = 0; i < 16; ++i) {
    const int t = w * 16 + i;
    float lf, k; hg_gate(bf2f(fraw[i]), lb, lf, k);
    run += lf; bl[i] = run; kk[i] = k;
    Bt[d * 136 + t] = vraw[i];
    const int e = w + 4 * i;
    Bt[e * 136 + 64 + d] = f2bf(sraw[i]);
  }
  segtot[w * 64 + d] = run;
  __syncthreads();
  float off = 0.f;
#pragma unroll
  for (int s = 0; s < 4; ++s) { float v = segtot[s * 64 + d]; if (s < w) off += v; }
  const float bm = segtot[d] + segtot[64 + d];
#pragma unroll
  for (int i = 0; i < 16; ++i) {
    const int t = w * 16 + i;
    const float bt = bl[i] + off;
    const float qv = silu_(bf2f(qraw[i]));
    Qp[t * 72 + d] = f2bf(qv * fexp(fmaxf(bt - bm, -80.f)));
    Kp[t * 72 + d] = f2bf(kk[i] * fexp(fminf(bm - bt, 80.f)));
    A[t * 136 + 64 + d] = f2bf(qv * fexp(bt));
  }
  __syncthreads();
  f32x4 acc[4];
#pragma unroll
  for (int i = 0; i < 4; ++i) acc[i] = (f32x4){0.f, 0.f, 0.f, 0.f};
  wave_mma<4, 2>(acc, Qp + w * 16 * 72, 72, Kp, 72, lane);
#pragma unroll
  for (int nt = 0; nt < 4; ++nt)
#pragma unroll
    for (int j = 0; j < 4; ++j) {
      const int t = w * 16 + q * 4 + j, s = nt * 16 + r;
      A[t * 136 + s] = f2bf(s <= t ? acc[nt][j] : 0.f);
    }
  __syncthreads();
  f32x4 o[4];
#pragma unroll
  for (int i = 0; i < 4; ++i) o[i] = (f32x4){0.f, 0.f, 0.f, 0.f};
  wave_mma<4, 4>(o, A + w * 16 * 136, 136, Bt, 136, lane);
#pragma unroll
  for (int j = 0; j < 4; ++j) {
    float ss = 0.f;
#pragma unroll
    for (int nt = 0; nt < 4; ++nt) ss += o[nt][j] * o[nt][j];
    ss = group16_sum(ss);
    const float sc = rsqrtf(ss * (1.f / 64.f) + 1e-6f);
    const int t = w * 16 + q * 4 + j;
    bfu* mrow = p.mixed + (size_t)(tok0 + t) * 1024 + hd * 64;
#pragma unroll
    for (int nt = 0; nt < 4; ++nt) {
      const int e = nt * 16 + r;
      mrow[e] = f2bf(o[nt][j] * sc * gw[nt] * silu_(bf2f(gt[j][nt])));
    }
  }
}

DI void ml_gates(const Params& p, int l, int tok0, int hd, float* bs, float* igs, int tid) {
  if (tid < 64) {
    const bfu* row = p.proj + (size_t)(tok0 + tid) * PS;
    const float ig = bf2f(row[COL_BIG + hd]);
    const float fg = bf2f(row[COL_BFG + hd]) + p.ml_fb[l * 4 + hd];
    float lf = logsig_(fg);
#pragma unroll
    for (int o = 1; o < 64; o <<= 1) { float v = __shfl_up(lf, o); if (tid >= o) lf += v; }
    bs[tid] = lf; igs[tid] = ig;
  }
}

DI void ml_local(const Params& p, int l, int b, int c, int hd, unsigned char* smem) {
  const int tid = threadIdx.x, lane = tid & 63, w = tid >> 6;
  bfu* At = (bfu*)smem;
  bfu* Bt = At + 64 * 72;
  float* bs = (float*)(smem + 2 * 64 * 72 * 2);
  float* igs = bs + 64; float* nseg = igs + 64;
  const int tok0 = b * SEQ + c * 64;
  const int d = lane;
  const bfu* pk = p.proj + (size_t)tok0 * PS + COL_BK + hd * 64 + d;
  const bfu* pv = p.proj + (size_t)tok0 * PS + COL_BV + hd * 64 + d;
  bfu kraw[16], vraw[16];
#pragma unroll
  for (int i = 0; i < 16; ++i) { kraw[i] = pk[(size_t)(w * 16 + i) * PS]; vraw[i] = pv[(size_t)(w * 16 + i) * PS]; }
  __syncthreads();
  ml_gates(p, l, tok0, hd, bs, igs, tid);
  __syncthreads();
  const float blast = bs[63];
  float nacc = 0.f;
#pragma unroll
  for (int i = 0; i < 16; ++i) {
    const int s = w * 16 + i;
    const float ws = fexp(blast - bs[s] + igs[s]);
    const float kw = bf2f(kraw[i]) * 0.125f * ws;
    Bt[d * 72 + s] = f2bf(kw); nacc += kw;
    At[d * 72 + s] = vraw[i];
  }
  nseg[w * 64 + d] = nacc;
  __syncthreads();
  const int base = (b * NCH + c) * 4 + hd;
  if (w == 0) p.ml_n[base * 64 + d] = nseg[d] + nseg[64 + d] + nseg[128 + d] + nseg[192 + d];
  if (tid == 0) p.ml_decay[base] = fexp(blast);
  f32x4 acc[4];
#pragma unroll
  for (int i = 0; i < 4; ++i) acc[i] = (f32x4){0.f, 0.f, 0.f, 0.f};
  wave_mma<4, 2>(acc, At + w * 16 * 72, 72, Bt, 72, lane);
  float* st = p.ml_state + (size_t)base * 4096;
  const int r = lane & 15, q = lane >> 4;
#pragma unroll
  for (int nt = 0; nt < 4; ++nt)
#pragma unroll
    for (int j = 0; j < 4; ++j) st[(w * 16 + q * 4 + j) * 64 + nt * 16 + r] = acc[nt][j];
}

DI void ml_out(const Params& p, int l, int b, int c, int hd, unsigned char* smem) {
  const int tid = threadIdx.x, lane = tid & 63, w = tid >> 6;
  bfu* A = (bfu*)(smem + O_A); bfu* Bt = (bfu*)(smem + O_BT); bfu* Qp = (bfu*)(smem + O_QP); bfu* Kp = (bfu*)(smem + O_KP);
  float* bs = (float*)(smem + O_MISC); float* igs = bs + 64; float* npv = igs + 64; float* den2 = npv + 64;
  const int tok0 = b * SEQ + c * 64;
  const int d = lane;
  const int base = (b * NCH + c) * 4 + hd;
  const float* st = p.ml_state + (size_t)base * 4096;
  const int r = lane & 15, q = lane >> 4;
  const bfu* pq = p.proj + (size_t)tok0 * PS + COL_BQ + hd * 64 + d;
  const bfu* pk = p.proj + (size_t)tok0 * PS + COL_BK + hd * 64 + d;
  const bfu* pv = p.proj + (size_t)tok0 * PS + COL_BV + hd * 64 + d;
  bfu qraw[16], kraw[16], vraw[16]; float sraw[16];
#pragma unroll
  for (int i = 0; i < 16; ++i) {
    const int t = w * 16 + i;
    qraw[i] = pq[(size_t)t * PS]; kraw[i] = pk[(size_t)t * PS]; vraw[i] = pv[(size_t)t * PS]; sraw[i] = st[(w + 4 * i) * 64 + d];
  }
  bfu gt[4][4]; float gw[4];
#pragma unroll
  for (int nt = 0; nt < 4; ++nt) {
    gw[nt] = p.ml_g[l * 256 + hd * 64 + nt * 16 + r];
#pragma unroll
    for (int j = 0; j < 4; ++j) gt[j][nt] = p.proj[(size_t)(tok0 + w * 16 + q * 4 + j) * PS + COL_BG + hd * 64 + nt * 16 + r];
  }
  __syncthreads();
  ml_gates(p, l, tok0, hd, bs, igs, tid);
  if (tid >= 64 && tid < 128) npv[tid - 64] = p.ml_n[base * 64 + tid - 64];
  __syncthreads();
#pragma unroll
  for (int i = 0; i < 16; ++i) {
    const int t = w * 16 + i;
    Qp[t * 72 + d] = qraw[i];
    Kp[t * 72 + d] = kraw[i];
    A[t * 136 + 64 + d] = f2bf(bf2f(qraw[i]) * fexp(bs[t]));
    Bt[d * 136 + t] = vraw[i];
    const int e = w + 4 * i;
    Bt[e * 136 + 64 + d] = f2bf(sraw[i]);
  }
  __syncthreads();
  if (tid < 64) {
    float s = 0.f;
    for (int dd = 0; dd < 64; ++dd) s += bf2f(A[tid * 136 + 64 + dd]) * npv[dd];
    den2[tid] = s;
  }
  f32x4 acc[4];
#pragma unroll
  for (int i = 0; i < 4; ++i) acc[i] = (f32x4){0.f, 0.f, 0.f, 0.f};
  wave_mma<4, 2>(acc, Qp + w * 16 * 72, 72, Kp, 72, lane);
  float den1[4];
#pragma unroll
  for (int j = 0; j < 4; ++j) {
    const int t = w * 16 + q * 4 + j;
    const float bt = bs[t];
    float rs = 0.f;
#pragma unroll
    for (int nt = 0; nt < 4; ++nt) {
      const int s = nt * 16 + r;
      float wv = 0.f;
      if (s <= t) wv = fexp(bt - bs[s] + igs[s]) * acc[nt][j] * 0.125f;
      rs += wv;
      A[t * 136 + s] = f2bf(wv);
    }
    den1[j] = group16_sum(rs);
  }
  __syncthreads();
  f32x4 o[4];
#pragma unroll
  for (int i = 0; i < 4; ++i) o[i] = (f32x4){0.f, 0.f, 0.f, 0.f};
  wave_mma<4, 4>(o, A + w * 16 * 136, 136, Bt, 136, lane);
#pragma unroll
  for (int j = 0; j < 4; ++j) {
    const int t = w * 16 + q * 4 + j;
    const float den = den1[j] + den2[t];
    const float inv = frcp(fmaxf(fabsf(den), 1.f));
    float hv[4];
    float ss = 0.f;
#pragma unroll
    for (int nt = 0; nt < 4; ++nt) { hv[nt] = o[nt][j] * inv; ss += hv[nt] * hv[nt]; }
    ss = group16_sum(ss);
    const float sc = rsqrtf(ss * (1.f / 64.f) + 1e-6f);
    bfu* mrow = p.mixed + (size_t)(tok0 + t) * 1024 + 256 + hd * 64;
#pragma unroll
    for (int nt = 0; nt < 4; ++nt) {
      const int e = nt * 16 + r;
      mrow[e] = f2bf(hv[nt] * sc * gw[nt] * silu_(bf2f(gt[j][nt])));
    }
  }
}

template <bool FINAL>
DI void lru_item(const Params& p, int l, int b, int c, int n, unsigned char* smem) {
  const int tid = threadIdx.x, lane = tid & 63, w = tid >> 6;
  bfu* xcb = (bfu*)smem;
  float* xcf = (float*)(smem + 9216);
  float* af = (float*)(smem + 9216 + 17408);
  float* segH = (float*)(smem + 9216 + 2 * 17408);
  float* segA = segH + 256;
  const int tok0 = b * SEQ + c * 64;
  const int ch = n * 64 + lane;
  const int r = lane & 15, q = lane >> 4;
  bf16x8 wfa[2][4], wfx[2][4];
#pragma unroll
  for (int ks = 0; ks < 2; ++ks)
#pragma unroll
    for (int nt = 0; nt < 4; ++nt) {
      wfa[ks][nt] = *(const bf16x8*)(p.wt_a + (l * 4 + n) * 4096 + (nt * 16 + r) * 64 + ks * 32 + q * 8);
      wfx[ks][nt] = *(const bf16x8*)(p.wt_x + (l * 4 + n) * 4096 + (nt * 16 + r) * 64 + ks * 32 + q * 8);
    }
  float e_ba[4], e_bx[4], e_lam[4];
#pragma unroll
  for (int nt = 0; nt < 4; ++nt) {
    const int che = n * 64 + nt * 16 + r;
    e_ba[nt] = p.b_a[l * 256 + che]; e_bx[nt] = p.b_x[l * 256 + che]; e_lam[nt] = p.lam[l * 256 + che];
  }
  const int sidx = (b * NCH + c) * 256 + ch;
  float Hprev = 0.f;
  bfu gq[16];
  if (FINAL) {
    Hprev = p.lru_h[sidx];
    const bfu* pg0 = p.proj + (size_t)tok0 * PS + COL_CG + ch;
#pragma unroll
    for (int i = 0; i < 16; ++i) gq[i] = pg0[(size_t)(w * 16 + i) * PS];
  }
  __syncthreads();
  {
    const float cw0 = p.conv_w[(l * 4 + 0) * 256 + ch], cw1 = p.conv_w[(l * 4 + 1) * 256 + ch];
    const float cw2 = p.conv_w[(l * 4 + 2) * 256 + ch], cw3 = p.conv_w[(l * 4 + 3) * 256 + ch];
    const float cb = p.conv_b[l * 256 + ch];
    const bfu* px = p.proj + (size_t)tok0 * PS + COL_CX + ch;
#pragma unroll
    for (int i = 0; i < 16; ++i) {
      const int t = w * 16 + i;
      const int sp = c * 64 + t;
      float x0 = (sp >= 3) ? bf2f(px[(ptrdiff_t)(t - 3) * PS]) : 0.f;
      float x1 = (sp >= 2) ? bf2f(px[(ptrdiff_t)(t - 2) * PS]) : 0.f;
      float x2 = (sp >= 1) ? bf2f(px[(ptrdiff_t)(t - 1) * PS]) : 0.f;
      float x3 = bf2f(px[(ptrdiff_t)t * PS]);
      const float xc = cb + cw0 * x0 + cw1 * x1 + cw2 * x2 + cw3 * x3;
      xcf[t * 68 + lane] = xc;
      xcb[t * 72 + lane] = f2bf(xc);
    }
  }
  __syncthreads();
  f32x4 aa[4], ax[4];
#pragma unroll
  for (int i = 0; i < 4; ++i) { aa[i] = (f32x4){0.f, 0.f, 0.f, 0.f}; ax[i] = (f32x4){0.f, 0.f, 0.f, 0.f}; }
#pragma unroll
  for (int ks = 0; ks < 2; ++ks) {
    const bf16x8 afr = *(const bf16x8*)(xcb + (w * 16 + r) * 72 + ks * 32 + q * 8);
#pragma unroll
    for (int nt = 0; nt < 4; ++nt) {
      aa[nt] = __builtin_amdgcn_mfma_f32_16x16x32_bf16(afr, wfa[ks][nt], aa[nt], 0, 0, 0);
      ax[nt] = __builtin_amdgcn_mfma_f32_16x16x32_bf16(afr, wfx[ks][nt], ax[nt], 0, 0, 0);
    }
  }
#pragma unroll
  for (int nt = 0; nt < 4; ++nt) {
    const int e = nt * 16 + r;
    const float ba = e_ba[nt], bx = e_bx[nt];
    const float lsl = 8.f * logsig_acc(e_lam[nt]);
#pragma unroll
    for (int j = 0; j < 4; ++j) {
      const int t = w * 16 + q * 4 + j;
      const float rg = sigmoid_(aa[nt][j] + ba), ig = sigmoid_(ax[nt][j] + bx);
      const float la = lsl * rg;
      const float a = fexp(la);
      const float y2 = 2.f * la;
      const float em = (y2 > -0.05f) ? -y2 * (1.f + y2 * (0.5f + y2 * (0.16666667f + y2 * 0.041666668f))) : 1.f - a * a;
      const float bv = __builtin_amdgcn_sqrtf(fmaxf(em, 0.f)) * ig * xcf[t * 68 + e];
      af[t * 68 + e] = a; xcf[t * 68 + e] = bv;
    }
  }
  __syncthreads();
  float hl[16], al[16];
  float h = 0.f, ap = 1.f;
#pragma unroll
  for (int i = 0; i < 16; ++i) {
    const int t = w * 16 + i;
    const float a = af[t * 68 + lane], bv = xcf[t * 68 + lane];
    h = a * h + bv; ap *= a; hl[i] = h; al[i] = ap;
  }
  segH[w * 64 + lane] = h; segA[w * 64 + lane] = ap;
  __syncthreads();
  if (!FINAL) {
    if (w == 0) {
      float H = 0.f, Ap = 1.f;
#pragma unroll
      for (int s = 0; s < 4; ++s) { H = segA[s * 64 + lane] * H + segH[s * 64 + lane]; Ap *= segA[s * 64 + lane]; }
      p.lru_h[sidx] = H; p.lru_a[sidx] = Ap;
    }
  } else {
    float H = Hprev;
#pragma unroll
    for (int s = 0; s < 4; ++s) if (s < w) H = segA[s * 64 + lane] * H + segH[s * 64 + lane];
    bfu* pm = p.mixed + (size_t)tok0 * 1024 + 512 + ch;
#pragma unroll
    for (int i = 0; i < 16; ++i) {
      const int t = w * 16 + i;
      const float hv = hl[i] + al[i] * H;
      pm[(size_t)t * 1024] = f2bf(hv * silu_(bf2f(gq[i])));
    }
  }
}

template <bool FINAL>
DI void s5_item(const Params& p, int l, int b, int c, int g4, unsigned char* smem) {
  const int tid = threadIdx.x, lane = tid & 63, w = tid >> 6;
  const int g = g4 * 4 + w;
  float* buw = (float*)(smem + w * 13312);
  bfu* stw = (bfu*)(smem + w * 13312 + 8448);
  const int tok0 = b * SEQ + c * 64;
  const int r = lane & 15, q = lane >> 4;
  const int lg = l * 16 + g;
  bf16x8 bfr[8], yfr[4];
#pragma unroll
  for (int nt = 0; nt < 8; ++nt) bfr[nt] = *(const bf16x8*)(p.bt_bu + ((size_t)lg * 128 + nt * 16 + r) * 32 + q * 8);
  if (FINAL) {
#pragma unroll
    for (int ks = 0; ks < 4; ++ks) yfr[ks] = *(const bf16x8*)(p.bt_y + ((size_t)lg * 16 + r) * 128 + ks * 32 + q * 8);
  }
  const float ar = p.abar[(lg * 64 + lane) * 2], ai = p.abar[(lg * 64 + lane) * 2 + 1];
  const size_t sbase = ((size_t)(b * NCH + c) * 16 + g) * 128;
  float xr = 0.f, xi = 0.f;
  if (FINAL) { xr = p.s5_state[sbase + lane]; xi = p.s5_state[sbase + 64 + lane]; }
  const float dsk = FINAL ? p.s5_d[l * 256 + g * 16 + r] : 0.f;
  bf16x8 afr[4];
  bfu uq[4][4];
#pragma unroll
  for (int mt = 0; mt < 4; ++mt) {
    afr[mt] = (bf16x8){0, 0, 0, 0, 0, 0, 0, 0};
    if (q < 2) afr[mt] = *(const bf16x8*)(p.proj + (size_t)(tok0 + mt * 16 + r) * PS + COL_DU + g * 16 + q * 8);
    if (FINAL) {
#pragma unroll
      for (int j = 0; j < 4; ++j) uq[mt][j] = p.proj[(size_t)(tok0 + mt * 16 + q * 4 + j) * PS + COL_DU + g * 16 + r];
    }
  }
  __syncthreads();
#pragma unroll
  for (int mt = 0; mt < 4; ++mt) {
    const bf16x8 a = afr[mt];
#pragma unroll
    for (int nt = 0; nt < 8; ++nt) {
      f32x4 acc = (f32x4){0.f, 0.f, 0.f, 0.f};
      acc = __builtin_amdgcn_mfma_f32_16x16x32_bf16(a, bfr[nt], acc, 0, 0, 0);
#pragma unroll
      for (int j = 0; j < 4; ++j) buw[(q * 4 + j) * 132 + nt * 16 + r] = acc[j];
    }
    wave_sync();
    {
      float br[16], bi[16];
#pragma unroll
      for (int tt = 0; tt < 16; ++tt) { br[tt] = buw[tt * 132 + lane]; bi[tt] = buw[tt * 132 + 64 + lane]; }
#pragma unroll
      for (int tt = 0; tt < 16; ++tt) {
        const float nr = ar * xr - ai * xi + br[tt];
        const float ni = ar * xi + ai * xr + bi[tt];
        xr = nr; xi = ni;
        br[tt] = xr; bi[tt] = xi;
      }
      if (FINAL) {
#pragma unroll
        for (int tt = 0; tt < 16; ++tt) { stw[tt * 136 + lane] = f2bf(br[tt]); stw[tt * 136 + 64 + lane] = f2bf(bi[tt]); }
      }
    }
    wave_sync();
    if (FINAL) {
      f32x4 y = (f32x4){0.f, 0.f, 0.f, 0.f};
#pragma unroll
      for (int ks = 0; ks < 4; ++ks) {
        bf16x8 a2 = *(const bf16x8*)(stw + r * 136 + ks * 32 + q * 8);
        y = __builtin_amdgcn_mfma_f32_16x16x32_bf16(a2, yfr[ks], y, 0, 0, 0);
      }
#pragma unroll
      for (int j = 0; j < 4; ++j) {
        const int t = mt * 16 + q * 4 + j;
        const float z = gelu_tanh_(y[j] + dsk * bf2f(uq[mt][j]));
        p.zbuf[(size_t)(tok0 + t) * 256 + g * 16 + r] = f2bf(z);
      }
      wave_sync();
    }
  }
  if (!FINAL) { p.s5_state[sbase + lane] = xr; p.s5_state[sbase + 64 + lane] = xi; }
}

DI void s5_glu(const Params& p, int l, int b, int c, unsigned char* smem) {
  const int tid = threadIdx.x, lane = tid & 63, w = tid >> 6;
  bfu* zs = (bfu*)smem;
  const int tok0 = b * SEQ + c * 64;
  const int r = lane & 15, q = lane >> 4;
  __syncthreads();
#pragma unroll
  for (int i = 0; i < 8; ++i) {
    const int id = tid + i * 256;
    *(uint4*)(zs + (id >> 5) * 264 + (id & 31) * 8) = *(const uint4*)(p.zbuf + (size_t)(tok0 + (id >> 5)) * 256 + (id & 31) * 8);
  }
  __syncthreads();
  const bfu* wg = p.wt_glu + l * 65536;
#pragma unroll 1
  for (int nc = 0; nc < 4; ++nc) {
    bfu gq[4][4]; float bgv[4];
#pragma unroll
    for (int nt = 0; nt < 4; ++nt) {
      bgv[nt] = p.b_glu[l * 256 + nc * 64 + nt * 16 + r];
#pragma unroll
      for (int j = 0; j < 4; ++j) gq[nt][j] = p.proj[(size_t)(tok0 + w * 16 + q * 4 + j) * PS + COL_DG + nc * 64 + nt * 16 + r];
    }
    f32x4 acc[4];
#pragma unroll
    for (int i = 0; i < 4; ++i) acc[i] = (f32x4){0.f, 0.f, 0.f, 0.f};
#pragma unroll
    for (int kh = 0; kh < 2; ++kh) {
      bf16x8 bq[4][4];
#pragma unroll
      for (int ks = 0; ks < 4; ++ks)
#pragma unroll
        for (int nt = 0; nt < 4; ++nt) bq[ks][nt] = *(const bf16x8*)(wg + (nc * 64 + nt * 16 + r) * 256 + kh * 128 + ks * 32 + q * 8);
#pragma unroll
      for (int ks = 0; ks < 4; ++ks) {
        const bf16x8 a = *(const bf16x8*)(zs + (w * 16 + r) * 264 + kh * 128 + ks * 32 + q * 8);
#pragma unroll
        for (int nt = 0; nt < 4; ++nt) acc[nt] = __builtin_amdgcn_mfma_f32_16x16x32_bf16(a, bq[ks][nt], acc[nt], 0, 0, 0);
      }
    }
#pragma unroll
    for (int nt = 0; nt < 4; ++nt) {
      const int n = nc * 64 + nt * 16 + r;
#pragma unroll
      for (int j = 0; j < 4; ++j) {
        const int t = w * 16 + q * 4 + j;
        const float zv = bf2f(zs[t * 264 + n]);
        const float gate = silu_(bf2f(gq[nt][j]));
        p.mixed[(size_t)(tok0 + t) * 1024 + 768 + n] = f2bf(zv * sigmoid_(acc[nt][j] + bgv[nt]) * gate);
      }
    }
  }
}

#define QLOOP(QI, N, BODY)                                                                            \
  {                                                                                                   \
    unsigned* q_ctr = p.cnt + CNT_Q + (l * 8 + (QI)) * 32;                                            \
    unsigned q_nxt = blockIdx.x;                                                                      \
    for (;;) {                                                                                        \
      __syncthreads();                                                                                \
      if (threadIdx.x == 0) *s_q = q_nxt;                                                             \
      __syncthreads();                                                                                \
      const int item = (int)*s_q;                                                                     \
      if (item >= (N)) break;                                                                         \
      if (threadIdx.x == 0) q_nxt = gridDim.x + __hip_atomic_fetch_add(q_ctr, 1u, __ATOMIC_RELAXED, __HIP_MEMORY_SCOPE_AGENT); \
      BODY;                                                                                           \
    }                                                                                                 \
  }

DI void phase2(const Params& p, int l, unsigned char* smem) {
  unsigned* s_q = (unsigned*)(smem + SMEM_BYTES - 32);
  QLOOP(0, 1024, s5_item<false>(p, l, item >> 7, (item >> 2) & 31, item & 3, smem))
  QLOOP(1, 1024, hg_local(p, l, item >> 7, (item >> 2) & 31, item & 3, smem))
  QLOOP(2, 1024, ml_local(p, l, item >> 7, (item >> 2) & 31, item & 3, smem))
  QLOOP(3, 1024, lru_item<false>(p, l, item >> 7, (item >> 2) & 31, item & 3, smem))
}

DI void phase3(const Params& p, int l) {
  const int gtid = blockIdx.x * 256 + threadIdx.x, gsz = gridDim.x * 256;
  constexpr int N1 = 131072, N2 = 131072, N3 = 2048, N4 = 2048, N5 = 8192;
  for (int i = gtid; i < N1 + N2 + N3 + N4 + N5; i += gsz) {
    if (i < N1 + N2) {
      const bool ml = i >= N1;
      const int j = ml ? i - N1 : i;
      const int b = j >> 14, rem = j & 16383, hd = rem >> 12, ed = rem & 4095, d = ed & 63;
      float* stp = (ml ? p.ml_state : p.hg_state) + (size_t)(b * NCH * 4 + hd) * 4096 + ed;
      const float* dcp = ml ? (p.ml_decay + b * NCH * 4 + hd) : (p.hg_decay + (b * NCH * 4 + hd) * 64 + d);
      const int dstride = ml ? 4 : 256;
      float S = 0.f;
#pragma unroll
      for (int c0 = 0; c0 < NCH; c0 += 16) {
        float loc[16], dec[16];
#pragma unroll
        for (int c = 0; c < 16; ++c) { loc[c] = stp[(size_t)(c0 + c) * 16384]; dec[c] = dcp[(c0 + c) * dstride]; }
#pragma unroll
        for (int c = 0; c < 16; ++c) { stp[(size_t)(c0 + c) * 16384] = S; S = dec[c] * S + loc[c]; }
      }
    } else if (i < N1 + N2 + N3) {
      const int j = i - N1 - N2, b = j >> 8, rem = j & 255, hd = rem >> 6, d = rem & 63;
      float S = 0.f;
#pragma unroll
      for (int c0 = 0; c0 < NCH; c0 += 16) {
        float loc[16], dec[16];
#pragma unroll
        for (int c = 0; c < 16; ++c) { const int base = (b * NCH + c0 + c) * 4 + hd; dec[c] = p.ml_decay[base]; loc[c] = p.ml_n[base * 64 + d]; }
#pragma unroll
        for (int c = 0; c < 16; ++c) { const int base = (b * NCH + c0 + c) * 4 + hd; p.ml_n[base * 64 + d] = S; S = dec[c] * S + loc[c]; }
      }
    } else if (i < N1 + N2 + N3 + N4) {
      const int j = i - N1 - N2 - N3, b = j >> 8, ch = j & 255;
      float H = 0.f;
#pragma unroll
      for (int c0 = 0; c0 < NCH; c0 += 16) {
        float av[16], hv[16];
#pragma unroll
        for (int c = 0; c < 16; ++c) { const int idx = (b * NCH + c0 + c) * 256 + ch; av[c] = p.lru_a[idx]; hv[c] = p.lru_h[idx]; }
#pragma unroll
        for (int c = 0; c < 16; ++c) { const int idx = (b * NCH + c0 + c) * 256 + ch; p.lru_h[idx] = H; H = av[c] * H + hv[c]; }
      }
    } else {
      const int j = i - N1 - N2 - N3 - N4, b = j >> 10, g = (j >> 6) & 15, pp = j & 63;
      const float ar = p.abar64[((l * 16 + g) * 64 + pp) * 2], ai = p.abar64[((l * 16 + g) * 64 + pp) * 2 + 1];
      float xr = 0.f, xi = 0.f;
#pragma unroll
      for (int c0 = 0; c0 < NCH; c0 += 16) {
        float lr[16], li[16];
#pragma unroll
        for (int c = 0; c < 16; ++c) { const size_t sb = ((size_t)(b * NCH + c0 + c) * 16 + g) * 128; lr[c] = p.s5_state[sb + pp]; li[c] = p.s5_state[sb + 64 + pp]; }
#pragma unroll
        for (int c = 0; c < 16; ++c) {
          const size_t sb = ((size_t)(b * NCH + c0 + c) * 16 + g) * 128;
          p.s5_state[sb + pp] = xr; p.s5_state[sb + 64 + pp] = xi;
          const float nr = ar * xr - ai * xi + lr[c], ni = ar * xi + ai * xr + li[c];
          xr = nr; xi = ni;
        }
      }
    }
  }
}

DI void phase4(const Params& p, int l, unsigned char* smem, unsigned long long& tp_acc) {
  unsigned* s_flag = (unsigned*)(smem + SMEM_BYTES - 16);
  unsigned* s_q = (unsigned*)(smem + SMEM_BYTES - 32);
  TPS(41)
  QLOOP(4, 256, {
    _Pragma("unroll 1") for (int g4 = 0; g4 < 4; ++g4) s5_item<true>(p, l, item >> 5, item & 31, g4, smem);
    asm volatile("s_waitcnt vmcnt(0)" ::: "memory");
    s5_glu(p, l, item >> 5, item & 31, smem);
  })
  TPE(41)
  TPS(42)
  QLOOP(5, 1024, hg_out(p, l, item >> 7, (item >> 2) & 31, item & 3, smem))
  TPE(42)
  TPS(43)
  QLOOP(6, 1024, ml_out(p, l, item >> 7, (item >> 2) & 31, item & 3, smem))
  TPE(43)
  TPS(44)
  QLOOP(7, 1024, lru_item<true>(p, l, item >> 7, (item >> 2) & 31, item & 3, smem))
  TPE(44)
}

#ifdef TPROBE
#define TP_CLASS(PH) ((PH) == 0 ? 0 : (((PH) - 1) % 6) + 1)
#define TP_BEGIN(PH) unsigned long long tp_t0 = 0; if (TP_CLASS(PH) == TPROBE) tp_t0 = __builtin_amdgcn_s_memrealtime();
#define TP_END(PH) if (TP_CLASS(PH) == TPROBE) tp_acc += __builtin_amdgcn_s_memrealtime() - tp_t0;
#else
#define TP_BEGIN(PH)
#define TP_END(PH)
#endif
#define RUN_PHASE(PH, CALL)                                       \
  if (ph0 <= (PH) && (PH) < ph1) {                                \
    TP_BEGIN(PH)                                                  \
    CALL;                                                         \
    if (COOP) { if ((PH) + 1 < ph1) xcd_barrier(xb); }            \
    TP_END(PH)                                                    \
  }

template <bool COOP, int L>
DI void run_layer(const Params& p, int ph0, int ph1, unsigned char* smem, const XcdBarrier& xb, unsigned long long& tp_acc) {
#ifdef DUP1
  RUN_PHASE(1 + 6 * L, phase1(p, L, smem))
#endif
  RUN_PHASE(1 + 6 * L, phase1(p, L, smem))
#ifdef DUP2
  RUN_PHASE(2 + 6 * L, phase2(p, L, smem))
#endif
  RUN_PHASE(2 + 6 * L, phase2(p, L, smem))
  RUN_PHASE(3 + 6 * L, { phase3(p, L); if (L + 1 < DEPTH) convert_weights<(L + 1 < DEPTH ? L + 1 : 0)>(p, smem); })
#ifdef DUP4
  RUN_PHASE(4 + 6 * L, phase4(p, L, smem, tp_acc))
#endif
  RUN_PHASE(4 + 6 * L, phase4(p, L, smem, tp_acc))
  RUN_PHASE(5 + 6 * L, phase5(p, L, smem, tp_acc))
  RUN_PHASE(6 + 6 * L, phase6(p, L))
}

template <bool COOP>
__global__ void __launch_bounds__(256, 2) mk_fwd(Params p, int ph0, int ph1) {
  __shared__ __attribute__((aligned(16))) unsigned char smem[SMEM_BYTES];
  __shared__ uint4 xb_words;
  XcdBarrier xb; xb.bar = p.bar; xb.x = 0; xb.st = nullptr;
  if (COOP) {
    if (ph1 < 0) cg::this_grid().sync();
    if (threadIdx.x == 0) xb_words = make_uint4(0u, 0u, 0u, 0u);
    __syncthreads();
    xb = xcd_barrier_post(p.bar, (volatile LAS unsigned*)&xb_words);
  }
  unsigned long long tp_acc = 0;
  RUN_PHASE(0, phase0(p, smem))
  run_layer<COOP, 0>(p, ph0, ph1, smem, xb, tp_acc);
  run_layer<COOP, 1>(p, ph0, ph1, smem, xb, tp_acc);
  run_layer<COOP, 2>(p, ph0, ph1, smem, xb, tp_acc);
  run_layer<COOP, 3>(p, ph0, ph1, smem, xb, tp_acc);
#ifdef TPROBE
  if (blockIdx.x == 0 && threadIdx.x == 0) {
    const unsigned long long t0 = __builtin_amdgcn_s_memrealtime();
    while (__builtin_amdgcn_s_memrealtime() - t0 < tp_acc) __builtin_amdgcn_s_sleep(8);
  }
#endif
}

extern "C" void kernel_launch(void* const* d_in, const int* in_sizes, int n_in, void* d_out, int out_size, void* d_ws,
                              size_t ws_size, hipStream_t stream) {
  static int grid_blocks = 0;
  if (!grid_blocks) {
    int dev = 0, cus = 0, per_cu = 0;
    hipGetDevice(&dev);
    hipDeviceGetAttribute(&cus, hipDeviceAttributeMultiprocessorCount, dev);
    hipOccupancyMaxActiveBlocksPerMultiprocessor(&per_cu, mk_fwd<(MEGA != 0)>, 256, 0);
    if (per_cu < 1) per_cu = 1;
    if (per_cu > 2) per_cu = 2;
    grid_blocks = cus * per_cu;
  }
  Params p{};
  const float** pin = (const float**)&p;
  for (int i = 0; i < 28; ++i) pin[i] = (const float*)d_in[i];
  p.out = (float*)d_out;
  unsigned char* ws = (unsigned char*)d_ws;
  size_t off = 0;
  auto take = [&](size_t bytes) { unsigned char* r = ws + off; off += (bytes + 255) & ~(size_t)255; return r; };
  p.wt_in = (bfu*)take((size_t)4 * PS * 1024 * 2);
  p.wt_out = (bfu*)take((size_t)4 * 1024 * 1024 * 2);
  p.wt_a = (bfu*)take(16 * 4096 * 2);
  p.wt_x = (bfu*)take(16 * 4096 * 2);
  p.wt_glu = (bfu*)take(4 * 65536 * 2);
  p.bt_bu = (bfu*)take(64 * 128 * 32 * 2);
  p.bt_y = (bfu*)take(64 * 16 * 128 * 2);
  p.hb = (bfu*)take((size_t)NTOK * 1024 * 2);
  p.proj = (bfu*)take((size_t)NTOK * PS * 2);
  p.mixed = (bfu*)take((size_t)NTOK * 1024 * 2);
  p.zbuf = (bfu*)take((size_t)NTOK * 256 * 2);
  p.abar = (float*)take(4096 * 2 * 4);
  p.abar64 = (float*)take(4096 * 2 * 4);
  p.lbs = (float*)take(1024 * 4);
  p.hg_state = (float*)take((size_t)BATCH * NCH * 4 * 4096 * 4);
  p.hg_decay = (float*)take((size_t)BATCH * NCH * 4 * 64 * 4);
  p.ml_state = (float*)take((size_t)BATCH * NCH * 4 * 4096 * 4);
  p.ml_n = (float*)take((size_t)BATCH * NCH * 4 * 64 * 4);
  p.ml_decay = (float*)take((size_t)BATCH * NCH * 4 * 4);
  p.lru_h = (float*)take((size_t)BATCH * NCH * 256 * 4);
  p.lru_a = (float*)take((size_t)BATCH * NCH * 256 * 4);
  p.s5_state = (float*)take((size_t)BATCH * NCH * 16 * 128 * 4);
  p.cnt = (unsigned*)take(CNT_TOTAL * 4);
  p.bar = (unsigned*)take(XCD_BAR_WORDS * 4);
  if (off > ws_size) { fprintf(stderr, "workspace too small: need %zu have %zu\n", off, ws_size); return; }
  const int NPH = 1 + 6 * DEPTH;
#if MEGA
  (void)hipMemsetAsync(p.bar, 0, XCD_BAR_WORDS * 4, stream);
  int ph0 = 0, ph1 = NPH;
  void* args[] = {&p, &ph0, &ph1};
  hipError_t e = hipLaunchCooperativeKernel((void*)mk_fwd<true>, dim3(grid_blocks), dim3(256), args, 0, stream);
  if (e != hipSuccess) fprintf(stderr, "cooperative launch failed: %s (grid %d)\n", hipGetErrorString(e), grid_blocks);
#else
  for (int ph = 0; ph < NPH; ++ph) hipLaunchKernelGGL(mk_fwd<false>, dim3(grid_blocks), dim3(256), 0, stream, p, ph, ph + 1);
#endif
}
```

```cpp
#include <hip/hip_runtime.h>
#include <hip/hip_cooperative_groups.h>
#include <stdint.h>
#include <stdio.h>
namespace cg = cooperative_groups;

#ifndef MEGA
#define MEGA 1
#endif

typedef unsigned short bfu;
using bf16x8 = __attribute__((ext_vector_type(8))) short;
using f32x4  = __attribute__((ext_vector_type(4))) float;
#define DI __device__ __forceinline__

constexpr int BATCH = 8, SEQ = 2048, DM = 1024, DEPTH = 4, NTOK = BATCH * SEQ, NCH = SEQ / 64;
constexpr int DIN = 3080, PS = 3200;
constexpr int COL_AQ = 0, COL_AF = 256, COL_AI = 512, COL_AG = 768;
constexpr int COL_BQ = 1024, COL_BK = 1280, COL_BV = 1536, COL_BG = 1792, COL_BIG = 3072, COL_BFG = 3076;
constexpr int COL_CX = 2048, COL_CG = 2304, COL_DU = 2560, COL_DG = 2816;
constexpr float DN_ALPHA = 1.681792830507429f;
constexpr int SMEM_BYTES = 56 * 1024;
constexpr int CNT_LN = 0, CNT_GLU = 4 * 128, CNT_Q = 4 * 128 + 4 * 256, CNT_TOTAL = CNT_Q + 32 * 32;

struct Params {
  const float *x, *w_in, *b_in, *lb_logits, *hg_g, *ml_fb, *ml_g, *conv_w, *conv_b, *w_a, *b_a, *w_x, *b_x, *lam,
      *a_re, *a_im, *log_dt, *sb_re, *sb_im, *c_re, *c_im, *s5_d, *w_glu, *b_glu, *w_out, *b_out, *ln_g, *ln_b;
  float* out;
  bfu *wt_in, *wt_out, *wt_a, *wt_x, *wt_glu, *bt_bu, *bt_y, *hb, *proj, *mixed, *zbuf;
  float *abar, *abar64, *lbs, *hg_state, *hg_decay, *ml_state, *ml_n, *ml_decay, *lru_h, *lru_a, *s5_state;
  unsigned* cnt;
  unsigned* bar;
};

DI bfu f2bf(float x) { return __builtin_bit_cast(unsigned short, (__bf16)x); }
DI float bf2f(bfu h) { return __uint_as_float(((unsigned)h) << 16); }
typedef __bf16 bf16v2 __attribute__((ext_vector_type(2)));
typedef float f32v2 __attribute__((ext_vector_type(2)));
DI unsigned pack2(float a, float b) { f32v2 v = {a, b}; return __builtin_bit_cast(unsigned, __builtin_convertvector(v, bf16v2)); }
DI float fexp(float x) { return __expf(x); }
DI float frcp(float x) { return __builtin_amdgcn_rcpf(x); }
DI float flog(float x) { return __logf(x); }
DI float sigmoid_(float x) { return frcp(1.f + fexp(-x)); }
DI float silu_(float x) { return x * frcp(1.f + fexp(-x)); }
DI float logsig_(float x) { return fminf(x, 0.f) - flog(1.f + fexp(-fabsf(x))); }
DI float logsig_acc(float x) { return fminf(x, 0.f) - log1pf(expf(-fabsf(x))); }
DI float gelu_tanh_(float x) {
  float u = 0.7978845608028654f * (x + 0.044715f * x * x * x);
  float th = 1.f - 2.f * frcp(fexp(2.f * u) + 1.f);
  return 0.5f * x * (1.f + th);
}

template <int NT, int KS>
DI void wave_mma(f32x4 (&acc)[NT], const bfu* A, int lda, const bfu* Bt, int ldb, int lane) {
  const int r = lane & 15, q = lane >> 4;
#pragma unroll
  for (int ks = 0; ks < KS; ++ks) {
    bf16x8 a = *(const bf16x8*)(A + r * lda + ks * 32 + q * 8);
#pragma unroll
    for (int nt = 0; nt < NT; ++nt) {
      bf16x8 b = *(const bf16x8*)(Bt + (nt * 16 + r) * ldb + ks * 32 + q * 8);
      acc[nt] = __builtin_amdgcn_mfma_f32_16x16x32_bf16(a, b, acc[nt], 0, 0, 0);
    }
  }
}

DI void wave_sync() { __builtin_amdgcn_fence(__ATOMIC_SEQ_CST, "wavefront"); __builtin_amdgcn_wave_barrier(); __builtin_amdgcn_fence(__ATOMIC_SEQ_CST, "wavefront"); }
DI float group16_sum(float v) {
  v += __shfl_xor(v, 1); v += __shfl_xor(v, 2); v += __shfl_xor(v, 4); v += __shfl_xor(v, 8);
  return v;
}
DI float wave_sum(float v) {
  v += __shfl_xor(v, 1); v += __shfl_xor(v, 2); v += __shfl_xor(v, 4); v += __shfl_xor(v, 8);
  v += __shfl_xor(v, 16); v += __shfl_xor(v, 32);
  return v;
}

DI bool last_arriver(unsigned* ctr, unsigned total, unsigned* s_flag) {
  asm volatile("s_waitcnt vmcnt(0)" ::: "memory");
  __syncthreads();
  if (threadIdx.x == 0) {
    __builtin_amdgcn_fence(__ATOMIC_RELEASE, "agent");
    asm volatile("s_waitcnt vmcnt(0)" ::: "memory");
    const unsigned old = __hip_atomic_fetch_add(ctr, 1u, __ATOMIC_RELAXED, __HIP_MEMORY_SCOPE_AGENT);
    const unsigned last = (old == total - 1u) ? 1u : 0u;
    if (last) { __builtin_amdgcn_fence(__ATOMIC_ACQUIRE, "agent"); asm volatile("s_waitcnt vmcnt(0)" ::: "memory"); }
    *s_flag = last;
  }
  __syncthreads();
  return (*s_flag != 0u);
}

#ifdef TPROBE
#define TPS(ID) unsigned long long tps_##ID = 0; if (TPROBE == (ID)) tps_##ID = __builtin_amdgcn_s_memrealtime();
#define TPE(ID) if (TPROBE == (ID)) tp_acc += __builtin_amdgcn_s_memrealtime() - tps_##ID;
#else
#define TPS(ID)
#define TPE(ID)
#endif

#define XB_TMO      128
#define XB_XCNT(j)  (256  + 64 * (j))
#define XB_XSUB(j)  (1280 + 64 * (j))
#define XB_XGEN(j)  (2304 + 64 * (j))
#define XB_TOP      3328
#define XB_TOPGEN   3392
#define XCD_BAR_WORDS 3456
#define XB_SPIN_CAP (1u << 22)
#define LAS __attribute__((address_space(3)))
DI unsigned xb_ld(unsigned* p) { return __hip_atomic_load(p, __ATOMIC_RELAXED, __HIP_MEMORY_SCOPE_AGENT); }
DI unsigned xb_add(unsigned* p, unsigned v) { return __hip_atomic_fetch_add(p, v, __ATOMIC_RELAXED, __HIP_MEMORY_SCOPE_AGENT); }
DI unsigned xb_xcc_id() { return (unsigned)__builtin_amdgcn_s_getreg((3 << 11) | 20) & 0xFu; }
#define XB_SPIN(cond, bar) do { unsigned _sp = 0; while (cond) { __builtin_amdgcn_s_sleep(1); \
    if ((++_sp & 255u) == 0u) { if (xb_ld(&(bar)[XB_TMO])) break; if (_sp > XB_SPIN_CAP) { atomicAdd(&(bar)[XB_TMO], 1u); break; } } } } while (0)
struct XcdBarrier { unsigned* bar; unsigned x; volatile LAS unsigned* st; };
DI XcdBarrier xcd_barrier_post(unsigned* bar, volatile LAS unsigned* st) {
  XcdBarrier b; b.bar = bar; b.x = xb_xcc_id(); b.st = st;
  if (threadIdx.x == 0) (void)xb_add(&bar[XB_XCNT(b.x)], 1u);
  return b;
}
DI void xcd_barrier_complete(unsigned* bar, unsigned x, unsigned& nloc, unsigned& nx) {
  const unsigned G = gridDim.x * gridDim.y * gridDim.z;
  unsigned sum, cnt, mine, sp = 0u;
  for (;;) {
    sum = 0u; cnt = 0u; mine = 0u;
#pragma unroll
    for (unsigned j = 0; j < 16; ++j) { const unsigned c = xb_ld(&bar[XB_XCNT(j)]); sum += c; cnt += (c > 0u) ? 1u : 0u; mine = (j == x) ? c : mine; }
    if (sum == G) break;
    __builtin_amdgcn_s_sleep(1);
    if ((++sp & 255u) == 0u) { if (xb_ld(&bar[XB_TMO])) break; if (sp > XB_SPIN_CAP) { atomicAdd(&bar[XB_TMO], 1u); break; } }
  }
  nloc = mine > 0u ? mine : 1u; nx = cnt > 0u ? cnt : 1u;
}
DI void xcd_barrier(const XcdBarrier& b) {
  asm volatile("s_waitcnt vmcnt(0)" ::: "memory");
  __syncthreads();
  if (threadIdx.x == 0) {
    unsigned* bar = b.bar;
    __builtin_amdgcn_s_waitcnt(0);
    unsigned nloc = b.st[0], nx = b.st[1];
    if (nloc == 0u) { xcd_barrier_complete(bar, b.x, nloc, nx); b.st[0] = nloc; b.st[1] = nx; }
    const unsigned old = xb_add(&bar[XB_XSUB(b.x)], 1u);
    const unsigned gen = old / nloc;
    if (old + 1u == (gen + 1u) * nloc) {
      __builtin_amdgcn_fence(__ATOMIC_RELEASE, "agent");
      asm volatile("s_waitcnt vmcnt(0)" ::: "memory");
      const unsigned og = xb_add(&bar[XB_TOP], 1u);
      const unsigned tg = og / nx;
      if (og + 1u == (tg + 1u) * nx) xb_add(&bar[XB_TOPGEN], 1u);
      else XB_SPIN(xb_ld(&bar[XB_TOPGEN]) == tg, bar);
      __builtin_amdgcn_fence(__ATOMIC_ACQUIRE, "agent");
      xb_add(&bar[XB_XGEN(b.x)], 1u);
      asm volatile("s_waitcnt vmcnt(0)" ::: "memory");
    } else {
      XB_SPIN(xb_ld(&bar[XB_XGEN(b.x)]) == gen, bar);
      __builtin_amdgcn_fence(__ATOMIC_ACQUIRE, "agent");
      asm volatile("s_waitcnt vmcnt(0)" ::: "memory");
    }
  }
  __syncthreads();
}

DI void transpose_tile(const float* src, int sld, int cv, bfu* dst, int dld, float* tile) {
  const int tid = threadIdx.x;
  __syncthreads();
  for (int i = tid; i < 4096; i += 256) {
    int r = i >> 6, c = i & 63;
    tile[r * 65 + c] = (c < cv) ? src[(size_t)r * sld + c] : 0.f;
  }
  __syncthreads();
  for (int i = tid; i < 4096; i += 256) {
    int n = i >> 6, k = i & 63;
    dst[(size_t)n * dld + k] = f2bf(tile[k * 65 + n]);
  }
}

template <int LSEL>
DI void convert_weights(const Params& p, unsigned char* smem) {
  const int tid = threadIdx.x;
  float* tile = (float*)smem;
  const int NJ = 3200 + 1024 + 16 + 16 + 64;
  for (int job = blockIdx.x; job < NJ; job += gridDim.x) {
    const float* src; int sld, cv = 64, dld; bfu* dst;
    if (job < 3200) {
      int l = job / 800, rem = job % 800, kt = rem / 50, nt = rem % 50;
      if (l != LSEL) continue;
      const int c0 = nt < 28 ? nt * 64 : (nt < 48 ? nt * 64 + 8 : 1792);
      src = p.w_in + (size_t)l * 1024 * DIN + (size_t)kt * 64 * DIN + c0; sld = DIN;
      cv = nt < 48 ? 64 : (nt == 48 ? 8 : 0);
      dst = p.wt_in + (size_t)l * PS * 1024 + (size_t)nt * 64 * 1024 + kt * 64; dld = 1024;
    } else if (job < 4224) {
      int j = job - 3200, l = j / 256, rem = j % 256, kt = rem / 16, nt = rem % 16;
      if (l != LSEL) continue;
      src = p.w_out + (size_t)l * 1048576 + (size_t)kt * 64 * 1024 + nt * 64; sld = 1024;
      dst = p.wt_out + (size_t)l * 1048576 + (size_t)nt * 64 * 1024 + kt * 64; dld = 1024;
    } else if (LSEL != 0) {
      continue;
    } else if (job < 4240) {
      int j = job - 4224; src = p.w_a + j * 4096; sld = 64; dst = p.wt_a + j * 4096; dld = 64;
    } else if (job < 4256) {
      int j = job - 4240; src = p.w_x + j * 4096; sld = 64; dst = p.wt_x + j * 4096; dld = 64;
    } else {
      int j = job - 4256, l = j / 16, rem = j % 16, kt = rem / 4, nt = rem % 4;
      src = p.w_glu + l * 65536 + kt * 64 * 256 + nt * 64; sld = 256;
      dst = p.wt_glu + l * 65536 + nt * 64 * 256 + kt * 64; dld = 256;
    }
    transpose_tile(src, sld, cv, dst, dld, tile);
  }
}

DI void phase0(const Params& p, unsigned char* smem) {
  const int tid = threadIdx.x;
  const int gtid = blockIdx.x * 256 + tid, gsz = gridDim.x * 256;
  for (int i0 = gtid; i0 < NTOK * DM / 8; i0 += 4 * gsz) {
    float4 a[4], b[4];
#pragma unroll
    for (int u = 0; u < 4; ++u) {
      const int i = i0 + u * gsz;
      if (i < NTOK * DM / 8) { a[u] = ((const float4*)p.x)[2 * i]; b[u] = ((const float4*)p.x)[2 * i + 1]; }
    }
#pragma unroll
    for (int u = 0; u < 4; ++u) {
      const int i = i0 + u * gsz;
      if (i < NTOK * DM / 8) {
        uint4 o; o.x = pack2(a[u].x, a[u].y); o.y = pack2(a[u].z, a[u].w); o.z = pack2(b[u].x, b[u].y); o.w = pack2(b[u].z, b[u].w);
        ((uint4*)p.hb)[i] = o;
      }
    }
  }
  convert_weights<0>(p, smem);
  for (int i = (gridDim.x - 1 - blockIdx.x) * 256 + tid; i < 4096; i += gsz) {
    int lg = i >> 6, pp = i & 63;
    double dt = exp((double)p.log_dt[lg]);
    double are = p.a_re[lg * 64 + pp], aim = p.a_im[lg * 64 + pp];
    double mag = exp(dt * are), ang = dt * aim;
    double abr = mag * cos(ang), abi = mag * sin(ang);
    double den = are * are + aim * aim;
    double xr = abr - 1.0, xi = abi;
    double zr = (xr * are + xi * aim) / den, zi = (xi * are - xr * aim) / den;
    bfu* o_re = p.bt_bu + ((size_t)lg * 128 + pp) * 32;
    bfu* o_im = p.bt_bu + ((size_t)lg * 128 + 64 + pp) * 32;
    for (int h = 0; h < 16; ++h) {
      double br = p.sb_re[(lg * 64 + pp) * 16 + h], bi = p.sb_im[(lg * 64 + pp) * 16 + h];
      o_re[h] = f2bf((float)(zr * br - zi * bi));
      o_im[h] = f2bf((float)(zr * bi + zi * br));
      o_re[16 + h] = 0; o_im[16 + h] = 0;
    }
    p.abar[(lg * 64 + pp) * 2 + 0] = (float)abr; p.abar[(lg * 64 + pp) * 2 + 1] = (float)abi;
    double mag64 = exp(64.0 * dt * are), ang64 = 64.0 * ang;
    p.abar64[(lg * 64 + pp) * 2 + 0] = (float)(mag64 * cos(ang64));
    p.abar64[(lg * 64 + pp) * 2 + 1] = (float)(mag64 * sin(ang64));
  }
  for (int i = gtid; i < 4 * 16 * 16 * 128; i += gsz) {
    int k = i & 127, lgn = i >> 7;
    p.bt_y[i] = (k < 64) ? f2bf(p.c_re[lgn * 64 + k]) : f2bf(-p.c_im[lgn * 64 + (k - 64)]);
  }
  for (int i = gtid; i < 256; i += gsz) {
    float v0 = p.lb_logits[i], v1 = p.lb_logits[256 + i], v2 = p.lb_logits[512 + i], v3 = p.lb_logits[768 + i];
    float m = fmaxf(fmaxf(v0, v1), fmaxf(v2, v3));
    float e0 = expf(v0 - m), e1 = expf(v1 - m), e2 = expf(v2 - m), e3 = expf(v3 - m);
    float s = e0 + e1 + e2 + e3;
    p.lbs[i] = 0.f; p.lbs[256 + i] = e1 / s; p.lbs[512 + i] = (e1 + e2) / s; p.lbs[768 + i] = (e1 + e2 + e3) / s;
  }
  for (int i = gtid; i < CNT_TOTAL; i += gsz) p.cnt[i] = 0u;
}

DI void gemm1_tile(const Params& p, int l, const bfu* A, const bfu* Bt, int m0, int n0, unsigned char* smem,
                   uint4& ra0, uint4& ra1, uint4& ra2, uint4& ra3, uint4& rb0, uint4& rb1, uint4& rb2, uint4& rb3, uint4& rb4, uint4& rb5, bool pre, long dA, long dB) {
  bfu* sA = (bfu*)smem; bfu* sB = sA + 128 * 72;
  bfu* sC = (bfu*)smem;
  const int tid = threadIdx.x, lane = tid & 63, w = tid >> 6, wm = w >> 1, wn = w & 1;
  const int r = lane & 15, q = lane >> 4;
  f32x4 acc[4][6];
#pragma unroll
  for (int i = 0; i < 4; ++i)
#pragma unroll
    for (int j = 0; j < 6; ++j) acc[i][j] = (f32x4){0.f, 0.f, 0.f, 0.f};
  const int lrow = tid >> 3, lkc = tid & 7;
  const bfu* ga = A + (size_t)(m0 + lrow) * 1024 + lkc * 8;
  const bfu* gb = Bt + (size_t)(n0 + lrow) * 1024 + lkc * 8;
  if (!pre) {
    ra0 = *(const uint4*)(ga); ra1 = *(const uint4*)(ga + 32 * 1024); ra2 = *(const uint4*)(ga + 64 * 1024); ra3 = *(const uint4*)(ga + 96 * 1024);
    rb0 = *(const uint4*)(gb); rb1 = *(const uint4*)(gb + 32 * 1024); rb2 = *(const uint4*)(gb + 64 * 1024); rb3 = *(const uint4*)(gb + 96 * 1024);
    rb4 = *(const uint4*)(gb + 128 * 1024); rb5 = *(const uint4*)(gb + 160 * 1024);
  }
  bfu* wa = sA + lrow * 72 + lkc * 8;
  bfu* wb = sB + lrow * 72 + lkc * 8;
  for (int kt = 0; kt < 16; ++kt) {
    __syncthreads();
    *(uint4*)(wa) = ra0; *(uint4*)(wa + 32 * 72) = ra1; *(uint4*)(wa + 64 * 72) = ra2; *(uint4*)(wa + 96 * 72) = ra3;
    *(uint4*)(wb) = rb0; *(uint4*)(wb + 32 * 72) = rb1; *(uint4*)(wb + 64 * 72) = rb2; *(uint4*)(wb + 96 * 72) = rb3;
    *(uint4*)(wb + 128 * 72) = rb4; *(uint4*)(wb + 160 * 72) = rb5;
    __syncthreads();
    {
      const long oa = (kt + 1 < 16) ? (long)(kt + 1) * 64 : dA, ob = (kt + 1 < 16) ? (long)(kt + 1) * 64 : dB;
      const bfu* ga2 = ga + oa; const bfu* gb2 = gb + ob;
      ra0 = *(const uint4*)(ga2); ra1 = *(const uint4*)(ga2 + 32 * 1024); ra2 = *(const uint4*)(ga2 + 64 * 1024); ra3 = *(const uint4*)(ga2 + 96 * 1024);
      rb0 = *(const uint4*)(gb2); rb1 = *(const uint4*)(gb2 + 32 * 1024); rb2 = *(const uint4*)(gb2 + 64 * 1024); rb3 = *(const uint4*)(gb2 + 96 * 1024);
      rb4 = *(const uint4*)(gb2 + 128 * 1024); rb5 = *(const uint4*)(gb2 + 160 * 1024);
    }
#pragma unroll
    for (int ks = 0; ks < 2; ++ks) {
      bf16x8 af[4], bfr[6];
#pragma unroll
      for (int mt = 0; mt < 4; ++mt) af[mt] = *(const bf16x8*)(sA + (wm * 64 + mt * 16 + r) * 72 + ks * 32 + q * 8);
#pragma unroll
      for (int nt = 0; nt < 6; ++nt) bfr[nt] = *(const bf16x8*)(sB + (wn * 96 + nt * 16 + r) * 72 + ks * 32 + q * 8);
#pragma unroll
      for (int mt = 0; mt < 4; ++mt)
#pragma unroll
        for (int nt = 0; nt < 6; ++nt) acc[mt][nt] = __builtin_amdgcn_mfma_f32_16x16x32_bf16(af[mt], bfr[nt], acc[mt][nt], 0, 0, 0);
    }
  }
  float bias[6];
#pragma unroll
  for (int nt = 0; nt < 6; ++nt) {
    const int col = n0 + wn * 96 + nt * 16 + r;
    bias[nt] = p.b_in[l * DIN + (col < 1792 ? col : col + 8)];
  }
  __syncthreads();
#pragma unroll
  for (int mt = 0; mt < 4; ++mt)
#pragma unroll
    for (int nt = 0; nt < 6; ++nt)
#pragma unroll
      for (int j = 0; j < 4; ++j)
        sC[(wm * 64 + mt * 16 + q * 4 + j) * 200 + wn * 96 + nt * 16 + r] = f2bf(acc[mt][nt][j] + bias[nt]);
  __syncthreads();
#pragma unroll
  for (int i = 0; i < 12; ++i) {
    const int id = tid + i * 256, row = id / 24, ch = id % 24;
    *(uint4*)(p.proj + (size_t)(m0 + row) * PS + n0 + ch * 8) = *(const uint4*)(sC + row * 200 + ch * 8);
  }
}

DI void gemm1_gates(const Params& p, int l, const bfu* A, const bfu* Bt, int m0) {
  const int tid = threadIdx.x, lane = tid & 63, w = tid >> 6, r = lane & 15, q = lane >> 4;
  const bfu* a0 = A + (size_t)(m0 + w * 32 + r) * 1024 + q * 8;
  const bfu* a1 = a0 + 16 * 1024;
  const bfu* bp = Bt + (size_t)(3072 + r) * 1024 + q * 8;
  f32x4 c0 = (f32x4){0.f, 0.f, 0.f, 0.f}, c1 = (f32x4){0.f, 0.f, 0.f, 0.f};
#pragma unroll 4
  for (int ks = 0; ks < 32; ++ks) {
    const bf16x8 b = *(const bf16x8*)(bp + ks * 32);
    const bf16x8 x0 = *(const bf16x8*)(a0 + ks * 32);
    const bf16x8 x1 = *(const bf16x8*)(a1 + ks * 32);
    c0 = __builtin_amdgcn_mfma_f32_16x16x32_bf16(x0, b, c0, 0, 0, 0);
    c1 = __builtin_amdgcn_mfma_f32_16x16x32_bf16(x1, b, c1, 0, 0, 0);
  }
  if (r < 8) {
    const float bias = p.b_in[l * DIN + 1792 + r];
#pragma unroll
    for (int j = 0; j < 4; ++j) {
      p.proj[(size_t)(m0 + w * 32 + q * 4 + j) * PS + 3072 + r] = f2bf(c0[j] + bias);
      p.proj[(size_t)(m0 + w * 32 + 16 + q * 4 + j) * PS + 3072 + r] = f2bf(c1[j] + bias);
    }
  }
}

DI void phase1(const Params& p, int l, unsigned char* smem) {
  const bfu* Bt = p.wt_in + (size_t)l * PS * 1024;
  {
    uint4 ra0, ra1, ra2, ra3, rb0, rb1, rb2, rb3, rb4, rb5;
    bool pre = false;
    for (int tile = blockIdx.x; tile < 128 * 16; tile += gridDim.x) {
      const int mt = tile >> 4, nt = tile & 15, nx = tile + gridDim.x;
      const bool hn = nx < 128 * 16;
      const long dA = hn ? (long)((nx >> 4) - mt) * 128 * 1024 : 0, dB = hn ? (long)((nx & 15) - nt) * 192 * 1024 : 0;
      gemm1_tile(p, l, p.hb, Bt, mt * 128, nt * 192, smem, ra0, ra1, ra2, ra3, rb0, rb1, rb2, rb3, rb4, rb5, pre, dA, dB);
      pre = true;
    }
  }
  for (int job = blockIdx.x; job < 128; job += gridDim.x) gemm1_gates(p, l, p.hb, Bt, job * 128);
}

template <int EPI>
DI void gemm2_tile(const Params& p, int l, const bfu* A, const bfu* Bt, int m0, int n0, const float* hin, unsigned char* smem) {
  bfu* sA = (bfu*)smem; bfu* sB = sA + 128 * 72;
  const int tid = threadIdx.x, lane = tid & 63, w = tid >> 6, wm = w >> 1, wn = w & 1;
  const int r = lane & 15, q = lane >> 4;
  f32x4 acc[4][4];
#pragma unroll
  for (int i = 0; i < 4; ++i)
#pragma unroll
    for (int j = 0; j < 4; ++j) acc[i][j] = (f32x4){0.f, 0.f, 0.f, 0.f};
  const int lrow = tid >> 3, lkc = tid & 7;
  const bfu* ga = A + (size_t)(m0 + lrow) * 1024 + lkc * 8;
  const bfu* gb = Bt + (size_t)(n0 + lrow) * 1024 + lkc * 8;
  uint4 ra0 = *(const uint4*)(ga), ra1 = *(const uint4*)(ga + 32 * 1024), ra2 = *(const uint4*)(ga + 64 * 1024), ra3 = *(const uint4*)(ga + 96 * 1024);
  uint4 rb0 = *(const uint4*)(gb), rb1 = *(const uint4*)(gb + 32 * 1024), rb2 = *(const uint4*)(gb + 64 * 1024), rb3 = *(const uint4*)(gb + 96 * 1024);
  bfu* wa = sA + lrow * 72 + lkc * 8;
  bfu* wb = sB + lrow * 72 + lkc * 8;
  for (int kt = 0; kt < 16; ++kt) {
    __syncthreads();
    *(uint4*)(wa) = ra0; *(uint4*)(wa + 32 * 72) = ra1; *(uint4*)(wa + 64 * 72) = ra2; *(uint4*)(wa + 96 * 72) = ra3;
    *(uint4*)(wb) = rb0; *(uint4*)(wb + 32 * 72) = rb1; *(uint4*)(wb + 64 * 72) = rb2; *(uint4*)(wb + 96 * 72) = rb3;
    __syncthreads();
    if (kt + 1 < 16) {
      const bfu* ga2 = ga + (kt + 1) * 64; const bfu* gb2 = gb + (kt + 1) * 64;
      ra0 = *(const uint4*)(ga2); ra1 = *(const uint4*)(ga2 + 32 * 1024); ra2 = *(const uint4*)(ga2 + 64 * 1024); ra3 = *(const uint4*)(ga2 + 96 * 1024);
      rb0 = *(const uint4*)(gb2); rb1 = *(const uint4*)(gb2 + 32 * 1024); rb2 = *(const uint4*)(gb2 + 64 * 1024); rb3 = *(const uint4*)(gb2 + 96 * 1024);
    }
#pragma unroll
    for (int ks = 0; ks < 2; ++ks) {
      bf16x8 af[4], bfr[4];
#pragma unroll
      for (int mt = 0; mt < 4; ++mt) af[mt] = *(const bf16x8*)(sA + (wm * 64 + mt * 16 + r) * 72 + ks * 32 + q * 8);
#pragma unroll
      for (int nt = 0; nt < 4; ++nt) bfr[nt] = *(const bf16x8*)(sB + (wn * 64 + nt * 16 + r) * 72 + ks * 32 + q * 8);
#pragma unroll
      for (int mt = 0; mt < 4; ++mt)
#pragma unroll
        for (int nt = 0; nt < 4; ++nt) acc[mt][nt] = __builtin_amdgcn_mfma_f32_16x16x32_bf16(af[mt], bfr[nt], acc[mt][nt], 0, 0, 0);
    }
  }
#pragma unroll
  for (int np = 0; np < 2; ++np) {
    float hv[2][4][4], bias[2];
#pragma unroll
    for (int u = 0; u < 2; ++u) {
      const int col = n0 + wn * 64 + (np * 2 + u) * 16 + r;
      bias[u] = p.b_out[l * 1024 + col];
#pragma unroll
      for (int mt = 0; mt < 4; ++mt)
#pragma unroll
        for (int j = 0; j < 4; ++j) hv[u][mt][j] = hin[(size_t)(m0 + wm * 64 + mt * 16 + q * 4 + j) * 1024 + col];
    }
#pragma unroll
    for (int u = 0; u < 2; ++u) {
      const int nt = np * 2 + u, col = n0 + wn * 64 + nt * 16 + r;
#pragma unroll
      for (int mt = 0; mt < 4; ++mt)
#pragma unroll
        for (int j = 0; j < 4; ++j) {
          const int row = m0 + wm * 64 + mt * 16 + q * 4 + j;
          p.out[(size_t)row * 1024 + col] = DN_ALPHA * hv[u][mt][j] + acc[mt][nt][j] + bias[u];
        }
    }
  }
}


DI void phase5(const Params& p, int l, unsigned char* smem, unsigned long long& tp_acc) {
  const bfu* Bt = p.wt_out + (size_t)l * 1048576;
  const float* hin = (l == 0) ? p.x : p.out;
  for (int tile = blockIdx.x; tile < 128 * 8; tile += gridDim.x) gemm2_tile<2>(p, l, p.mixed, Bt, (tile >> 3) * 128, (tile & 7) * 128, hin, smem);
}

DI void phase6(const Params& p, int l) {
  const int tid = threadIdx.x, lane = tid & 63, w = tid >> 6;
  float4 g[4], bb[4];
#pragma unroll
  for (int i = 0; i < 4; ++i) { g[i] = *(const float4*)(p.ln_g + l * 1024 + i * 256 + lane * 4); bb[i] = *(const float4*)(p.ln_b + l * 1024 + i * 256 + lane * 4); }
  for (int rb = blockIdx.x; rb < NTOK / 16; rb += gridDim.x) {
    const int row0 = rb * 16 + w * 4;
    float4 v[4][4];
#pragma unroll
    for (int rr = 0; rr < 4; ++rr)
#pragma unroll
      for (int i = 0; i < 4; ++i) v[rr][i] = *(const float4*)(p.out + (size_t)(row0 + rr) * 1024 + i * 256 + lane * 4);
#pragma unroll
    for (int rr = 0; rr < 4; ++rr) {
      float sm = 0.f;
#pragma unroll
      for (int i = 0; i < 4; ++i) sm += v[rr][i].x + v[rr][i].y + v[rr][i].z + v[rr][i].w;
      const float mu = wave_sum(sm) * (1.f / 1024.f);
      float ss = 0.f;
#pragma unroll
      for (int i = 0; i < 4; ++i) {
        v[rr][i].x -= mu; v[rr][i].y -= mu; v[rr][i].z -= mu; v[rr][i].w -= mu;
        ss += v[rr][i].x * v[rr][i].x + v[rr][i].y * v[rr][i].y + v[rr][i].z * v[rr][i].z + v[rr][i].w * v[rr][i].w;
      }
      const float rs = rsqrtf(wave_sum(ss) * (1.f / 1024.f) + 1e-5f);
#pragma unroll
      for (int i = 0; i < 4; ++i) {
        const int c = i * 256 + lane * 4;
        float4 o;
        o.x = v[rr][i].x * rs * g[i].x + bb[i].x; o.y = v[rr][i].y * rs * g[i].y + bb[i].y;
        o.z = v[rr][i].z * rs * g[i].z + bb[i].z; o.w = v[rr][i].w * rs * g[i].w + bb[i].w;
        *(float4*)(p.out + (size_t)(row0 + rr) * 1024 + c) = o;
        uint2 ob; ob.x = pack2(o.x, o.y); ob.y = pack2(o.z, o.w);
        *(uint2*)(p.hb + (size_t)(row0 + rr) * 1024 + c) = ob;
      }
    }
  }
}

DI void hg_gate(float x, float lb, float& lf, float& k) {
  x = fmaxf(x, -80.f);
  const float E = fexp(-x);
  const float sg = frcp(1.f + E);
  k = (1.f - lb) * (E * sg);
  lf = flog(lb + (1.f - lb) * sg);
}

DI void hg_local(const Params& p, int l, int b, int c, int hd, unsigned char* smem) {
  const int tid = threadIdx.x, lane = tid & 63, w = tid >> 6;
  bfu* At = (bfu*)smem;
  bfu* Bt = At + 64 * 72;
  float* segtot = (float*)(smem + 2 * 64 * 72 * 2);
  const int tok0 = b * SEQ + c * 64;
  const int d = lane;
  const float lb = p.lbs[l * 256 + hd * 64 + d];
  const bfu* pf = p.proj + (size_t)tok0 * PS + COL_AF + hd * 64 + d;
  const bfu* pv = p.proj + (size_t)tok0 * PS + COL_AI + hd * 64 + d;
  float bl[16], kk[16];
  float run = 0.f;
  __syncthreads();
#pragma unroll
  for (int i = 0; i < 16; ++i) {
    const int t = w * 16 + i;
    float lf, k; hg_gate(bf2f(pf[(size_t)t * PS]), lb, lf, k);
    run += lf; bl[i] = run; kk[i] = k;
    At[d * 72 + t] = pv[(size_t)t * PS];
  }
  segtot[w * 64 + d] = run;
  __syncthreads();
  float off = 0.f, tot = 0.f;
#pragma unroll
  for (int s = 0; s < 4; ++s) { float v = segtot[s * 64 + d]; tot += v; if (s < w) off += v; }
#pragma unroll
  for (int i = 0; i < 16; ++i) { const int t = w * 16 + i; Bt[d * 72 + t] = f2bf(kk[i] * fexp(tot - (bl[i] + off))); }
  const int base = (b * NCH + c) * 4 + hd;
  if (w == 0) p.hg_decay[base * 64 + d] = fexp(tot);
  __syncthreads();
  f32x4 acc[4];
#pragma unroll
  for (int i = 0; i < 4; ++i) acc[i] = (f32x4){0.f, 0.f, 0.f, 0.f};
  wave_mma<4, 2>(acc, At + w * 16 * 72, 72, Bt, 72, lane);
  float* st = p.hg_state + (size_t)base * 4096;
  const int r = lane & 15, q = lane >> 4;
#pragma unroll
  for (int nt = 0; nt < 4; ++nt)
#pragma unroll
    for (int j = 0; j < 4; ++j) st[(w * 16 + q * 4 + j) * 64 + nt * 16 + r] = acc[nt][j];
}

constexpr int O_A = 0, O_BT = 17408, O_QP = 34816, O_KP = 44032, O_MISC = 53248;

DI void hg_out(const Params& p, int l, int b, int c, int hd, unsigned char* smem) {
  const int tid = threadIdx.x, lane = tid & 63, w = tid >> 6;
  bfu* A = (bfu*)(smem + O_A); bfu* Bt = (bfu*)(smem + O_BT); bfu* Qp = (bfu*)(smem + O_QP); bfu* Kp = (bfu*)(smem + O_KP);
  float* segtot = (float*)(smem + O_MISC);
  const int tok0 = b * SEQ + c * 64;
  const int d = lane;
  const float lb = p.lbs[l * 256 + hd * 64 + d];
  const bfu* pq = p.proj + (size_t)tok0 * PS + COL_AQ + hd * 64 + d;
  const bfu* pf = p.proj + (size_t)tok0 * PS + COL_AF + hd * 64 + d;
  const bfu* pv = p.proj + (size_t)tok0 * PS + COL_AI + hd * 64 + d;
  const int base = (b * NCH + c) * 4 + hd;
  const float* st = p.hg_state + (size_t)base * 4096;
  float bl[16], kk[16];
  float run = 0.f;
  const int r = lane & 15, q = lane >> 4;
  bfu fraw[16], vraw[16], qraw[16]; float sraw[16];
#pragma unroll
  for (int i = 0; i < 16; ++i) {
    const int t = w * 16 + i;
    fraw[i] = pf[(size_t)t * PS]; vraw[i] = pv[(size_t)t * PS]; qraw[i] = pq[(size_t)t * PS]; sraw[i] = st[(w + 4 * i) * 64 + d];
  }
  bfu gt[4][4]; float gw[4];
#pragma unroll
  for (int nt = 0; nt < 4; ++nt) {
    gw[nt] = p.hg_g[l * 256 + hd * 64 + nt * 16 + r];
#pragma unroll
    for (int j = 0; j < 4; ++j) gt[j][nt] = p.proj[(size_t)(tok0 + w * 16 + q * 4 + j) * PS + COL_AG + hd * 64 + nt * 16 + r];
  }
  __syncthreads();
#pragma unroll
  for (int i = 0; i < 16; ++i) {
    const int t = w * 16 + i;
    float lf, k; hg_gate(bf2f(fraw[i]), lb, lf, k);
    run += lf; bl[i] = run; kk[i] = k;
    Bt[d * 136 + t] = vraw[i];
    const int e = w + 4 * i;
    Bt[e * 136 + 64 + d] = f2bf(sraw[i]);
  }
  segtot[w * 64 + d] = run;
  __syncthreads();
  float off = 0.f;
#pragma unroll
  for (int s = 0; s < 4; ++s) { float v = segtot[s * 64 + d]; if (s < w) off += v; }
  const float bm = segtot[d] + segtot[64 + d];
#pragma unroll
  for (int i = 0; i < 16; ++i) {
    const int t = w * 16 + i;
    const float bt = bl[i] + off;
    const float qv = silu_(bf2f(qraw[i]));
    Qp[t * 72 + d] = f2bf(qv * fexp(fmaxf(bt - bm, -80.f)));
    Kp[t * 72 + d] = f2bf(kk[i] * fexp(fminf(bm - bt, 80.f)));
    A[t * 136 + 64 + d] = f2bf(qv * fexp(bt));
  }
  __syncthreads();
  f32x4 acc[4];
#pragma unroll
  for (int i = 0; i < 4; ++i) acc[i] = (f32x4){0.f, 0.f, 0.f, 0.f};
  wave_mma<4, 2>(acc, Qp + w * 16 * 72, 72, Kp, 72, lane);
#pragma unroll
  for (int nt = 0; nt < 4; ++nt)
#pragma unroll
    for (int j = 0; j < 4; ++j) {
      const int t = w * 16 + q * 4 + j, s = nt * 16 + r;
      A[t * 136 + s] = f2bf(s <= t ? acc[nt][j] : 0.f);
    }
  __syncthreads();
  f32x4 o[4];
#pragma unroll
  for (int i = 0; i < 4; ++i) o[i] = (f32x4){0.f, 0.f, 0.f, 0.f};
  wave_mma<4, 4>(o, A + w * 16 * 136, 136, Bt, 136, lane);
#pragma unroll
  for (int j = 0; j < 4; ++j) {
    float ss = 0.f;
#pragma unroll
    for (int nt = 0; nt < 4; ++nt) ss += o[nt][j] * o[nt][j];
    ss = group16_sum(ss);
    const float sc = rsqrtf(ss * (1.f / 64.f) + 1e-6f);
    const int t = w * 16 + q * 4 + j;
    bfu* mrow = p.mixed + (size_t)(tok0 + t) * 1024 + hd * 64;
#pragma unroll
    for (int nt = 0; nt < 4; ++nt) {
      const int e = nt * 16 + r;
      mrow[e] = f2bf(o[nt][j] * sc * gw[nt] * silu_(bf2f(gt[j][nt])));
    }
  }
}

DI void ml_gates(const Params& p, int l, int tok0, int hd, float* bs, float* igs, int tid) {
  if (tid < 64) {
    const bfu* row = p.proj + (size_t)(tok0 + tid) * PS;
    const float ig = bf2f(row[COL_BIG + hd]);
    const float fg = bf2f(row[COL_BFG + hd]) + p.ml_fb[l * 4 + hd];
    float lf = logsig_(fg);
#pragma unroll
    for (int o = 1; o < 64; o <<= 1) { float v = __shfl_up(lf, o); if (tid >= o) lf += v; }
    bs[tid] = lf; igs[tid] = ig;
  }
}

DI void ml_local(const Params& p, int l, int b, int c, int hd, unsigned char* smem) {
  const int tid = threadIdx.x, lane = tid & 63, w = tid >> 6;
  bfu* At = (bfu*)smem;
  bfu* Bt = At + 64 * 72;
  float* bs = (float*)(smem + 2 * 64 * 72 * 2);
  float* igs = bs + 64; float* nseg = igs + 64;
  const int tok0 = b * SEQ + c * 64;
  const int d = lane;
  const bfu* pk = p.proj + (size_t)tok0 * PS + COL_BK + hd * 64 + d;
  const bfu* pv = p.proj + (size_t)tok0 * PS + COL_BV + hd * 64 + d;
  bfu kraw[16], vraw[16];
#pragma unroll
  for (int i = 0; i < 16; ++i) { kraw[i] = pk[(size_t)(w * 16 + i) * PS]; vraw[i] = pv[(size_t)(w * 16 + i) * PS]; }
  __syncthreads();
  ml_gates(p, l, tok0, hd, bs, igs, tid);
  __syncthreads();
  const float blast = bs[63];
  float nacc = 0.f;
#pragma unroll
  for (int i = 0; i < 16; ++i) {
    const int s = w * 16 + i;
    const float ws = fexp(blast - bs[s] + igs[s]);
    const float kw = bf2f(kraw[i]) * 0.125f * ws;
    Bt[d * 72 + s] = f2bf(kw); nacc += kw;
    At[d * 72 + s] = vraw[i];
  }
  nseg[w * 64 + d] = nacc;
  __syncthreads();
  const int base = (b * NCH + c) * 4 + hd;
  if (w == 0) p.ml_n[base * 64 + d] = nseg[d] + nseg[64 + d] + nseg[128 + d] + nseg[192 + d];
  if (tid == 0) p.ml_decay[base] = fexp(blast);
  f32x4 acc[4];
#pragma unroll
  for (int i = 0; i < 4; ++i) acc[i] = (f32x4){0.f, 0.f, 0.f, 0.f};
  wave_mma<4, 2>(acc, At + w * 16 * 72, 72, Bt, 72, lane);
  float* st = p.ml_state + (size_t)base * 4096;
  const int r = lane & 15, q = lane >> 4;
#pragma unroll
  for (int nt = 0; nt < 4; ++nt)
#pragma unroll
    for (int j = 0; j < 4; ++j) st[(w * 16 + q * 4 + j) * 64 + nt * 16 + r] = acc[nt][j];
}

DI void ml_out(const Params& p, int l, int b, int c, int hd, unsigned char* smem) {
  const int tid = threadIdx.x, lane = tid & 63, w = tid >> 6;
  bfu* A = (bfu*)(smem + O_A); bfu* Bt = (bfu*)(smem + O_BT); bfu* Qp = (bfu*)(smem + O_QP); bfu* Kp = (bfu*)(smem + O_KP);
  float* bs = (float*)(smem + O_MISC); float* igs = bs + 64; float* npv = igs + 64; float* den2 = npv + 64;
  const int tok0 = b * SEQ + c * 64;
  const int d = lane;
  const int base = (b * NCH + c) * 4 + hd;
  const float* st = p.ml_state + (size_t)base * 4096;
  const int r = lane & 15, q = lane >> 4;
  const bfu* pq = p.proj + (size_t)tok0 * PS + COL_BQ + hd * 64 + d;
  const bfu* pk = p.proj + (size_t)tok0 * PS + COL_BK + hd * 64 + d;
  const bfu* pv = p.proj + (size_t)tok0 * PS + COL_BV + hd * 64 + d;
  bfu qraw[16], kraw[16], vraw[16]; float sraw[16];
#pragma unroll
  for (int i = 0; i < 16; ++i) {
    const int t = w * 16 + i;
    qraw[i] = pq[(size_t)t * PS]; kraw[i] = pk[(size_t)t * PS]; vraw[i] = pv[(size_t)t * PS]; sraw[i] = st[(w + 4 * i) * 64 + d];
  }
  bfu gt[4][4]; float gw[4];
#pragma unroll
  for (int nt = 0; nt < 4; ++nt) {
    gw[nt] = p.ml_g[l * 256 + hd * 64 + nt * 16 + r];
#pragma unroll
    for (int j = 0; j < 4; ++j) gt[j][nt] = p.proj[(size_t)(tok0 + w * 16 + q * 4 + j) * PS + COL_BG + hd * 64 + nt * 16 + r];
  }
  __syncthreads();
  ml_gates(p, l, tok0, hd, bs, igs, tid);
  if (tid >= 64 && tid < 128) npv[tid - 64] = p.ml_n[base * 64 + tid - 64];
  __syncthreads();
#pragma unroll
  for (int i = 0; i < 16; ++i) {
    const int t = w * 16 + i;
    Qp[t * 72 + d] = qraw[i];
    Kp[t * 72 + d] = kraw[i];
    A[t * 136 + 64 + d] = f2bf(bf2f(qraw[i]) * fexp(bs[t]));
    Bt[d * 136 + t] = vraw[i];
    const int e = w + 4 * i;
    Bt[e * 136 + 64 + d] = f2bf(sraw[i]);
  }
  __syncthreads();
  if (tid < 64) {
    float s = 0.f;
    for (int dd = 0; dd < 64; ++dd) s += bf2f(A[tid * 136 + 64 + dd]) * npv[dd];
    den2[tid] = s;
  }
  f32x4 acc[4];
#pragma unroll
  for (int i = 0; i < 4; ++i) acc[i] = (f32x4){0.f, 0.f, 0.f, 0.f};
  wave_mma<4, 2>(acc, Qp + w * 16 * 72, 72, Kp, 72, lane);
  float den1[4];
#pragma unroll
  for (int j = 0; j < 4; ++j) {
    const int t = w * 16 + q * 4 + j;
    const float bt = bs[t];
    float rs = 0.f;
#pragma unroll
    for (int nt = 0; nt < 4; ++nt) {
      const int s = nt * 16 + r;
      float wv = 0.f;
      if (s <= t) wv = fexp(bt - bs[s] + igs[s]) * acc[nt][j] * 0.125f;
      rs += wv;
      A[t * 136 + s] = f2bf(wv);
    }
    den1[j] = group16_sum(rs);
  }
  __syncthreads();
  f32x4 o[4];
#pragma unroll
  for (int i = 0; i < 4; ++i) o[i] = (f32x4){0.f, 0.f, 0.f, 0.f};
  wave_mma<4, 4>(o, A + w * 16 * 136, 136, Bt, 136, lane);
#pragma unroll
  for (int j = 0; j < 4; ++j) {
    const int t = w * 16 + q * 4 + j;
    const float den = den1[j] + den2[t];
    const float inv = frcp(fmaxf(fabsf(den), 1.f));
    float hv[4];
    float ss = 0.f;
#pragma unroll
    for (int nt = 0; nt < 4; ++nt) { hv[nt] = o[nt][j] * inv; ss += hv[nt] * hv[nt]; }
    ss = group16_sum(ss);
    const float sc = rsqrtf(ss * (1.f / 64.f) + 1e-6f);
    bfu* mrow = p.mixed + (size_t)(tok0 + t) * 1024 + 256 + hd * 64;
#pragma unroll
    for (int nt = 0; nt < 4; ++nt) {
      const int e = nt * 16 + r;
      mrow[e] = f2bf(hv[nt] * sc * gw[nt] * silu_(bf2f(gt[j][nt])));
    }
  }
}

template <bool FINAL>
DI void lru_item(const Params& p, int l, int b, int c, int n, unsigned char* smem) {
  const int tid = threadIdx.x, lane = tid & 63, w = tid >> 6;
  bfu* xcb = (bfu*)smem;
  float* xcf = (float*)(smem + 9216);
  float* af = (float*)(smem + 9216 + 17408);
  float* segH = (float*)(smem + 9216 + 2 * 17408);
  float* segA = segH + 256;
  const int tok0 = b * SEQ + c * 64;
  const int ch = n * 64 + lane;
  const int r = lane & 15, q = lane >> 4;
  bf16x8 wfa[2][4], wfx[2][4];
#pragma unroll
  for (int ks = 0; ks < 2; ++ks)
#pragma unroll
    for (int nt = 0; nt < 4; ++nt) {
      wfa[ks][nt] = *(const bf16x8*)(p.wt_a + (l * 4 + n) * 4096 + (nt * 16 + r) * 64 + ks * 32 + q * 8);
      wfx[ks][nt] = *(const bf16x8*)(p.wt_x + (l * 4 + n) * 4096 + (nt * 16 + r) * 64 + ks * 32 + q * 8);
    }
  float e_ba[4], e_bx[4], e_lam[4];
#pragma unroll
  for (int nt = 0; nt < 4; ++nt) {
    const int che = n * 64 + nt * 16 + r;
    e_ba[nt] = p.b_a[l * 256 + che]; e_bx[nt] = p.b_x[l * 256 + che]; e_lam[nt] = p.lam[l * 256 + che];
  }
  const int sidx = (b * NCH + c) * 256 + ch;
  float Hprev = 0.f;
  bfu gq[16];
  if (FINAL) {
    Hprev = p.lru_h[sidx];
    const bfu* pg0 = p.proj + (size_t)tok0 * PS + COL_CG + ch;
#pragma unroll
    for (int i = 0; i < 16; ++i) gq[i] = pg0[(size_t)(w * 16 + i) * PS];
  }
  __syncthreads();
  {
    const float cw0 = p.conv_w[(l * 4 + 0) * 256 + ch], cw1 = p.conv_w[(l * 4 + 1) * 256 + ch];
    const float cw2 = p.conv_w[(l * 4 + 2) * 256 + ch], cw3 = p.conv_w[(l * 4 + 3) * 256 + ch];
    const float cb = p.conv_b[l * 256 + ch];
    const bfu* px = p.proj + (size_t)tok0 * PS + COL_CX + ch;
#pragma unroll
    for (int i = 0; i < 16; ++i) {
      const int t = w * 16 + i;
      const int sp = c * 64 + t;
      float x0 = (sp >= 3) ? bf2f(px[(ptrdiff_t)(t - 3) * PS]) : 0.f;
      float x1 = (sp >= 2) ? bf2f(px[(ptrdiff_t)(t - 2) * PS]) : 0.f;
      float x2 = (sp >= 1) ? bf2f(px[(ptrdiff_t)(t - 1) * PS]) : 0.f;
      float x3 = bf2f(px[(ptrdiff_t)t * PS]);
      const float xc = cb + cw0 * x0 + cw1 * x1 + cw2 * x2 + cw3 * x3;
      xcf[t * 68 + lane] = xc;
      xcb[t * 72 + lane] = f2bf(xc);
    }
  }
  __syncthreads();
  f32x4 aa[4], ax[4];
#pragma unroll
  for (int i = 0; i < 4; ++i) { aa[i] = (f32x4){0.f, 0.f, 0.f, 0.f}; ax[i] = (f32x4){0.f, 0.f, 0.f, 0.f}; }
#pragma unroll
  for (int ks = 0; ks < 2; ++ks) {
    const bf16x8 afr = *(const bf16x8*)(xcb + (w * 16 + r) * 72 + ks * 32 + q * 8);
#pragma unroll
    for (int nt = 0; nt < 4; ++nt) {
      aa[nt] = __builtin_amdgcn_mfma_f32_16x16x32_bf16(afr, wfa[ks][nt], aa[nt], 0, 0, 0);
      ax[nt] = __builtin_amdgcn_mfma_f32_16x16x32_bf16(afr, wfx[ks][nt], ax[nt], 0, 0, 0);
    }
  }
#pragma unroll
  for (int nt = 0; nt < 4; ++nt) {
    const int e = nt * 16 + r;
    const float ba = e_ba[nt], bx = e_bx[nt];
    const float lsl = 8.f * logsig_acc(e_lam[nt]);
#pragma unroll
    for (int j = 0; j < 4; ++j) {
      const int t = w * 16 + q * 4 + j;
      const float rg = sigmoid_(aa[nt][j] + ba), ig = sigmoid_(ax[nt][j] + bx);
      const float la = lsl * rg;
      const float a = fexp(la);
      const float y2 = 2.f * la;
      const float em = (y2 > -0.05f) ? -y2 * (1.f + y2 * (0.5f + y2 * (0.16666667f + y2 * 0.041666668f))) : 1.f - a * a;
      const float bv = __builtin_amdgcn_sqrtf(fmaxf(em, 0.f)) * ig * xcf[t * 68 + e];
      af[t * 68 + e] = a; xcf[t * 68 + e] = bv;
    }
  }
  __syncthreads();
  float hl[16], al[16];
  float h = 0.f, ap = 1.f;
#pragma unroll
  for (int i = 0; i < 16; ++i) {
    const int t = w * 16 + i;
    const float a = af[t * 68 + lane], bv = xcf[t * 68 + lane];
    h = a * h + bv; ap *= a; hl[i] = h; al[i] = ap;
  }
  segH[w * 64 + lane] = h; segA[w * 64 + lane] = ap;
  __syncthreads();
  if (!FINAL) {
    if (w == 0) {
      float H = 0.f, Ap = 1.f;
#pragma unroll
      for (int s = 0; s < 4; ++s) { H = segA[s * 64 + lane] * H + segH[s * 64 + lane]; Ap *= segA[s * 64 + lane]; }
      p.lru_h[sidx] = H; p.lru_a[sidx] = Ap;
    }
  } else {
    float H = Hprev;
#pragma unroll
    for (int s = 0; s < 4; ++s) if (s < w) H = segA[s * 64 + lane] * H + segH[s * 64 + lane];
    bfu* pm = p.mixed + (size_t)tok0 * 1024 + 512 + ch;
#pragma unroll
    for (int i = 0; i < 16; ++i) {
      const int t = w * 16 + i;
      const float hv = hl[i] + al[i] * H;
      pm[(size_t)t * 1024] = f2bf(hv * silu_(bf2f(gq[i])));
    }
  }
}

template <bool FINAL>
DI void s5_item(const Params& p, int l, int b, int c, int g4, unsigned char* smem) {
  const int tid = threadIdx.x, lane = tid & 63, w = tid >> 6;
  const int g = g4 * 4 + w;
  float* buw = (float*)(smem + w * 13312);
  bfu* stw = (bfu*)(smem + w * 13312 + 8448);
  const int tok0 = b * SEQ + c * 64;
  const int r = lane & 15, q = lane >> 4;
  const int lg = l * 16 + g;
  bf16x8 bfr[8], yfr[4];
#pragma unroll
  for (int nt = 0; nt < 8; ++nt) bfr[nt] = *(const bf16x8*)(p.bt_bu + ((size_t)lg * 128 + nt * 16 + r) * 32 + q * 8);
  if (FINAL) {
#pragma unroll
    for (int ks = 0; ks < 4; ++ks) yfr[ks] = *(const bf16x8*)(p.bt_y + ((size_t)lg * 16 + r) * 128 + ks * 32 + q * 8);
  }
  const float ar = p.abar[(lg * 64 + lane) * 2], ai = p.abar[(lg * 64 + lane) * 2 + 1];
  const size_t sbase = ((size_t)(b * NCH + c) * 16 + g) * 128;
  float xr = 0.f, xi = 0.f;
  if (FINAL) { xr = p.s5_state[sbase + lane]; xi = p.s5_state[sbase + 64 + lane]; }
  const float dsk = FINAL ? p.s5_d[l * 256 + g * 16 + r] : 0.f;
  bf16x8 afr[4];
  bfu uq[4][4];
#pragma unroll
  for (int mt = 0; mt < 4; ++mt) {
    afr[mt] = (bf16x8){0, 0, 0, 0, 0, 0, 0, 0};
    if (q < 2) afr[mt] = *(const bf16x8*)(p.proj + (size_t)(tok0 + mt * 16 + r) * PS + COL_DU + g * 16 + q * 8);
    if (FINAL) {
#pragma unroll
      for (int j = 0; j < 4; ++j) uq[mt][j] = p.proj[(size_t)(tok0 + mt * 16 + q * 4 + j) * PS + COL_DU + g * 16 + r];
    }
  }
  __syncthreads();
#pragma unroll
  for (int mt = 0; mt < 4; ++mt) {
    const bf16x8 a = afr[mt];
#pragma unroll
    for (int nt = 0; nt < 8; ++nt) {
      f32x4 acc = (f32x4){0.f, 0.f, 0.f, 0.f};
      acc = __builtin_amdgcn_mfma_f32_16x16x32_bf16(a, bfr[nt], acc, 0, 0, 0);
#pragma unroll
      for (int j = 0; j < 4; ++j) buw[(q * 4 + j) * 132 + nt * 16 + r] = acc[j];
    }
    wave_sync();
    {
      float br[16], bi[16];
#pragma unroll
      for (int tt = 0; tt < 16; ++tt) { br[tt] = buw[tt * 132 + lane]; bi[tt] = buw[tt * 132 + 64 + lane]; }
#pragma unroll
      for (int tt = 0; tt < 16; ++tt) {
        const float nr = ar * xr - ai * xi + br[tt];
        const float ni = ar * xi + ai * xr + bi[tt];
        xr = nr; xi = ni;
        br[tt] = xr; bi[tt] = xi;
      }
      if (FINAL) {
#pragma unroll
        for (int tt = 0; tt < 16; ++tt) { stw[tt * 136 + lane] = f2bf(br[tt]); stw[tt * 136 + 64 + lane] = f2bf(bi[tt]); }
      }
    }
    wave_sync();
    if (FINAL) {
      f32x4 y = (f32x4){0.f, 0.f, 0.f, 0.f};
#pragma unroll
      for (int ks = 0; ks < 4; ++ks) {
        bf16x8 a2 = *(const bf16x8*)(stw + r * 136 + ks * 32 + q * 8);
        y = __builtin_amdgcn_mfma_f32_16x16x32_bf16(a2, yfr[ks], y, 0, 0, 0);
      }
#pragma unroll
      for (int j = 0; j < 4; ++j) {
        const int t = mt * 16 + q * 4 + j;
        const float z = gelu_tanh_(y[j] + dsk * bf2f(uq[mt][j]));
        p.zbuf[(size_t)(tok0 + t) * 256 + g * 16 + r] = f2bf(z);
      }
      wave_sync();
    }
  }
  if (!FINAL) { p.s5_state[sbase + lane] = xr; p.s5_state[sbase + 64 + lane] = xi; }
}

DI void s5_glu(const Params& p, int l, int b, int c, unsigned char* smem) {
  const int tid = threadIdx.x, lane = tid & 63, w = tid >> 6;
  bfu* zs = (bfu*)smem;
  const int tok0 = b * SEQ + c * 64;
  const int r = lane & 15, q = lane >> 4;
  __syncthreads();
#pragma unroll
  for (int i = 0; i < 8; ++i) {
    const int id = tid + i * 256;
    *(uint4*)(zs + (id >> 5) * 264 + (id & 31) * 8) = *(const uint4*)(p.zbuf + (size_t)(tok0 + (id >> 5)) * 256 + (id & 31) * 8);
  }
  __syncthreads();
  const bfu* wg = p.wt_glu + l * 65536;
#pragma unroll 1
  for (int nc = 0; nc < 4; ++nc) {
    bfu gq[4][4]; float bgv[4];
#pragma unroll
    for (int nt = 0; nt < 4; ++nt) {
      bgv[nt] = p.b_glu[l * 256 + nc * 64 + nt * 16 + r];
#pragma unroll
      for (int j = 0; j < 4; ++j) gq[nt][j] = p.proj[(size_t)(tok0 + w * 16 + q * 4 + j) * PS + COL_DG + nc * 64 + nt * 16 + r];
    }
    f32x4 acc[4];
#pragma unroll
    for (int i = 0; i < 4; ++i) acc[i] = (f32x4){0.f, 0.f, 0.f, 0.f};
#pragma unroll
    for (int kh = 0; kh < 2; ++kh) {
      bf16x8 bq[4][4];
#pragma unroll
      for (int ks = 0; ks < 4; ++ks)
#pragma unroll
        for (int nt = 0; nt < 4; ++nt) bq[ks][nt] = *(const bf16x8*)(wg + (nc * 64 + nt * 16 + r) * 256 + kh * 128 + ks * 32 + q * 8);
#pragma unroll
      for (int ks = 0; ks < 4; ++ks) {
        const bf16x8 a = *(const bf16x8*)(zs + (w * 16 + r) * 264 + kh * 128 + ks * 32 + q * 8);
#pragma unroll
        for (int nt = 0; nt < 4; ++nt) acc[nt] = __builtin_amdgcn_mfma_f32_16x16x32_bf16(a, bq[ks][nt], acc[nt], 0, 0, 0);
      }
    }
#pragma unroll
    for (int nt = 0; nt < 4; ++nt) {
      const int n = nc * 64 + nt * 16 + r;
#pragma unroll
      for (int j = 0; j < 4; ++j) {
        const int t = w * 16 + q * 4 + j;
        const float zv = bf2f(zs[t * 264 + n]);
        const float gate = silu_(bf2f(gq[nt][j]));
        p.mixed[(size_t)(tok0 + t) * 1024 + 768 + n] = f2bf(zv * sigmoid_(acc[nt][j] + bgv[nt]) * gate);
      }
    }
  }
}

#define QLOOP(QI, N, BODY)                                                                            \
  {                                                                                                   \
    unsigned* q_ctr = p.cnt + CNT_Q + (l * 8 + (QI)) * 32;                                            \
    unsigned q_nxt = blockIdx.x;                                                                      \
    for (;;) {                                                                                        \
      __syncthreads();                                                                                \
      if (threadIdx.x == 0) *s_q = q_nxt;                                                             \
      __syncthreads();                                                                                \
      const int item = (int)*s_q;                                                                     \
      if (item >= (N)) break;                                                                         \
      if (threadIdx.x == 0) q_nxt = gridDim.x + __hip_atomic_fetch_add(q_ctr, 1u, __ATOMIC_RELAXED, __HIP_MEMORY_SCOPE_AGENT); \
      BODY;                                                                                           \
    }                                                                                                 \
  }

DI void phase2(const Params& p, int l, unsigned char* smem) {
  unsigned* s_q = (unsigned*)(smem + SMEM_BYTES - 32);
  QLOOP(0, 1024, s5_item<false>(p, l, item >> 7, (item >> 2) & 31, item & 3, smem))
  QLOOP(1, 1024, hg_local(p, l, item >> 7, (item >> 2) & 31, item & 3, smem))
  QLOOP(2, 1024, ml_local(p, l, item >> 7, (item >> 2) & 31, item & 3, smem))
  QLOOP(3, 1024, lru_item<false>(p, l, item >> 7, (item >> 2) & 31, item & 3, smem))
}

DI void phase3(const Params& p, int l) {
  const int gtid = blockIdx.x * 256 + threadIdx.x, gsz = gridDim.x * 256;
  constexpr int N1 = 131072, N2 = 131072, N3 = 2048, N4 = 2048, N5 = 8192;
  for (int i = gtid; i < N1 + N2 + N3 + N4 + N5; i += gsz) {
    if (i < N1 + N2) {
      const bool ml = i >= N1;
      const int j = ml ? i - N1 : i;
      const int b = j >> 14, rem = j & 16383, hd = rem >> 12, ed = rem & 4095, d = ed & 63;
      float* stp = (ml ? p.ml_state : p.hg_state) + (size_t)(b * NCH * 4 + hd) * 4096 + ed;
      const float* dcp = ml ? (p.ml_decay + b * NCH * 4 + hd) : (p.hg_decay + (b * NCH * 4 + hd) * 64 + d);
      const int dstride = ml ? 4 : 256;
      float S = 0.f;
#pragma unroll
      for (int c0 = 0; c0 < NCH; c0 += 16) {
        float loc[16], dec[16];
#pragma unroll
        for (int c = 0; c < 16; ++c) { loc[c] = stp[(size_t)(c0 + c) * 16384]; dec[c] = dcp[(c0 + c) * dstride]; }
#pragma unroll
        for (int c = 0; c < 16; ++c) { stp[(size_t)(c0 + c) * 16384] = S; S = dec[c] * S + loc[c]; }
      }
    } else if (i < N1 + N2 + N3) {
      const int j = i - N1 - N2, b = j >> 8, rem = j & 255, hd = rem >> 6, d = rem & 63;
      float S = 0.f;
#pragma unroll
      for (int c0 = 0; c0 < NCH; c0 += 16) {
        float loc[16], dec[16];
#pragma unroll
        for (int c = 0; c < 16; ++c) { const int base = (b * NCH + c0 + c) * 4 + hd; dec[c] = p.ml_decay[base]; loc[c] = p.ml_n[base * 64 + d]; }
#pragma unroll
        for (int c = 0; c < 16; ++c) { const int base = (b * NCH + c0 + c) * 4 + hd; p.ml_n[base * 64 + d] = S; S = dec[c] * S + loc[c]; }
      }
    } else if (i < N1 + N2 + N3 + N4) {
      const int j = i - N1 - N2 - N3, b = j >> 8, ch = j & 255;
      float H = 0.f;
#pragma unroll
      for (int c0 = 0; c0 < NCH; c0 += 16) {
        float av[16], hv[16];
#pragma unroll
        for (int c = 0; c < 16; ++c) { const int idx = (b * NCH + c0 + c) * 256 + ch; av[c] = p.lru_a[idx]; hv[c] = p.lru_h[idx]; }
#pragma unroll
        for (int c = 0; c < 16; ++c) { const int idx = (b * NCH + c0 + c) * 256 + ch; p.lru_h[idx] = H; H = av[c] * H + hv[c]; }
      }
    } else {
      const int j = i - N1 - N2 - N3 - N4, b = j >> 10, g = (j >> 6) & 15, pp = j & 63;
      const float ar = p.abar64[((l * 16 + g) * 64 + pp) * 2], ai = p.abar64[((l * 16 + g) * 64 + pp) * 2 + 1];
      float xr = 0.f, xi = 0.f;
#pragma unroll
      for (int c0 = 0; c0 < NCH; c0 += 16) {
        float lr[16], li[16];
#pragma unroll
        for (int c = 0; c < 16; ++c) { const size_t sb = ((size_t)(b * NCH + c0 + c) * 16 + g) * 128; lr[c] = p.s5_state[sb + pp]; li[c] = p.s5_state[sb + 64 + pp]; }
#pragma unroll
        for (int c = 0; c < 16; ++c) {
          const size_t sb = ((size_t)(b * NCH + c0 + c) * 16 + g) * 128;
          p.s5_state[sb + pp] = xr; p.s5_state[sb + 64 + pp] = xi;
          const float nr = ar * xr - ai * xi + lr[c], ni = ar * xi + ai * xr + li[c];
          xr = nr; xi = ni;
        }
      }
    }
  }
}

DI void phase4(const Params& p, int l, unsigned char* smem, unsigned long long& tp_acc) {
  unsigned* s_flag = (unsigned*)(smem + SMEM_BYTES - 16);
  unsigned* s_q = (unsigned*)(smem + SMEM_BYTES - 32);
  TPS(41)
  QLOOP(4, 256, {
    _Pragma("unroll 1") for (int g4 = 0; g4 < 4; ++g4) s5_item<true>(p, l, item >> 5, item & 31, g4, smem);
    asm volatile("s_waitcnt vmcnt(0)" ::: "memory");
    s5_glu(p, l, item >> 5, item & 31, smem);
  })
  TPE(41)
  TPS(42)
  QLOOP(5, 1024, hg_out(p, l, item >> 7, (item >> 2) & 31, item & 3, smem))
  TPE(42)
  TPS(43)
  QLOOP(6, 1024, ml_out(p, l, item >> 7, (item >> 2) & 31, item & 3, smem))
  TPE(43)
  TPS(44)
  QLOOP(7, 1024, lru_item<true>(p, l, item >> 7, (item >> 2) & 31, item & 3, smem))
  TPE(44)
}

#ifdef TPROBE
#define TP_CLASS(PH) ((PH) == 0 ? 0 : (((PH) - 1) % 6) + 1)
#define TP_BEGIN(PH) unsigned long long tp_t0 = 0; if (TP_CLASS(PH) == TPROBE) tp_t0 = __builtin_amdgcn_s_memrealtime();
#define TP_END(PH) if (TP_CLASS(PH) == TPROBE) tp_acc += __builtin_amdgcn_s_memrealtime() - tp_t0;
#else
#define TP_BEGIN(PH)
#define TP_END(PH)
#endif
#define RUN_PHASE(PH, CALL)                                       \
  if (ph0 <= (PH) && (PH) < ph1) {                                \
    TP_BEGIN(PH)                                                  \
    CALL;                                                         \
    if (COOP) { if ((PH) + 1 < ph1) xcd_barrier(xb); }            \
    TP_END(PH)                                                    \
  }

template <bool COOP, int L>
DI void run_layer(const Params& p, int ph0, int ph1, unsigned char* smem, const XcdBarrier& xb, unsigned long long& tp_acc) {
#ifdef DUP1
  RUN_PHASE(1 + 6 * L, phase1(p, L, smem))
#endif
  RUN_PHASE(1 + 6 * L, phase1(p, L, smem))
#ifdef DUP2
  RUN_PHASE(2 + 6 * L, phase2(p, L, smem))
#endif
  RUN_PHASE(2 + 6 * L, phase2(p, L, smem))
  RUN_PHASE(3 + 6 * L, { phase3(p, L); if (L + 1 < DEPTH) convert_weights<(L + 1 < DEPTH ? L + 1 : 0)>(p, smem); })
#ifdef DUP4
  RUN_PHASE(4 + 6 * L, phase4(p, L, smem, tp_acc))
#endif
  RUN_PHASE(4 + 6 * L, phase4(p, L, smem, tp_acc))
  RUN_PHASE(5 + 6 * L, phase5(p, L, smem, tp_acc))
  RUN_PHASE(6 + 6 * L, phase6(p, L))
}

template <bool COOP>
__global__ void __launch_bounds__(256, 2) mk_fwd(Params p, int ph0, int ph1) {
  __shared__ __attribute__((aligned(16))) unsigned char smem[SMEM_BYTES];
  __shared__ uint4 xb_words;
  XcdBarrier xb; xb.bar = p.bar; xb.x = 0; xb.st = nullptr;
  if (COOP) {
    if (ph1 < 0) cg::this_grid().sync();
    if (threadIdx.x == 0) xb_words = make_uint4(0u, 0u, 0u, 0u);
    __syncthreads();
    xb = xcd_barrier_post(p.bar, (volatile LAS unsigned*)&xb_words);
  }
  unsigned long long tp_acc = 0;
  RUN_PHASE(0, phase0(p, smem))
  run_layer<COOP, 0>(p, ph0, ph1, smem, xb, tp_acc);
  run_layer<COOP, 1>(p, ph0, ph1, smem, xb, tp_acc);
  run_layer<COOP, 2>(p, ph0, ph1, smem, xb, tp_acc);
  run_layer<COOP, 3>(p, ph0, ph1, smem, xb, tp_acc);
#ifdef TPROBE
  if (blockIdx.x == 0 && threadIdx.x == 0) {
    const unsigned long long t0 = __builtin_amdgcn_s_memrealtime();
    while (__builtin_amdgcn_s_memrealtime() - t0 < tp_acc) __builtin_amdgcn_s_sleep(8);
  }
#endif
}

extern "C" void kernel_launch(void* const* d_in, const int* in_sizes, int n_in, void* d_out, int out_size, void* d_ws,
                              size_t ws_size, hipStream_t stream) {
  static int grid_blocks = 0;
  if (!grid_blocks) {
    int dev = 0, cus = 0, per_cu = 0;
    hipGetDevice(&dev);
    hipDeviceGetAttribute(&cus, hipDeviceAttributeMultiprocessorCount, dev);
    hipOccupancyMaxActiveBlocksPerMultiprocessor(&per_cu, mk_fwd<(MEGA != 0)>, 256, 0);
    if (per_cu < 1) per_cu = 1;
    if (per_cu > 2) per_cu = 2;
    grid_blocks = cus * per_cu;
  }
  Params p{};
  const float** pin = (const float**)&p;
  for (int i = 0; i < 28; ++i) pin[i] = (const float*)d_in[i];
  p.out = (float*)d_out;
  unsigned char* ws = (unsigned char*)d_ws;
  size_t off = 0;
  auto take = [&](size_t bytes) { unsigned char* r = ws + off; off += (bytes + 255) & ~(size_t)255; return r; };
  p.wt_in = (bfu*)take((size_t)4 * PS * 1024 * 2);
  p.wt_out = (bfu*)take((size_t)4 * 1024 * 1024 * 2);
  p.wt_a = (bfu*)take(16 * 4096 * 2);
  p.wt_x = (bfu*)take(16 * 4096 * 2);
  p.wt_glu = (bfu*)take(4 * 65536 * 2);
  p.bt_bu = (bfu*)take(64 * 128 * 32 * 2);
  p.bt_y = (bfu*)take(64 * 16 * 128 * 2);
  p.hb = (bfu*)take((size_t)NTOK * 1024 * 2);
  p.proj = (bfu*)take((size_t)NTOK * PS * 2);
  p.mixed = (bfu*)take((size_t)NTOK * 1024 * 2);
  p.zbuf = (bfu*)take((size_t)NTOK * 256 * 2);
  p.abar = (float*)take(4096 * 2 * 4);
  p.abar64 = (float*)take(4096 * 2 * 4);
  p.lbs = (float*)take(1024 * 4);
  p.hg_state = (float*)take((size_t)BATCH * NCH * 4 * 4096 * 4);
  p.hg_decay = (float*)take((size_t)BATCH * NCH * 4 * 64 * 4);
  p.ml_state = (float*)take((size_t)BATCH * NCH * 4 * 4096 * 4);
  p.ml_n = (float*)take((size_t)BATCH * NCH * 4 * 64 * 4);
  p.ml_decay = (float*)take((size_t)BATCH * NCH * 4 * 4);
  p.lru_h = (float*)take((size_t)BATCH * NCH * 256 * 4);
  p.lru_a = (float*)take((size_t)BATCH * NCH * 256 * 4);
  p.s5_state = (float*)take((size_t)BATCH * NCH * 16 * 128 * 4);
  p.cnt = (unsigned*)take(CNT_TOTAL * 4);
  p.bar = (unsigned*)take(XCD_BAR_WORDS * 4);
  if (off > ws_size) { fprintf(stderr, "workspace too small: need %zu have %zu\n", off, ws_size); return; }
  const int NPH = 1 + 6 * DEPTH;
#if MEGA
  (void)hipMemsetAsync(p.bar, 0, XCD_BAR_WORDS * 4, stream);
  int ph0 = 0, ph1 = NPH;
  void* args[] = {&p, &ph0, &ph1};
  hipError_t e = hipLaunchCooperativeKernel((void*)mk_fwd<true>, dim3(grid_blocks), dim3(256), args, 0, stream);
  if (e != hipSuccess) fprintf(stderr, "cooperative launch failed: %s (grid %d)\n", hipGetErrorString(e), grid_blocks);
#else
  for (int ph = 0; ph < NPH; ++ph) hipLaunchKernelGGL(mk_fwd<false>, dim3(grid_blocks), dim3(256), 0, stream, p, ph, ph + 1);
#endif
}
```

```cpp
#include <hip/hip_runtime.h>
#include <hip/hip_cooperative_groups.h>
#include <stdint.h>
#include <stdio.h>
namespace cg = cooperative_groups;

#ifndef MEGA
#define MEGA 1
#endif

typedef unsigned short bfu;
using bf16x8 = __attribute__((ext_vector_type(8))) short;
using f32x4  = __attribute__((ext_vector_type(4))) float;
#define DI __device__ __forceinline__

constexpr int BATCH = 8, SEQ = 2048, DM = 1024, DEPTH = 4, NTOK = BATCH * SEQ, NCH = SEQ / 64;
constexpr int DIN = 3080, PS = 3200;
constexpr int COL_AQ = 0, COL_AF = 256, COL_AI = 512, COL_AG = 768;
constexpr int COL_BQ = 1024, COL_BK = 1280, COL_BV = 1536, COL_BG = 1792, COL_BIG = 3072, COL_BFG = 3076;
constexpr int COL_CX = 2048, COL_CG = 2304, COL_DU = 2560, COL_DG = 2816;
constexpr float DN_ALPHA = 1.681792830507429f;
constexpr int SMEM_BYTES = 56 * 1024;
constexpr int CNT_LN = 0, CNT_GLU = 4 * 128, CNT_Q = 4 * 128 + 4 * 256, CNT_TOTAL = CNT_Q + 32 * 32;

struct Params {
  const float *x, *w_in, *b_in, *lb_logits, *hg_g, *ml_fb, *ml_g, *conv_w, *conv_b, *w_a, *b_a, *w_x, *b_x, *lam,
      *a_re, *a_im, *log_dt, *sb_re, *sb_im, *c_re, *c_im, *s5_d, *w_glu, *b_glu, *w_out, *b_out, *ln_g, *ln_b;
  float* out;
  bfu *wt_in, *wt_out, *wt_a, *wt_x, *wt_glu, *bt_bu, *bt_y, *hb, *proj, *mixed, *zbuf;
  float *abar, *abar64, *lbs, *hg_state, *hg_decay, *ml_state, *ml_n, *ml_decay, *lru_h, *lru_a, *s5_state;
  unsigned* cnt;
  unsigned* bar;
};

DI bfu f2bf(float x) { return __builtin_bit_cast(unsigned short, (__bf16)x); }
DI float bf2f(bfu h) { return __uint_as_float(((unsigned)h) << 16); }
typedef __bf16 bf16v2 __attribute__((ext_vector_type(2)));
typedef float f32v2 __attribute__((ext_vector_type(2)));
DI unsigned pack2(float a, float b) { f32v2 v = {a, b}; return __builtin_bit_cast(unsigned, __builtin_convertvector(v, bf16v2)); }
DI float fexp(float x) { return __expf(x); }
DI float frcp(float x) { return __builtin_amdgcn_rcpf(x); }
DI float flog(float x) { return __logf(x); }
DI float sigmoid_(float x) { return frcp(1.f + fexp(-x)); }
DI float silu_(float x) { return x * frcp(1.f + fexp(-x)); }
DI float logsig_(float x) { return fminf(x, 0.f) - flog(1.f + fexp(-fabsf(x))); }
DI float logsig_acc(float x) { return fminf(x, 0.f) - log1pf(expf(-fabsf(x))); }
DI float gelu_tanh_(float x) {
  float u = 0.7978845608028654f * (x + 0.044715f * x * x * x);
  float th = 1.f - 2.f * frcp(fexp(2.f * u) + 1.f);
  return 0.5f * x * (1.f + th);
}

template <int NT, int KS>
DI void wave_mma(f32x4 (&acc)[NT], const bfu* A, int lda, const bfu* Bt, int ldb, int lane) {
  const int r = lane & 15, q = lane >> 4;
#pragma unroll
  for (int ks = 0; ks < KS; ++ks) {
    bf16x8 a = *(const bf16x8*)(A + r * lda + ks * 32 + q * 8);
#pragma unroll
    for (int nt = 0; nt < NT; ++nt) {
      bf16x8 b = *(const bf16x8*)(Bt + (nt * 16 + r) * ldb + ks * 32 + q * 8);
      acc[nt] = __builtin_amdgcn_mfma_f32_16x16x32_bf16(a, b, acc[nt], 0, 0, 0);
    }
  }
}

DI void wave_sync() { __builtin_amdgcn_fence(__ATOMIC_SEQ_CST, "wavefront"); __builtin_amdgcn_wave_barrier(); __builtin_amdgcn_fence(__ATOMIC_SEQ_CST, "wavefront"); }
DI float group16_sum(float v) {
  v += __shfl_xor(v, 1); v += __shfl_xor(v, 2); v += __shfl_xor(v, 4); v += __shfl_xor(v, 8);
  return v;
}
DI float wave_sum(float v) {
  v += __shfl_xor(v, 1); v += __shfl_xor(v, 2); v += __shfl_xor(v, 4); v += __shfl_xor(v, 8);
  v += __shfl_xor(v, 16); v += __shfl_xor(v, 32);
  return v;
}

DI bool last_arriver(unsigned* ctr, unsigned total, unsigned* s_flag) {
  asm volatile("s_waitcnt vmcnt(0)" ::: "memory");
  __syncthreads();
  if (threadIdx.x == 0) {
    __builtin_amdgcn_fence(__ATOMIC_RELEASE, "agent");
    asm volatile("s_waitcnt vmcnt(0)" ::: "memory");
    const unsigned old = __hip_atomic_fetch_add(ctr, 1u, __ATOMIC_RELAXED, __HIP_MEMORY_SCOPE_AGENT);
    const unsigned last = (old == total - 1u) ? 1u : 0u;
    if (last) { __builtin_amdgcn_fence(__ATOMIC_ACQUIRE, "agent"); asm volatile("s_waitcnt vmcnt(0)" ::: "memory"); }
    *s_flag = last;
  }
  __syncthreads();
  return (*s_flag != 0u);
}

#ifdef TPROBE
#define TPS(ID) unsigned long long tps_##ID = 0; if (TPROBE == (ID)) tps_##ID = __builtin_amdgcn_s_memrealtime();
#define TPE(ID) if (TPROBE == (ID)) tp_acc += __builtin_amdgcn_s_memrealtime() - tps_##ID;
#else
#define TPS(ID)
#define TPE(ID)
#endif

#define XB_TMO      128
#define XB_XCNT(j)  (256  + 64 * (j))
#define XB_XSUB(j)  (1280 + 64 * (j))
#define XB_XGEN(j)  (2304 + 64 * (j))
#define XB_TOP      3328
#define XB_TOPGEN   3392
#define XCD_BAR_WORDS 3456
#define XB_SPIN_CAP (1u << 22)
#define LAS __attribute__((address_space(3)))
DI unsigned xb_ld(unsigned* p) { return __hip_atomic_load(p, __ATOMIC_RELAXED, __HIP_MEMORY_SCOPE_AGENT); }
DI unsigned xb_add(unsigned* p, unsigned v) { return __hip_atomic_fetch_add(p, v, __ATOMIC_RELAXED, __HIP_MEMORY_SCOPE_AGENT); }
DI unsigned xb_xcc_id() { return (unsigned)__builtin_amdgcn_s_getreg((3 << 11) | 20) & 0xFu; }
#define XB_SPIN(cond, bar) do { unsigned _sp = 0; while (cond) { __builtin_amdgcn_s_sleep(1); \
    if ((++_sp & 255u) == 0u) { if (xb_ld(&(bar)[XB_TMO])) break; if (_sp > XB_SPIN_CAP) { atomicAdd(&(bar)[XB_TMO], 1u); break; } } } } while (0)
struct XcdBarrier { unsigned* bar; unsigned x; volatile LAS unsigned* st; };
DI XcdBarrier xcd_barrier_post(unsigned* bar, volatile LAS unsigned* st) {
  XcdBarrier b; b.bar = bar; b.x = xb_xcc_id(); b.st = st;
  if (threadIdx.x == 0) (void)xb_add(&bar[XB_XCNT(b.x)], 1u);
  return b;
}
DI void xcd_barrier_complete(unsigned* bar, unsigned x, unsigned& nloc, unsigned& nx) {
  const unsigned G = gridDim.x * gridDim.y * gridDim.z;
  unsigned sum, cnt, mine, sp = 0u;
  for (;;) {
    sum = 0u; cnt = 0u; mine = 0u;
#pragma unroll
    for (unsigned j = 0; j < 16; ++j) { const unsigned c = xb_ld(&bar[XB_XCNT(j)]); sum += c; cnt += (c > 0u) ? 1u : 0u; mine = (j == x) ? c : mine; }
    if (sum == G) break;
    __builtin_amdgcn_s_sleep(1);
    if ((++sp & 255u) == 0u) { if (xb_ld(&bar[XB_TMO])) break; if (sp > XB_SPIN_CAP) { atomicAdd(&bar[XB_TMO], 1u); break; } }
  }
  nloc = mine > 0u ? mine : 1u; nx = cnt > 0u ? cnt : 1u;
}
DI void xcd_barrier(const XcdBarrier& b) {
  asm volatile("s_waitcnt vmcnt(0)" ::: "memory");
  __syncthreads();
  if (threadIdx.x == 0) {
    unsigned* bar = b.bar;
    __builtin_amdgcn_s_waitcnt(0);
    unsigned nloc = b.st[0], nx = b.st[1];
    if (nloc == 0u) { xcd_barrier_complete(bar, b.x, nloc, nx); b.st[0] = nloc; b.st[1] = nx; }
    const unsigned old = xb_add(&bar[XB_XSUB(b.x)], 1u);
    const unsigned gen = old / nloc;
    if (old + 1u == (gen + 1u) * nloc) {
      __builtin_amdgcn_fence(__ATOMIC_RELEASE, "agent");
      asm volatile("s_waitcnt vmcnt(0)" ::: "memory");
      const unsigned og = xb_add(&bar[XB_TOP], 1u);
      const unsigned tg = og / nx;
      if (og + 1u == (tg + 1u) * nx) xb_add(&bar[XB_TOPGEN], 1u);
      else XB_SPIN(xb_ld(&bar[XB_TOPGEN]) == tg, bar);
      __builtin_amdgcn_fence(__ATOMIC_ACQUIRE, "agent");
      xb_add(&bar[XB_XGEN(b.x)], 1u);
      asm volatile("s_waitcnt vmcnt(0)" ::: "memory");
    } else {
      XB_SPIN(xb_ld(&bar[XB_XGEN(b.x)]) == gen, bar);
      __builtin_amdgcn_fence(__ATOMIC_ACQUIRE, "agent");
      asm volatile("s_waitcnt vmcnt(0)" ::: "memory");
    }
  }
  __syncthreads();
}

DI void transpose_tile(const float* src, int sld, int cv, bfu* dst, int dld, float* tile) {
  const int tid = threadIdx.x;
  __syncthreads();
  for (int i = tid; i < 4096; i += 256) {
    int r = i >> 6, c = i & 63;
    tile[r * 65 + c] = (c < cv) ? src[(size_t)r * sld + c] : 0.f;
  }
  __syncthreads();
  for (int i = tid; i < 4096; i += 256) {
    int n = i >> 6, k = i & 63;
    dst[(size_t)n * dld + k] = f2bf(tile[k * 65 + n]);
  }
}

template <int LSEL>
DI void convert_weights(const Params& p, unsigned char* smem) {
  const int tid = threadIdx.x;
  float* tile = (float*)smem;
  const int NJ = 3200 + 1024 + 16 + 16 + 64;
  for (int job = blockIdx.x; job < NJ; job += gridDim.x) {
    const float* src; int sld, cv = 64, dld; bfu* dst;
    if (job < 3200) {
      int l = job / 800, rem = job % 800, kt = rem / 50, nt = rem % 50;
      if (l != LSEL) continue;
      const int c0 = nt < 28 ? nt * 64 : (nt < 48 ? nt * 64 + 8 : 1792);
      src = p.w_in + (size_t)l * 1024 * DIN + (size_t)kt * 64 * DIN + c0; sld = DIN;
      cv = nt < 48 ? 64 : (nt == 48 ? 8 : 0);
      dst = p.wt_in + (size_t)l * PS * 1024 + (size_t)nt * 64 * 1024 + kt * 64; dld = 1024;
    } else if (job < 4224) {
      int j = job - 3200, l = j / 256, rem = j % 256, kt = rem / 16, nt = rem % 16;
      if (l != LSEL) continue;
      src = p.w_out + (size_t)l * 1048576 + (size_t)kt * 64 * 1024 + nt * 64; sld = 1024;
      dst = p.wt_out + (size_t)l * 1048576 + (size_t)nt * 64 * 1024 + kt * 64; dld = 1024;
    } else if (LSEL != 0) {
      continue;
    } else if (job < 4240) {
      int j = job - 4224; src = p.w_a + j * 4096; sld = 64; dst = p.wt_a + j * 4096; dld = 64;
    } else if (job < 4256) {
      int j = job - 4240; src = p.w_x + j * 4096; sld = 64; dst = p.wt_x + j * 4096; dld = 64;
    } else {
      int j = job - 4256, l = j / 16, rem = j % 16, kt = rem / 4, nt = rem % 4;
      src = p.w_glu + l * 65536 + kt * 64 * 256 + nt * 64; sld = 256;
      dst = p.wt_glu + l * 65536 + nt * 64 * 256 + kt * 64; dld = 256;
    }
    transpose_tile(src, sld, cv, dst, dld, tile);
  }
}

DI void phase0(const Params& p, unsigned char* smem) {
  const int tid = threadIdx.x;
  const int gtid = blockIdx.x * 256 + tid, gsz = gridDim.x * 256;
  for (int i0 = gtid; i0 < NTOK * DM / 8; i0 += 4 * gsz) {
    float4 a[4], b[4];
#pragma unroll
    for (int u = 0; u < 4; ++u) {
      const int i = i0 + u * gsz;
      if (i < NTOK * DM / 8) { a[u] = ((const float4*)p.x)[2 * i]; b[u] = ((const float4*)p.x)[2 * i + 1]; }
    }
#pragma unroll
    for (int u = 0; u < 4; ++u) {
      const int i = i0 + u * gsz;
      if (i < NTOK * DM / 8) {
        uint4 o; o.x = pack2(a[u].x, a[u].y); o.y = pack2(a[u].z, a[u].w); o.z = pack2(b[u].x, b[u].y); o.w = pack2(b[u].z, b[u].w);
        ((uint4*)p.hb)[i] = o;
      }
    }
  }
  convert_weights<0>(p, smem);
  for (int i = (gridDim.x - 1 - blockIdx.x) * 256 + tid; i < 4096; i += gsz) {
    int lg = i >> 6, pp = i & 63;
    double dt = exp((double)p.log_dt[lg]);
    double are = p.a_re[lg * 64 + pp], aim = p.a_im[lg * 64 + pp];
    double mag = exp(dt * are), ang = dt * aim;
    double abr = mag * cos(ang), abi = mag * sin(ang);
    double den = are * are + aim * aim;
    double xr = abr - 1.0, xi = abi;
    double zr = (xr * are + xi * aim) / den, zi = (xi * are - xr * aim) / den;
    bfu* o_re = p.bt_bu + ((size_t)lg * 128 + pp) * 32;
    bfu* o_im = p.bt_bu + ((size_t)lg * 128 + 64 + pp) * 32;
    for (int h = 0; h < 16; ++h) {
      double br = p.sb_re[(lg * 64 + pp) * 16 + h], bi = p.sb_im[(lg * 64 + pp) * 16 + h];
      o_re[h] = f2bf((float)(zr * br - zi * bi));
      o_im[h] = f2bf((float)(zr * bi + zi * br));
      o_re[16 + h] = 0; o_im[16 + h] = 0;
    }
    p.abar[(lg * 64 + pp) * 2 + 0] = (float)abr; p.abar[(lg * 64 + pp) * 2 + 1] = (float)abi;
    double mag64 = exp(64.0 * dt * are), ang64 = 64.0 * ang;
    p.abar64[(lg * 64 + pp) * 2 + 0] = (float)(mag64 * cos(ang64));
    p.abar64[(lg * 64 + pp) * 2 + 1] = (float)(mag64 * sin(ang64));
  }
  for (int i = gtid; i < 4 * 16 * 16 * 128; i += gsz) {
    int k = i & 127, lgn = i >> 7;
    p.bt_y[i] = (k < 64) ? f2bf(p.c_re[lgn * 64 + k]) : f2bf(-p.c_im[lgn * 64 + (k - 64)]);
  }
  for (int i = gtid; i < 256; i += gsz) {
    float v0 = p.lb_logits[i], v1 = p.lb_logits[256 + i], v2 = p.lb_logits[512 + i], v3 = p.lb_logits[768 + i];
    float m = fmaxf(fmaxf(v0, v1), fmaxf(v2, v3));
    float e0 = expf(v0 - m), e1 = expf(v1 - m), e2 = expf(v2 - m), e3 = expf(v3 - m);
    float s = e0 + e1 + e2 + e3;
    p.lbs[i] = 0.f; p.lbs[256 + i] = e1 / s; p.lbs[512 + i] = (e1 + e2) / s; p.lbs[768 + i] = (e1 + e2 + e3) / s;
  }
  for (int i = gtid; i < CNT_TOTAL; i += gsz) p.cnt[i] = 0u;
}

DI void gemm1_tile(const Params& p, int l, const bfu* A, const bfu* Bt, int m0, int n0, unsigned char* smem,
                   uint4& ra0, uint4& ra1, uint4& ra2, uint4& ra3, uint4& rb0, uint4& rb1, uint4& rb2, uint4& rb3, uint4& rb4, uint4& rb5, bool pre, long dA, long dB) {
  bfu* sA = (bfu*)smem; bfu* sB = sA + 128 * 72;
  bfu* sC = (bfu*)smem;
  const int tid = threadIdx.x, lane = tid & 63, w = tid >> 6, wm = w >> 1, wn = w & 1;
  const int r = lane & 15, q = lane >> 4;
  f32x4 acc[4][6];
#pragma unroll
  for (int i = 0; i < 4; ++i)
#pragma unroll
    for (int j = 0; j < 6; ++j) acc[i][j] = (f32x4){0.f, 0.f, 0.f, 0.f};
  const int lrow = tid >> 3, lkc = tid & 7;
  const bfu* ga = A + (size_t)(m0 + lrow) * 1024 + lkc * 8;
  const bfu* gb = Bt + (size_t)(n0 + lrow) * 1024 + lkc * 8;
  if (!pre) {
    ra0 = *(const uint4*)(ga); ra1 = *(const uint4*)(ga + 32 * 1024); ra2 = *(const uint4*)(ga + 64 * 1024); ra3 = *(const uint4*)(ga + 96 * 1024);
    rb0 = *(const uint4*)(gb); rb1 = *(const uint4*)(gb + 32 * 1024); rb2 = *(const uint4*)(gb + 64 * 1024); rb3 = *(const uint4*)(gb + 96 * 1024);
    rb4 = *(const uint4*)(gb + 128 * 1024); rb5 = *(const uint4*)(gb + 160 * 1024);
  }
  bfu* wa = sA + lrow * 72 + lkc * 8;
  bfu* wb = sB + lrow * 72 + lkc * 8;
  for (int kt = 0; kt < 16; ++kt) {
    __syncthreads();
    *(uint4*)(wa) = ra0; *(uint4*)(wa + 32 * 72) = ra1; *(uint4*)(wa + 64 * 72) = ra2; *(uint4*)(wa + 96 * 72) = ra3;
    *(uint4*)(wb) = rb0; *(uint4*)(wb + 32 * 72) = rb1; *(uint4*)(wb + 64 * 72) = rb2; *(uint4*)(wb + 96 * 72) = rb3;
    *(uint4*)(wb + 128 * 72) = rb4; *(uint4*)(wb + 160 * 72) = rb5;
    __syncthreads();
    {
      const long oa = (kt + 1 < 16) ? (long)(kt + 1) * 64 : dA, ob = (kt + 1 < 16) ? (long)(kt + 1) * 64 : dB;
      const bfu* ga2 = ga + oa; const bfu* gb2 = gb + ob;
      ra0 = *(const uint4*)(ga2); ra1 = *(const uint4*)(ga2 + 32 * 1024); ra2 = *(const uint4*)(ga2 + 64 * 1024); ra3 = *(const uint4*)(ga2 + 96 * 1024);
      rb0 = *(const uint4*)(gb2); rb1 = *(const uint4*)(gb2 + 32 * 1024); rb2 = *(const uint4*)(gb2 + 64 * 1024); rb3 = *(const uint4*)(gb2 + 96 * 1024);
      rb4 = *(const uint4*)(gb2 + 128 * 1024); rb5 = *(const uint4*)(gb2 + 160 * 1024);
    }
#pragma unroll
    for (int ks = 0; ks < 2; ++ks) {
      bf16x8 af[4], bfr[6];
#pragma unroll
      for (int mt = 0; mt < 4; ++mt) af[mt] = *(const bf16x8*)(sA + (wm * 64 + mt * 16 + r) * 72 + ks * 32 + q * 8);
#pragma unroll
      for (int nt = 0; nt < 6; ++nt) bfr[nt] = *(const bf16x8*)(sB + (wn * 96 + nt * 16 + r) * 72 + ks * 32 + q * 8);
#pragma unroll
      for (int mt = 0; mt < 4; ++mt)
#pragma unroll
        for (int nt = 0; nt < 6; ++nt) acc[mt][nt] = __builtin_amdgcn_mfma_f32_16x16x32_bf16(af[mt], bfr[nt], acc[mt][nt], 0, 0, 0);
    }
  }
  float bias[6];
#pragma unroll
  for (int nt = 0; nt < 6; ++nt) {
    const int col = n0 + wn * 96 + nt * 16 + r;
    bias[nt] = p.b_in[l * DIN + (col < 1792 ? col : col + 8)];
  }
  __syncthreads();
#pragma unroll
  for (int mt = 0; mt < 4; ++mt)
#pragma unroll
    for (int nt = 0; nt < 6; ++nt)
#pragma unroll
      for (int j = 0; j < 4; ++j)
        sC[(wm * 64 + mt * 16 + q * 4 + j) * 200 + wn * 96 + nt * 16 + r] = f2bf(acc[mt][nt][j] + bias[nt]);
  __syncthreads();
#pragma unroll
  for (int i = 0; i < 12; ++i) {
    const int id = tid + i * 256, row = id / 24, ch = id % 24;
    *(uint4*)(p.proj + (size_t)(m0 + row) * PS + n0 + ch * 8) = *(const uint4*)(sC + row * 200 + ch * 8);
  }
}

DI void gemm1_gates(const Params& p, int l, const bfu* A, const bfu* Bt, int m0) {
  const int tid = threadIdx.x, lane = tid & 63, w = tid >> 6, r = lane & 15, q = lane >> 4;
  const bfu* a0 = A + (size_t)(m0 + w * 32 + r) * 1024 + q * 8;
  const bfu* a1 = a0 + 16 * 1024;
  const bfu* bp = Bt + (size_t)(3072 + r) * 1024 + q * 8;
  f32x4 c0 = (f32x4){0.f, 0.f, 0.f, 0.f}, c1 = (f32x4){0.f, 0.f, 0.f, 0.f};
#pragma unroll 4
  for (int ks = 0; ks < 32; ++ks) {
    const bf16x8 b = *(const bf16x8*)(bp + ks * 32);
    const bf16x8 x0 = *(const bf16x8*)(a0 + ks * 32);
    const bf16x8 x1 = *(const bf16x8*)(a1 + ks * 32);
    c0 = __builtin_amdgcn_mfma_f32_16x16x32_bf16(x0, b, c0, 0, 0, 0);
    c1 = __builtin_amdgcn_mfma_f32_16x16x32_bf16(x1, b, c1, 0, 0, 0);
  }
  if (r < 8) {
    const float bias = p.b_in[l * DIN + 1792 + r];
#pragma unroll
    for (int j = 0; j < 4; ++j) {
      p.proj[(size_t)(m0 + w * 32 + q * 4 + j) * PS + 3072 + r] = f2bf(c0[j] + bias);
      p.proj[(size_t)(m0 + w * 32 + 16 + q * 4 + j) * PS + 3072 + r] = f2bf(c1[j] + bias);
    }
  }
}

DI void phase1(const Params& p, int l, unsigned char* smem) {
  const bfu* Bt = p.wt_in + (size_t)l * PS * 1024;
  {
    uint4 ra0, ra1, ra2, ra3, rb0, rb1, rb2, rb3, rb4, rb5;
    bool pre = false;
    for (int tile = blockIdx.x; tile < 128 * 16; tile += gridDim.x) {
      const int mt = tile >> 4, nt = tile & 15, nx = tile + gridDim.x;
      const bool hn = nx < 128 * 16;
      const long dA = hn ? (long)((nx >> 4) - mt) * 128 * 1024 : 0, dB = hn ? (long)((nx & 15) - nt) * 192 * 1024 : 0;
      gemm1_tile(p, l, p.hb, Bt, mt * 128, nt * 192, smem, ra0, ra1, ra2, ra3, rb0, rb1, rb2, rb3, rb4, rb5, pre, dA, dB);
      pre = true;
    }
  }
  for (int job = blockIdx.x; job < 128; job += gridDim.x) gemm1_gates(p, l, p.hb, Bt, job * 128);
}

template <int EPI>
DI void gemm2_tile(const Params& p, int l, const bfu* A, const bfu* Bt, int m0, int n0, const float* hin, unsigned char* smem,
                   uint4& ra0, uint4& ra1, uint4& ra2, uint4& ra3, uint4& rb0, uint4& rb1, uint4& rb2, uint4& rb3, bool pre, long dA, long dB) {
  bfu* sA = (bfu*)smem; bfu* sB = sA + 128 * 72;
  const int tid = threadIdx.x, lane = tid & 63, w = tid >> 6, wm = w >> 1, wn = w & 1;
  const int r = lane & 15, q = lane >> 4;
  f32x4 acc[4][4];
#pragma unroll
  for (int i = 0; i < 4; ++i)
#pragma unroll
    for (int j = 0; j < 4; ++j) acc[i][j] = (f32x4){0.f, 0.f, 0.f, 0.f};
  const int lrow = tid >> 3, lkc = tid & 7;
  const bfu* ga = A + (size_t)(m0 + lrow) * 1024 + lkc * 8;
  const bfu* gb = Bt + (size_t)(n0 + lrow) * 1024 + lkc * 8;
  if (!pre) {
    ra0 = *(const uint4*)(ga); ra1 = *(const uint4*)(ga + 32 * 1024); ra2 = *(const uint4*)(ga + 64 * 1024); ra3 = *(const uint4*)(ga + 96 * 1024);
    rb0 = *(const uint4*)(gb); rb1 = *(const uint4*)(gb + 32 * 1024); rb2 = *(const uint4*)(gb + 64 * 1024); rb3 = *(const uint4*)(gb + 96 * 1024);
  }
  bfu* wa = sA + lrow * 72 + lkc * 8;
  bfu* wb = sB + lrow * 72 + lkc * 8;
  for (int kt = 0; kt < 16; ++kt) {
    __syncthreads();
    *(uint4*)(wa) = ra0; *(uint4*)(wa + 32 * 72) = ra1; *(uint4*)(wa + 64 * 72) = ra2; *(uint4*)(wa + 96 * 72) = ra3;
    *(uint4*)(wb) = rb0; *(uint4*)(wb + 32 * 72) = rb1; *(uint4*)(wb + 64 * 72) = rb2; *(uint4*)(wb + 96 * 72) = rb3;
    __syncthreads();
    {
      const long oa = (kt + 1 < 16) ? (long)(kt + 1) * 64 : dA, ob = (kt + 1 < 16) ? (long)(kt + 1) * 64 : dB;
      const bfu* ga2 = ga + oa; const bfu* gb2 = gb + ob;
      ra0 = *(const uint4*)(ga2); ra1 = *(const uint4*)(ga2 + 32 * 1024); ra2 = *(const uint4*)(ga2 + 64 * 1024); ra3 = *(const uint4*)(ga2 + 96 * 1024);
      rb0 = *(const uint4*)(gb2); rb1 = *(const uint4*)(gb2 + 32 * 1024); rb2 = *(const uint4*)(gb2 + 64 * 1024); rb3 = *(const uint4*)(gb2 + 96 * 1024);
    }
#pragma unroll
    for (int ks = 0; ks < 2; ++ks) {
      bf16x8 af[4], bfr[4];
#pragma unroll
      for (int mt = 0; mt < 4; ++mt) af[mt] = *(const bf16x8*)(sA + (wm * 64 + mt * 16 + r) * 72 + ks * 32 + q * 8);
#pragma unroll
      for (int nt = 0; nt < 4; ++nt) bfr[nt] = *(const bf16x8*)(sB + (wn * 64 + nt * 16 + r) * 72 + ks * 32 + q * 8);
#pragma unroll
      for (int mt = 0; mt < 4; ++mt)
#pragma unroll
        for (int nt = 0; nt < 4; ++nt) acc[mt][nt] = __builtin_amdgcn_mfma_f32_16x16x32_bf16(af[mt], bfr[nt], acc[mt][nt], 0, 0, 0);
    }
  }
#pragma unroll
  for (int np = 0; np < 2; ++np) {
    float hv[2][4][4], bias[2];
#pragma unroll
    for (int u = 0; u < 2; ++u) {
      const int col = n0 + wn * 64 + (np * 2 + u) * 16 + r;
      bias[u] = p.b_out[l * 1024 + col];
#pragma unroll
      for (int mt = 0; mt < 4; ++mt)
#pragma unroll
        for (int j = 0; j < 4; ++j) hv[u][mt][j] = hin[(size_t)(m0 + wm * 64 + mt * 16 + q * 4 + j) * 1024 + col];
    }
#pragma unroll
    for (int u = 0; u < 2; ++u) {
      const int nt = np * 2 + u, col = n0 + wn * 64 + nt * 16 + r;
#pragma unroll
      for (int mt = 0; mt < 4; ++mt)
#pragma unroll
        for (int j = 0; j < 4; ++j) {
          const int row = m0 + wm * 64 + mt * 16 + q * 4 + j;
          p.out[(size_t)row * 1024 + col] = DN_ALPHA * hv[u][mt][j] + acc[mt][nt][j] + bias[u];
        }
    }
  }
}


DI void phase5(const Params& p, int l, unsigned char* smem, unsigned long long& tp_acc) {
  const bfu* Bt = p.wt_out + (size_t)l * 1048576;
  const float* hin = (l == 0) ? p.x : p.out;
  uint4 ra0, ra1, ra2, ra3, rb0, rb1, rb2, rb3;
  bool pre = false;
  for (int tile = blockIdx.x; tile < 128 * 8; tile += gridDim.x) {
    const int mt = tile >> 3, nt = tile & 7, nx = tile + gridDim.x;
    const bool hn = nx < 128 * 8;
    const long dA = hn ? (long)((nx >> 3) - mt) * 128 * 1024 : 0, dB = hn ? (long)((nx & 7) - nt) * 128 * 1024 : 0;
    gemm2_tile<2>(p, l, p.mixed, Bt, mt * 128, nt * 128, hin, smem, ra0, ra1, ra2, ra3, rb0, rb1, rb2, rb3, pre, dA, dB);
    pre = true;
  }
}

DI void phase6(const Params& p, int l) {
  const int tid = threadIdx.x, lane = tid & 63, w = tid >> 6;
  float4 g[4], bb[4];
#pragma unroll
  for (int i = 0; i < 4; ++i) { g[i] = *(const float4*)(p.ln_g + l * 1024 + i * 256 + lane * 4); bb[i] = *(const float4*)(p.ln_b + l * 1024 + i * 256 + lane * 4); }
  for (int rb = blockIdx.x; rb < NTOK / 16; rb += gridDim.x) {
    const int row0 = rb * 16 + w * 4;
    float4 v[4][4];
#pragma unroll
    for (int rr = 0; rr < 4; ++rr)
#pragma unroll
      for (int i = 0; i < 4; ++i) v[rr][i] = *(const float4*)(p.out + (size_t)(row0 + rr) * 1024 + i * 256 + lane * 4);
#pragma unroll
    for (int rr = 0; rr < 4; ++rr) {
      float sm = 0.f;
#pragma unroll
      for (int i = 0; i < 4; ++i) sm += v[rr][i].x + v[rr][i].y + v[rr][i].z + v[rr][i].w;
      const float mu = wave_sum(sm) * (1.f / 1024.f);
      float ss = 0.f;
#pragma unroll
      for (int i = 0; i < 4; ++i) {
        v[rr][i].x -= mu; v[rr][i].y -= mu; v[rr][i].z -= mu; v[rr][i].w -= mu;
        ss += v[rr][i].x * v[rr][i].x + v[rr][i].y * v[rr][i].y + v[rr][i].z * v[rr][i].z + v[rr][i].w * v[rr][i].w;
      }
      const float rs = rsqrtf(wave_sum(ss) * (1.f / 1024.f) + 1e-5f);
#pragma unroll
      for (int i = 0; i < 4; ++i) {
        const int c = i * 256 + lane * 4;
        float4 o;
        o.x = v[rr][i].x * rs * g[i].x + bb[i].x; o.y = v[rr][i].y * rs * g[i].y + bb[i].y;
        o.z = v[rr][i].z * rs * g[i].z + bb[i].z; o.w = v[rr][i].w * rs * g[i].w + bb[i].w;
        *(float4*)(p.out + (size_t)(row0 + rr) * 1024 + c) = o;
        uint2 ob; ob.x = pack2(o.x, o.y); ob.y = pack2(o.z, o.w);
        *(uint2*)(p.hb + (size_t)(row0 + rr) * 1024 + c) = ob;
      }
    }
  }
}

DI void hg_gate(float x, float lb, float& lf, float& k) {
  x = fmaxf(x, -80.f);
  const float E = fexp(-x);
  const float sg = frcp(1.f + E);
  k = (1.f - lb) * (E * sg);
  lf = flog(lb + (1.f - lb) * sg);
}

DI void hg_local(const Params& p, int l, int b, int c, int hd, unsigned char* smem) {
  const int tid = threadIdx.x, lane = tid & 63, w = tid >> 6;
  bfu* At = (bfu*)smem;
  bfu* Bt = At + 64 * 72;
  float* segtot = (float*)(smem + 2 * 64 * 72 * 2);
  const int tok0 = b * SEQ + c * 64;
  const int d = lane;
  const float lb = p.lbs[l * 256 + hd * 64 + d];
  const bfu* pf = p.proj + (size_t)tok0 * PS + COL_AF + hd * 64 + d;
  const bfu* pv = p.proj + (size_t)tok0 * PS + COL_AI + hd * 64 + d;
  float bl[16], kk[16];
  float run = 0.f;
  __syncthreads();
#pragma unroll
  for (int i = 0; i < 16; ++i) {
    const int t = w * 16 + i;
    float lf, k; hg_gate(bf2f(pf[(size_t)t * PS]), lb, lf, k);
    run += lf; bl[i] = run; kk[i] = k;
    At[d * 72 + t] = pv[(size_t)t * PS];
  }
  segtot[w * 64 + d] = run;
  __syncthreads();
  float off = 0.f, tot = 0.f;
#pragma unroll
  for (int s = 0; s < 4; ++s) { float v = segtot[s * 64 + d]; tot += v; if (s < w) off += v; }
#pragma unroll
  for (int i = 0; i < 16; ++i) { const int t = w * 16 + i; Bt[d * 72 + t] = f2bf(kk[i] * fexp(tot - (bl[i] + off))); }
  const int base = (b * NCH + c) * 4 + hd;
  if (w == 0) p.hg_decay[base * 64 + d] = fexp(tot);
  __syncthreads();
  f32x4 acc[4];
#pragma unroll
  for (int i = 0; i < 4; ++i) acc[i] = (f32x4){0.f, 0.f, 0.f, 0.f};
  wave_mma<4, 2>(acc, At + w * 16 * 72, 72, Bt, 72, lane);
  float* st = p.hg_state + (size_t)base * 4096;
  const int r = lane & 15, q = lane >> 4;
#pragma unroll
  for (int nt = 0; nt < 4; ++nt)
#pragma unroll
    for (int j = 0; j < 4; ++j) st[(w * 16 + q * 4 + j) * 64 + nt * 16 + r] = acc[nt][j];
}

constexpr int O_A = 0, O_BT = 17408, O_QP = 34816, O_KP = 44032, O_MISC = 53248;

DI void hg_out(const Params& p, int l, int b, int c, int hd, unsigned char* smem) {
  const int tid = threadIdx.x, lane = tid & 63, w = tid >> 6;
  bfu* A = (bfu*)(smem + O_A); bfu* Bt = (bfu*)(smem + O_BT); bfu* Qp = (bfu*)(smem + O_QP); bfu* Kp = (bfu*)(smem + O_KP);
  float* segtot = (float*)(smem + O_MISC);
  const int tok0 = b * SEQ + c * 64;
  const int d = lane;
  const float lb = p.lbs[l * 256 + hd * 64 + d];
  const bfu* pq = p.proj + (size_t)tok0 * PS + COL_AQ + hd * 64 + d;
  const bfu* pf = p.proj + (size_t)tok0 * PS + COL_AF + hd * 64 + d;
  const bfu* pv = p.proj + (size_t)tok0 * PS + COL_AI + hd * 64 + d;
  const int base = (b * NCH + c) * 4 + hd;
  const float* st = p.hg_state + (size_t)base * 4096;
  float bl[16], kk[16];
  float run = 0.f;
  const int r = lane & 15, q = lane >> 4;
  bfu fraw[16], vraw[16], qraw[16]; float sraw[16];
#pragma unroll
  for (int i = 0; i < 16; ++i) {
    const int t = w * 16 + i;
    fraw[i] = pf[(size_t)t * PS]; vraw[i] = pv[(size_t)t * PS]; qraw[i] = pq[(size_t)t * PS]; sraw[i] = st[(w + 4 * i) * 64 + d];
  }
  bfu gt[4][4]; float gw[4];
#pragma unroll
  for (int nt = 0; nt < 4; ++nt) {
    gw[nt] = p.hg_g[l * 256 + hd * 64 + nt * 16 + r];
#pragma unroll
    for (int j = 0; j < 4; ++j) gt[j][nt] = p.proj[(size_t)(tok0 + w * 16 + q * 4 + j) * PS + COL_AG + hd * 64 + nt * 16 + r];
  }
  __syncthreads();
#pragma unroll
  for (int i = 0; i < 16; ++i) {
    const int t = w * 16 + i;
    float lf, k; hg_gate(bf2f(fraw[i]), lb, lf, k);
    run += lf; bl[i] = run; kk[i] = k;
    Bt[d * 136 + t] = vraw[i];
    const int e = w + 4 * i;
    Bt[e * 136 + 64 + d] = f2bf(sraw[i]);
  }
  segtot[w * 64 + d] = run;
  __syncthreads();
  float off = 0.f;
#pragma unroll
  for (int s = 0; s < 4; ++s) { float v = segtot[s * 64 + d]; if (s < w) off += v; }
  const float bm = segtot[d] + segtot[64 + d];
#pragma unroll
  for (int i = 0; i < 16; ++i) {
    const int t = w * 16 + i;
    const float bt = bl[i] + off;
    const float qv = silu_(bf2f(qraw[i]));
    Qp[t * 72 + d] = f2bf(qv * fexp(fmaxf(bt - bm, -80.f)));
    Kp[t * 72 + d] = f2bf(kk[i] * fexp(fminf(bm - bt, 80.f)));
    A[t * 136 + 64 + d] = f2bf(qv * fexp(bt));
  }
  __syncthreads();
  f32x4 acc[4];
#pragma unroll
  for (int i = 0; i < 4; ++i) acc[i] = (f32x4){0.f, 0.f, 0.f, 0.f};
  wave_mma<4, 2>(acc, Qp + w * 16 * 72, 72, Kp, 72, lane);
#pragma unroll
  for (int nt = 0; nt < 4; ++nt)
#pragma unroll
    for (int j = 0; j < 4; ++j) {
      const int t = w * 16 + q * 4 + j, s = nt * 16 + r;
      A[t * 136 + s] = f2bf(s <= t ? acc[nt][j] : 0.f);
    }
  __syncthreads();
  f32x4 o[4];
#pragma unroll
  for (int i = 0; i < 4; ++i) o[i] = (f32x4){0.f, 0.f, 0.f, 0.f};
  wave_mma<4, 4>(o, A + w * 16 * 136, 136, Bt, 136, lane);
#pragma unroll
  for (int j = 0; j < 4; ++j) {
    float ss = 0.f;
#pragma unroll
    for (int nt = 0; nt < 4; ++nt) ss += o[nt][j] * o[nt][j];
    ss = group16_sum(ss);
    const float sc = rsqrtf(ss * (1.f / 64.f) + 1e-6f);
    const int t = w * 16 + q * 4 + j;
    bfu* mrow = p.mixed + (size_t)(tok0 + t) * 1024 + hd * 64;
#pragma unroll
    for (int nt = 0; nt < 4; ++nt) {
      const int e = nt * 16 + r;
      mrow[e] = f2bf(o[nt][j] * sc * gw[nt] * silu_(bf2f(gt[j][nt])));
    }
  }
}

DI void ml_gates(const Params& p, int l, int tok0, int hd, float* bs, float* igs, int tid) {
  if (tid < 64) {
    const bfu* row = p.proj + (size_t)(tok0 + tid) * PS;
    const float ig = bf2f(row[COL_BIG + hd]);
    const float fg = bf2f(row[COL_BFG + hd]) + p.ml_fb[l * 4 + hd];
    float lf = logsig_(fg);
#pragma unroll
    for (int o = 1; o < 64; o <<= 1) { float v = __shfl_up(lf, o); if (tid >= o) lf += v; }
    bs[tid] = lf; igs[tid] = ig;
  }
}

DI void ml_local(const Params& p, int l, int b, int c, int hd, unsigned char* smem) {
  const int tid = threadIdx.x, lane = tid & 63, w = tid >> 6;
  bfu* At = (bfu*)smem;
  bfu* Bt = At + 64 * 72;
  float* bs = (float*)(smem + 2 * 64 * 72 * 2);
  float* igs = bs + 64; float* nseg = igs + 64;
  const int tok0 = b * SEQ + c * 64;
  const int d = lane;
  const bfu* pk = p.proj + (size_t)tok0 * PS + COL_BK + hd * 64 + d;
  const bfu* pv = p.proj + (size_t)tok0 * PS + COL_BV + hd * 64 + d;
  bfu kraw[16], vraw[16];
#pragma unroll
  for (int i = 0; i < 16; ++i) { kraw[i] = pk[(size_t)(w * 16 + i) * PS]; vraw[i] = pv[(size_t)(w * 16 + i) * PS]; }
  __syncthreads();
  ml_gates(p, l, tok0, hd, bs, igs, tid);
  __syncthreads();
  const float blast = bs[63];
  float nacc = 0.f;
#pragma unroll
  for (int i = 0; i < 16; ++i) {
    const int s = w * 16 + i;
    const float ws = fexp(blast - bs[s] + igs[s]);
    const float kw = bf2f(kraw[i]) * 0.125f * ws;
    Bt[d * 72 + s] = f2bf(kw); nacc += kw;
    At[d * 72 + s] = vraw[i];
  }
  nseg[w * 64 + d] = nacc;
  __syncthreads();
  const int base = (b * NCH + c) * 4 + hd;
  if (w == 0) p.ml_n[base * 64 + d] = nseg[d] + nseg[64 + d] + nseg[128 + d] + nseg[192 + d];
  if (tid == 0) p.ml_decay[base] = fexp(blast);
  f32x4 acc[4];
#pragma unroll
  for (int i = 0; i < 4; ++i) acc[i] = (f32x4){0.f, 0.f, 0.f, 0.f};
  wave_mma<4, 2>(acc, At + w * 16 * 72, 72, Bt, 72, lane);
  float* st = p.ml_state + (size_t)base * 4096;
  const int r = lane & 15, q = lane >> 4;
#pragma unroll
  for (int nt = 0; nt < 4; ++nt)
#pragma unroll
    for (int j = 0; j < 4; ++j) st[(w * 16 + q * 4 + j) * 64 + nt * 16 + r] = acc[nt][j];
}

DI void ml_out(const Params& p, int l, int b, int c, int hd, unsigned char* smem) {
  const int tid = threadIdx.x, lane = tid & 63, w = tid >> 6;
  bfu* A = (bfu*)(smem + O_A); bfu* Bt = (bfu*)(smem + O_BT); bfu* Qp = (bfu*)(smem + O_QP); bfu* Kp = (bfu*)(smem + O_KP);
  float* bs = (float*)(smem + O_MISC); float* igs = bs + 64; float* npv = igs + 64; float* den2 = npv + 64;
  const int tok0 = b * SEQ + c * 64;
  const int d = lane;
  const int base = (b * NCH + c) * 4 + hd;
  const float* st = p.ml_state + (size_t)base * 4096;
  const int r = lane & 15, q = lane >> 4;
  const bfu* pq = p.proj + (size_t)tok0 * PS + COL_BQ + hd * 64 + d;
  const bfu* pk = p.proj + (size_t)tok0 * PS + COL_BK + hd * 64 + d;
  const bfu* pv = p.proj + (size_t)tok0 * PS + COL_BV + hd * 64 + d;
  bfu qraw[16], kraw[16], vraw[16]; float sraw[16];
#pragma unroll
  for (int i = 0; i < 16; ++i) {
    const int t = w * 16 + i;
    qraw[i] = pq[(size_t)t * PS]; kraw[i] = pk[(size_t)t * PS]; vraw[i] = pv[(size_t)t * PS]; sraw[i] = st[(w + 4 * i) * 64 + d];
  }
  bfu gt[4][4]; float gw[4];
#pragma unroll
  for (int nt = 0; nt < 4; ++nt) {
    gw[nt] = p.ml_g[l * 256 + hd * 64 + nt * 16 + r];
#pragma unroll
    for (int j = 0; j < 4; ++j) gt[j][nt] = p.proj[(size_t)(tok0 + w * 16 + q * 4 + j) * PS + COL_BG + hd * 64 + nt * 16 + r];
  }
  __syncthreads();
  ml_gates(p, l, tok0, hd, bs, igs, tid);
  if (tid >= 64 && tid < 128) npv[tid - 64] = p.ml_n[base * 64 + tid - 64];
  __syncthreads();
#pragma unroll
  for (int i = 0; i < 16; ++i) {
    const int t = w * 16 + i;
    Qp[t * 72 + d] = qraw[i];
    Kp[t * 72 + d] = kraw[i];
    A[t * 136 + 64 + d] = f2bf(bf2f(qraw[i]) * fexp(bs[t]));
    Bt[d * 136 + t] = vraw[i];
    const int e = w + 4 * i;
    Bt[e * 136 + 64 + d] = f2bf(sraw[i]);
  }
  __syncthreads();
  if (tid < 64) {
    float s = 0.f;
    for (int dd = 0; dd < 64; ++dd) s += bf2f(A[tid * 136 + 64 + dd]) * npv[dd];
    den2[tid] = s;
  }
  f32x4 acc[4];
#pragma unroll
  for (int i = 0; i < 4; ++i) acc[i] = (f32x4){0.f, 0.f, 0.f, 0.f};
  wave_mma<4, 2>(acc, Qp + w * 16 * 72, 72, Kp, 72, lane);
  float den1[4];
#pragma unroll
  for (int j = 0; j < 4; ++j) {
    const int t = w * 16 + q * 4 + j;
    const float bt = bs[t];
    float rs = 0.f;
#pragma unroll
    for (int nt = 0; nt < 4; ++nt) {
      const int s = nt * 16 + r;
      float wv = 0.f;
      if (s <= t) wv = fexp(bt - bs[s] + igs[s]) * acc[nt][j] * 0.125f;
      rs += wv;
      A[t * 136 + s] = f2bf(wv);
    }
    den1[j] = group16_sum(rs);
  }
  __syncthreads();
  f32x4 o[4];
#pragma unroll
  for (int i = 0; i < 4; ++i) o[i] = (f32x4){0.f, 0.f, 0.f, 0.f};
  wave_mma<4, 4>(o, A + w * 16 * 136, 136, Bt, 136, lane);
#pragma unroll
  for (int j = 0; j < 4; ++j) {
    const int t = w * 16 + q * 4 + j;
    const float den = den1[j] + den2[t];
    const float inv = frcp(fmaxf(fabsf(den), 1.f));
    float hv[4];
    float ss = 0.f;
#pragma unroll
    for (int nt = 0; nt < 4; ++nt) { hv[nt] = o[nt][j] * inv; ss += hv[nt] * hv[nt]; }
    ss = group16_sum(ss);
    const float sc = rsqrtf(ss * (1.f / 64.f) + 1e-6f);
    bfu* mrow = p.mixed + (size_t)(tok0 + t) * 1024 + 256 + hd * 64;
#pragma unroll
    for (int nt = 0; nt < 4; ++nt) {
      const int e = nt * 16 + r;
      mrow[e] = f2bf(hv[nt] * sc * gw[nt] * silu_(bf2f(gt[j][nt])));
    }
  }
}

template <bool FINAL>
DI void lru_item(const Params& p, int l, int b, int c, int n, unsigned char* smem) {
  const int tid = threadIdx.x, lane = tid & 63, w = tid >> 6;
  bfu* xcb = (bfu*)smem;
  float* xcf = (float*)(smem + 9216);
  float* af = (float*)(smem + 9216 + 17408);
  float* segH = (float*)(smem + 9216 + 2 * 17408);
  float* segA = segH + 256;
  const int tok0 = b * SEQ + c * 64;
  const int ch = n * 64 + lane;
  const int r = lane & 15, q = lane >> 4;
  bf16x8 wfa[2][4], wfx[2][4];
#pragma unroll
  for (int ks = 0; ks < 2; ++ks)
#pragma unroll
    for (int nt = 0; nt < 4; ++nt) {
      wfa[ks][nt] = *(const bf16x8*)(p.wt_a + (l * 4 + n) * 4096 + (nt * 16 + r) * 64 + ks * 32 + q * 8);
      wfx[ks][nt] = *(const bf16x8*)(p.wt_x + (l * 4 + n) * 4096 + (nt * 16 + r) * 64 + ks * 32 + q * 8);
    }
  float e_ba[4], e_bx[4], e_lam[4];
#pragma unroll
  for (int nt = 0; nt < 4; ++nt) {
    const int che = n * 64 + nt * 16 + r;
    e_ba[nt] = p.b_a[l * 256 + che]; e_bx[nt] = p.b_x[l * 256 + che]; e_lam[nt] = p.lam[l * 256 + che];
  }
  const int sidx = (b * NCH + c) * 256 + ch;
  float Hprev = 0.f;
  bfu gq[16];
  if (FINAL) {
    Hprev = p.lru_h[sidx];
    const bfu* pg0 = p.proj + (size_t)tok0 * PS + COL_CG + ch;
#pragma unroll
    for (int i = 0; i < 16; ++i) gq[i] = pg0[(size_t)(w * 16 + i) * PS];
  }
  __syncthreads();
  {
    const float cw0 = p.conv_w[(l * 4 + 0) * 256 + ch], cw1 = p.conv_w[(l * 4 + 1) * 256 + ch];
    const float cw2 = p.conv_w[(l * 4 + 2) * 256 + ch], cw3 = p.conv_w[(l * 4 + 3) * 256 + ch];
    const float cb = p.conv_b[l * 256 + ch];
    const bfu* px = p.proj + (size_t)tok0 * PS + COL_CX + ch;
#pragma unroll
    for (int i = 0; i < 16; ++i) {
      const int t = w * 16 + i;
      const int sp = c * 64 + t;
      float x0 = (sp >= 3) ? bf2f(px[(ptrdiff_t)(t - 3) * PS]) : 0.f;
      float x1 = (sp >= 2) ? bf2f(px[(ptrdiff_t)(t - 2) * PS]) : 0.f;
      float x2 = (sp >= 1) ? bf2f(px[(ptrdiff_t)(t - 1) * PS]) : 0.f;
      float x3 = bf2f(px[(ptrdiff_t)t * PS]);
      const float xc = cb + cw0 * x0 + cw1 * x1 + cw2 * x2 + cw3 * x3;
      xcf[t * 68 + lane] = xc;
      xcb[t * 72 + lane] = f2bf(xc);
    }
  }
  __syncthreads();
  f32x4 aa[4], ax[4];
#pragma unroll
  for (int i = 0; i < 4; ++i) { aa[i] = (f32x4){0.f, 0.f, 0.f, 0.f}; ax[i] = (f32x4){0.f, 0.f, 0.f, 0.f}; }
#pragma unroll
  for (int ks = 0; ks < 2; ++ks) {
    const bf16x8 afr = *(const bf16x8*)(xcb + (w * 16 + r) * 72 + ks * 32 + q * 8);
#pragma unroll
    for (int nt = 0; nt < 4; ++nt) {
      aa[nt] = __builtin_amdgcn_mfma_f32_16x16x32_bf16(afr, wfa[ks][nt], aa[nt], 0, 0, 0);
      ax[nt] = __builtin_amdgcn_mfma_f32_16x16x32_bf16(afr, wfx[ks][nt], ax[nt], 0, 0, 0);
    }
  }
#pragma unroll
  for (int nt = 0; nt < 4; ++nt) {
    const int e = nt * 16 + r;
    const float ba = e_ba[nt], bx = e_bx[nt];
    const float lsl = 8.f * logsig_acc(e_lam[nt]);
#pragma unroll
    for (int j = 0; j < 4; ++j) {
      const int t = w * 16 + q * 4 + j;
      const float rg = sigmoid_(aa[nt][j] + ba), ig = sigmoid_(ax[nt][j] + bx);
      const float la = lsl * rg;
      const float a = fexp(la);
      const float y2 = 2.f * la;
      const float em = (y2 > -0.05f) ? -y2 * (1.f + y2 * (0.5f + y2 * (0.16666667f + y2 * 0.041666668f))) : 1.f - a * a;
      const float bv = __builtin_amdgcn_sqrtf(fmaxf(em, 0.f)) * ig * xcf[t * 68 + e];
      af[t * 68 + e] = a; xcf[t * 68 + e] = bv;
    }
  }
  __syncthreads();
  float hl[16], al[16];
  float h = 0.f, ap = 1.f;
#pragma unroll
  for (int i = 0; i < 16; ++i) {
    const int t = w * 16 + i;
    const float a = af[t * 68 + lane], bv = xcf[t * 68 + lane];
    h = a * h + bv; ap *= a; hl[i] = h; al[i] = ap;
  }
  segH[w * 64 + lane] = h; segA[w * 64 + lane] = ap;
  __syncthreads();
  if (!FINAL) {
    if (w == 0) {
      float H = 0.f, Ap = 1.f;
#pragma unroll
      for (int s = 0; s < 4; ++s) { H = segA[s * 64 + lane] * H + segH[s * 64 + lane]; Ap *= segA[s * 64 + lane]; }
      p.lru_h[sidx] = H; p.lru_a[sidx] = Ap;
    }
  } else {
    float H = Hprev;
#pragma unroll
    for (int s = 0; s < 4; ++s) if (s < w) H = segA[s * 64 + lane] * H + segH[s * 64 + lane];
    bfu* pm = p.mixed + (size_t)tok0 * 1024 + 512 + ch;
#pragma unroll
    for (int i = 0; i < 16; ++i) {
      const int t = w * 16 + i;
      const float hv = hl[i] + al[i] * H;
      pm[(size_t)t * 1024] = f2bf(hv * silu_(bf2f(gq[i])));
    }
  }
}

template <bool FINAL>
DI void s5_item(const Params& p, int l, int b, int c, int g4, unsigned char* smem) {
  const int tid = threadIdx.x, lane = tid & 63, w = tid >> 6;
  const int g = g4 * 4 + w;
  float* buw = (float*)(smem + w * 13312);
  bfu* stw = (bfu*)(smem + w * 13312 + 8448);
  const int tok0 = b * SEQ + c * 64;
  const int r = lane & 15, q = lane >> 4;
  const int lg = l * 16 + g;
  bf16x8 bfr[8], yfr[4];
#pragma unroll
  for (int nt = 0; nt < 8; ++nt) bfr[nt] = *(const bf16x8*)(p.bt_bu + ((size_t)lg * 128 + nt * 16 + r) * 32 + q * 8);
  if (FINAL) {
#pragma unroll
    for (int ks = 0; ks < 4; ++ks) yfr[ks] = *(const bf16x8*)(p.bt_y + ((size_t)lg * 16 + r) * 128 + ks * 32 + q * 8);
  }
  const float ar = p.abar[(lg * 64 + lane) * 2], ai = p.abar[(lg * 64 + lane) * 2 + 1];
  const size_t sbase = ((size_t)(b * NCH + c) * 16 + g) * 128;
  float xr = 0.f, xi = 0.f;
  if (FINAL) { xr = p.s5_state[sbase + lane]; xi = p.s5_state[sbase + 64 + lane]; }
  const float dsk = FINAL ? p.s5_d[l * 256 + g * 16 + r] : 0.f;
  bf16x8 afr[4];
  bfu uq[4][4];
#pragma unroll
  for (int mt = 0; mt < 4; ++mt) {
    afr[mt] = (bf16x8){0, 0, 0, 0, 0, 0, 0, 0};
    if (q < 2) afr[mt] = *(const bf16x8*)(p.proj + (size_t)(tok0 + mt * 16 + r) * PS + COL_DU + g * 16 + q * 8);
    if (FINAL) {
#pragma unroll
      for (int j = 0; j < 4; ++j) uq[mt][j] = p.proj[(size_t)(tok0 + mt * 16 + q * 4 + j) * PS + COL_DU + g * 16 + r];
    }
  }
  __syncthreads();
#pragma unroll
  for (int mt = 0; mt < 4; ++mt) {
    const bf16x8 a = afr[mt];
#pragma unroll
    for (int nt = 0; nt < 8; ++nt) {
      f32x4 acc = (f32x4){0.f, 0.f, 0.f, 0.f};
      acc = __builtin_amdgcn_mfma_f32_16x16x32_bf16(a, bfr[nt], acc, 0, 0, 0);
#pragma unroll
      for (int j = 0; j < 4; ++j) buw[(q * 4 + j) * 132 + nt * 16 + r] = acc[j];
    }
    wave_sync();
    {
      float br[16], bi[16];
#pragma unroll
      for (int tt = 0; tt < 16; ++tt) { br[tt] = buw[tt * 132 + lane]; bi[tt] = buw[tt * 132 + 64 + lane]; }
#pragma unroll
      for (int tt = 0; tt < 16; ++tt) {
        const float nr = ar * xr - ai * xi + br[tt];
        const float ni = ar * xi + ai * xr + bi[tt];
        xr = nr; xi = ni;
        br[tt] = xr; bi[tt] = xi;
      }
      if (FINAL) {
#pragma unroll
        for (int tt = 0; tt < 16; ++tt) { stw[tt * 136 + lane] = f2bf(br[tt]); stw[tt * 136 + 64 + lane] = f2bf(bi[tt]); }
      }
    }
    wave_sync();
    if (FINAL) {
      f32x4 y = (f32x4){0.f, 0.f, 0.f, 0.f};
#pragma unroll
      for (int ks = 0; ks < 4; ++ks) {
        bf16x8 a2 = *(const bf16x8*)(stw + r * 136 + ks * 32 + q * 8);
        y = __builtin_amdgcn_mfma_f32_16x16x32_bf16(a2, yfr[ks], y, 0, 0, 0);
      }
#pragma unroll
      for (int j = 0; j < 4; ++j) {
        const int t = mt * 16 + q * 4 + j;
        const float z = gelu_tanh_(y[j] + dsk * bf2f(uq[mt][j]));
        p.zbuf[(size_t)(tok0 + t) * 256 + g * 16 + r] = f2bf(z);
      }
      wave_sync();
    }
  }
  if (!FINAL) { p.s5_state[sbase + lane] = xr; p.s5_state[sbase + 64 + lane] = xi; }
}

DI void s5_glu(const Params& p, int l, int b, int c, unsigned char* smem) {
  const int tid = threadIdx.x, lane = tid & 63, w = tid >> 6;
  bfu* zs = (bfu*)smem;
  const int tok0 = b * SEQ + c * 64;
  const int r = lane & 15, q = lane >> 4;
  __syncthreads();
#pragma unroll
  for (int i = 0; i < 8; ++i) {
    const int id = tid + i * 256;
    *(uint4*)(zs + (id >> 5) * 264 + (id & 31) * 8) = *(const uint4*)(p.zbuf + (size_t)(tok0 + (id >> 5)) * 256 + (id & 31) * 8);
  }
  __syncthreads();
  const bfu* wg = p.wt_glu + l * 65536;
#pragma unroll 1
  for (int nc = 0; nc < 4; ++nc) {
    bfu gq[4][4]; float bgv[4];
#pragma unroll
    for (int nt = 0; nt < 4; ++nt) {
      bgv[nt] = p.b_glu[l * 256 + nc * 64 + nt * 16 + r];
#pragma unroll
      for (int j = 0; j < 4; ++j) gq[nt][j] = p.proj[(size_t)(tok0 + w * 16 + q * 4 + j) * PS + COL_DG + nc * 64 + nt * 16 + r];
    }
    f32x4 acc[4];
#pragma unroll
    for (int i = 0; i < 4; ++i) acc[i] = (f32x4){0.f, 0.f, 0.f, 0.f};
#pragma unroll
    for (int kh = 0; kh < 2; ++kh) {
      bf16x8 bq[4][4];
#pragma unroll
      for (int ks = 0; ks < 4; ++ks)
#pragma unroll
        for (int nt = 0; nt < 4; ++nt) bq[ks][nt] = *(const bf16x8*)(wg + (nc * 64 + nt * 16 + r) * 256 + kh * 128 + ks * 32 + q * 8);
#pragma unroll
      for (int ks = 0; ks < 4; ++ks) {
        const bf16x8 a = *(const bf16x8*)(zs + (w * 16 + r) * 264 + kh * 128 + ks * 32 + q * 8);
#pragma unroll
        for (int nt = 0; nt < 4; ++nt) acc[nt] = __builtin_amdgcn_mfma_f32_16x16x32_bf16(a, bq[ks][nt], acc[nt], 0, 0, 0);
      }
    }
#pragma unroll
    for (int nt = 0; nt < 4; ++nt) {
      const int n = nc * 64 + nt * 16 + r;
#pragma unroll
      for (int j = 0; j < 4; ++j) {
        const int t = w * 16 + q * 4 + j;
        const float zv = bf2f(zs[t * 264 + n]);
        const float gate = silu_(bf2f(gq[nt][j]));
        p.mixed[(size_t)(tok0 + t) * 1024 + 768 + n] = f2bf(zv * sigmoid_(acc[nt][j] + bgv[nt]) * gate);
      }
    }
  }
}

#define QLOOP(QI, N, BODY)                                                                            \
  {                                                                                                   \
    unsigned* q_ctr = p.cnt + CNT_Q + (l * 8 + (QI)) * 32;                                            \
    unsigned q_nxt = blockIdx.x;                                                                      \
    for (;;) {                                                                                        \
      __syncthreads();                                                                                \
      if (threadIdx.x == 0) *s_q = q_nxt;                                                             \
      __syncthreads();                                                                                \
      const int item = (int)*s_q;                                                                     \
      if (item >= (N)) break;                                                                         \
      if (threadIdx.x == 0) q_nxt = gridDim.x + __hip_atomic_fetch_add(q_ctr, 1u, __ATOMIC_RELAXED, __HIP_MEMORY_SCOPE_AGENT); \
      BODY;                                                                                           \
    }                                                                                                 \
  }

DI void phase2(const Params& p, int l, unsigned char* smem) {
  unsigned* s_q = (unsigned*)(smem + SMEM_BYTES - 32);
  QLOOP(0, 1024, s5_item<false>(p, l, item >> 7, (item >> 2) & 31, item & 3, smem))
  QLOOP(1, 1024, hg_local(p, l, item >> 7, (item >> 2) & 31, item & 3, smem))
  QLOOP(2, 1024, ml_local(p, l, item >> 7, (item >> 2) & 31, item & 3, smem))
  QLOOP(3, 1024, lru_item<false>(p, l, item >> 7, (item >> 2) & 31, item & 3, smem))
}

DI void phase3(const Params& p, int l) {
  const int gtid = blockIdx.x * 256 + threadIdx.x, gsz = gridDim.x * 256;
  constexpr int N1 = 131072, N2 = 131072, N3 = 2048, N4 = 2048, N5 = 8192;
  for (int i = gtid; i < N1 + N2 + N3 + N4 + N5; i += gsz) {
    if (i < N1 + N2) {
      const bool ml = i >= N1;
      const int j = ml ? i - N1 : i;
      const int b = j >> 14, rem = j & 16383, hd = rem >> 12, ed = rem & 4095, d = ed & 63;
      float* stp = (ml ? p.ml_state : p.hg_state) + (size_t)(b * NCH * 4 + hd) * 4096 + ed;
      const float* dcp = ml ? (p.ml_decay + b * NCH * 4 + hd) : (p.hg_decay + (b * NCH * 4 + hd) * 64 + d);
      const int dstride = ml ? 4 : 256;
      float S = 0.f;
#pragma unroll
      for (int c0 = 0; c0 < NCH; c0 += 16) {
        float loc[16], dec[16];
#pragma unroll
        for (int c = 0; c < 16; ++c) { loc[c] = stp[(size_t)(c0 + c) * 16384]; dec[c] = dcp[(c0 + c) * dstride]; }
#pragma unroll
        for (int c = 0; c < 16; ++c) { stp[(size_t)(c0 + c) * 16384] = S; S = dec[c] * S + loc[c]; }
      }
    } else if (i < N1 + N2 + N3) {
      const int j = i - N1 - N2, b = j >> 8, rem = j & 255, hd = rem >> 6, d = rem & 63;
      float S = 0.f;
#pragma unroll
      for (int c0 = 0; c0 < NCH; c0 += 16) {
        float loc[16], dec[16];
#pragma unroll
        for (int c = 0; c < 16; ++c) { const int base = (b * NCH + c0 + c) * 4 + hd; dec[c] = p.ml_decay[base]; loc[c] = p.ml_n[base * 64 + d]; }
#pragma unroll
        for (int c = 0; c < 16; ++c) { const int base = (b * NCH + c0 + c) * 4 + hd; p.ml_n[base * 64 + d] = S; S = dec[c] * S + loc[c]; }
      }
    } else if (i < N1 + N2 + N3 + N4) {
      const int j = i - N1 - N2 - N3, b = j >> 8, ch = j & 255;
      float H = 0.f;
#pragma unroll
      for (int c0 = 0; c0 < NCH; c0 += 16) {
        float av[16], hv[16];
#pragma unroll
        for (int c = 0; c < 16; ++c) { const int idx = (b * NCH + c0 + c) * 256 + ch; av[c] = p.lru_a[idx]; hv[c] = p.lru_h[idx]; }
#pragma unroll
        for (int c = 0; c < 16; ++c) { const int idx = (b * NCH + c0 + c) * 256 + ch; p.lru_h[idx] = H; H = av[c] * H + hv[c]; }
      }
    } else {
      const int j = i - N1 - N2 - N3 - N4, b = j >> 10, g = (j >> 6) & 15, pp = j & 63;
      const float ar = p.abar64[((l * 16 + g) * 64 + pp) * 2], ai = p.abar64[((l * 16 + g) * 64 + pp) * 2 + 1];
      float xr = 0.f, xi = 0.f;
#pragma unroll
      for (int c0 = 0; c0 < NCH; c0 += 16) {
        float lr[16], li[16];
#pragma unroll
        for (int c = 0; c < 16; ++c) { const size_t sb = ((size_t)(b * NCH + c0 + c) * 16 + g) * 128; lr[c] = p.s5_state[sb + pp]; li[c] = p.s5_state[sb + 64 + pp]; }
#pragma unroll
        for (int c = 0; c < 16; ++c) {
          const size_t sb = ((size_t)(b * NCH + c0 + c) * 16 + g) * 128;
          p.s5_state[sb + pp] = xr; p.s5_state[sb + 64 + pp] = xi;
          const float nr = ar * xr - ai * xi + lr[c], ni = ar * xi + ai * xr + li[c];
          xr = nr; xi = ni;
        }
      }
    }
  }
}

DI void phase4(const Params& p, int l, unsigned char* smem, unsigned long long& tp_acc) {
  unsigned* s_flag = (unsigned*)(smem + SMEM_BYTES - 16);
  unsigned* s_q = (unsigned*)(smem + SMEM_BYTES - 32);
  TPS(41)
  QLOOP(4, 256, {
    _Pragma("unroll 1") for (int g4 = 0; g4 < 4; ++g4) s5_item<true>(p, l, item >> 5, item & 31, g4, smem);
    asm volatile("s_waitcnt vmcnt(0)" ::: "memory");
    s5_glu(p, l, item >> 5, item & 31, smem);
  })
  TPE(41)
  TPS(42)
  QLOOP(5, 1024, hg_out(p, l, item >> 7, (item >> 2) & 31, item & 3, smem))
  TPE(42)
  TPS(43)
  QLOOP(6, 1024, ml_out(p, l, item >> 7, (item >> 2) & 31, item & 3, smem))
  TPE(43)
  TPS(44)
  QLOOP(7, 1024, lru_item<true>(p, l, item >> 7, (item >> 2) & 31, item & 3, smem))
  TPE(44)
}

#ifdef TPROBE
#define TP_CLASS(PH) ((PH) == 0 ? 0 : (((PH) - 1) % 6) + 1)
#define TP_BEGIN(PH) unsigned long long tp_t0 = 0; if (TP_CLASS(PH) == TPROBE) tp_t0 = __builtin_amdgcn_s_memrealtime();
#define TP_END(PH) if (TP_CLASS(PH) == TPROBE) tp_acc += __builtin_amdgcn_s_memrealtime() - tp_t0;
#else
#define TP_BEGIN(PH)
#define TP_END(PH)
#endif
#define RUN_PHASE(PH, CALL)                                       \
  if (ph0 <= (PH) && (PH) < ph1) {                                \
    TP_BEGIN(PH)                                                  \
    CALL;                                                         \
    if (COOP) { if ((PH) + 1 < ph1) xcd_barrier(xb); }            \
    TP_END(PH)                                                    \
  }

template <bool COOP, int L>
DI void run_layer(const Params& p, int ph0, int ph1, unsigned char* smem, const XcdBarrier& xb, unsigned long long& tp_acc) {
#ifdef DUP1
  RUN_PHASE(1 + 6 * L, phase1(p, L, smem))
#endif
  RUN_PHASE(1 + 6 * L, phase1(p, L, smem))
#ifdef DUP2
  RUN_PHASE(2 + 6 * L, phase2(p, L, smem))
#endif
  RUN_PHASE(2 + 6 * L, phase2(p, L, smem))
  RUN_PHASE(3 + 6 * L, { phase3(p, L); if (L + 1 < DEPTH) convert_weights<(L + 1 < DEPTH ? L + 1 : 0)>(p, smem); })
#ifdef DUP4
  RUN_PHASE(4 + 6 * L, phase4(p, L, smem, tp_acc))
#endif
  RUN_PHASE(4 + 6 * L, phase4(p, L, smem, tp_acc))
  RUN_PHASE(5 + 6 * L, phase5(p, L, smem, tp_acc))
  RUN_PHASE(6 + 6 * L, phase6(p, L))
}

template <bool COOP>
__global__ void __launch_bounds__(256, 2) mk_fwd(Params p, int ph0, int ph1) {
  __shared__ __attribute__((aligned(16))) unsigned char smem[SMEM_BYTES];
  __shared__ uint4 xb_words;
  XcdBarrier xb; xb.bar = p.bar; xb.x = 0; xb.st = nullptr;
  if (COOP) {
    if (ph1 < 0) cg::this_grid().sync();
    if (threadIdx.x == 0) xb_words = make_uint4(0u, 0u, 0u, 0u);
    __syncthreads();
    xb = xcd_barrier_post(p.bar, (volatile LAS unsigned*)&xb_words);
  }
  unsigned long long tp_acc = 0;
  RUN_PHASE(0, phase0(p, smem))
  run_layer<COOP, 0>(p, ph0, ph1, smem, xb, tp_acc);
  run_layer<COOP, 1>(p, ph0, ph1, smem, xb, tp_acc);
  run_layer<COOP, 2>(p, ph0, ph1, smem, xb, tp_acc);
  run_layer<COOP, 3>(p, ph0, ph1, smem, xb, tp_acc);
#ifdef TPROBE
  if (blockIdx.x == 0 && threadIdx.x == 0) {
    const unsigned long long t0 = __builtin_amdgcn_s_memrealtime();
    while (__builtin_amdgcn_s_memrealtime() - t0 < tp_acc) __builtin_amdgcn_s_sleep(8);
  }
#endif
}

extern "C" void kernel_launch(void* const* d_in, const int* in_sizes, int n_in, void* d_out, int out_size, void* d_ws,
                              size_t ws_size, hipStream_t stream) {
  static int grid_blocks = 0;
  if (!grid_blocks) {
    int dev = 0, cus = 0, per_cu = 0;
    hipGetDevice(&dev);
    hipDeviceGetAttribute(&cus, hipDeviceAttributeMultiprocessorCount, dev);
    hipOccupancyMaxActiveBlocksPerMultiprocessor(&per_cu, mk_fwd<(MEGA != 0)>, 256, 0);
    if (per_cu < 1) per_cu = 1;
    if (per_cu > 2) per_cu = 2;
    grid_blocks = cus * per_cu;
  }
  Params p{};
  const float** pin = (const float**)&p;
  for (int i = 0; i < 28; ++i) pin[i] = (const float*)d_in[i];
  p.out = (float*)d_out;
  unsigned char* ws = (unsigned char*)d_ws;
  size_t off = 0;
  auto take = [&](size_t bytes) { unsigned char* r = ws + off; off += (bytes + 255) & ~(size_t)255; return r; };
  p.wt_in = (bfu*)take((size_t)4 * PS * 1024 * 2);
  p.wt_out = (bfu*)take((size_t)4 * 1024 * 1024 * 2);
  p.wt_a = (bfu*)take(16 * 4096 * 2);
  p.wt_x = (bfu*)take(16 * 4096 * 2);
  p.wt_glu = (bfu*)take(4 * 65536 * 2);
  p.bt_bu = (bfu*)take(64 * 128 * 32 * 2);
  p.bt_y = (bfu*)take(64 * 16 * 128 * 2);
  p.hb = (bfu*)take((size_t)NTOK * 1024 * 2);
  p.proj = (bfu*)take((size_t)NTOK * PS * 2);
  p.mixed = (bfu*)take((size_t)NTOK * 1024 * 2);
  p.zbuf = (bfu*)take((size_t)NTOK * 256 * 2);
  p.abar = (float*)take(4096 * 2 * 4);
  p.abar64 = (float*)take(4096 * 2 * 4);
  p.lbs = (float*)take(1024 * 4);
  p.hg_state = (float*)take((size_t)BATCH * NCH * 4 * 4096 * 4);
  p.hg_decay = (float*)take((size_t)BATCH * NCH * 4 * 64 * 4);
  p.ml_state = (float*)take((size_t)BATCH * NCH * 4 * 4096 * 4);
  p.ml_n = (float*)take((size_t)BATCH * NCH * 4 * 64 * 4);
  p.ml_decay = (float*)take((size_t)BATCH * NCH * 4 * 4);
  p.lru_h = (float*)take((size_t)BATCH * NCH * 256 * 4);
  p.lru_a = (float*)take((size_t)BATCH * NCH * 256 * 4);
  p.s5_state = (float*)take((size_t)BATCH * NCH * 16 * 128 * 4);
  p.cnt = (unsigned*)take(CNT_TOTAL * 4);
  p.bar = (unsigned*)take(XCD_BAR_WORDS * 4);
  if (off > ws_size) { fprintf(stderr, "workspace too small: need %zu have %zu\n", off, ws_size); return; }
  const int NPH = 1 + 6 * DEPTH;
#if MEGA
  (void)hipMemsetAsync(p.bar, 0, XCD_BAR_WORDS * 4, stream);
  int ph0 = 0, ph1 = NPH;
  void* args[] = {&p, &ph0, &ph1};
  hipError_t e = hipLaunchCooperativeKernel((void*)mk_fwd<true>, dim3(grid_blocks), dim3(256), args, 0, stream);
  if (e != hipSuccess) fprintf(stderr, "cooperative launch failed: %s (grid %d)\n", hipGetErrorString(e), grid_blocks);
#else
  for (int ph = 0; ph < NPH; ++ph) hipLaunchKernelGGL(mk_fwd<false>, dim3(grid_blocks), dim3(256), 0, stream, p, ph, ph + 1);
#endif
}
```

```cpp
#include <hip/hip_runtime.h>
#include <hip/hip_cooperative_groups.h>
#include <stdint.h>
#include <stdio.h>
namespace cg = cooperative_groups;

#ifndef MEGA
#define MEGA 1
#endif

typedef unsigned short bfu;
using bf16x8 = __attribute__((ext_vector_type(8))) short;
using f32x4  = __attribute__((ext_vector_type(4))) float;
#define DI __device__ __forceinline__

constexpr int BATCH = 8, SEQ = 2048, DM = 1024, DEPTH = 4, NTOK = BATCH * SEQ, NCH = SEQ / 64;
constexpr int DIN = 3080, PS = 3200;
constexpr int COL_AQ = 0, COL_AF = 256, COL_AI = 512, COL_AG = 768;
constexpr int COL_BQ = 1024, COL_BK = 1280, COL_BV = 1536, COL_BG = 1792, COL_BIG = 3072, COL_BFG = 3076;
constexpr int COL_CX = 2048, COL_CG = 2304, COL_DU = 2560, COL_DG = 2816;
constexpr float DN_ALPHA = 1.681792830507429f;
constexpr int SMEM_BYTES = 56 * 1024;
constexpr int CNT_LN = 0, CNT_GLU = 4 * 128, CNT_Q = 4 * 128 + 4 * 256, CNT_TOTAL = CNT_Q + 32 * 32;

struct Params {
  const float *x, *w_in, *b_in, *lb_logits, *hg_g, *ml_fb, *ml_g, *conv_w, *conv_b, *w_a, *b_a, *w_x, *b_x, *lam,
      *a_re, *a_im, *log_dt, *sb_re, *sb_im, *c_re, *c_im, *s5_d, *w_glu, *b_glu, *w_out, *b_out, *ln_g, *ln_b;
  float* out;
  bfu *wt_in, *wt_out, *wt_a, *wt_x, *wt_glu, *bt_bu, *bt_y, *hb, *proj, *mixed, *zbuf;
  float *abar, *abar64, *lbs, *hg_state, *hg_decay, *ml_state, *ml_n, *ml_decay, *lru_h, *lru_a, *s5_state;
  unsigned* cnt;
  unsigned* bar;
};

DI bfu f2bf(float x) { return __builtin_bit_cast(unsigned short, (__bf16)x); }
DI float bf2f(bfu h) { return __uint_as_float(((unsigned)h) << 16); }
typedef __bf16 bf16v2 __attribute__((ext_vector_type(2)));
typedef float f32v2 __attribute__((ext_vector_type(2)));
DI unsigned pack2(float a, float b) { f32v2 v = {a, b}; return __builtin_bit_cast(unsigned, __builtin_convertvector(v, bf16v2)); }
DI float fexp(float x) { return __expf(x); }
DI float frcp(float x) { return __builtin_amdgcn_rcpf(x); }
DI float flog(float x) { return __logf(x); }
DI float sigmoid_(float x) { return frcp(1.f + fexp(-x)); }
DI float silu_(float x) { return x * frcp(1.f + fexp(-x)); }
DI float logsig_(float x) { return fminf(x, 0.f) - flog(1.f + fexp(-fabsf(x))); }
DI float logsig_acc(float x) { return fminf(x, 0.f) - log1pf(expf(-fabsf(x))); }
DI float gelu_tanh_(float x) {
  float u = 0.7978845608028654f * (x + 0.044715f * x * x * x);
  float th = 1.f - 2.f * frcp(fexp(2.f * u) + 1.f);
  return 0.5f * x * (1.f + th);
}

template <int NT, int KS>
DI void wave_mma(f32x4 (&acc)[NT], const bfu* A, int lda, const bfu* Bt, int ldb, int lane) {
  const int r = lane & 15, q = lane >> 4;
#pragma unroll
  for (int ks = 0; ks < KS; ++ks) {
    bf16x8 a = *(const bf16x8*)(A + r * lda + ks * 32 + q * 8);
#pragma unroll
    for (int nt = 0; nt < NT; ++nt) {
      bf16x8 b = *(const bf16x8*)(Bt + (nt * 16 + r) * ldb + ks * 32 + q * 8);
      acc[nt] = __builtin_amdgcn_mfma_f32_16x16x32_bf16(a, b, acc[nt], 0, 0, 0);
    }
  }
}

DI void wave_sync() { __builtin_amdgcn_fence(__ATOMIC_SEQ_CST, "wavefront"); __builtin_amdgcn_wave_barrier(); __builtin_amdgcn_fence(__ATOMIC_SEQ_CST, "wavefront"); }
DI float group16_sum(float v) {
  v += __shfl_xor(v, 1); v += __shfl_xor(v, 2); v += __shfl_xor(v, 4); v += __shfl_xor(v, 8);
  return v;
}
DI float wave_sum(float v) {
  v += __shfl_xor(v, 1); v += __shfl_xor(v, 2); v += __shfl_xor(v, 4); v += __shfl_xor(v, 8);
  v += __shfl_xor(v, 16); v += __shfl_xor(v, 32);
  return v;
}

DI bool last_arriver(unsigned* ctr, unsigned total, unsigned* s_flag) {
  asm volatile("s_waitcnt vmcnt(0)" ::: "memory");
  __syncthreads();
  if (threadIdx.x == 0) {
    __builtin_amdgcn_fence(__ATOMIC_RELEASE, "agent");
    asm volatile("s_waitcnt vmcnt(0)" ::: "memory");
    const unsigned old = __hip_atomic_fetch_add(ctr, 1u, __ATOMIC_RELAXED, __HIP_MEMORY_SCOPE_AGENT);
    const unsigned last = (old == total - 1u) ? 1u : 0u;
    if (last) { __builtin_amdgcn_fence(__ATOMIC_ACQUIRE, "agent"); asm volatile("s_waitcnt vmcnt(0)" ::: "memory"); }
    *s_flag = last;
  }
  __syncthreads();
  return (*s_flag != 0u);
}

#ifdef TPROBE
#define TPS(ID) unsigned long long tps_##ID = 0; if (TPROBE == (ID)) tps_##ID = __builtin_amdgcn_s_memrealtime();
#define TPE(ID) if (TPROBE == (ID)) tp_acc += __builtin_amdgcn_s_memrealtime() - tps_##ID;
#else
#define TPS(ID)
#define TPE(ID)
#endif

#define XB_TMO      128
#define XB_XCNT(j)  (256  + 64 * (j))
#define XB_XSUB(j)  (1280 + 64 * (j))
#define XB_XGEN(j)  (2304 + 64 * (j))
#define XB_TOP      3328
#define XB_TOPGEN   3392
#define XCD_BAR_WORDS 3456
#define XB_SPIN_CAP (1u << 22)
#define LAS __attribute__((address_space(3)))
DI unsigned xb_ld(unsigned* p) { return __hip_atomic_load(p, __ATOMIC_RELAXED, __HIP_MEMORY_SCOPE_AGENT); }
DI unsigned xb_add(unsigned* p, unsigned v) { return __hip_atomic_fetch_add(p, v, __ATOMIC_RELAXED, __HIP_MEMORY_SCOPE_AGENT); }
DI unsigned xb_xcc_id() { return (unsigned)__builtin_amdgcn_s_getreg((3 << 11) | 20) & 0xFu; }
#define XB_SPIN(cond, bar) do { unsigned _sp = 0; while (cond) { __builtin_amdgcn_s_sleep(1); \
    if ((++_sp & 255u) == 0u) { if (xb_ld(&(bar)[XB_TMO])) break; if (_sp > XB_SPIN_CAP) { atomicAdd(&(bar)[XB_TMO], 1u); break; } } } } while (0)
struct XcdBarrier { unsigned* bar; unsigned x; volatile LAS unsigned* st; };
DI XcdBarrier xcd_barrier_post(unsigned* bar, volatile LAS unsigned* st) {
  XcdBarrier b; b.bar = bar; b.x = xb_xcc_id(); b.st = st;
  if (threadIdx.x == 0) (void)xb_add(&bar[XB_XCNT(b.x)], 1u);
  return b;
}
DI void xcd_barrier_complete(unsigned* bar, unsigned x, unsigned& nloc, unsigned& nx) {
  const unsigned G = gridDim.x * gridDim.y * gridDim.z;
  unsigned sum, cnt, mine, sp = 0u;
  for (;;) {
    sum = 0u; cnt = 0u; mine = 0u;
#pragma unroll
    for (unsigned j = 0; j < 16; ++j) { const unsigned c = xb_ld(&bar[XB_XCNT(j)]); sum += c; cnt += (c > 0u) ? 1u : 0u; mine = (j == x) ? c : mine; }
    if (sum == G) break;
    __builtin_amdgcn_s_sleep(1);
    if ((++sp & 255u) == 0u) { if (xb_ld(&bar[XB_TMO])) break; if (sp > XB_SPIN_CAP) { atomicAdd(&bar[XB_TMO], 1u); break; } }
  }
  nloc = mine > 0u ? mine : 1u; nx = cnt > 0u ? cnt : 1u;
}
DI void xcd_barrier(const XcdBarrier& b) {
  asm volatile("s_waitcnt vmcnt(0)" ::: "memory");
  __syncthreads();
  if (threadIdx.x == 0) {
    unsigned* bar = b.bar;
    __builtin_amdgcn_s_waitcnt(0);
    unsigned nloc = b.st[0], nx = b.st[1];
    if (nloc == 0u) { xcd_barrier_complete(bar, b.x, nloc, nx); b.st[0] = nloc; b.st[1] = nx; }
    const unsigned old = xb_add(&bar[XB_XSUB(b.x)], 1u);
    const unsigned gen = old / nloc;
    if (old + 1u == (gen + 1u) * nloc) {
      __builtin_amdgcn_fence(__ATOMIC_RELEASE, "agent");
      asm volatile("s_waitcnt vmcnt(0)" ::: "memory");
      const unsigned og = xb_add(&bar[XB_TOP], 1u);
      const unsigned tg = og / nx;
      if (og + 1u == (tg + 1u) * nx) xb_add(&bar[XB_TOPGEN], 1u);
      else XB_SPIN(xb_ld(&bar[XB_TOPGEN]) == tg, bar);
      __builtin_amdgcn_fence(__ATOMIC_ACQUIRE, "agent");
      xb_add(&bar[XB_XGEN(b.x)], 1u);
      asm volatile("s_waitcnt vmcnt(0)" ::: "memory");
    } else {
      XB_SPIN(xb_ld(&bar[XB_XGEN(b.x)]) == gen, bar);
      __builtin_amdgcn_fence(__ATOMIC_ACQUIRE, "agent");
      asm volatile("s_waitcnt vmcnt(0)" ::: "memory");
    }
  }
  __syncthreads();
}

DI void transpose_tile(const float* src, int sld, int cv, bfu* dst, int dld, float* tile) {
  const int tid = threadIdx.x;
  __syncthreads();
  for (int i = tid; i < 4096; i += 256) {
    int r = i >> 6, c = i & 63;
    tile[r * 65 + c] = (c < cv) ? src[(size_t)r * sld + c] : 0.f;
  }
  __syncthreads();
  for (int i = tid; i < 4096; i += 256) {
    int n = i >> 6, k = i & 63;
    dst[(size_t)n * dld + k] = f2bf(tile[k * 65 + n]);
  }
}

template <int LSEL>
DI void convert_weights(const Params& p, unsigned char* smem) {
  const int tid = threadIdx.x;
  float* tile = (float*)smem;
  const int NJ = 3200 + 1024 + 16 + 16 + 64;
  for (int job = blockIdx.x; job < NJ; job += gridDim.x) {
    const float* src; int sld, cv = 64, dld; bfu* dst;
    if (job < 3200) {
      int l = job / 800, rem = job % 800, kt = rem / 50, nt = rem % 50;
      if (l != LSEL) continue;
      const int c0 = nt < 28 ? nt * 64 : (nt < 48 ? nt * 64 + 8 : 1792);
      src = p.w_in + (size_t)l * 1024 * DIN + (size_t)kt * 64 * DIN + c0; sld = DIN;
      cv = nt < 48 ? 64 : (nt == 48 ? 8 : 0);
      dst = p.wt_in + (size_t)l * PS * 1024 + (size_t)nt * 64 * 1024 + kt * 64; dld = 1024;
    } else if (job < 4224) {
      int j = job - 3200, l = j / 256, rem = j % 256, kt = rem / 16, nt = rem % 16;
      if (l != LSEL) continue;
      src = p.w_out + (size_t)l * 1048576 + (size_t)kt * 64 * 1024 + nt * 64; sld = 1024;
      dst = p.wt_out + (size_t)l * 1048576 + (size_t)nt * 64 * 1024 + kt * 64; dld = 1024;
    } else if (LSEL != 0) {
      continue;
    } else if (job < 4240) {
      int j = job - 4224; src = p.w_a + j * 4096; sld = 64; dst = p.wt_a + j * 4096; dld = 64;
    } else if (job < 4256) {
      int j = job - 4240; src = p.w_x + j * 4096; sld = 64; dst = p.wt_x + j * 4096; dld = 64;
    } else {
      int j = job - 4256, l = j / 16, rem = j % 16, kt = rem / 4, nt = rem % 4;
      src = p.w_glu + l * 65536 + kt * 64 * 256 + nt * 64; sld = 256;
      dst = p.wt_glu + l * 65536 + nt * 64 * 256 + kt * 64; dld = 256;
    }
    transpose_tile(src, sld, cv, dst, dld, tile);
  }
}

DI void phase0(const Params& p, unsigned char* smem) {
  const int tid = threadIdx.x;
  const int gtid = blockIdx.x * 256 + tid, gsz = gridDim.x * 256;
  for (int i0 = gtid; i0 < NTOK * DM / 8; i0 += 4 * gsz) {
    float4 a[4], b[4];
#pragma unroll
    for (int u = 0; u < 4; ++u) {
      const int i = i0 + u * gsz;
      if (i < NTOK * DM / 8) { a[u] = ((const float4*)p.x)[2 * i]; b[u] = ((const float4*)p.x)[2 * i + 1]; }
    }
#pragma unroll
    for (int u = 0; u < 4; ++u) {
      const int i = i0 + u * gsz;
      if (i < NTOK * DM / 8) {
        uint4 o; o.x = pack2(a[u].x, a[u].y); o.y = pack2(a[u].z, a[u].w); o.z = pack2(b[u].x, b[u].y); o.w = pack2(b[u].z, b[u].w);
        ((uint4*)p.hb)[i] = o;
      }
    }
  }
  convert_weights<0>(p, smem);
  for (int i = (gridDim.x - 1 - blockIdx.x) * 256 + tid; i < 4096; i += gsz) {
    int lg = i >> 6, pp = i & 63;
    double dt = exp((double)p.log_dt[lg]);
    double are = p.a_re[lg * 64 + pp], aim = p.a_im[lg * 64 + pp];
    double mag = exp(dt * are), ang = dt * aim;
    double abr = mag * cos(ang), abi = mag * sin(ang);
    double den = are * are + aim * aim;
    double xr = abr - 1.0, xi = abi;
    double zr = (xr * are + xi * aim) / den, zi = (xi * are - xr * aim) / den;
    bfu* o_re = p.bt_bu + ((size_t)lg * 128 + pp) * 32;
    bfu* o_im = p.bt_bu + ((size_t)lg * 128 + 64 + pp) * 32;
    float4 brv[4], biv[4];
#pragma unroll
    for (int h4 = 0; h4 < 4; ++h4) { brv[h4] = *(const float4*)(p.sb_re + (lg * 64 + pp) * 16 + h4 * 4); biv[h4] = *(const float4*)(p.sb_im + (lg * 64 + pp) * 16 + h4 * 4); }
#pragma unroll
    for (int h4 = 0; h4 < 4; ++h4) {
      const float brs[4] = {brv[h4].x, brv[h4].y, brv[h4].z, brv[h4].w}, bis[4] = {biv[h4].x, biv[h4].y, biv[h4].z, biv[h4].w};
#pragma unroll
      for (int k = 0; k < 4; ++k) {
        const int h = h4 * 4 + k;
        const double br = brs[k], bi = bis[k];
        o_re[h] = f2bf((float)(zr * br - zi * bi));
        o_im[h] = f2bf((float)(zr * bi + zi * br));
        o_re[16 + h] = 0; o_im[16 + h] = 0;
      }
    }
    p.abar[(lg * 64 + pp) * 2 + 0] = (float)abr; p.abar[(lg * 64 + pp) * 2 + 1] = (float)abi;
    double mag64 = exp(64.0 * dt * are), ang64 = 64.0 * ang;
    p.abar64[(lg * 64 + pp) * 2 + 0] = (float)(mag64 * cos(ang64));
    p.abar64[(lg * 64 + pp) * 2 + 1] = (float)(mag64 * sin(ang64));
  }
  for (int i = gtid; i < 4 * 16 * 16 * 128; i += gsz) {
    int k = i & 127, lgn = i >> 7;
    p.bt_y[i] = (k < 64) ? f2bf(p.c_re[lgn * 64 + k]) : f2bf(-p.c_im[lgn * 64 + (k - 64)]);
  }
  for (int i = gtid; i < 256; i += gsz) {
    float v0 = p.lb_logits[i], v1 = p.lb_logits[256 + i], v2 = p.lb_logits[512 + i], v3 = p.lb_logits[768 + i];
    float m = fmaxf(fmaxf(v0, v1), fmaxf(v2, v3));
    float e0 = expf(v0 - m), e1 = expf(v1 - m), e2 = expf(v2 - m), e3 = expf(v3 - m);
    float s = e0 + e1 + e2 + e3;
    p.lbs[i] = 0.f; p.lbs[256 + i] = e1 / s; p.lbs[512 + i] = (e1 + e2) / s; p.lbs[768 + i] = (e1 + e2 + e3) / s;
  }
  for (int i = gtid; i < CNT_TOTAL; i += gsz) p.cnt[i] = 0u;
}

DI void gemm1_tile(const Params& p, int l, const bfu* A, const bfu* Bt, int m0, int n0, unsigned char* smem,
                   uint4& ra0, uint4& ra1, uint4& ra2, uint4& ra3, uint4& rb0, uint4& rb1, uint4& rb2, uint4& rb3, uint4& rb4, uint4& rb5, bool pre, long dA, long dB) {
  bfu* sA = (bfu*)smem; bfu* sB = sA + 128 * 72;
  bfu* sC = (bfu*)smem;
  const int tid = threadIdx.x, lane = tid & 63, w = tid >> 6, wm = w >> 1, wn = w & 1;
  const int r = lane & 15, q = lane >> 4;
  f32x4 acc[4][6];
#pragma unroll
  for (int i = 0; i < 4; ++i)
#pragma unroll
    for (int j = 0; j < 6; ++j) acc[i][j] = (f32x4){0.f, 0.f, 0.f, 0.f};
  const int lrow = tid >> 3, lkc = tid & 7;
  const bfu* ga = A + (size_t)(m0 + lrow) * 1024 + lkc * 8;
  const bfu* gb = Bt + (size_t)(n0 + lrow) * 1024 + lkc * 8;
  if (!pre) {
    ra0 = *(const uint4*)(ga); ra1 = *(const uint4*)(ga + 32 * 1024); ra2 = *(const uint4*)(ga + 64 * 1024); ra3 = *(const uint4*)(ga + 96 * 1024);
    rb0 = *(const uint4*)(gb); rb1 = *(const uint4*)(gb + 32 * 1024); rb2 = *(const uint4*)(gb + 64 * 1024); rb3 = *(const uint4*)(gb + 96 * 1024);
    rb4 = *(const uint4*)(gb + 128 * 1024); rb5 = *(const uint4*)(gb + 160 * 1024);
  }
  bfu* wa = sA + lrow * 72 + lkc * 8;
  bfu* wb = sB + lrow * 72 + lkc * 8;
  for (int kt = 0; kt < 16; ++kt) {
    __syncthreads();
    *(uint4*)(wa) = ra0; *(uint4*)(wa + 32 * 72) = ra1; *(uint4*)(wa + 64 * 72) = ra2; *(uint4*)(wa + 96 * 72) = ra3;
    *(uint4*)(wb) = rb0; *(uint4*)(wb + 32 * 72) = rb1; *(uint4*)(wb + 64 * 72) = rb2; *(uint4*)(wb + 96 * 72) = rb3;
    *(uint4*)(wb + 128 * 72) = rb4; *(uint4*)(wb + 160 * 72) = rb5;
    __syncthreads();
    {
      const long oa = (kt + 1 < 16) ? (long)(kt + 1) * 64 : dA, ob = (kt + 1 < 16) ? (long)(kt + 1) * 64 : dB;
      const bfu* ga2 = ga + oa; const bfu* gb2 = gb + ob;
      ra0 = *(const uint4*)(ga2); ra1 = *(const uint4*)(ga2 + 32 * 1024); ra2 = *(const uint4*)(ga2 + 64 * 1024); ra3 = *(const uint4*)(ga2 + 96 * 1024);
      rb0 = *(const uint4*)(gb2); rb1 = *(const uint4*)(gb2 + 32 * 1024); rb2 = *(const uint4*)(gb2 + 64 * 1024); rb3 = *(const uint4*)(gb2 + 96 * 1024);
      rb4 = *(const uint4*)(gb2 + 128 * 1024); rb5 = *(const uint4*)(gb2 + 160 * 1024);
    }
#pragma unroll
    for (int ks = 0; ks < 2; ++ks) {
      bf16x8 af[4], bfr[6];
#pragma unroll
      for (int mt = 0; mt < 4; ++mt) af[mt] = *(const bf16x8*)(sA + (wm * 64 + mt * 16 + r) * 72 + ks * 32 + q * 8);
#pragma unroll
      for (int nt = 0; nt < 6; ++nt) bfr[nt] = *(const bf16x8*)(sB + (wn * 96 + nt * 16 + r) * 72 + ks * 32 + q * 8);
#pragma unroll
      for (int mt = 0; mt < 4; ++mt)
#pragma unroll
        for (int nt = 0; nt < 6; ++nt) acc[mt][nt] = __builtin_amdgcn_mfma_f32_16x16x32_bf16(af[mt], bfr[nt], acc[mt][nt], 0, 0, 0);
    }
  }
  float bias[6];
#pragma unroll
  for (int nt = 0; nt < 6; ++nt) {
    const int col = n0 + wn * 96 + nt * 16 + r;
    bias[nt] = p.b_in[l * DIN + (col < 1792 ? col : col + 8)];
  }
  __syncthreads();
#pragma unroll
  for (int mt = 0; mt < 4; ++mt)
#pragma unroll
    for (int nt = 0; nt < 6; ++nt)
#pragma unroll
      for (int j = 0; j < 4; ++j)
        sC[(wm * 64 + mt * 16 + q * 4 + j) * 200 + wn * 96 + nt * 16 + r] = f2bf(acc[mt][nt][j] + bias[nt]);
  __syncthreads();
#pragma unroll
  for (int i = 0; i < 12; ++i) {
    const int id = tid + i * 256, row = id / 24, ch = id % 24;
    *(uint4*)(p.proj + (size_t)(m0 + row) * PS + n0 + ch * 8) = *(const uint4*)(sC + row * 200 + ch * 8);
  }
}

DI void gemm1_gates(const Params& p, int l, const bfu* A, const bfu* Bt, int m0) {
  const int tid = threadIdx.x, lane = tid & 63, w = tid >> 6, r = lane & 15, q = lane >> 4;
  const bfu* a0 = A + (size_t)(m0 + w * 32 + r) * 1024 + q * 8;
  const bfu* a1 = a0 + 16 * 1024;
  const bfu* bp = Bt + (size_t)(3072 + r) * 1024 + q * 8;
  f32x4 c0 = (f32x4){0.f, 0.f, 0.f, 0.f}, c1 = (f32x4){0.f, 0.f, 0.f, 0.f};
#pragma unroll 4
  for (int ks = 0; ks < 32; ++ks) {
    const bf16x8 b = *(const bf16x8*)(bp + ks * 32);
    const bf16x8 x0 = *(const bf16x8*)(a0 + ks * 32);
    const bf16x8 x1 = *(const bf16x8*)(a1 + ks * 32);
    c0 = __builtin_amdgcn_mfma_f32_16x16x32_bf16(x0, b, c0, 0, 0, 0);
    c1 = __builtin_amdgcn_mfma_f32_16x16x32_bf16(x1, b, c1, 0, 0, 0);
  }
  if (r < 8) {
    const float bias = p.b_in[l * DIN + 1792 + r];
#pragma unroll
    for (int j = 0; j < 4; ++j) {
      p.proj[(size_t)(m0 + w * 32 + q * 4 + j) * PS + 3072 + r] = f2bf(c0[j] + bias);
      p.proj[(size_t)(m0 + w * 32 + 16 + q * 4 + j) * PS + 3072 + r] = f2bf(c1[j] + bias);
    }
  }
}

DI void phase1(const Params& p, int l, unsigned char* smem) {
  const bfu* Bt = p.wt_in + (size_t)l * PS * 1024;
  {
    uint4 ra0, ra1, ra2, ra3, rb0, rb1, rb2, rb3, rb4, rb5;
    bool pre = false;
    for (int tile = blockIdx.x; tile < 128 * 16; tile += gridDim.x) {
      const int mt = tile >> 4, nt = tile & 15, nx = tile + gridDim.x;
      const bool hn = nx < 128 * 16;
      const long dA = hn ? (long)((nx >> 4) - mt) * 128 * 1024 : 0, dB = hn ? (long)((nx & 15) - nt) * 192 * 1024 : 0;
      gemm1_tile(p, l, p.hb, Bt, mt * 128, nt * 192, smem, ra0, ra1, ra2, ra3, rb0, rb1, rb2, rb3, rb4, rb5, pre, dA, dB);
      pre = true;
    }
  }
  for (int job = blockIdx.x; job < 128; job += gridDim.x) gemm1_gates(p, l, p.hb, Bt, job * 128);
}

template <int EPI>
DI void gemm2_tile(const Params& p, int l, const bfu* A, const bfu* Bt, int m0, int n0, const float* hin, unsigned char* smem,
                   uint4& ra0, uint4& ra1, uint4& ra2, uint4& ra3, uint4& rb0, uint4& rb1, uint4& rb2, uint4& rb3, bool pre, long dA, long dB) {
  bfu* sA = (bfu*)smem; bfu* sB = sA + 128 * 72;
  const int tid = threadIdx.x, lane = tid & 63, w = tid >> 6, wm = w >> 1, wn = w & 1;
  const int r = lane & 15, q = lane >> 4;
  f32x4 acc[4][4];
#pragma unroll
  for (int i = 0; i < 4; ++i)
#pragma unroll
    for (int j = 0; j < 4; ++j) acc[i][j] = (f32x4){0.f, 0.f, 0.f, 0.f};
  const int lrow = tid >> 3, lkc = tid & 7;
  const bfu* ga = A + (size_t)(m0 + lrow) * 1024 + lkc * 8;
  const bfu* gb = Bt + (size_t)(n0 + lrow) * 1024 + lkc * 8;
  if (!pre) {
    ra0 = *(const uint4*)(ga); ra1 = *(const uint4*)(ga + 32 * 1024); ra2 = *(const uint4*)(ga + 64 * 1024); ra3 = *(const uint4*)(ga + 96 * 1024);
    rb0 = *(const uint4*)(gb); rb1 = *(const uint4*)(gb + 32 * 1024); rb2 = *(const uint4*)(gb + 64 * 1024); rb3 = *(const uint4*)(gb + 96 * 1024);
  }
  bfu* wa = sA + lrow * 72 + lkc * 8;
  bfu* wb = sB + lrow * 72 + lkc * 8;
  for (int kt = 0; kt < 16; ++kt) {
    __syncthreads();
    *(uint4*)(wa) = ra0; *(uint4*)(wa + 32 * 72) = ra1; *(uint4*)(wa + 64 * 72) = ra2; *(uint4*)(wa + 96 * 72) = ra3;
    *(uint4*)(wb) = rb0; *(uint4*)(wb + 32 * 72) = rb1; *(uint4*)(wb + 64 * 72) = rb2; *(uint4*)(wb + 96 * 72) = rb3;
    __syncthreads();
    {
      const long oa = (kt + 1 < 16) ? (long)(kt + 1) * 64 : dA, ob = (kt + 1 < 16) ? (long)(kt + 1) * 64 : dB;
      const bfu* ga2 = ga + oa; const bfu* gb2 = gb + ob;
      ra0 = *(const uint4*)(ga2); ra1 = *(const uint4*)(ga2 + 32 * 1024); ra2 = *(const uint4*)(ga2 + 64 * 1024); ra3 = *(const uint4*)(ga2 + 96 * 1024);
      rb0 = *(const uint4*)(gb2); rb1 = *(const uint4*)(gb2 + 32 * 1024); rb2 = *(const uint4*)(gb2 + 64 * 1024); rb3 = *(const uint4*)(gb2 + 96 * 1024);
    }
#pragma unroll
    for (int ks = 0; ks < 2; ++ks) {
      bf16x8 af[4], bfr[4];
#pragma unroll
      for (int mt = 0; mt < 4; ++mt) af[mt] = *(const bf16x8*)(sA + (wm * 64 + mt * 16 + r) * 72 + ks * 32 + q * 8);
#pragma unroll
      for (int nt = 0; nt < 4; ++nt) bfr[nt] = *(const bf16x8*)(sB + (wn * 64 + nt * 16 + r) * 72 + ks * 32 + q * 8);
#pragma unroll
      for (int mt = 0; mt < 4; ++mt)
#pragma unroll
        for (int nt = 0; nt < 4; ++nt) acc[mt][nt] = __builtin_amdgcn_mfma_f32_16x16x32_bf16(af[mt], bfr[nt], acc[mt][nt], 0, 0, 0);
    }
  }
#pragma unroll
  for (int np = 0; np < 2; ++np) {
    float hv[2][4][4], bias[2];
#pragma unroll
    for (int u = 0; u < 2; ++u) {
      const int col = n0 + wn * 64 + (np * 2 + u) * 16 + r;
      bias[u] = p.b_out[l * 1024 + col];
#pragma unroll
      for (int mt = 0; mt < 4; ++mt)
#pragma unroll
        for (int j = 0; j < 4; ++j) hv[u][mt][j] = hin[(size_t)(m0 + wm * 64 + mt * 16 + q * 4 + j) * 1024 + col];
    }
#pragma unroll
    for (int u = 0; u < 2; ++u) {
      const int nt = np * 2 + u, col = n0 + wn * 64 + nt * 16 + r;
#pragma unroll
      for (int mt = 0; mt < 4; ++mt)
#pragma unroll
        for (int j = 0; j < 4; ++j) {
          const int row = m0 + wm * 64 + mt * 16 + q * 4 + j;
          p.out[(size_t)row * 1024 + col] = DN_ALPHA * hv[u][mt][j] + acc[mt][nt][j] + bias[u];
        }
    }
  }
}


DI void phase5(const Params& p, int l, unsigned char* smem, unsigned long long& tp_acc) {
  const bfu* Bt = p.wt_out + (size_t)l * 1048576;
  const float* hin = (l == 0) ? p.x : p.out;
  uint4 ra0, ra1, ra2, ra3, rb0, rb1, rb2, rb3;
  bool pre = false;
  for (int tile = blockIdx.x; tile < 128 * 8; tile += gridDim.x) {
    const int mt = tile >> 3, nt = tile & 7, nx = tile + gridDim.x;
    const bool hn = nx < 128 * 8;
    const long dA = hn ? (long)((nx >> 3) - mt) * 128 * 1024 : 0, dB = hn ? (long)((nx & 7) - nt) * 128 * 1024 : 0;
    gemm2_tile<2>(p, l, p.mixed, Bt, mt * 128, nt * 128, hin, smem, ra0, ra1, ra2, ra3, rb0, rb1, rb2, rb3, pre, dA, dB);
    pre = true;
  }
}

DI void phase6(const Params& p, int l) {
  const int tid = threadIdx.x, lane = tid & 63, w = tid >> 6;
  float4 g[4], bb[4];
#pragma unroll
  for (int i = 0; i < 4; ++i) { g[i] = *(const float4*)(p.ln_g + l * 1024 + i * 256 + lane * 4); bb[i] = *(const float4*)(p.ln_b + l * 1024 + i * 256 + lane * 4); }
  for (int rb = blockIdx.x; rb < NTOK / 16; rb += gridDim.x) {
    const int row0 = rb * 16 + w * 4;
    float4 v[4][4];
#pragma unroll
    for (int rr = 0; rr < 4; ++rr)
#pragma unroll
      for (int i = 0; i < 4; ++i) v[rr][i] = *(const float4*)(p.out + (size_t)(row0 + rr) * 1024 + i * 256 + lane * 4);
#pragma unroll
    for (int rr = 0; rr < 4; ++rr) {
      float sm = 0.f;
#pragma unroll
      for (int i = 0; i < 4; ++i) sm += v[rr][i].x + v[rr][i].y + v[rr][i].z + v[rr][i].w;
      const float mu = wave_sum(sm) * (1.f / 1024.f);
      float ss = 0.f;
#pragma unroll
      for (int i = 0; i < 4; ++i) {
        v[rr][i].x -= mu; v[rr][i].y -= mu; v[rr][i].z -= mu; v[rr][i].w -= mu;
        ss += v[rr][i].x * v[rr][i].x + v[rr][i].y * v[rr][i].y + v[rr][i].z * v[rr][i].z + v[rr][i].w * v[rr][i].w;
      }
      const float rs = rsqrtf(wave_sum(ss) * (1.f / 1024.f) + 1e-5f);
#pragma unroll
      for (int i = 0; i < 4; ++i) {
        const int c = i * 256 + lane * 4;
        float4 o;
        o.x = v[rr][i].x * rs * g[i].x + bb[i].x; o.y = v[rr][i].y * rs * g[i].y + bb[i].y;
        o.z = v[rr][i].z * rs * g[i].z + bb[i].z; o.w = v[rr][i].w * rs * g[i].w + bb[i].w;
        *(float4*)(p.out + (size_t)(row0 + rr) * 1024 + c) = o;
        uint2 ob; ob.x = pack2(o.x, o.y); ob.y = pack2(o.z, o.w);
        *(uint2*)(p.hb + (size_t)(row0 + rr) * 1024 + c) = ob;
      }
    }
  }
}

DI void hg_gate(float x, float lb, float& lf, float& k) {
  x = fmaxf(x, -80.f);
  const float E = fexp(-x);
  const float sg = frcp(1.f + E);
  k = (1.f - lb) * (E * sg);
  lf = flog(lb + (1.f - lb) * sg);
}

DI void hg_local(const Params& p, int l, int b, int c, int hd, unsigned char* smem) {
  const int tid = threadIdx.x, lane = tid & 63, w = tid >> 6;
  bfu* At = (bfu*)smem;
  bfu* Bt = At + 64 * 72;
  float* segtot = (float*)(smem + 2 * 64 * 72 * 2);
  const int tok0 = b * SEQ + c * 64;
  const int d = lane;
  const float lb = p.lbs[l * 256 + hd * 64 + d];
  const bfu* pf = p.proj + (size_t)tok0 * PS + COL_AF + hd * 64 + d;
  const bfu* pv = p.proj + (size_t)tok0 * PS + COL_AI + hd * 64 + d;
  float bl[16], kk[16];
  float run = 0.f;
  __syncthreads();
#pragma unroll
  for (int i = 0; i < 16; ++i) {
    const int t = w * 16 + i;
    float lf, k; hg_gate(bf2f(pf[(size_t)t * PS]), lb, lf, k);
    run += lf; bl[i] = run; kk[i] = k;
    At[d * 72 + t] = pv[(size_t)t * PS];
  }
  segtot[w * 64 + d] = run;
  __syncthreads();
  float off = 0.f, tot = 0.f;
#pragma unroll
  for (int s = 0; s < 4; ++s) { float v = segtot[s * 64 + d]; tot += v; if (s < w) off += v; }
#pragma unroll
  for (int i = 0; i < 16; ++i) { const int t = w * 16 + i; Bt[d * 72 + t] = f2bf(kk[i] * fexp(tot - (bl[i] + off))); }
  const int base = (b * NCH + c) * 4 + hd;
  if (w == 0) p.hg_decay[base * 64 + d] = fexp(tot);
  __syncthreads();
  f32x4 acc[4];
#pragma unroll
  for (int i = 0; i < 4; ++i) acc[i] = (f32x4){0.f, 0.f, 0.f, 0.f};
  wave_mma<4, 2>(acc, At + w * 16 * 72, 72, Bt, 72, lane);
  float* st = p.hg_state + (size_t)base * 4096;
  const int r = lane & 15, q = lane >> 4;
#pragma unroll
  for (int nt = 0; nt < 4; ++nt)
#pragma unroll
    for (int j = 0; j < 4; ++j) st[(w * 16 + q * 4 + j) * 64 + nt * 16 + r] = acc[nt][j];
}

constexpr int O_A = 0, O_BT = 17408, O_QP = 34816, O_KP = 44032, O_MISC = 53248;

DI void hg_out(const Params& p, int l, int b, int c, int hd, unsigned char* smem) {
  const int tid = threadIdx.x, lane = tid & 63, w = tid >> 6;
  bfu* A = (bfu*)(smem + O_A); bfu* Bt = (bfu*)(smem + O_BT); bfu* Qp = (bfu*)(smem + O_QP); bfu* Kp = (bfu*)(smem + O_KP);
  float* segtot = (float*)(smem + O_MISC);
  const int tok0 = b * SEQ + c * 64;
  const int d = lane;
  const float lb = p.lbs[l * 256 + hd * 64 + d];
  const bfu* pq = p.proj + (size_t)tok0 * PS + COL_AQ + hd * 64 + d;
  const bfu* pf = p.proj + (size_t)tok0 * PS + COL_AF + hd * 64 + d;
  const bfu* pv = p.proj + (size_t)tok0 * PS + COL_AI + hd * 64 + d;
  const int base = (b * NCH + c) * 4 + hd;
  const float* st = p.hg_state + (size_t)base * 4096;
  float bl[16], kk[16];
  float run = 0.f;
  const int r = lane & 15, q = lane >> 4;
  bfu fraw[16], vraw[16], qraw[16]; float sraw[16];
#pragma unroll
  for (int i = 0; i < 16; ++i) {
    const int t = w * 16 + i;
    fraw[i] = pf[(size_t)t * PS]; vraw[i] = pv[(size_t)t * PS]; qraw[i] = pq[(size_t)t * PS]; sraw[i] = st[(w + 4 * i) * 64 + d];
  }
  bfu gt[4][4]; float gw[4];
#pragma unroll
  for (int nt = 0; nt < 4; ++nt) {
    gw[nt] = p.hg_g[l * 256 + hd * 64 + nt * 16 + r];
#pragma unroll
    for (int j = 0; j < 4; ++j) gt[j][nt] = p.proj[(size_t)(tok0 + w * 16 + q * 4 + j) * PS + COL_AG + hd * 64 + nt * 16 + r];
  }
  __syncthreads();
#pragma unroll
  for (int i = 0; i < 16; ++i) {
    const int t = w * 16 + i;
    float lf, k; hg_gate(bf2f(fraw[i]), lb, lf, k);
    run += lf; bl[i] = run; kk[i] = k;
    Bt[d * 136 + t] = vraw[i];
    const int e = w + 4 * i;
    Bt[e * 136 + 64 + d] = f2bf(sraw[i]);
  }
  segtot[w * 64 + d] = run;
  __syncthreads();
  float off = 0.f;
#pragma unroll
  for (int s = 0; s < 4; ++s) { float v = segtot[s * 64 + d]; if (s < w) off += v; }
  const float bm = segtot[d] + segtot[64 + d];
#pragma unroll
  for (int i = 0; i < 16; ++i) {
    const int t = w * 16 + i;
    const float bt = bl[i] + off;
    const float qv = silu_(bf2f(qraw[i]));
    Qp[t * 72 + d] = f2bf(qv * fexp(fmaxf(bt - bm, -80.f)));
    Kp[t * 72 + d] = f2bf(kk[i] * fexp(fminf(bm - bt, 80.f)));
    A[t * 136 + 64 + d] = f2bf(qv * fexp(bt));
  }
  __syncthreads();
  f32x4 acc[4];
#pragma unroll
  for (int i = 0; i < 4; ++i) acc[i] = (f32x4){0.f, 0.f, 0.f, 0.f};
  wave_mma<4, 2>(acc, Qp + w * 16 * 72, 72, Kp, 72, lane);
#pragma unroll
  for (int nt = 0; nt < 4; ++nt)
#pragma unroll
    for (int j = 0; j < 4; ++j) {
      const int t = w * 16 + q * 4 + j, s = nt * 16 + r;
      A[t * 136 + s] = f2bf(s <= t ? acc[nt][j] : 0.f);
    }
  __syncthreads();
  f32x4 o[4];
#pragma unroll
  for (int i = 0; i < 4; ++i) o[i] = (f32x4){0.f, 0.f, 0.f, 0.f};
  wave_mma<4, 4>(o, A + w * 16 * 136, 136, Bt, 136, lane);
#pragma unroll
  for (int j = 0; j < 4; ++j) {
    float ss = 0.f;
#pragma unroll
    for (int nt = 0; nt < 4; ++nt) ss += o[nt][j] * o[nt][j];
    ss = group16_sum(ss);
    const float sc = rsqrtf(ss * (1.f / 64.f) + 1e-6f);
    const int t = w * 16 + q * 4 + j;
    bfu* mrow = p.mixed + (size_t)(tok0 + t) * 1024 + hd * 64;
#pragma unroll
    for (int nt = 0; nt < 4; ++nt) {
      const int e = nt * 16 + r;
      mrow[e] = f2bf(o[nt][j] * sc * gw[nt] * silu_(bf2f(gt[j][nt])));
    }
  }
}

DI void ml_gates(const Params& p, int l, int tok0, int hd, float* bs, float* igs, int tid) {
  if (tid < 64) {
    const bfu* row = p.proj + (size_t)(tok0 + tid) * PS;
    const float ig = bf2f(row[COL_BIG + hd]);
    const float fg = bf2f(row[COL_BFG + hd]) + p.ml_fb[l * 4 + hd];
    float lf = logsig_(fg);
#pragma unroll
    for (int o = 1; o < 64; o <<= 1) { float v = __shfl_up(lf, o); if (tid >= o) lf += v; }
    bs[tid] = lf; igs[tid] = ig;
  }
}

DI void ml_local(const Params& p, int l, int b, int c, int hd, unsigned char* smem) {
  const int tid = threadIdx.x, lane = tid & 63, w = tid >> 6;
  bfu* At = (bfu*)smem;
  bfu* Bt = At + 64 * 72;
  float* bs = (float*)(smem + 2 * 64 * 72 * 2);
  float* igs = bs + 64; float* nseg = igs + 64;
  const int tok0 = b * SEQ + c * 64;
  const int d = lane;
  const bfu* pk = p.proj + (size_t)tok0 * PS + COL_BK + hd * 64 + d;
  const bfu* pv = p.proj + (size_t)tok0 * PS + COL_BV + hd * 64 + d;
  bfu kraw[16], vraw[16];
#pragma unroll
  for (int i = 0; i < 16; ++i) { kraw[i] = pk[(size_t)(w * 16 + i) * PS]; vraw[i] = pv[(size_t)(w * 16 + i) * PS]; }
  __syncthreads();
  ml_gates(p, l, tok0, hd, bs, igs, tid);
  __syncthreads();
  const float blast = bs[63];
  float nacc = 0.f;
#pragma unroll
  for (int i = 0; i < 16; ++i) {
    const int s = w * 16 + i;
    const float ws = fexp(blast - bs[s] + igs[s]);
    const float kw = bf2f(kraw[i]) * 0.125f * ws;
    Bt[d * 72 + s] = f2bf(kw); nacc += kw;
    At[d * 72 + s] = vraw[i];
  }
  nseg[w * 64 + d] = nacc;
  __syncthreads();
  const int base = (b * NCH + c) * 4 + hd;
  if (w == 0) p.ml_n[base * 64 + d] = nseg[d] + nseg[64 + d] + nseg[128 + d] + nseg[192 + d];
  if (tid == 0) p.ml_decay[base] = fexp(blast);
  f32x4 acc[4];
#pragma unroll
  for (int i = 0; i < 4; ++i) acc[i] = (f32x4){0.f, 0.f, 0.f, 0.f};
  wave_mma<4, 2>(acc, At + w * 16 * 72, 72, Bt, 72, lane);
  float* st = p.ml_state + (size_t)base * 4096;
  const int r = lane & 15, q = lane >> 4;
#pragma unroll
  for (int nt = 0; nt < 4; ++nt)
#pragma unroll
    for (int j = 0; j < 4; ++j) st[(w * 16 + q * 4 + j) * 64 + nt * 16 + r] = acc[nt][j];
}

DI void ml_out(const Params& p, int l, int b, int c, int hd, unsigned char* smem) {
  const int tid = threadIdx.x, lane = tid & 63, w = tid >> 6;
  bfu* A = (bfu*)(smem + O_A); bfu* Bt = (bfu*)(smem + O_BT); bfu* Qp = (bfu*)(smem + O_QP); bfu* Kp = (bfu*)(smem + O_KP);
  float* bs = (float*)(smem + O_MISC); float* igs = bs + 64; float* npv = igs + 64; float* den2 = npv + 64;
  const int tok0 = b * SEQ + c * 64;
  const int d = lane;
  const int base = (b * NCH + c) * 4 + hd;
  const float* st = p.ml_state + (size_t)base * 4096;
  const int r = lane & 15, q = lane >> 4;
  const bfu* pq = p.proj + (size_t)tok0 * PS + COL_BQ + hd * 64 + d;
  const bfu* pk = p.proj + (size_t)tok0 * PS + COL_BK + hd * 64 + d;
  const bfu* pv = p.proj + (size_t)tok0 * PS + COL_BV + hd * 64 + d;
  bfu qraw[16], kraw[16], vraw[16]; float sraw[16];
#pragma unroll
  for (int i = 0; i < 16; ++i) {
    const int t = w * 16 + i;
    qraw[i] = pq[(size_t)t * PS]; kraw[i] = pk[(size_t)t * PS]; vraw[i] = pv[(size_t)t * PS]; sraw[i] = st[(w + 4 * i) * 64 + d];
  }
  bfu gt[4][4]; float gw[4];
#pragma unroll
  for (int nt = 0; nt < 4; ++nt) {
    gw[nt] = p.ml_g[l * 256 + hd * 64 + nt * 16 + r];
#pragma unroll
    for (int j = 0; j < 4; ++j) gt[j][nt] = p.proj[(size_t)(tok0 + w * 16 + q * 4 + j) * PS + COL_BG + hd * 64 + nt * 16 + r];
  }
  __syncthreads();
  ml_gates(p, l, tok0, hd, bs, igs, tid);
  if (tid >= 64 && tid < 128) npv[tid - 64] = p.ml_n[base * 64 + tid - 64];
  __syncthreads();
#pragma unroll
  for (int i = 0; i < 16; ++i) {
    const int t = w * 16 + i;
    Qp[t * 72 + d] = qraw[i];
    Kp[t * 72 + d] = kraw[i];
    A[t * 136 + 64 + d] = f2bf(bf2f(qraw[i]) * fexp(bs[t]));
    Bt[d * 136 + t] = vraw[i];
    const int e = w + 4 * i;
    Bt[e * 136 + 64 + d] = f2bf(sraw[i]);
  }
  __syncthreads();
  if (tid < 64) {
    float s = 0.f;
    for (int dd = 0; dd < 64; ++dd) s += bf2f(A[tid * 136 + 64 + dd]) * npv[dd];
    den2[tid] = s;
  }
  f32x4 acc[4];
#pragma unroll
  for (int i = 0; i < 4; ++i) acc[i] = (f32x4){0.f, 0.f, 0.f, 0.f};
  wave_mma<4, 2>(acc, Qp + w * 16 * 72, 72, Kp, 72, lane);
  float den1[4];
#pragma unroll
  for (int j = 0; j < 4; ++j) {
    const int t = w * 16 + q * 4 + j;
    const float bt = bs[t];
    float rs = 0.f;
#pragma unroll
    for (int nt = 0; nt < 4; ++nt) {
      const int s = nt * 16 + r;
      float wv = 0.f;
      if (s <= t) wv = fexp(bt - bs[s] + igs[s]) * acc[nt][j] * 0.125f;
      rs += wv;
      A[t * 136 + s] = f2bf(wv);
    }
    den1[j] = group16_sum(rs);
  }
  __syncthreads();
  f32x4 o[4];
#pragma unroll
  for (int i = 0; i < 4; ++i) o[i] = (f32x4){0.f, 0.f, 0.f, 0.f};
  wave_mma<4, 4>(o, A + w * 16 * 136, 136, Bt, 136, lane);
#pragma unroll
  for (int j = 0; j < 4; ++j) {
    const int t = w * 16 + q * 4 + j;
    const float den = den1[j] + den2[t];
    const float inv = frcp(fmaxf(fabsf(den), 1.f));
    float hv[4];
    float ss = 0.f;
#pragma unroll
    for (int nt = 0; nt < 4; ++nt) { hv[nt] = o[nt][j] * inv; ss += hv[nt] * hv[nt]; }
    ss = group16_sum(ss);
    const float sc = rsqrtf(ss * (1.f / 64.f) + 1e-6f);
    bfu* mrow = p.mixed + (size_t)(tok0 + t) * 1024 + 256 + hd * 64;
#pragma unroll
    for (int nt = 0; nt < 4; ++nt) {
      const int e = nt * 16 + r;
      mrow[e] = f2bf(hv[nt] * sc * gw[nt] * silu_(bf2f(gt[j][nt])));
    }
  }
}

template <bool FINAL>
DI void lru_item(const Params& p, int l, int b, int c, int n, unsigned char* smem) {
  const int tid = threadIdx.x, lane = tid & 63, w = tid >> 6;
  bfu* xcb = (bfu*)smem;
  float* xcf = (float*)(smem + 9216);
  float* af = (float*)(smem + 9216 + 17408);
  float* segH = (float*)(smem + 9216 + 2 * 17408);
  float* segA = segH + 256;
  const int tok0 = b * SEQ + c * 64;
  const int ch = n * 64 + lane;
  const int r = lane & 15, q = lane >> 4;
  bf16x8 wfa[2][4], wfx[2][4];
#pragma unroll
  for (int ks = 0; ks < 2; ++ks)
#pragma unroll
    for (int nt = 0; nt < 4; ++nt) {
      wfa[ks][nt] = *(const bf16x8*)(p.wt_a + (l * 4 + n) * 4096 + (nt * 16 + r) * 64 + ks * 32 + q * 8);
      wfx[ks][nt] = *(const bf16x8*)(p.wt_x + (l * 4 + n) * 4096 + (nt * 16 + r) * 64 + ks * 32 + q * 8);
    }
  float e_ba[4], e_bx[4], e_lam[4];
#pragma unroll
  for (int nt = 0; nt < 4; ++nt) {
    const int che = n * 64 + nt * 16 + r;
    e_ba[nt] = p.b_a[l * 256 + che]; e_bx[nt] = p.b_x[l * 256 + che]; e_lam[nt] = p.lam[l * 256 + che];
  }
  const int sidx = (b * NCH + c) * 256 + ch;
  float Hprev = 0.f;
  bfu gq[16];
  if (FINAL) {
    Hprev = p.lru_h[sidx];
    const bfu* pg0 = p.proj + (size_t)tok0 * PS + COL_CG + ch;
#pragma unroll
    for (int i = 0; i < 16; ++i) gq[i] = pg0[(size_t)(w * 16 + i) * PS];
  }
  __syncthreads();
  {
    const float cw0 = p.conv_w[(l * 4 + 0) * 256 + ch], cw1 = p.conv_w[(l * 4 + 1) * 256 + ch];
    const float cw2 = p.conv_w[(l * 4 + 2) * 256 + ch], cw3 = p.conv_w[(l * 4 + 3) * 256 + ch];
    const float cb = p.conv_b[l * 256 + ch];
    const bfu* px = p.proj + (size_t)tok0 * PS + COL_CX + ch;
#pragma unroll
    for (int i = 0; i < 16; ++i) {
      const int t = w * 16 + i;
      const int sp = c * 64 + t;
      float x0 = (sp >= 3) ? bf2f(px[(ptrdiff_t)(t - 3) * PS]) : 0.f;
      float x1 = (sp >= 2) ? bf2f(px[(ptrdiff_t)(t - 2) * PS]) : 0.f;
      float x2 = (sp >= 1) ? bf2f(px[(ptrdiff_t)(t - 1) * PS]) : 0.f;
      float x3 = bf2f(px[(ptrdiff_t)t * PS]);
      const float xc = cb + cw0 * x0 + cw1 * x1 + cw2 * x2 + cw3 * x3;
      xcf[t * 68 + lane] = xc;
      xcb[t * 72 + lane] = f2bf(xc);
    }
  }
  __syncthreads();
  f32x4 aa[4], ax[4];
#pragma unroll
  for (int i = 0; i < 4; ++i) { aa[i] = (f32x4){0.f, 0.f, 0.f, 0.f}; ax[i] = (f32x4){0.f, 0.f, 0.f, 0.f}; }
#pragma unroll
  for (int ks = 0; ks < 2; ++ks) {
    const bf16x8 afr = *(const bf16x8*)(xcb + (w * 16 + r) * 72 + ks * 32 + q * 8);
#pragma unroll
    for (int nt = 0; nt < 4; ++nt) {
      aa[nt] = __builtin_amdgcn_mfma_f32_16x16x32_bf16(afr, wfa[ks][nt], aa[nt], 0, 0, 0);
      ax[nt] = __builtin_amdgcn_mfma_f32_16x16x32_bf16(afr, wfx[ks][nt], ax[nt], 0, 0, 0);
    }
  }
#pragma unroll
  for (int nt = 0; nt < 4; ++nt) {
    const int e = nt * 16 + r;
    const float ba = e_ba[nt], bx = e_bx[nt];
    const float lsl = 8.f * logsig_acc(e_lam[nt]);
#pragma unroll
    for (int j = 0; j < 4; ++j) {
      const int t = w * 16 + q * 4 + j;
      const float rg = sigmoid_(aa[nt][j] + ba), ig = sigmoid_(ax[nt][j] + bx);
      const float la = lsl * rg;
      const float a = fexp(la);
      const float y2 = 2.f * la;
      const float em = (y2 > -0.05f) ? -y2 * (1.f + y2 * (0.5f + y2 * (0.16666667f + y2 * 0.041666668f))) : 1.f - a * a;
      const float bv = __builtin_amdgcn_sqrtf(fmaxf(em, 0.f)) * ig * xcf[t * 68 + e];
      af[t * 68 + e] = a; xcf[t * 68 + e] = bv;
    }
  }
  __syncthreads();
  float hl[16], al[16];
  float h = 0.f, ap = 1.f;
#pragma unroll
  for (int i = 0; i < 16; ++i) {
    const int t = w * 16 + i;
    const float a = af[t * 68 + lane], bv = xcf[t * 68 + lane];
    h = a * h + bv; ap *= a; hl[i] = h; al[i] = ap;
  }
  segH[w * 64 + lane] = h; segA[w * 64 + lane] = ap;
  __syncthreads();
  if (!FINAL) {
    if (w == 0) {
      float H = 0.f, Ap = 1.f;
#pragma unroll
      for (int s = 0; s < 4; ++s) { H = segA[s * 64 + lane] * H + segH[s * 64 + lane]; Ap *= segA[s * 64 + lane]; }
      p.lru_h[sidx] = H; p.lru_a[sidx] = Ap;
    }
  } else {
    float H = Hprev;
#pragma unroll
    for (int s = 0; s < 4; ++s) if (s < w) H = segA[s * 64 + lane] * H + segH[s * 64 + lane];
    bfu* pm = p.mixed + (size_t)tok0 * 1024 + 512 + ch;
#pragma unroll
    for (int i = 0; i < 16; ++i) {
      const int t = w * 16 + i;
      const float hv = hl[i] + al[i] * H;
      pm[(size_t)t * 1024] = f2bf(hv * silu_(bf2f(gq[i])));
    }
  }
}

template <bool FINAL>
DI void s5_item(const Params& p, int l, int b, int c, int g4, unsigned char* smem) {
  const int tid = threadIdx.x, lane = tid & 63, w = tid >> 6;
  const int g = g4 * 4 + w;
  float* buw = (float*)(smem + w * 13312);
  bfu* stw = (bfu*)(smem + w * 13312 + 8448);
  const int tok0 = b * SEQ + c * 64;
  const int r = lane & 15, q = lane >> 4;
  const int lg = l * 16 + g;
  bf16x8 bfr[8], yfr[4];
#pragma unroll
  for (int nt = 0; nt < 8; ++nt) bfr[nt] = *(const bf16x8*)(p.bt_bu + ((size_t)lg * 128 + nt * 16 + r) * 32 + q * 8);
  if (FINAL) {
#pragma unroll
    for (int ks = 0; ks < 4; ++ks) yfr[ks] = *(const bf16x8*)(p.bt_y + ((size_t)lg * 16 + r) * 128 + ks * 32 + q * 8);
  }
  const float ar = p.abar[(lg * 64 + lane) * 2], ai = p.abar[(lg * 64 + lane) * 2 + 1];
  const size_t sbase = ((size_t)(b * NCH + c) * 16 + g) * 128;
  float xr = 0.f, xi = 0.f;
  if (FINAL) { xr = p.s5_state[sbase + lane]; xi = p.s5_state[sbase + 64 + lane]; }
  const float dsk = FINAL ? p.s5_d[l * 256 + g * 16 + r] : 0.f;
  bf16x8 afr[4];
  bfu uq[4][4];
#pragma unroll
  for (int mt = 0; mt < 4; ++mt) {
    afr[mt] = (bf16x8){0, 0, 0, 0, 0, 0, 0, 0};
    if (q < 2) afr[mt] = *(const bf16x8*)(p.proj + (size_t)(tok0 + mt * 16 + r) * PS + COL_DU + g * 16 + q * 8);
    if (FINAL) {
#pragma unroll
      for (int j = 0; j < 4; ++j) uq[mt][j] = p.proj[(size_t)(tok0 + mt * 16 + q * 4 + j) * PS + COL_DU + g * 16 + r];
    }
  }
  __syncthreads();
#pragma unroll
  for (int mt = 0; mt < 4; ++mt) {
    const bf16x8 a = afr[mt];
#pragma unroll
    for (int nt = 0; nt < 8; ++nt) {
      f32x4 acc = (f32x4){0.f, 0.f, 0.f, 0.f};
      acc = __builtin_amdgcn_mfma_f32_16x16x32_bf16(a, bfr[nt], acc, 0, 0, 0);
#pragma unroll
      for (int j = 0; j < 4; ++j) buw[(q * 4 + j) * 132 + nt * 16 + r] = acc[j];
    }
    wave_sync();
    {
      float br[16], bi[16];
#pragma unroll
      for (int tt = 0; tt < 16; ++tt) { br[tt] = buw[tt * 132 + lane]; bi[tt] = buw[tt * 132 + 64 + lane]; }
#pragma unroll
      for (int tt = 0; tt < 16; ++tt) {
        const float nr = ar * xr - ai * xi + br[tt];
        const float ni = ar * xi + ai * xr + bi[tt];
        xr = nr; xi = ni;
        br[tt] = xr; bi[tt] = xi;
      }
      if (FINAL) {
#pragma unroll
        for (int tt = 0; tt < 16; ++tt) { stw[tt * 136 + lane] = f2bf(br[tt]); stw[tt * 136 + 64 + lane] = f2bf(bi[tt]); }
      }
    }
    wave_sync();
    if (FINAL) {
      f32x4 y = (f32x4){0.f, 0.f, 0.f, 0.f};
#pragma unroll
      for (int ks = 0; ks < 4; ++ks) {
        bf16x8 a2 = *(const bf16x8*)(stw + r * 136 + ks * 32 + q * 8);
        y = __builtin_amdgcn_mfma_f32_16x16x32_bf16(a2, yfr[ks], y, 0, 0, 0);
      }
#pragma unroll
      for (int j = 0; j < 4; ++j) {
        const int t = mt * 16 + q * 4 + j;
        const float z = gelu_tanh_(y[j] + dsk * bf2f(uq[mt][j]));
        p.zbuf[(size_t)(tok0 + t) * 256 + g * 16 + r] = f2bf(z);
      }
      wave_sync();
    }
  }
  if (!FINAL) { p.s5_state[sbase + lane] = xr; p.s5_state[sbase + 64 + lane] = xi; }
}

DI void s5_glu(const Params& p, int l, int b, int c, unsigned char* smem) {
  const int tid = threadIdx.x, lane = tid & 63, w = tid >> 6;
  bfu* zs = (bfu*)smem;
  const int tok0 = b * SEQ + c * 64;
  const int r = lane & 15, q = lane >> 4;
  __syncthreads();
#pragma unroll
  for (int i = 0; i < 8; ++i) {
    const int id = tid + i * 256;
    *(uint4*)(zs + (id >> 5) * 264 + (id & 31) * 8) = *(const uint4*)(p.zbuf + (size_t)(tok0 + (id >> 5)) * 256 + (id & 31) * 8);
  }
  __syncthreads();
  const bfu* wg = p.wt_glu + l * 65536;
#pragma unroll 1
  for (int nc = 0; nc < 4; ++nc) {
    bfu gq[4][4]; float bgv[4];
#pragma unroll
    for (int nt = 0; nt < 4; ++nt) {
      bgv[nt] = p.b_glu[l * 256 + nc * 64 + nt * 16 + r];
#pragma unroll
      for (int j = 0; j < 4; ++j) gq[nt][j] = p.proj[(size_t)(tok0 + w * 16 + q * 4 + j) * PS + COL_DG + nc * 64 + nt * 16 + r];
    }
    f32x4 acc[4];
#pragma unroll
    for (int i = 0; i < 4; ++i) acc[i] = (f32x4){0.f, 0.f, 0.f, 0.f};
#pragma unroll
    for (int kh = 0; kh < 2; ++kh) {
      bf16x8 bq[4][4];
#pragma unroll
      for (int ks = 0; ks < 4; ++ks)
#pragma unroll
        for (int nt = 0; nt < 4; ++nt) bq[ks][nt] = *(const bf16x8*)(wg + (nc * 64 + nt * 16 + r) * 256 + kh * 128 + ks * 32 + q * 8);
#pragma unroll
      for (int ks = 0; ks < 4; ++ks) {
        const bf16x8 a = *(const bf16x8*)(zs + (w * 16 + r) * 264 + kh * 128 + ks * 32 + q * 8);
#pragma unroll
        for (int nt = 0; nt < 4; ++nt) acc[nt] = __builtin_amdgcn_mfma_f32_16x16x32_bf16(a, bq[ks][nt], acc[nt], 0, 0, 0);
      }
    }
#pragma unroll
    for (int nt = 0; nt < 4; ++nt) {
      const int n = nc * 64 + nt * 16 + r;
#pragma unroll
      for (int j = 0; j < 4; ++j) {
        const int t = w * 16 + q * 4 + j;
        const float zv = bf2f(zs[t * 264 + n]);
        const float gate = silu_(bf2f(gq[nt][j]));
        p.mixed[(size_t)(tok0 + t) * 1024 + 768 + n] = f2bf(zv * sigmoid_(acc[nt][j] + bgv[nt]) * gate);
      }
    }
  }
}

#define QLOOP(QI, N, BODY)                                                                            \
  {                                                                                                   \
    unsigned* q_ctr = p.cnt + CNT_Q + (l * 8 + (QI)) * 32;                                            \
    unsigned q_nxt = blockIdx.x;                                                                      \
    for (;;) {                                                                                        \
      __syncthreads();                                                                                \
      if (threadIdx.x == 0) *s_q = q_nxt;                                                             \
      __syncthreads();                                                                                \
      const int item = (int)*s_q;                                                                     \
      if (item >= (N)) break;                                                                         \
      if (threadIdx.x == 0) q_nxt = gridDim.x + __hip_atomic_fetch_add(q_ctr, 1u, __ATOMIC_RELAXED, __HIP_MEMORY_SCOPE_AGENT); \
      BODY;                                                                                           \
    }                                                                                                 \
  }

DI void phase2(const Params& p, int l, unsigned char* smem) {
  unsigned* s_q = (unsigned*)(smem + SMEM_BYTES - 32);
  QLOOP(0, 1024, s5_item<false>(p, l, item >> 7, (item >> 2) & 31, item & 3, smem))
  QLOOP(1, 1024, hg_local(p, l, item >> 7, (item >> 2) & 31, item & 3, smem))
  QLOOP(2, 1024, ml_local(p, l, item >> 7, (item >> 2) & 31, item & 3, smem))
  QLOOP(3, 1024, lru_item<false>(p, l, item >> 7, (item >> 2) & 31, item & 3, smem))
}

DI void phase3(const Params& p, int l) {
  const int gtid = blockIdx.x * 256 + threadIdx.x, gsz = gridDim.x * 256;
  constexpr int N1 = 131072, N2 = 131072, N3 = 2048, N4 = 2048, N5 = 8192;
  for (int i = gtid; i < N1 + N2 + N3 + N4 + N5; i += gsz) {
    if (i < N1 + N2) {
      const bool ml = i >= N1;
      const int j = ml ? i - N1 : i;
      const int b = j >> 14, rem = j & 16383, hd = rem >> 12, ed = rem & 4095, d = ed & 63;
      float* stp = (ml ? p.ml_state : p.hg_state) + (size_t)(b * NCH * 4 + hd) * 4096 + ed;
      const float* dcp = ml ? (p.ml_decay + b * NCH * 4 + hd) : (p.hg_decay + (b * NCH * 4 + hd) * 64 + d);
      const int dstride = ml ? 4 : 256;
      float S = 0.f;
#pragma unroll
      for (int c0 = 0; c0 < NCH; c0 += 16) {
        float loc[16], dec[16];
#pragma unroll
        for (int c = 0; c < 16; ++c) { loc[c] = stp[(size_t)(c0 + c) * 16384]; dec[c] = dcp[(c0 + c) * dstride]; }
#pragma unroll
        for (int c = 0; c < 16; ++c) { stp[(size_t)(c0 + c) * 16384] = S; S = dec[c] * S + loc[c]; }
      }
    } else if (i < N1 + N2 + N3) {
      const int j = i - N1 - N2, b = j >> 8, rem = j & 255, hd = rem >> 6, d = rem & 63;
      float S = 0.f;
#pragma unroll
      for (int c0 = 0; c0 < NCH; c0 += 16) {
        float loc[16], dec[16];
#pragma unroll
        for (int c = 0; c < 16; ++c) { const int base = (b * NCH + c0 + c) * 4 + hd; dec[c] = p.ml_decay[base]; loc[c] = p.ml_n[base * 64 + d]; }
#pragma unroll
        for (int c = 0; c < 16; ++c) { const int base = (b * NCH + c0 + c) * 4 + hd; p.ml_n[base * 64 + d] = S; S = dec[c] * S + loc[c]; }
      }
    } else if (i < N1 + N2 + N3 + N4) {
      const int j = i - N1 - N2 - N3, b = j >> 8, ch = j & 255;
      float H = 0.f;
#pragma unroll
      for (int c0 = 0; c0 < NCH; c0 += 16) {
        float av[16], hv[16];
#pragma unroll
        for (int c = 0; c < 16; ++c) { const int idx = (b * NCH + c0 + c) * 256 + ch; av[c] = p.lru_a[idx]; hv[c] = p.lru_h[idx]; }
#pragma unroll
        for (int c = 0; c < 16; ++c) { const int idx = (b * NCH + c0 + c) * 256 + ch; p.lru_h[idx] = H; H = av[c] * H + hv[c]; }
      }
    } else {
      const int j = i - N1 - N2 - N3 - N4, b = j >> 10, g = (j >> 6) & 15, pp = j & 63;
      const float ar = p.abar64[((l * 16 + g) * 64 + pp) * 2], ai = p.abar64[((l * 16 + g) * 64 + pp) * 2 + 1];
      float xr = 0.f, xi = 0.f;
#pragma unroll
      for (int c0 = 0; c0 < NCH; c0 += 16) {
        float lr[16], li[16];
#pragma unroll
        for (int c = 0; c < 16; ++c) { const size_t sb = ((size_t)(b * NCH + c0 + c) * 16 + g) * 128; lr[c] = p.s5_state[sb + pp]; li[c] = p.s5_state[sb + 64 + pp]; }
#pragma unroll
        for (int c = 0; c < 16; ++c) {
          const size_t sb = ((size_t)(b * NCH + c0 + c) * 16 + g) * 128;
          p.s5_state[sb + pp] = xr; p.s5_state[sb + 64 + pp] = xi;
          const float nr = ar * xr - ai * xi + lr[c], ni = ar * xi + ai * xr + li[c];
          xr = nr; xi = ni;
        }
      }
    }
  }
}

DI void phase4(const Params& p, int l, unsigned char* smem, unsigned long long& tp_acc) {
  unsigned* s_flag = (unsigned*)(smem + SMEM_BYTES - 16);
  unsigned* s_q = (unsigned*)(smem + SMEM_BYTES - 32);
  TPS(41)
  QLOOP(4, 256, {
    _Pragma("unroll 1") for (int g4 = 0; g4 < 4; ++g4) s5_item<true>(p, l, item >> 5, item & 31, g4, smem);
    asm volatile("s_waitcnt vmcnt(0)" ::: "memory");
    s5_glu(p, l, item >> 5, item & 31, smem);
  })
  TPE(41)
  TPS(42)
  QLOOP(5, 1024, hg_out(p, l, item >> 7, (item >> 2) & 31, item & 3, smem))
  TPE(42)
  TPS(43)
  QLOOP(6, 1024, ml_out(p, l, item >> 7, (item >> 2) & 31, item & 3, smem))
  TPE(43)
  TPS(44)
  QLOOP(7, 1024, lru_item<true>(p, l, item >> 7, (item >> 2) & 31, item & 3, smem))
  TPE(44)
}

#ifdef TPROBE
#define TP_CLASS(PH) ((PH) == 0 ? 0 : (((PH) - 1) % 6) + 1)
#define TP_BEGIN(PH) unsigned long long tp_t0 = 0; if (TP_CLASS(PH) == TPROBE) tp_t0 = __builtin_amdgcn_s_memrealtime();
#define TP_END(PH) if (TP_CLASS(PH) == TPROBE) tp_acc += __builtin_amdgcn_s_memrealtime() - tp_t0;
#else
#define TP_BEGIN(PH)
#define TP_END(PH)
#endif
#define RUN_PHASE(PH, CALL)                                       \
  if (ph0 <= (PH) && (PH) < ph1) {                                \
    TP_BEGIN(PH)                                                  \
    CALL;                                                         \
    if (COOP) { if ((PH) + 1 < ph1) xcd_barrier(xb); }            \
    TP_END(PH)                                                    \
  }

template <bool COOP, int L>
DI void run_layer(const Params& p, int ph0, int ph1, unsigned char* smem, const XcdBarrier& xb, unsigned long long& tp_acc) {
#ifdef DUP1
  RUN_PHASE(1 + 6 * L, phase1(p, L, smem))
#endif
  RUN_PHASE(1 + 6 * L, phase1(p, L, smem))
#ifdef DUP2
  RUN_PHASE(2 + 6 * L, phase2(p, L, smem))
#endif
  RUN_PHASE(2 + 6 * L, phase2(p, L, smem))
  RUN_PHASE(3 + 6 * L, { phase3(p, L); if (L + 1 < DEPTH) convert_weights<(L + 1 < DEPTH ? L + 1 : 0)>(p, smem); })
#ifdef DUP4
  RUN_PHASE(4 + 6 * L, phase4(p, L, smem, tp_acc))
#endif
  RUN_PHASE(4 + 6 * L, phase4(p, L, smem, tp_acc))
  RUN_PHASE(5 + 6 * L, phase5(p, L, smem, tp_acc))
  RUN_PHASE(6 + 6 * L, phase6(p, L))
}

template <bool COOP>
__global__ void __launch_bounds__(256, 2) mk_fwd(Params p, int ph0, int ph1) {
  __shared__ __attribute__((aligned(16))) unsigned char smem[SMEM_BYTES];
  __shared__ uint4 xb_words;
  XcdBarrier xb; xb.bar = p.bar; xb.x = 0; xb.st = nullptr;
  if (COOP) {
    if (ph1 < 0) cg::this_grid().sync();
    if (threadIdx.x == 0) xb_words = make_uint4(0u, 0u, 0u, 0u);
    __syncthreads();
    xb = xcd_barrier_post(p.bar, (volatile LAS unsigned*)&xb_words);
  }
  unsigned long long tp_acc = 0;
  RUN_PHASE(0, phase0(p, smem))
  run_layer<COOP, 0>(p, ph0, ph1, smem, xb, tp_acc);
  run_layer<COOP, 1>(p, ph0, ph1, smem, xb, tp_acc);
  run_layer<COOP, 2>(p, ph0, ph1, smem, xb, tp_acc);
  run_layer<COOP, 3>(p, ph0, ph1, smem, xb, tp_acc);
#ifdef TPROBE
  if (blockIdx.x == 0 && threadIdx.x == 0) {
    const unsigned long long t0 = __builtin_amdgcn_s_memrealtime();
    while (__builtin_amdgcn_s_memrealtime() - t0 < tp_acc) __builtin_amdgcn_s_sleep(8);
  }
#endif
}

extern "C" void kernel_launch(void* const* d_in, const int* in_sizes, int n_in, void* d_out, int out_size, void* d_ws,
                              size_t ws_size, hipStream_t stream) {
  static int grid_blocks = 0;
  if (!grid_blocks) {
    int dev = 0, cus = 0, per_cu = 0;
    hipGetDevice(&dev);
    hipDeviceGetAttribute(&cus, hipDeviceAttributeMultiprocessorCount, dev);
    hipOccupancyMaxActiveBlocksPerMultiprocessor(&per_cu, mk_fwd<(MEGA != 0)>, 256, 0);
    if (per_cu < 1) per_cu = 1;
    if (per_cu > 2) per_cu = 2;
    grid_blocks = cus * per_cu;
  }
  Params p{};
  const float** pin = (const float**)&p;
  for (int i = 0; i < 28; ++i) pin[i] = (const float*)d_in[i];
  p.out = (float*)d_out;
  unsigned char* ws = (unsigned char*)d_ws;
  size_t off = 0;
  auto take = [&](size_t bytes) { unsigned char* r = ws + off; off += (bytes + 255) & ~(size_t)255; return r; };
  p.wt_in = (bfu*)take((size_t)4 * PS * 1024 * 2);
  p.wt_out = (bfu*)take((size_t)4 * 1024 * 1024 * 2);
  p.wt_a = (bfu*)take(16 * 4096 * 2);
  p.wt_x = (bfu*)take(16 * 4096 * 2);
  p.wt_glu = (bfu*)take(4 * 65536 * 2);
  p.bt_bu = (bfu*)take(64 * 128 * 32 * 2);
  p.bt_y = (bfu*)take(64 * 16 * 128 * 2);
  p.hb = (bfu*)take((size_t)NTOK * 1024 * 2);
  p.proj = (bfu*)take((size_t)NTOK * PS * 2);
  p.mixed = (bfu*)take((size_t)NTOK * 1024 * 2);
  p.zbuf = (bfu*)take((size_t)NTOK * 256 * 2);
  p.abar = (float*)take(4096 * 2 * 4);
  p.abar64 = (float*)take(4096 * 2 * 4);
  p.lbs = (float*)take(1024 * 4);
  p.hg_state = (float*)take((size_t)BATCH * NCH * 4 * 4096 * 4);
  p.hg_decay = (float*)take((size_t)BATCH * NCH * 4 * 64 * 4);
  p.ml_state = (float*)take((size_t)BATCH * NCH * 4 * 4096 * 4);
  p.ml_n = (float*)take((size_t)BATCH * NCH * 4 * 64 * 4);
  p.ml_decay = (float*)take((size_t)BATCH * NCH * 4 * 4);
  p.lru_h = (float*)take((size_t)BATCH * NCH * 256 * 4);
  p.lru_a = (float*)take((size_t)BATCH * NCH * 256 * 4);
  p.s5_state = (float*)take((size_t)BATCH * NCH * 16 * 128 * 4);
  p.cnt = (unsigned*)take(CNT_TOTAL * 4);
  p.bar = (unsigned*)take(XCD_BAR_WORDS * 4);
  if (off > ws_size) { fprintf(stderr, "workspace too small: need %zu have %zu\n", off, ws_size); return; }
  const int NPH = 1 + 6 * DEPTH;
#if MEGA
  (void)hipMemsetAsync(p.bar, 0, XCD_BAR_WORDS * 4, stream);
  int ph0 = 0, ph1 = NPH;
  void* args[] = {&p, &ph0, &ph1};
  hipError_t e = hipLaunchCooperativeKernel((void*)mk_fwd<true>, dim3(grid_blocks), dim3(256), args, 0, stream);
  if (e != hipSuccess) fprintf(stderr, "cooperative launch failed: %s (grid %d)\n", hipGetErrorString(e), grid_blocks);
#else
  for (int ph = 0; ph < NPH; ++ph) hipLaunchKernelGGL(mk_fwd<false>, dim3(grid_blocks), dim3(256), 0, stream, p, ph, ph + 1);
#endif
}
```
